# Optimizing an MI355X kernel written in HIP

```python
import jax, jax.numpy as jnp
from jax import lax
import numpy as np

D_MODEL = 2048
BATCH = 4
SEQ = 4096
DEPTH = 2

N_EVEN = (DEPTH + 1) // 2
N_ODD = DEPTH // 2
EPS = 1e-6

HG_DK = 128
HG_DV = 128
HG_HEADS = (D_MODEL // 2) // HG_DV
HG_QK = HG_HEADS * HG_DK
HG_V = HG_HEADS * HG_DV
GLA_HEADS = 4
GLA_DV = (D_MODEL // 2) // GLA_HEADS
GLA_DK = GLA_DV // 2
GLA_QK = GLA_HEADS * GLA_DK
GLA_V = GLA_HEADS * GLA_DV
GLA_RANK = 16
GLA_GATE_NORM = 16.0
MIX_WIDTH = HG_V + GLA_V
EVEN_SIZES = (HG_QK, HG_QK, HG_V, HG_V, GLA_QK, GLA_QK, GLA_V, GLA_V, GLA_RANK)
EVEN_SPLITS = tuple(int(c) for c in np.cumsum(EVEN_SIZES)[:-1])
EVEN_IN = int(sum(EVEN_SIZES))
CHUNK = 64

MOBA_HEADS = 16
MOBA_DH = D_MODEL // MOBA_HEADS
MOBA_BLOCK = 256
MOBA_TOPK = 3
MOBA_QC = 16

N_GROUPS = 4
EXPERTS_PER_GROUP = 8
N_EXPERTS = N_GROUPS * EXPERTS_PER_GROUP
TOP_K = 2
D_EXPERT = D_MODEL // 4
MOE_BLOCK = 128

kernel_name = "hybrid_hgrn2_gla_moba_hmoe"


def rms_norm(x, g):
    xf = x.astype(jnp.float32)
    y = xf * lax.rsqrt(jnp.mean(xf * xf, axis=-1, keepdims=True) + EPS)
    return (y * g.astype(jnp.float32)).astype(x.dtype)


def split_heads(t, n_heads):
    b, s, _ = t.shape
    return t.reshape(b, s, n_heads, -1).transpose(0, 2, 1, 3)


def merge_heads(t):
    b, h, s, d = t.shape
    return t.transpose(0, 2, 1, 3).reshape(b, s, h * d)


def chunk_gated_linear_attention(q, k, v, log_a):
    b, h, s, dk = q.shape
    dv = v.shape[-1]
    n = s // CHUNK

    def to_chunks(t):
        t = t.astype(jnp.float32).reshape(b, h, n, CHUNK, t.shape[-1])
        return jnp.moveaxis(t, 2, 0)

    xs = tuple(to_chunks(t) for t in (q, k, v, log_a))
    causal = jnp.tril(jnp.ones((CHUNK, CHUNK), dtype=bool))[:, :, None]

    def step(state, inp):
        qc, kc, vc, ac = inp
        cum = jnp.cumsum(ac, axis=2)
        last = cum[:, :, -1:, :]
        rel = jnp.where(causal, cum[:, :, :, None, :] - cum[:, :, None, :, :], -jnp.inf)
        scores = jnp.einsum('bhid,bhjd,bhijd->bhij', qc, kc, jnp.exp(rel))
        out = (jnp.einsum('bhij,bhjv->bhiv', scores, vc)
               + jnp.einsum('bhid,bhdv->bhiv', qc * jnp.exp(cum), state))
        state = (jnp.exp(last[:, :, 0, :])[..., None] * state
                 + jnp.einsum('bhjd,bhjv->bhdv', kc * jnp.exp(last - cum), vc))
        return state, out

    state0 = jnp.zeros((b, h, dk, dv), jnp.float32)
    _, out = lax.scan(step, state0, xs)
    return jnp.moveaxis(out, 0, 2).reshape(b, h, s, dv).astype(v.dtype)


def hgrn2_gla_mixer(xn, lb, w_in, hg_norm, gla_gk2, gla_gk_bias, gla_norm, w_out):
    f32 = jnp.float32
    proj = xn @ w_in
    hq, hf, hi, hg, gq, gk, gv, gg, glow = jnp.split(proj, EVEN_SPLITS, axis=-1)
    forget = lb + (1.0 - lb) * jax.nn.sigmoid(hf.astype(f32))
    o_hg = chunk_gated_linear_attention(
        split_heads(jax.nn.silu(hq) * HG_DK ** -0.5, HG_HEADS),
        split_heads(1.0 - forget, HG_HEADS),
        split_heads(hi, HG_HEADS),
        split_heads(jnp.log(forget), HG_HEADS))
    o_hg = rms_norm(o_hg, hg_norm) * jax.nn.silu(split_heads(hg, HG_HEADS))
    log_alpha = jax.nn.log_sigmoid((glow @ gla_gk2 + gla_gk_bias).astype(f32)) / GLA_GATE_NORM
    o_gla = chunk_gated_linear_attention(
        split_heads(gq * GLA_DK ** -0.5, GLA_HEADS),
        split_heads(gk, GLA_HEADS),
        split_heads(gv, GLA_HEADS),
        split_heads(log_alpha, GLA_HEADS))
    o_gla = rms_norm(o_gla, gla_norm) * jax.nn.silu(split_heads(gg, GLA_HEADS))
    mixed = jnp.concatenate([merge_heads(o_hg), merge_heads(o_gla)], axis=-1)
    return mixed @ w_out


def moba_attention(xn, w_qkv, w_o):
    f32 = jnp.float32
    b, s, _ = xn.shape
    q, k, v = (split_heads(t, MOBA_HEADS) for t in jnp.split(xn @ w_qkv, 3, axis=-1))
    s_pad = -(-s // MOBA_BLOCK) * MOBA_BLOCK
    n_blocks = s_pad // MOBA_BLOCK
    k_eff = max(1, min(MOBA_TOPK, n_blocks))
    pad = ((0, 0), (0, 0), (0, s_pad - s), (0, 0))
    k_pad, v_pad = jnp.pad(k, pad), jnp.pad(v, pad)
    k_blk = k_pad.reshape(b, MOBA_HEADS, n_blocks, MOBA_BLOCK, MOBA_DH)
    v_blk = v_pad.reshape(b, MOBA_HEADS, n_blocks, MOBA_BLOCK, MOBA_DH)
    k_mean = jnp.mean(k_blk.astype(f32), axis=3)
    gate = jnp.einsum('bhtd,bhnd->bhtn', q.astype(f32), k_mean)
    q_block = jnp.arange(s) // MOBA_BLOCK
    past = jnp.arange(n_blocks)[None, :] < q_block[:, None]
    gate = jnp.where(past, gate, -jnp.inf)
    _, sel = lax.top_k(gate, k_eff)
    slot_valid = jnp.arange(k_eff)[None, :] < q_block[:, None]
    b_idx = jnp.arange(b)[:, None, None, None]
    h_idx = jnp.arange(MOBA_HEADS)[None, :, None, None]
    scale = MOBA_DH ** -0.5
    n_sel = k_eff * MOBA_BLOCK

    def query_chunk(i):
        start = i * MOBA_QC
        qi = lax.dynamic_slice_in_dim(q, start, MOBA_QC, axis=2)
        sel_i = lax.dynamic_slice_in_dim(sel, start, MOBA_QC, axis=2)
        valid_i = lax.dynamic_slice_in_dim(slot_valid, start, MOBA_QC, axis=0)
        own_start = (start // MOBA_BLOCK) * MOBA_BLOCK
        k_own = lax.dynamic_slice_in_dim(k_pad, own_start, MOBA_BLOCK, axis=2)
        v_own = lax.dynamic_slice_in_dim(v_pad, own_start, MOBA_BLOCK, axis=2)
        k_sel = k_blk[b_idx, h_idx, sel_i]
        v_sel = v_blk[b_idx, h_idx, sel_i]
        s_sel = jnp.einsum('bhqd,bhqnkd->bhqnk', qi, k_sel).astype(f32) * scale
        s_sel = jnp.where(valid_i[None, None, :, :, None], s_sel, -jnp.inf)
        s_own = jnp.einsum('bhqd,bhkd->bhqk', qi, k_own).astype(f32) * scale
        q_pos = start + jnp.arange(MOBA_QC)
        k_pos = own_start + jnp.arange(MOBA_BLOCK)
        s_own = jnp.where(k_pos[None, :] <= q_pos[:, None], s_own, -jnp.inf)
        logits = jnp.concatenate(
            [s_sel.reshape(b, MOBA_HEADS, MOBA_QC, n_sel), s_own], axis=-1)
        p = jax.nn.softmax(logits, axis=-1).astype(v.dtype)
        p_sel = p[..., :n_sel].reshape(b, MOBA_HEADS, MOBA_QC, k_eff, MOBA_BLOCK)
        return (jnp.einsum('bhqnk,bhqnkd->bhqd', p_sel, v_sel)
                + jnp.einsum('bhqk,bhkd->bhqd', p[..., n_sel:], v_own))

    out = lax.map(query_chunk, jnp.arange(s // MOBA_QC))
    out = jnp.moveaxis(out, 0, 2).reshape(b, MOBA_HEADS, s, MOBA_DH)
    return merge_heads(out) @ w_o


def hierarchical_moe(xn, w_group, b_group, w_router, b_router, w1, w3, w2):
    f32 = jnp.float32
    b, s, d = xn.shape
    n_tok = b * s
    xt = xn.reshape(n_tok, d)
    g_logits = (xt @ w_group).astype(f32) + b_group
    grp = jnp.argmax(g_logits, axis=-1)
    p_grp = jnp.take_along_axis(jax.nn.softmax(g_logits, axis=-1), grp[:, None], axis=-1)
    e_logits = ((xt @ w_router).astype(f32) + b_router).reshape(n_tok, N_GROUPS, EXPERTS_PER_GROUP)
    e_in = jnp.take_along_axis(e_logits, grp[:, None, None], axis=1)[:, 0]
    top_val, top_j = lax.top_k(e_in, TOP_K)
    weight = p_grp * jax.nn.softmax(top_val, axis=-1)
    eid = grp[:, None] * EXPERTS_PER_GROUP + top_j
    n_assign = n_tok * TOP_K
    eid_f = eid.reshape(n_assign)
    tok_f = jnp.repeat(jnp.arange(n_tok), TOP_K)
    w_f = weight.reshape(n_assign)
    order = jnp.argsort(eid_f)
    e_s, tok_s, w_s = eid_f[order], tok_f[order], w_f[order]
    counts = jnp.bincount(eid_f, length=N_EXPERTS)
    starts = jnp.cumsum(counts) - counts
    padded = (counts + MOE_BLOCK - 1) // MOE_BLOCK * MOE_BLOCK
    pends = jnp.cumsum(padded)
    pstarts = pends - padded
    dest = pstarts[e_s] + (jnp.arange(n_assign) - starts[e_s])
    n_blocks = -(-n_assign // MOE_BLOCK) + N_EXPERTS
    rows = n_blocks * MOE_BLOCK
    x_pad = jnp.zeros((rows, d), xt.dtype).at[dest].set(xt[tok_s])
    block_e = jnp.minimum(
        jnp.searchsorted(pends, jnp.arange(n_blocks) * MOE_BLOCK, side='right'), N_EXPERTS - 1)

    def expert_block(args):
        xb, e = args
        return (jax.nn.silu(xb @ w1[e]) * (xb @ w3[e])) @ w2[e]

    y_pad = lax.map(expert_block, (x_pad.reshape(n_blocks, MOE_BLOCK, d), block_e))
    y = y_pad.reshape(rows, d)[dest] * w_s[:, None].astype(xt.dtype)
    out = jax.ops.segment_sum(y, tok_s, num_segments=n_tok)
    return out.reshape(b, s, d)


def setup_inputs(seed: int = 0) -> dict:
    key = jax.random.key(seed)
    ks = jax.random.split(key, 20)
    f32 = jnp.float32

    def normal(k, shape, scale):
        return jax.random.normal(k, shape, f32) * scale

    def gain(k, shape):
        return 1.0 + 0.02 * jax.random.normal(k, shape, f32)

    return {
        "x": normal(ks[0], (BATCH, SEQ, D_MODEL), 1.0),
        "norm_mix": gain(ks[1], (DEPTH, D_MODEL)),
        "norm_ffn": gain(ks[2], (DEPTH, D_MODEL)),
        "norm_final": gain(ks[3], (D_MODEL,)),
        "w_in_even": normal(ks[4], (N_EVEN, D_MODEL, EVEN_IN), D_MODEL ** -0.5),
        "hg_lb_logits": normal(ks[5], (DEPTH + 1, HG_QK), 1.0),
        "hg_norm": gain(ks[6], (N_EVEN, HG_DV)),
        "gla_gk2": normal(ks[7], (N_EVEN, GLA_RANK, GLA_QK), GLA_RANK ** -0.5),
        "gla_gk_bias": normal(ks[8], (N_EVEN, GLA_QK), 0.1),
        "gla_norm": gain(ks[9], (N_EVEN, GLA_DV)),
        "w_out_even": normal(ks[10], (N_EVEN, MIX_WIDTH, D_MODEL), MIX_WIDTH ** -0.5),
        "w_qkv_odd": normal(ks[11], (N_ODD, D_MODEL, 3 * D_MODEL), D_MODEL ** -0.5),
        "w_o_odd": normal(ks[12], (N_ODD, D_MODEL, D_MODEL), D_MODEL ** -0.5),
        "router_group_w": normal(ks[13], (DEPTH, D_MODEL, N_GROUPS), D_MODEL ** -0.5),
        "router_group_b": normal(ks[14], (DEPTH, N_GROUPS), 0.01),
        "router_expert_w": normal(ks[15], (DEPTH, D_MODEL, N_EXPERTS), D_MODEL ** -0.5),
        "router_expert_b": normal(ks[16], (DEPTH, N_EXPERTS), 0.01),
        "expert_w1": normal(ks[17], (DEPTH, N_EXPERTS, D_MODEL, D_EXPERT), D_MODEL ** -0.5),
        "expert_w3": normal(ks[18], (DEPTH, N_EXPERTS, D_MODEL, D_EXPERT), D_MODEL ** -0.5),
        "expert_w2": normal(ks[19], (DEPTH, N_EXPERTS, D_EXPERT, D_MODEL), D_EXPERT ** -0.5),
    }


def reference(x, norm_mix, norm_ffn, norm_final, w_in_even, hg_lb_logits, hg_norm,
              gla_gk2, gla_gk_bias, gla_norm, w_out_even, w_qkv_odd, w_o_odd,
              router_group_w, router_group_b, router_expert_w, router_expert_b,
              expert_w1, expert_w3, expert_w2):
    lb_table = jnp.cumsum(jax.nn.softmax(hg_lb_logits.astype(jnp.float32), axis=0), axis=0)
    h = x
    for l in range(DEPTH):
        xn = rms_norm(h, norm_mix[l])
        if l % 2 == 0:
            e = l // 2
            h = h + hgrn2_gla_mixer(xn, lb_table[l], w_in_even[e], hg_norm[e], gla_gk2[e],
                                    gla_gk_bias[e], gla_norm[e], w_out_even[e])
        else:
            o = l // 2
            h = h + moba_attention(xn, w_qkv_odd[o], w_o_odd[o])
        h = h + hierarchical_moe(rms_norm(h, norm_ffn[l]), router_group_w[l], router_group_b[l],
                                 router_expert_w[l], router_expert_b[l],
                                 expert_w1[l], expert_w3[l], expert_w2[l])
    return rms_norm(h, norm_final)
```

```cpp
#include <hip/hip_runtime.h>
#include <cstdio>
#include <cstdint>

typedef unsigned short bf16_t;
#define DI __device__ __forceinline__

constexpr int D = 2048, NB = 4, SEQ = 4096, NTOK = NB * SEQ;
constexpr int HG_H = 8, HG_DK = 128, HG_DV = 128, HG_QK = 1024, HG_V = 1024;
constexpr int GL_H = 4, GL_DK = 128, GL_DV = 256, GL_QK = 512, GL_V = 1024, GL_RANK = 16;
constexpr int EVEN_IN = 7184, EVEN_MAIN = 7168;
constexpr int MB_H = 16, MB_DH = 128, MB_BLK = 256, MB_NBLK = SEQ / MB_BLK;
constexpr int NEXP = 32, NGRP = 4, EPG = 8, DEXP = 512;
constexpr int MOE_TILE = 256, MOE_MAXT = (2 * NTOK) / MOE_TILE + NEXP, MOE_ROWS = MOE_MAXT * MOE_TILE;
constexpr float EPS = 1e-6f;

constexpr size_t MBy = 1024 * 1024;
constexpr size_t WS_CTL   = 0;
constexpr size_t CTL_BYTES = 64 * 1024;
constexpr size_t WS_SMALL = WS_CTL + CTL_BYTES;
constexpr size_t WS_WIN   = WS_SMALL + 1 * MBy;
constexpr size_t WS_WOUT  = WS_WIN + (size_t)EVEN_MAIN * D * 2;
constexpr size_t WS_WQKV  = WS_WOUT + (size_t)D * D * 2;
constexpr size_t WS_WO    = WS_WQKV + (size_t)3 * D * D * 2;
constexpr size_t WS_WUP   = WS_WO + (size_t)D * D * 2;
constexpr size_t WS_WDN   = WS_WUP + (size_t)2 * NEXP * 1024 * D * 2;
constexpr size_t WS_XN    = WS_WDN + (size_t)2 * NEXP * D * DEXP * 2;
constexpr size_t WS_H     = WS_XN + (size_t)NTOK * D * 2;
constexpr size_t WS_U     = WS_H + (size_t)NTOK * D * 4;
constexpr size_t U_HQ  = WS_U;
constexpr size_t U_HLF = U_HQ + (size_t)NTOK * 1024 * 2;
constexpr size_t U_HI  = U_HLF + (size_t)NTOK * 1024 * 4;
constexpr size_t U_HGG = U_HI + (size_t)NTOK * 1024 * 2;
constexpr size_t U_GQ  = U_HGG + (size_t)NTOK * 1024 * 2;
constexpr size_t U_GK  = U_GQ + (size_t)NTOK * 512 * 2;
constexpr size_t U_GV  = U_GK + (size_t)NTOK * 512 * 2;
constexpr size_t U_GG  = U_GV + (size_t)NTOK * 1024 * 2;
constexpr size_t U_END0 = U_GG + (size_t)NTOK * 1024 * 2;
constexpr size_t U_Q = WS_U, U_K = U_Q + (size_t)NTOK * D * 2, U_V = U_K + (size_t)NTOK * D * 2, U_END1 = U_V + (size_t)NTOK * D * 2;
constexpr size_t U_HMID = WS_U;
constexpr size_t U_Y = U_HMID + (size_t)MOE_ROWS * DEXP * 2;
constexpr size_t U_END2 = U_Y + (size_t)MOE_ROWS * D * 2;
constexpr size_t U_BYTES = U_END0 - WS_U;
static_assert(U_END1 - WS_U <= U_BYTES && U_END2 - WS_U <= U_BYTES, "union");
constexpr size_t WS_END = WS_U + U_BYTES;
constexpr size_t SM_LB    = WS_SMALL;
constexpr size_t SM_GLOW  = SM_LB + 4096;
constexpr size_t SM_KMEAN = WS_SMALL + 64 * 1024;
constexpr size_t SM_TILEE = SM_KMEAN + 512 * 1024;
constexpr size_t WS_GLOW  = WS_END;
constexpr size_t WS_EID   = WS_GLOW + (size_t)NTOK * 16 * 4;
constexpr size_t WS_WGT   = WS_EID + (size_t)NTOK * 2 * 4;
constexpr size_t WS_SLOT  = WS_WGT + (size_t)NTOK * 2 * 4;
constexpr size_t WS_ROWTOK = WS_SLOT + (size_t)NTOK * 2 * 4;
constexpr size_t WS_TOTAL = WS_ROWTOK + (size_t)MOE_ROWS * 4;
constexpr int CW_CNT = 0;
constexpr int CW_CUR = 64;
constexpr int CW_BASE = 128;
constexpr int CW_NT = 192;

DI float bf2f(bf16_t b) { return __uint_as_float(((unsigned)b) << 16); }
DI bf16_t f2bf(float f) { unsigned u = __float_as_uint(f); u += 0x7FFFu + ((u >> 16) & 1u); return (bf16_t)(u >> 16); }
DI float sigmoidf_(float x) { return 1.0f / (1.0f + __expf(-x)); }
DI float siluf_(float x) { return x / (1.0f + __expf(-x)); }
DI float wave_sum(float v) { for (int o = 32; o > 0; o >>= 1) v += __shfl_xor(v, o); return v; }

template <int MODE>
__global__ void k_transpose(const float* __restrict__ src, bf16_t* __restrict__ dst, int K, int N, int ld, int c0, int half, size_t src_bstride, size_t dst_bstride) {
    __shared__ float t[64][65];
    src += (size_t)blockIdx.z * src_bstride; dst += (size_t)blockIdx.z * dst_bstride;
    const int k0 = blockIdx.y * 64, n0 = blockIdx.x * 64, tx = threadIdx.x & 63, ty = threadIdx.x >> 6;
    for (int i = ty; i < 64; i += 4) t[i][tx] = src[(size_t)(k0 + i) * ld + c0 + n0 + tx];
    __syncthreads();
    for (int i = ty; i < 64; i += 4) { const int n = n0 + i; const int r = MODE == 0 ? n : (n / 128) * 256 + half * 128 + (n % 128);
        dst[(size_t)r * K + k0 + tx] = f2bf(t[tx][i]); }
}
__global__ void k_lb(const float* __restrict__ lg, float* __restrict__ lb) {
    const int d = blockIdx.x * blockDim.x + threadIdx.x; if (d >= HG_QK) return;
    const float a = lg[d], b = lg[HG_QK + d], c = lg[2 * HG_QK + d], m = fmaxf(a, fmaxf(b, c));
    const float ea = __expf(a - m), eb = __expf(b - m), ec = __expf(c - m); lb[d] = ea / (ea + eb + ec);
}

template <int MODE>
__global__ void k_rmsnorm(const float* __restrict__ h, const float* __restrict__ g, bf16_t* __restrict__ xn, float* __restrict__ fout,
                          const float* __restrict__ w_in, float* __restrict__ glow,
                          const float* __restrict__ wg, const float* __restrict__ bg, const float* __restrict__ we, const float* __restrict__ be,
                          int* __restrict__ eid, float* __restrict__ wgt, unsigned* __restrict__ ctl) {
    const int row = blockIdx.x * 4 + (threadIdx.x >> 6), lane = threadIdx.x & 63;
    const float* hr = h + (size_t)row * D;
    float v[32]; float ss = 0.f;
#pragma unroll
    for (int j = 0; j < 8; ++j) { const float4 x = *(const float4*)(hr + j * 256 + lane * 4); v[4 * j] = x.x; v[4 * j + 1] = x.y; v[4 * j + 2] = x.z; v[4 * j + 3] = x.w; ss += x.x * x.x + x.y * x.y + x.z * x.z + x.w * x.w; }
    ss = wave_sum(ss); const float rstd = rsqrtf(ss * (1.0f / D) + EPS);
#pragma unroll
    for (int j = 0; j < 8; ++j) { const float4 gg = *(const float4*)(g + j * 256 + lane * 4);
        v[4 * j] *= rstd * gg.x; v[4 * j + 1] *= rstd * gg.y; v[4 * j + 2] *= rstd * gg.z; v[4 * j + 3] *= rstd * gg.w; }
    if (MODE == 3) {
#pragma unroll
        for (int j = 0; j < 8; ++j) *(float4*)(fout + (size_t)row * D + j * 256 + lane * 4) = make_float4(v[4 * j], v[4 * j + 1], v[4 * j + 2], v[4 * j + 3]);
        return;
    }
#pragma unroll
    for (int j = 0; j < 8; ++j) { ushort4 o; o.x = f2bf(v[4 * j]); o.y = f2bf(v[4 * j + 1]); o.z = f2bf(v[4 * j + 2]); o.w = f2bf(v[4 * j + 3]);
        *(ushort4*)(xn + (size_t)row * D + j * 256 + lane * 4) = o; }
    if (MODE == 1) {
        float acc[16];
#pragma unroll
        for (int c = 0; c < 16; ++c) acc[c] = 0.f;
#pragma unroll
        for (int j = 0; j < 8; ++j)
#pragma unroll
            for (int e = 0; e < 4; ++e) { const int k = j * 256 + lane * 4 + e; const float* wr = w_in + (size_t)k * EVEN_IN + EVEN_MAIN; const float xv = v[4 * j + e];
#pragma unroll
                for (int c4 = 0; c4 < 4; ++c4) { const float4 w = *(const float4*)(wr + c4 * 4); acc[c4 * 4] += xv * w.x; acc[c4 * 4 + 1] += xv * w.y; acc[c4 * 4 + 2] += xv * w.z; acc[c4 * 4 + 3] += xv * w.w; } }
#pragma unroll
        for (int c = 0; c < 16; ++c) acc[c] = wave_sum(acc[c]);
        if (lane == 0) {
#pragma unroll
            for (int c = 0; c < 16; ++c) glow[(size_t)row * 16 + c] = acc[c]; }
    }
    if (MODE == 2) {
        float lg[4], le[32];
#pragma unroll
        for (int c = 0; c < 4; ++c) lg[c] = 0.f;
#pragma unroll
        for (int c = 0; c < 32; ++c) le[c] = 0.f;
#pragma unroll
        for (int j = 0; j < 8; ++j)
#pragma unroll
            for (int e = 0; e < 4; ++e) { const int k = j * 256 + lane * 4 + e; const float xv = v[4 * j + e];
                const float4 w4 = *(const float4*)(wg + (size_t)k * 4); lg[0] += xv * w4.x; lg[1] += xv * w4.y; lg[2] += xv * w4.z; lg[3] += xv * w4.w;
#pragma unroll
                for (int c4 = 0; c4 < 8; ++c4) { const float4 w = *(const float4*)(we + (size_t)k * 32 + c4 * 4); le[c4 * 4] += xv * w.x; le[c4 * 4 + 1] += xv * w.y; le[c4 * 4 + 2] += xv * w.z; le[c4 * 4 + 3] += xv * w.w; } }
#pragma unroll
        for (int c = 0; c < 4; ++c) lg[c] = wave_sum(lg[c]) + bg[c];
#pragma unroll
        for (int c = 0; c < 32; ++c) le[c] = wave_sum(le[c]) + be[c];
        if (lane == 0) {
            int grp = 0; float mx = lg[0];
#pragma unroll
            for (int c = 1; c < 4; ++c) if (lg[c] > mx) { mx = lg[c]; grp = c; }
            float den = 0.f;
#pragma unroll
            for (int c = 0; c < 4; ++c) den += __expf(lg[c] - mx);
            const float pg = 1.0f / den;
            float e8[8];
#pragma unroll
            for (int c = 0; c < 8; ++c) { e8[c] = grp == 0 ? le[c] : grp == 1 ? le[8 + c] : grp == 2 ? le[16 + c] : le[24 + c]; }
            int j0 = 0; float v0 = e8[0];
#pragma unroll
            for (int c = 1; c < 8; ++c) if (e8[c] > v0) { v0 = e8[c]; j0 = c; }
            int j1 = -1; float v1 = -3.0e38f;
#pragma unroll
            for (int c = 0; c < 8; ++c) if (c != j0 && e8[c] > v1) { v1 = e8[c]; j1 = c; }
            const float e1 = __expf(v1 - v0), s = 1.0f / (1.0f + e1);
            const int ea = grp * 8 + j0, eb = grp * 8 + j1;
            eid[row * 2] = ea; eid[row * 2 + 1] = eb; wgt[row * 2] = pg * s; wgt[row * 2 + 1] = pg * e1 * s;
            atomicAdd(&ctl[CW_CNT + ea], 1u); atomicAdd(&ctl[CW_CNT + eb], 1u);
        }
    }
}

struct EpiProj0 { bf16_t* hq; float* hlf; bf16_t* hi; bf16_t* hgg; bf16_t* gq; bf16_t* gk; bf16_t* gv; bf16_t* gg; const float* lb;
    DI void operator()(int r, int c, float v) const {
        const int seg = c >> 10, cc = c & 1023; const float sc = 0.08838834764831845f;
        if (seg == 0) hq[(size_t)r * 1024 + cc] = f2bf(siluf_(v) * sc);
        else if (seg == 1) { const float l = lb[cc]; const float f = l + (1.0f - l) * sigmoidf_(v); hlf[(size_t)r * 1024 + cc] = __logf(f); }
        else if (seg == 2) hi[(size_t)r * 1024 + cc] = f2bf(v);
        else if (seg == 3) hgg[(size_t)r * 1024 + cc] = f2bf(siluf_(v));
        else if (seg == 4) { if (cc < 512) gq[(size_t)r * 512 + cc] = f2bf(v * sc); else gk[(size_t)r * 512 + cc - 512] = f2bf(v); }
        else if (seg == 5) gv[(size_t)r * 1024 + cc] = f2bf(v);
        else gg[(size_t)r * 1024 + cc] = f2bf(siluf_(v));
    } };
struct EpiResid { const float* res; float* out;
    DI void operator()(int r, int c, float v) const { out[(size_t)r * D + c] = res[(size_t)r * D + c] + v; } };
struct EpiQKV { bf16_t* q; bf16_t* k; bf16_t* v_;
    DI void operator()(int r, int c, float v) const { const int s = c >> 11, cc = c & 2047; bf16_t* o = s == 0 ? q : s == 1 ? k : v_; o[(size_t)r * D + cc] = f2bf(v); } };
struct EpiBf { bf16_t* o; int ld; int pad;
    DI void operator()(int r, int c, float v) const { o[(size_t)r * ld + c] = f2bf(v); } };
struct EpiSwiglu { bf16_t* o;
    DI void operator()(int r, int j, float a, float b) const { o[(size_t)r * DEXP + j] = f2bf(siluf_(a) * b); } };

template <class Epi, bool DUAL>
__global__ void k_gemm_naive(const bf16_t* __restrict__ A, const int* __restrict__ rowidx, const bf16_t* __restrict__ Bt, int K, int lda,
                             const int* __restrict__ tile_e, size_t b_estride, Epi epi) {
    __shared__ float As[32][65], Bs[32][65], Bs2[DUAL ? 32 : 1][65];
    const int m0 = blockIdx.y * 64, n0 = blockIdx.x * 64, tid = threadIdx.x, tx = tid & 15, ty = tid >> 4;
    if (tile_e) { const int e = tile_e[m0 / MOE_TILE]; if (e < 0) return; Bt += (size_t)e * b_estride; }
    float acc[4][4], acc2[4][4];
#pragma unroll
    for (int i = 0; i < 4; ++i)
#pragma unroll
        for (int j = 0; j < 4; ++j) { acc[i][j] = 0.f; acc2[i][j] = 0.f; }
    const int lr = tid >> 2, lk = (tid & 3) * 8;
    const int arow = rowidx ? rowidx[m0 + lr] : (m0 + lr);
    const bf16_t* ap = A + (size_t)arow * lda + lk;
    const int nl = n0 + lr; const int brow = DUAL ? (nl / 128) * 256 + (nl % 128) : nl;
    const bf16_t* bp = Bt + (size_t)brow * K + lk; const bf16_t* bp2 = bp + (size_t)128 * K;
    for (int k0 = 0; k0 < K; k0 += 32) {
        { const uint4 a = *(const uint4*)(ap + k0); const unsigned w[4] = {a.x, a.y, a.z, a.w};
#pragma unroll
          for (int i = 0; i < 4; ++i) { As[lk + 2 * i][lr] = __uint_as_float(w[i] << 16); As[lk + 2 * i + 1][lr] = __uint_as_float(w[i] & 0xFFFF0000u); } }
        { const uint4 a = *(const uint4*)(bp + k0); const unsigned w[4] = {a.x, a.y, a.z, a.w};
#pragma unroll
          for (int i = 0; i < 4; ++i) { Bs[lk + 2 * i][lr] = __uint_as_float(w[i] << 16); Bs[lk + 2 * i + 1][lr] = __uint_as_float(w[i] & 0xFFFF0000u); } }
        if (DUAL) { const uint4 a = *(const uint4*)(bp2 + k0); const unsigned w[4] = {a.x, a.y, a.z, a.w};
#pragma unroll
          for (int i = 0; i < 4; ++i) { Bs2[lk + 2 * i][lr] = __uint_as_float(w[i] << 16); Bs2[lk + 2 * i + 1][lr] = __uint_as_float(w[i] & 0xFFFF0000u); } }
        __syncthreads();
#pragma unroll 8
        for (int k = 0; k < 32; ++k) {
            float a[4], b[4], b2[4];
#pragma unroll
            for (int i = 0; i < 4; ++i) { a[i] = As[k][ty * 4 + i]; b[i] = Bs[k][tx * 4 + i]; if (DUAL) b2[i] = Bs2[k][tx * 4 + i]; }
#pragma unroll
            for (int i = 0; i < 4; ++i)
#pragma unroll
                for (int j = 0; j < 4; ++j) { acc[i][j] += a[i] * b[j]; if (DUAL) acc2[i][j] += a[i] * b2[j]; }
        }
        __syncthreads();
    }
#pragma unroll
    for (int i = 0; i < 4; ++i)
#pragma unroll
        for (int j = 0; j < 4; ++j) { const int r = m0 + ty * 4 + i, c = n0 + tx * 4 + j;
            if constexpr (DUAL) epi(r, c, acc[i][j], acc2[i][j]); else epi(r, c, acc[i][j]); }
}

template <int DV, bool IS_GLA>
__global__ void __launch_bounds__(DV) k_scan_naive(const bf16_t* __restrict__ Q, const float* __restrict__ LF, const bf16_t* __restrict__ Kx, const bf16_t* __restrict__ V,
                             const float* __restrict__ glow, const float* __restrict__ gk2, const float* __restrict__ gkb, float* __restrict__ oraw, int nheads, int ocol0) {
    constexpr int T = 16;
    __shared__ float sq[T][128], sk[T][128], sa[T][128];
    const int b = blockIdx.x / nheads, hh = blockIdx.x % nheads, v = threadIdx.x;
    const int qld = nheads * 128, vld = nheads * DV;
    float S[128];
#pragma unroll
    for (int d = 0; d < 128; ++d) S[d] = 0.f;
    for (int t0 = 0; t0 < SEQ; t0 += T) {
        __syncthreads();
        for (int i = threadIdx.x; i < T * 128; i += DV) { const int tt = i >> 7, d = i & 127; const size_t tok = (size_t)b * SEQ + t0 + tt;
            sq[tt][d] = bf2f(Q[tok * qld + hh * 128 + d]);
            if (IS_GLA) { float z = gkb[hh * 128 + d];
#pragma unroll
                for (int r = 0; r < GL_RANK; ++r) z += glow[tok * 16 + r] * gk2[r * GL_QK + hh * 128 + d];
                const float ls = fminf(z, 0.f) - log1pf(__expf(-fabsf(z)));
                sa[tt][d] = __expf(ls * (1.0f / 16.0f)); sk[tt][d] = bf2f(Kx[tok * qld + hh * 128 + d]); }
            else { const float a = __expf(LF[tok * qld + hh * 128 + d]); sa[tt][d] = a; sk[tt][d] = 1.0f - a; } }
        __syncthreads();
        for (int tt = 0; tt < T; ++tt) { const size_t tok = (size_t)b * SEQ + t0 + tt;
            const float vv = bf2f(V[tok * vld + hh * DV + v]); float o = 0.f;
#pragma unroll
            for (int d = 0; d < 128; ++d) { S[d] = sa[tt][d] * S[d] + sk[tt][d] * vv; o += sq[tt][d] * S[d]; }
            oraw[tok * D + ocol0 + hh * DV + v] = o; }
    }
}
__global__ void k_norm_gate(const float* __restrict__ oraw, const float* __restrict__ hg_norm, const float* __restrict__ gla_norm,
                            const bf16_t* __restrict__ hgg, const bf16_t* __restrict__ gg, bf16_t* __restrict__ mix) {
    const int w = blockIdx.x * 4 + (threadIdx.x >> 6), lane = threadIdx.x & 63; const int tok = w / 12, s = w % 12;
    const bool gla = s >= 8; const int dv = gla ? 256 : 128, col0 = gla ? 1024 + (s - 8) * 256 : s * 128;
    const float* o = oraw + (size_t)tok * D + col0; float x[4]; float ss = 0.f; const int n = dv / 64;
#pragma unroll
    for (int i = 0; i < 4; ++i) { x[i] = i < n ? o[lane + 64 * i] : 0.f; ss += x[i] * x[i]; }
    ss = wave_sum(ss); const float rstd = rsqrtf(ss / dv + EPS);
#pragma unroll
    for (int i = 0; i < 4; ++i) if (i < n) { const int c = lane + 64 * i; const float gain = gla ? gla_norm[c] : hg_norm[c];
        const float gate = gla ? bf2f(gg[(size_t)tok * 1024 + (s - 8) * 256 + c]) : bf2f(hgg[(size_t)tok * 1024 + s * 128 + c]);
        mix[(size_t)tok * D + col0 + c] = f2bf(x[i] * rstd * gain * gate); }
}

__global__ void k_kmean(const bf16_t* __restrict__ Kb, float* __restrict__ kmean) {
    const int n = blockIdx.x % MB_NBLK, hh = (blockIdx.x / MB_NBLK) % MB_H, b = blockIdx.x / (MB_NBLK * MB_H), d = threadIdx.x;
    float s = 0.f; const bf16_t* p = Kb + ((size_t)b * SEQ + n * MB_BLK) * D + hh * MB_DH + d;
    for (int j = 0; j < MB_BLK; ++j) s += bf2f(p[(size_t)j * D]);
    kmean[(size_t)blockIdx.x * MB_DH + d] = s * (1.0f / MB_BLK);
}
__global__ void k_moba_naive(const bf16_t* __restrict__ Qb, const bf16_t* __restrict__ Kb, const bf16_t* __restrict__ Vb, const float* __restrict__ kmean, bf16_t* __restrict__ AO) {
    __shared__ float sq[4][128]; __shared__ float sp[4][1024]; __shared__ int ssel[4][4];
    const int wv = threadIdx.x >> 6, lane = threadIdx.x & 63;
    const int qi = blockIdx.x * 4 + wv; const int t = qi % SEQ, hh = (qi / SEQ) % MB_H, b = qi / (SEQ * MB_H);
    const size_t tok = (size_t)b * SEQ + t; const int qb = t / MB_BLK;
    sq[wv][lane] = bf2f(Qb[tok * D + hh * MB_DH + lane]); sq[wv][lane + 64] = bf2f(Qb[tok * D + hh * MB_DH + lane + 64]);
    __syncthreads();
    float gate = -3.0e38f;
    if (lane < qb) { const float* km = kmean + ((size_t)(b * MB_H + hh) * MB_NBLK + lane) * MB_DH; float s = 0.f; for (int d = 0; d < 128; ++d) s += sq[wv][d] * km[d]; gate = s; }
    int nsel = qb < 3 ? qb : 3;
    for (int s = 0; s < 3; ++s) { float best = gate; int bi = lane;
        for (int o = 32; o > 0; o >>= 1) { const float ob = __shfl_xor(best, o); const int oi = __shfl_xor(bi, o); if (ob > best || (ob == best && oi < bi)) { best = ob; bi = oi; } }
        if (lane == 0) ssel[wv][s] = bi; if (lane == bi) gate = -3.4e38f; }
    __syncthreads();
    const float scale = 0.08838834764831845f;
    float mx = -3.0e38f;
    for (int sgi = 0; sgi <= nsel; ++sgi) { const int blk = sgi < nsel ? ssel[wv][sgi] : qb;
        for (int i = 0; i < 4; ++i) { const int j = lane + 64 * i, kp = blk * MB_BLK + j; float s = -__builtin_inff();
            if (sgi < nsel || kp <= t) { const bf16_t* kr = Kb + ((size_t)b * SEQ + kp) * D + hh * MB_DH; float a = 0.f;
                for (int d = 0; d < 128; d += 2) { const unsigned w = *(const unsigned*)(kr + d); a += sq[wv][d] * __uint_as_float(w << 16) + sq[wv][d + 1] * __uint_as_float(w & 0xFFFF0000u); }
                s = a * scale; }
            sp[wv][sgi * 256 + j] = s; mx = fmaxf(mx, s); } }
    for (int o = 32; o > 0; o >>= 1) mx = fmaxf(mx, __shfl_xor(mx, o));
    float den = 0.f;
    for (int sgi = 0; sgi <= nsel; ++sgi) for (int i = 0; i < 4; ++i) { const int idx = sgi * 256 + lane + 64 * i; const float p = __expf(sp[wv][idx] - mx); sp[wv][idx] = p; den += p; }
    den = wave_sum(den);
    __syncthreads();
    float o0 = 0.f, o1 = 0.f;
    for (int sgi = 0; sgi <= nsel; ++sgi) { const int blk = sgi < nsel ? ssel[wv][sgi] : qb; const int jmax = sgi < nsel ? 256 : (t - qb * MB_BLK + 1);
        for (int j = 0; j < jmax; ++j) { const float p = sp[wv][sgi * 256 + j]; const unsigned w = *(const unsigned*)(Vb + ((size_t)b * SEQ + blk * MB_BLK + j) * D + hh * MB_DH + lane * 2);
            o0 += p * __uint_as_float(w << 16); o1 += p * __uint_as_float(w & 0xFFFF0000u); } }
    const float inv = 1.0f / den;
    *(unsigned*)(AO + tok * D + hh * MB_DH + lane * 2) = (unsigned)f2bf(o0 * inv) | ((unsigned)f2bf(o1 * inv) << 16);
}

__global__ void k_moe_plan(unsigned* __restrict__ ctl, int* __restrict__ tile_e, int* __restrict__ rowtok) {
    __shared__ int base[NEXP + 1];
    if (threadIdx.x == 0) { int t = 0; for (int e = 0; e < NEXP; ++e) { base[e] = t; const int c = (int)ctl[CW_CNT + e]; const int nt = (c + MOE_TILE - 1) / MOE_TILE;
            for (int i = 0; i < nt; ++i) tile_e[t + i] = e; t += nt; ctl[CW_BASE + e] = (unsigned)(base[e] * MOE_TILE); ctl[CW_CUR + e] = 0u; }
        base[NEXP] = t; ctl[CW_NT] = (unsigned)t; for (int i = t; i < MOE_MAXT; ++i) tile_e[i] = -1; }
    __syncthreads();
    for (int i = threadIdx.x; i < MOE_ROWS; i += blockDim.x) rowtok[i] = 0;
}
__global__ void k_moe_scatter(const int* __restrict__ eid, unsigned* __restrict__ ctl, int* __restrict__ slot, int* __restrict__ rowtok) {
    const int i = blockIdx.x * blockDim.x + threadIdx.x; if (i >= NTOK * 2) return;
    const int e = eid[i]; const unsigned p = atomicAdd(&ctl[CW_CUR + e], 1u); const int s = (int)ctl[CW_BASE + e] + (int)p; slot[i] = s; rowtok[s] = i >> 1;
}
__global__ void k_moe_combine(float* __restrict__ h, const bf16_t* __restrict__ Y, const int* __restrict__ slot, const float* __restrict__ wgt) {
    const int row = blockIdx.x * 4 + (threadIdx.x >> 6), lane = threadIdx.x & 63;
    const int s0 = slot[row * 2], s1 = slot[row * 2 + 1]; const float w0 = wgt[row * 2], w1 = wgt[row * 2 + 1];
    for (int j = 0; j < 8; ++j) { const int c = j * 256 + lane * 4; float4 x = *(float4*)(h + (size_t)row * D + c);
        const ushort4 a = *(const ushort4*)(Y + (size_t)s0 * D + c), bb = *(const ushort4*)(Y + (size_t)s1 * D + c);
        x.x += w0 * bf2f(a.x) + w1 * bf2f(bb.x); x.y += w0 * bf2f(a.y) + w1 * bf2f(bb.y); x.z += w0 * bf2f(a.z) + w1 * bf2f(bb.z); x.w += w0 * bf2f(a.w) + w1 * bf2f(bb.w);
        *(float4*)(h + (size_t)row * D + c) = x; }
}

extern "C" void kernel_launch(void* const* d_in, const int* in_sizes, int n_in, void* d_out, int out_size, void* d_ws, size_t ws_size, hipStream_t stream) {
    if (n_in != 20 || out_size != NTOK * D || ws_size < WS_TOTAL) { fprintf(stderr, "kernel_launch: unexpected shapes / workspace (%d inputs, out %d, ws %zu need %zu)\n", n_in, out_size, ws_size, (size_t)WS_TOTAL); return; }
    const float* x = (const float*)d_in[0]; const float* norm_mix = (const float*)d_in[1]; const float* norm_ffn = (const float*)d_in[2]; const float* norm_final = (const float*)d_in[3];
    const float* w_in = (const float*)d_in[4]; const float* lb_logits = (const float*)d_in[5]; const float* hg_norm = (const float*)d_in[6];
    const float* gk2 = (const float*)d_in[7]; const float* gkb = (const float*)d_in[8]; const float* gla_norm = (const float*)d_in[9];
    const float* w_out = (const float*)d_in[10]; const float* w_qkv = (const float*)d_in[11]; const float* w_o = (const float*)d_in[12];
    const float* rgw = (const float*)d_in[13]; const float* rgb = (const float*)d_in[14]; const float* rew = (const float*)d_in[15]; const float* reb = (const float*)d_in[16];
    const float* ew1 = (const float*)d_in[17]; const float* ew3 = (const float*)d_in[18]; const float* ew2 = (const float*)d_in[19];
    unsigned char* ws = (unsigned char*)d_ws;
    unsigned* ctl = (unsigned*)(ws + WS_CTL);
    bf16_t* WinT = (bf16_t*)(ws + WS_WIN); bf16_t* WoutT = (bf16_t*)(ws + WS_WOUT); bf16_t* WqkvT = (bf16_t*)(ws + WS_WQKV); bf16_t* WoT = (bf16_t*)(ws + WS_WO);
    bf16_t* Wup = (bf16_t*)(ws + WS_WUP); bf16_t* Wdn = (bf16_t*)(ws + WS_WDN);
    bf16_t* XN = (bf16_t*)(ws + WS_XN); float* H = (float*)(ws + WS_H);
    float* LB = (float*)(ws + SM_LB); float* KMEAN = (float*)(ws + SM_KMEAN); int* TILEE = (int*)(ws + SM_TILEE);
    float* GLOW = (float*)(ws + WS_GLOW); int* EID = (int*)(ws + WS_EID); float* WGT = (float*)(ws + WS_WGT); int* SLOT = (int*)(ws + WS_SLOT); int* ROWTOK = (int*)(ws + WS_ROWTOK);
    bf16_t* HQ = (bf16_t*)(ws + U_HQ); float* HLF = (float*)(ws + U_HLF); bf16_t* HI = (bf16_t*)(ws + U_HI); bf16_t* HGG = (bf16_t*)(ws + U_HGG);
    bf16_t* GQ = (bf16_t*)(ws + U_GQ); bf16_t* GK = (bf16_t*)(ws + U_GK); bf16_t* GV = (bf16_t*)(ws + U_GV); bf16_t* GG = (bf16_t*)(ws + U_GG);
    bf16_t* Qb = (bf16_t*)(ws + U_Q); bf16_t* Kb = (bf16_t*)(ws + U_K); bf16_t* Vb = (bf16_t*)(ws + U_V);
    bf16_t* HMID = (bf16_t*)(ws + U_HMID); bf16_t* Y = (bf16_t*)(ws + U_Y);

    k_lb<<<4, 256, 0, stream>>>(lb_logits, LB);
    k_transpose<0><<<dim3(EVEN_MAIN / 64, D / 64, 1), 256, 0, stream>>>(w_in, WinT, D, EVEN_MAIN, EVEN_IN, 0, 0, 0, 0);
    k_transpose<0><<<dim3(D / 64, D / 64, 1), 256, 0, stream>>>(w_out, WoutT, D, D, D, 0, 0, 0, 0);
    k_transpose<0><<<dim3(3 * D / 64, D / 64, 1), 256, 0, stream>>>(w_qkv, WqkvT, D, 3 * D, 3 * D, 0, 0, 0, 0);
    k_transpose<0><<<dim3(D / 64, D / 64, 1), 256, 0, stream>>>(w_o, WoT, D, D, D, 0, 0, 0, 0);
    k_transpose<1><<<dim3(DEXP / 64, D / 64, 2 * NEXP), 256, 0, stream>>>(ew1, Wup, D, DEXP, DEXP, 0, 0, (size_t)D * DEXP, (size_t)1024 * D);
    k_transpose<1><<<dim3(DEXP / 64, D / 64, 2 * NEXP), 256, 0, stream>>>(ew3, Wup, D, DEXP, DEXP, 0, 1, (size_t)D * DEXP, (size_t)1024 * D);
    k_transpose<0><<<dim3(D / 64, DEXP / 64, 2 * NEXP), 256, 0, stream>>>(ew2, Wdn, DEXP, D, D, 0, 0, (size_t)DEXP * D, (size_t)D * DEXP);

    auto moe = [&](int l) {
        (void)hipMemsetAsync(ctl, 0, CTL_BYTES, stream);
        k_rmsnorm<2><<<NTOK / 4, 256, 0, stream>>>(H, norm_ffn + l * D, XN, nullptr, nullptr, nullptr, rgw + (size_t)l * D * NGRP, rgb + l * NGRP, rew + (size_t)l * D * NEXP, reb + l * NEXP, EID, WGT, ctl);
        k_moe_plan<<<1, 256, 0, stream>>>(ctl, TILEE, ROWTOK);
        k_moe_scatter<<<NTOK * 2 / 256, 256, 0, stream>>>(EID, ctl, SLOT, ROWTOK);
        k_gemm_naive<EpiSwiglu, true><<<dim3(DEXP / 64, MOE_ROWS / 64), 256, 0, stream>>>(XN, ROWTOK, Wup + (size_t)l * NEXP * 1024 * D, D, D, TILEE, (size_t)1024 * D, EpiSwiglu{HMID});
        k_gemm_naive<EpiBf, false><<<dim3(D / 64, MOE_ROWS / 64), 256, 0, stream>>>(HMID, nullptr, Wdn + (size_t)l * NEXP * D * DEXP, DEXP, DEXP, TILEE, (size_t)D * DEXP, EpiBf{Y, D, 0});
        k_moe_combine<<<NTOK / 4, 256, 0, stream>>>(H, Y, SLOT, WGT);
    };

    k_rmsnorm<1><<<NTOK / 4, 256, 0, stream>>>(x, norm_mix, XN, nullptr, w_in, GLOW, nullptr, nullptr, nullptr, nullptr, nullptr, nullptr, nullptr);
    k_gemm_naive<EpiProj0, false><<<dim3(EVEN_MAIN / 64, NTOK / 64), 256, 0, stream>>>(XN, nullptr, WinT, D, D, nullptr, 0, EpiProj0{HQ, HLF, HI, HGG, GQ, GK, GV, GG, LB});
    k_scan_naive<128, false><<<NB * HG_H, 128, 0, stream>>>(HQ, HLF, nullptr, HI, nullptr, nullptr, nullptr, H, HG_H, 0);
    k_scan_naive<256, true><<<NB * GL_H, 256, 0, stream>>>(GQ, nullptr, GK, GV, GLOW, gk2, gkb, H, GL_H, 1024);
    k_norm_gate<<<NTOK * 12 / 4, 256, 0, stream>>>(H, hg_norm, gla_norm, HGG, GG, XN);
    k_gemm_naive<EpiResid, false><<<dim3(D / 64, NTOK / 64), 256, 0, stream>>>(XN, nullptr, WoutT, D, D, nullptr, 0, EpiResid{x, H});
    moe(0);
    k_rmsnorm<0><<<NTOK / 4, 256, 0, stream>>>(H, norm_mix + D, XN, nullptr, nullptr, nullptr, nullptr, nullptr, nullptr, nullptr, nullptr, nullptr, nullptr);
    k_gemm_naive<EpiQKV, false><<<dim3(3 * D / 64, NTOK / 64), 256, 0, stream>>>(XN, nullptr, WqkvT, D, D, nullptr, 0, EpiQKV{Qb, Kb, Vb});
    k_kmean<<<NB * MB_H * MB_NBLK, 128, 0, stream>>>(Kb, KMEAN);
    k_moba_naive<<<NB * MB_H * SEQ / 4, 256, 0, stream>>>(Qb, Kb, Vb, KMEAN, XN);
    k_gemm_naive<EpiResid, false><<<dim3(D / 64, NTOK / 64), 256, 0, stream>>>(XN, nullptr, WoT, D, D, nullptr, 0, EpiResid{H, H});
    moe(1);
    k_rmsnorm<3><<<NTOK / 4, 256, 0, stream>>>(H, norm_final, nullptr, (float*)d_out, nullptr, nullptr, nullptr, nullptr, nullptr, nullptr, nullptr, nullptr, nullptr);
}
```

```cpp
#include <hip/hip_runtime.h>
#include <cstdio>
#include <cstdint>

typedef unsigned short bf16_t;
#define DI __device__ __forceinline__

constexpr int D = 2048, NB = 4, SEQ = 4096, NTOK = NB * SEQ;
constexpr int HG_H = 8, HG_DK = 128, HG_DV = 128, HG_QK = 1024, HG_V = 1024;
constexpr int GL_H = 4, GL_DK = 128, GL_DV = 256, GL_QK = 512, GL_V = 1024, GL_RANK = 16;
constexpr int EVEN_IN = 7184, EVEN_MAIN = 7168;
constexpr int MB_H = 16, MB_DH = 128, MB_BLK = 256, MB_NBLK = SEQ / MB_BLK;
constexpr int NEXP = 32, NGRP = 4, EPG = 8, DEXP = 512;
constexpr int MOE_TILE = 256, MOE_MAXT = (2 * NTOK) / MOE_TILE + NEXP, MOE_ROWS = MOE_MAXT * MOE_TILE;
constexpr float EPS = 1e-6f;

constexpr size_t MBy = 1024 * 1024;
constexpr size_t WS_CTL   = 0;
constexpr size_t CTL_BYTES = 64 * 1024;
constexpr size_t WS_SMALL = WS_CTL + CTL_BYTES;
constexpr size_t WS_WIN   = WS_SMALL + 1 * MBy;
constexpr size_t WS_WOUT  = WS_WIN + (size_t)EVEN_MAIN * D * 2;
constexpr size_t WS_WQKV  = WS_WOUT + (size_t)D * D * 2;
constexpr size_t WS_WO    = WS_WQKV + (size_t)3 * D * D * 2;
constexpr size_t WS_WUP   = WS_WO + (size_t)D * D * 2;
constexpr size_t WS_WDN   = WS_WUP + (size_t)2 * NEXP * 1024 * D * 2;
constexpr size_t WS_XN    = WS_WDN + (size_t)2 * NEXP * D * DEXP * 2;
constexpr size_t WS_H     = WS_XN + (size_t)NTOK * D * 2;
constexpr size_t WS_U     = WS_H + (size_t)NTOK * D * 4;
constexpr size_t U_HQ  = WS_U;
constexpr size_t U_HLF = U_HQ + (size_t)NTOK * 1024 * 2;
constexpr size_t U_HI  = U_HLF + (size_t)NTOK * 1024 * 4;
constexpr size_t U_HGG = U_HI + (size_t)NTOK * 1024 * 2;
constexpr size_t U_GQ  = U_HGG + (size_t)NTOK * 1024 * 2;
constexpr size_t U_GK  = U_GQ + (size_t)NTOK * 512 * 2;
constexpr size_t U_GV  = U_GK + (size_t)NTOK * 512 * 2;
constexpr size_t U_GG  = U_GV + (size_t)NTOK * 1024 * 2;
constexpr size_t U_END0 = U_GG + (size_t)NTOK * 1024 * 2;
constexpr size_t U_Q = WS_U, U_K = U_Q + (size_t)NTOK * D * 2, U_V = U_K + (size_t)NTOK * D * 2, U_END1 = U_V + (size_t)NTOK * D * 2;
constexpr size_t U_HMID = WS_U;
constexpr size_t U_Y = U_HMID + (size_t)MOE_ROWS * DEXP * 2;
constexpr size_t U_END2 = U_Y + (size_t)MOE_ROWS * D * 2;
constexpr size_t U_BYTES = U_END0 - WS_U;
static_assert(U_END1 - WS_U <= U_BYTES && U_END2 - WS_U <= U_BYTES, "union");
constexpr size_t WS_END = WS_U + U_BYTES;
constexpr size_t SM_LB    = WS_SMALL;
constexpr size_t SM_GLOW  = SM_LB + 4096;
constexpr size_t SM_KMEAN = WS_SMALL + 64 * 1024;
constexpr size_t SM_TILEE = SM_KMEAN + 512 * 1024;
constexpr size_t WS_GLOW  = WS_END;
constexpr size_t WS_EID   = WS_GLOW + (size_t)NTOK * 16 * 4;
constexpr size_t WS_WGT   = WS_EID + (size_t)NTOK * 2 * 4;
constexpr size_t WS_SLOT  = WS_WGT + (size_t)NTOK * 2 * 4;
constexpr size_t WS_ROWTOK = WS_SLOT + (size_t)NTOK * 2 * 4;
constexpr size_t WS_TOTAL = WS_ROWTOK + (size_t)MOE_ROWS * 4;
constexpr int CW_CNT = 0;
constexpr int CW_CUR = 64;
constexpr int CW_BASE = 128;
constexpr int CW_NT = 192;

DI float bf2f(bf16_t b) { return __uint_as_float(((unsigned)b) << 16); }
DI bf16_t f2bf(float f) { unsigned u = __float_as_uint(f); u += 0x7FFFu + ((u >> 16) & 1u); return (bf16_t)(u >> 16); }
DI float sigmoidf_(float x) { return 1.0f / (1.0f + __expf(-x)); }
DI float siluf_(float x) { return x / (1.0f + __expf(-x)); }
DI float wave_sum(float v) { for (int o = 32; o > 0; o >>= 1) v += __shfl_xor(v, o); return v; }

template <int MODE>
__global__ void k_transpose(const float* __restrict__ src, bf16_t* __restrict__ dst, int K, int N, int ld, int c0, int half, size_t src_bstride, size_t dst_bstride) {
    __shared__ float t[64][65];
    src += (size_t)blockIdx.z * src_bstride; dst += (size_t)blockIdx.z * dst_bstride;
    const int k0 = blockIdx.y * 64, n0 = blockIdx.x * 64, tx = threadIdx.x & 63, ty = threadIdx.x >> 6;
    for (int i = ty; i < 64; i += 4) t[i][tx] = src[(size_t)(k0 + i) * ld + c0 + n0 + tx];
    __syncthreads();
    for (int i = ty; i < 64; i += 4) { const int n = n0 + i; const int r = MODE == 0 ? n : (n / 128) * 256 + half * 128 + (n % 128);
        dst[(size_t)r * K + k0 + tx] = f2bf(t[tx][i]); }
}
__global__ void k_lb(const float* __restrict__ lg, float* __restrict__ lb) {
    const int d = blockIdx.x * blockDim.x + threadIdx.x; if (d >= HG_QK) return;
    const float a = lg[d], b = lg[HG_QK + d], c = lg[2 * HG_QK + d], m = fmaxf(a, fmaxf(b, c));
    const float ea = __expf(a - m), eb = __expf(b - m), ec = __expf(c - m); lb[d] = ea / (ea + eb + ec);
}

template <int MODE>
__global__ void k_rmsnorm(const float* __restrict__ h, const float* __restrict__ g, bf16_t* __restrict__ xn, float* __restrict__ fout,
                          const float* __restrict__ w_in, float* __restrict__ glow,
                          const float* __restrict__ wg, const float* __restrict__ bg, const float* __restrict__ we, const float* __restrict__ be,
                          int* __restrict__ eid, float* __restrict__ wgt, unsigned* __restrict__ ctl) {
    const int row = blockIdx.x * 4 + (threadIdx.x >> 6), lane = threadIdx.x & 63;
    const float* hr = h + (size_t)row * D;
    float v[32]; float ss = 0.f;
#pragma unroll
    for (int j = 0; j < 8; ++j) { const float4 x = *(const float4*)(hr + j * 256 + lane * 4); v[4 * j] = x.x; v[4 * j + 1] = x.y; v[4 * j + 2] = x.z; v[4 * j + 3] = x.w; ss += x.x * x.x + x.y * x.y + x.z * x.z + x.w * x.w; }
    ss = wave_sum(ss); const float rstd = rsqrtf(ss * (1.0f / D) + EPS);
#pragma unroll
    for (int j = 0; j < 8; ++j) { const float4 gg = *(const float4*)(g + j * 256 + lane * 4);
        v[4 * j] *= rstd * gg.x; v[4 * j + 1] *= rstd * gg.y; v[4 * j + 2] *= rstd * gg.z; v[4 * j + 3] *= rstd * gg.w; }
    if (MODE == 3) {
#pragma unroll
        for (int j = 0; j < 8; ++j) *(float4*)(fout + (size_t)row * D + j * 256 + lane * 4) = make_float4(v[4 * j], v[4 * j + 1], v[4 * j + 2], v[4 * j + 3]);
        return;
    }
#pragma unroll
    for (int j = 0; j < 8; ++j) { ushort4 o; o.x = f2bf(v[4 * j]); o.y = f2bf(v[4 * j + 1]); o.z = f2bf(v[4 * j + 2]); o.w = f2bf(v[4 * j + 3]);
        *(ushort4*)(xn + (size_t)row * D + j * 256 + lane * 4) = o; }
    if (MODE == 1) {
        float acc[16];
#pragma unroll
        for (int c = 0; c < 16; ++c) acc[c] = 0.f;
#pragma unroll
        for (int j = 0; j < 8; ++j)
#pragma unroll
            for (int e = 0; e < 4; ++e) { const int k = j * 256 + lane * 4 + e; const float* wr = w_in + (size_t)k * EVEN_IN + EVEN_MAIN; const float xv = v[4 * j + e];
#pragma unroll
                for (int c4 = 0; c4 < 4; ++c4) { const float4 w = *(const float4*)(wr + c4 * 4); acc[c4 * 4] += xv * w.x; acc[c4 * 4 + 1] += xv * w.y; acc[c4 * 4 + 2] += xv * w.z; acc[c4 * 4 + 3] += xv * w.w; } }
#pragma unroll
        for (int c = 0; c < 16; ++c) acc[c] = wave_sum(acc[c]);
        if (lane == 0) {
#pragma unroll
            for (int c = 0; c < 16; ++c) glow[(size_t)row * 16 + c] = acc[c]; }
    }
    if (MODE == 2) {
        float lg[4], le[32];
#pragma unroll
        for (int c = 0; c < 4; ++c) lg[c] = 0.f;
#pragma unroll
        for (int c = 0; c < 32; ++c) le[c] = 0.f;
#pragma unroll
        for (int j = 0; j < 8; ++j)
#pragma unroll
            for (int e = 0; e < 4; ++e) { const int k = j * 256 + lane * 4 + e; const float xv = v[4 * j + e];
                const float4 w4 = *(const float4*)(wg + (size_t)k * 4); lg[0] += xv * w4.x; lg[1] += xv * w4.y; lg[2] += xv * w4.z; lg[3] += xv * w4.w;
#pragma unroll
                for (int c4 = 0; c4 < 8; ++c4) { const float4 w = *(const float4*)(we + (size_t)k * 32 + c4 * 4); le[c4 * 4] += xv * w.x; le[c4 * 4 + 1] += xv * w.y; le[c4 * 4 + 2] += xv * w.z; le[c4 * 4 + 3] += xv * w.w; } }
#pragma unroll
        for (int c = 0; c < 4; ++c) lg[c] = wave_sum(lg[c]) + bg[c];
#pragma unroll
        for (int c = 0; c < 32; ++c) le[c] = wave_sum(le[c]) + be[c];
        if (lane == 0) {
            int grp = 0; float mx = lg[0];
#pragma unroll
            for (int c = 1; c < 4; ++c) if (lg[c] > mx) { mx = lg[c]; grp = c; }
            float den = 0.f;
#pragma unroll
            for (int c = 0; c < 4; ++c) den += __expf(lg[c] - mx);
            const float pg = 1.0f / den;
            float e8[8];
#pragma unroll
            for (int c = 0; c < 8; ++c) { e8[c] = grp == 0 ? le[c] : grp == 1 ? le[8 + c] : grp == 2 ? le[16 + c] : le[24 + c]; }
            int j0 = 0; float v0 = e8[0];
#pragma unroll
            for (int c = 1; c < 8; ++c) if (e8[c] > v0) { v0 = e8[c]; j0 = c; }
            int j1 = -1; float v1 = -3.0e38f;
#pragma unroll
            for (int c = 0; c < 8; ++c) if (c != j0 && e8[c] > v1) { v1 = e8[c]; j1 = c; }
            const float e1 = __expf(v1 - v0), s = 1.0f / (1.0f + e1);
            const int ea = grp * 8 + j0, eb = grp * 8 + j1;
            eid[row * 2] = ea; eid[row * 2 + 1] = eb; wgt[row * 2] = pg * s; wgt[row * 2 + 1] = pg * e1 * s;
            atomicAdd(&ctl[CW_CNT + ea], 1u); atomicAdd(&ctl[CW_CNT + eb], 1u);
        }
    }
}

struct EpiProj0 { bf16_t* hq; float* hlf; bf16_t* hi; bf16_t* hgg; bf16_t* gq; bf16_t* gk; bf16_t* gv; bf16_t* gg; const float* lb;
    DI void operator()(int r, int c, float v) const {
        const int seg = c >> 10, cc = c & 1023; const float sc = 0.08838834764831845f;
        if (seg == 0) hq[(size_t)r * 1024 + cc] = f2bf(siluf_(v) * sc);
        else if (seg == 1) { const float l = lb[cc]; const float f = l + (1.0f - l) * sigmoidf_(v); hlf[(size_t)r * 1024 + cc] = __logf(f); }
        else if (seg == 2) hi[(size_t)r * 1024 + cc] = f2bf(v);
        else if (seg == 3) hgg[(size_t)r * 1024 + cc] = f2bf(siluf_(v));
        else if (seg == 4) { if (cc < 512) gq[(size_t)r * 512 + cc] = f2bf(v * sc); else gk[(size_t)r * 512 + cc - 512] = f2bf(v); }
        else if (seg == 5) gv[(size_t)r * 1024 + cc] = f2bf(v);
        else gg[(size_t)r * 1024 + cc] = f2bf(siluf_(v));
    } };
struct EpiResid { const float* res; float* out;
    DI void operator()(int r, int c, float v) const { out[(size_t)r * D + c] = res[(size_t)r * D + c] + v; } };
struct EpiQKV { bf16_t* q; bf16_t* k; bf16_t* v_;
    DI void operator()(int r, int c, float v) const { const int s = c >> 11, cc = c & 2047; bf16_t* o = s == 0 ? q : s == 1 ? k : v_; o[(size_t)r * D + cc] = f2bf(v); } };
struct EpiBf { bf16_t* o; int ld; int pad;
    DI void operator()(int r, int c, float v) const { o[(size_t)r * ld + c] = f2bf(v); } };
struct EpiSwiglu { bf16_t* o;
    DI void operator()(int r, int j, float a, float b) const { o[(size_t)r * DEXP + j] = f2bf(siluf_(a) * b); } };

template <class Epi, bool DUAL>
__global__ void k_gemm_naive(const bf16_t* __restrict__ A, const int* __restrict__ rowidx, const bf16_t* __restrict__ Bt, int K, int lda,
                             const int* __restrict__ tile_e, size_t b_estride, Epi epi) {
    __shared__ float As[32][65], Bs[32][65], Bs2[DUAL ? 32 : 1][65];
    const int m0 = blockIdx.y * 64, n0 = blockIdx.x * 64, tid = threadIdx.x, tx = tid & 15, ty = tid >> 4;
    if (tile_e) { const int e = tile_e[m0 / MOE_TILE]; if (e < 0) return; Bt += (size_t)e * b_estride; }
    float acc[4][4], acc2[4][4];
#pragma unroll
    for (int i = 0; i < 4; ++i)
#pragma unroll
        for (int j = 0; j < 4; ++j) { acc[i][j] = 0.f; acc2[i][j] = 0.f; }
    const int lr = tid >> 2, lk = (tid & 3) * 8;
    const int arow = rowidx ? rowidx[m0 + lr] : (m0 + lr);
    const bf16_t* ap = A + (size_t)arow * lda + lk;
    const int nl = n0 + lr; const int brow = DUAL ? (nl / 128) * 256 + (nl % 128) : nl;
    const bf16_t* bp = Bt + (size_t)brow * K + lk; const bf16_t* bp2 = bp + (size_t)128 * K;
    for (int k0 = 0; k0 < K; k0 += 32) {
        { const uint4 a = *(const uint4*)(ap + k0); const unsigned w[4] = {a.x, a.y, a.z, a.w};
#pragma unroll
          for (int i = 0; i < 4; ++i) { As[lk + 2 * i][lr] = __uint_as_float(w[i] << 16); As[lk + 2 * i + 1][lr] = __uint_as_float(w[i] & 0xFFFF0000u); } }
        { const uint4 a = *(const uint4*)(bp + k0); const unsigned w[4] = {a.x, a.y, a.z, a.w};
#pragma unroll
          for (int i = 0; i < 4; ++i) { Bs[lk + 2 * i][lr] = __uint_as_float(w[i] << 16); Bs[lk + 2 * i + 1][lr] = __uint_as_float(w[i] & 0xFFFF0000u); } }
        if (DUAL) { const uint4 a = *(const uint4*)(bp2 + k0); const unsigned w[4] = {a.x, a.y, a.z, a.w};
#pragma unroll
          for (int i = 0; i < 4; ++i) { Bs2[lk + 2 * i][lr] = __uint_as_float(w[i] << 16); Bs2[lk + 2 * i + 1][lr] = __uint_as_float(w[i] & 0xFFFF0000u); } }
        __syncthreads();
#pragma unroll 8
        for (int k = 0; k < 32; ++k) {
            float a[4], b[4], b2[4];
#pragma unroll
            for (int i = 0; i < 4; ++i) { a[i] = As[k][ty * 4 + i]; b[i] = Bs[k][tx * 4 + i]; if (DUAL) b2[i] = Bs2[k][tx * 4 + i]; }
#pragma unroll
            for (int i = 0; i < 4; ++i)
#pragma unroll
                for (int j = 0; j < 4; ++j) { acc[i][j] += a[i] * b[j]; if (DUAL) acc2[i][j] += a[i] * b2[j]; }
        }
        __syncthreads();
    }
#pragma unroll
    for (int i = 0; i < 4; ++i)
#pragma unroll
        for (int j = 0; j < 4; ++j) { const int r = m0 + ty * 4 + i, c = n0 + tx * 4 + j;
            if constexpr (DUAL) epi(r, c, acc[i][j], acc2[i][j]); else epi(r, c, acc[i][j]); }
}

template <int DV, bool IS_GLA>
__global__ void __launch_bounds__(DV) k_scan_naive(const bf16_t* __restrict__ Q, const float* __restrict__ LF, const bf16_t* __restrict__ Kx, const bf16_t* __restrict__ V,
                             const float* __restrict__ glow, const float* __restrict__ gk2, const float* __restrict__ gkb, float* __restrict__ oraw, int nheads, int ocol0) {
    constexpr int T = 16;
    __shared__ float sq[T][128], sk[T][128], sa[T][128];
    const int b = blockIdx.x / nheads, hh = blockIdx.x % nheads, v = threadIdx.x;
    const int qld = nheads * 128, vld = nheads * DV;
    float S[128];
#pragma unroll
    for (int d = 0; d < 128; ++d) S[d] = 0.f;
    for (int t0 = 0; t0 < SEQ; t0 += T) {
        __syncthreads();
        for (int i = threadIdx.x; i < T * 128; i += DV) { const int tt = i >> 7, d = i & 127; const size_t tok = (size_t)b * SEQ + t0 + tt;
            sq[tt][d] = bf2f(Q[tok * qld + hh * 128 + d]);
            if (IS_GLA) { float z = gkb[hh * 128 + d];
#pragma unroll
                for (int r = 0; r < GL_RANK; ++r) z += glow[tok * 16 + r] * gk2[r * GL_QK + hh * 128 + d];
                const float ls = fminf(z, 0.f) - log1pf(__expf(-fabsf(z)));
                sa[tt][d] = __expf(ls * (1.0f / 16.0f)); sk[tt][d] = bf2f(Kx[tok * qld + hh * 128 + d]); }
            else { const float a = __expf(LF[tok * qld + hh * 128 + d]); sa[tt][d] = a; sk[tt][d] = 1.0f - a; } }
        __syncthreads();
        for (int tt = 0; tt < T; ++tt) { const size_t tok = (size_t)b * SEQ + t0 + tt;
            const float vv = bf2f(V[tok * vld + hh * DV + v]); float o = 0.f;
#pragma unroll
            for (int d = 0; d < 128; ++d) { S[d] = sa[tt][d] * S[d] + sk[tt][d] * vv; o += sq[tt][d] * S[d]; }
            oraw[tok * D + ocol0 + hh * DV + v] = o; }
    }
}
__global__ void k_norm_gate(const float* __restrict__ oraw, const float* __restrict__ hg_norm, const float* __restrict__ gla_norm,
                            const bf16_t* __restrict__ hgg, const bf16_t* __restrict__ gg, bf16_t* __restrict__ mix) {
    const int w = blockIdx.x * 4 + (threadIdx.x >> 6), lane = threadIdx.x & 63; const int tok = w / 12, s = w % 12;
    const bool gla = s >= 8; const int dv = gla ? 256 : 128, col0 = gla ? 1024 + (s - 8) * 256 : s * 128;
    const float* o = oraw + (size_t)tok * D + col0; float x[4]; float ss = 0.f; const int n = dv / 64;
#pragma unroll
    for (int i = 0; i < 4; ++i) { x[i] = i < n ? o[lane + 64 * i] : 0.f; ss += x[i] * x[i]; }
    ss = wave_sum(ss); const float rstd = rsqrtf(ss / dv + EPS);
#pragma unroll
    for (int i = 0; i < 4; ++i) if (i < n) { const int c = lane + 64 * i; const float gain = gla ? gla_norm[c] : hg_norm[c];
        const float gate = gla ? bf2f(gg[(size_t)tok * 1024 + (s - 8) * 256 + c]) : bf2f(hgg[(size_t)tok * 1024 + s * 128 + c]);
        mix[(size_t)tok * D + col0 + c] = f2bf(x[i] * rstd * gain * gate); }
}

__global__ void k_kmean(const bf16_t* __restrict__ Kb, float* __restrict__ kmean) {
    const int n = blockIdx.x % MB_NBLK, hh = (blockIdx.x / MB_NBLK) % MB_H, b = blockIdx.x / (MB_NBLK * MB_H), d = threadIdx.x;
    float s = 0.f; const bf16_t* p = Kb + ((size_t)b * SEQ + n * MB_BLK) * D + hh * MB_DH + d;
    for (int j = 0; j < MB_BLK; ++j) s += bf2f(p[(size_t)j * D]);
    kmean[(size_t)blockIdx.x * MB_DH + d] = s * (1.0f / MB_BLK);
}
__global__ void k_moba_naive(const bf16_t* __restrict__ Qb, const bf16_t* __restrict__ Kb, const bf16_t* __restrict__ Vb, const float* __restrict__ kmean, bf16_t* __restrict__ AO) {
    __shared__ float sq[4][128]; __shared__ float sp[4][1024]; __shared__ int ssel[4][4];
    const int wv = threadIdx.x >> 6, lane = threadIdx.x & 63;
    const int qi = blockIdx.x * 4 + wv; const int t = qi % SEQ, hh = (qi / SEQ) % MB_H, b = qi / (SEQ * MB_H);
    const size_t tok = (size_t)b * SEQ + t; const int qb = t / MB_BLK;
    sq[wv][lane] = bf2f(Qb[tok * D + hh * MB_DH + lane]); sq[wv][lane + 64] = bf2f(Qb[tok * D + hh * MB_DH + lane + 64]);
    __syncthreads();
    float gate = -3.0e38f;
    if (lane < qb) { const float* km = kmean + ((size_t)(b * MB_H + hh) * MB_NBLK + lane) * MB_DH; float s = 0.f; for (int d = 0; d < 128; ++d) s += sq[wv][d] * km[d]; gate = s; }
    int nsel = qb < 3 ? qb : 3;
    for (int s = 0; s < 3; ++s) { float best = gate; int bi = lane;
        for (int o = 32; o > 0; o >>= 1) { const float ob = __shfl_xor(best, o); const int oi = __shfl_xor(bi, o); if (ob > best || (ob == best && oi < bi)) { best = ob; bi = oi; } }
        if (lane == 0) ssel[wv][s] = bi; if (lane == bi) gate = -3.4e38f; }
    __syncthreads();
    const float scale = 0.08838834764831845f;
    float mx = -3.0e38f;
    for (int sgi = 0; sgi <= nsel; ++sgi) { const int blk = sgi < nsel ? ssel[wv][sgi] : qb;
        for (int i = 0; i < 4; ++i) { const int j = lane + 64 * i, kp = blk * MB_BLK + j; float s = -__builtin_inff();
            if (sgi < nsel || kp <= t) { const bf16_t* kr = Kb + ((size_t)b * SEQ + kp) * D + hh * MB_DH; float a = 0.f;
                for (int d = 0; d < 128; d += 2) { const unsigned w = *(const unsigned*)(kr + d); a += sq[wv][d] * __uint_as_float(w << 16) + sq[wv][d + 1] * __uint_as_float(w & 0xFFFF0000u); }
                s = a * scale; }
            sp[wv][sgi * 256 + j] = s; mx = fmaxf(mx, s); } }
    for (int o = 32; o > 0; o >>= 1) mx = fmaxf(mx, __shfl_xor(mx, o));
    float den = 0.f;
    for (int sgi = 0; sgi <= nsel; ++sgi) for (int i = 0; i < 4; ++i) { const int idx = sgi * 256 + lane + 64 * i; const float p = __expf(sp[wv][idx] - mx); sp[wv][idx] = p; den += p; }
    den = wave_sum(den);
    __syncthreads();
    float o0 = 0.f, o1 = 0.f;
    for (int sgi = 0; sgi <= nsel; ++sgi) { const int blk = sgi < nsel ? ssel[wv][sgi] : qb; const int jmax = sgi < nsel ? 256 : (t - qb * MB_BLK + 1);
        for (int j = 0; j < jmax; ++j) { const float p = sp[wv][sgi * 256 + j]; const unsigned w = *(const unsigned*)(Vb + ((size_t)b * SEQ + blk * MB_BLK + j) * D + hh * MB_DH + lane * 2);
            o0 += p * __uint_as_float(w << 16); o1 += p * __uint_as_float(w & 0xFFFF0000u); } }
    const float inv = 1.0f / den;
    *(unsigned*)(AO + tok * D + hh * MB_DH + lane * 2) = (unsigned)f2bf(o0 * inv) | ((unsigned)f2bf(o1 * inv) << 16);
}

__global__ void k_moe_plan(unsigned* __restrict__ ctl, int* __restrict__ tile_e, int* __restrict__ rowtok) {
    __shared__ int base[NEXP + 1];
    if (threadIdx.x == 0) { int t = 0; for (int e = 0; e < NEXP; ++e) { base[e] = t; const int c = (int)ctl[CW_CNT + e]; const int nt = (c + MOE_TILE - 1) / MOE_TILE;
            for (int i = 0; i < nt; ++i) tile_e[t + i] = e; t += nt; ctl[CW_BASE + e] = (unsigned)(base[e] * MOE_TILE); ctl[CW_CUR + e] = 0u; }
        base[NEXP] = t; ctl[CW_NT] = (unsigned)t; for (int i = t; i < MOE_MAXT; ++i) tile_e[i] = -1; }
    __syncthreads();
    for (int i = threadIdx.x; i < MOE_ROWS; i += blockDim.x) rowtok[i] = 0;
}
__global__ void k_moe_scatter(const int* __restrict__ eid, unsigned* __restrict__ ctl, int* __restrict__ slot, int* __restrict__ rowtok) {
    const int i = blockIdx.x * blockDim.x + threadIdx.x; if (i >= NTOK * 2) return;
    const int e = eid[i]; const unsigned p = atomicAdd(&ctl[CW_CUR + e], 1u); const int s = (int)ctl[CW_BASE + e] + (int)p; slot[i] = s; rowtok[s] = i >> 1;
}
__global__ void k_moe_combine(float* __restrict__ h, const bf16_t* __restrict__ Y, const int* __restrict__ slot, const float* __restrict__ wgt) {
    const int row = blockIdx.x * 4 + (threadIdx.x >> 6), lane = threadIdx.x & 63;
    const int s0 = slot[row * 2], s1 = slot[row * 2 + 1]; const float w0 = wgt[row * 2], w1 = wgt[row * 2 + 1];
    for (int j = 0; j < 8; ++j) { const int c = j * 256 + lane * 4; float4 x = *(float4*)(h + (size_t)row * D + c);
        const ushort4 a = *(const ushort4*)(Y + (size_t)s0 * D + c), bb = *(const ushort4*)(Y + (size_t)s1 * D + c);
        x.x += w0 * bf2f(a.x) + w1 * bf2f(bb.x); x.y += w0 * bf2f(a.y) + w1 * bf2f(bb.y); x.z += w0 * bf2f(a.z) + w1 * bf2f(bb.z); x.w += w0 * bf2f(a.w) + w1 * bf2f(bb.w);
        *(float4*)(h + (size_t)row * D + c) = x; }
}


#define XB_TMO      128
#define XB_XCNT(j)  (256  + 64 * (j))
#define XB_XSUB(j)  (1280 + 64 * (j))
#define XB_XGEN(j)  (2304 + 64 * (j))
#define XB_TOP      3328
#define XB_TOPGEN   3392
#define XCD_BAR_WORDS 3456
#define XB_SPIN_CAP (1u << 18)
#define LAS __attribute__((address_space(3)))

__device__ __forceinline__ unsigned xb_ld(unsigned* p)              { return __hip_atomic_load(p, __ATOMIC_RELAXED, __HIP_MEMORY_SCOPE_AGENT); }
__device__ __forceinline__ unsigned xb_add(unsigned* p, unsigned v) { return __hip_atomic_fetch_add(p, v, __ATOMIC_RELAXED, __HIP_MEMORY_SCOPE_AGENT); }
__device__ __forceinline__ unsigned xb_xcc_id() { return (unsigned)__builtin_amdgcn_s_getreg((3 << 11) | 20) & 0xFu; }
#define XB_SPIN(cond, bar) do { unsigned _sp = 0; while (cond) { __builtin_amdgcn_s_sleep(1); \
    if ((++_sp & 255u) == 0u) { if (xb_ld(&(bar)[XB_TMO])) break; if (_sp > XB_SPIN_CAP) { atomicAdd(&(bar)[XB_TMO], 1u); break; } } } } while (0)

struct XcdBarrier {
    unsigned* bar; unsigned x;
    volatile LAS unsigned* st;
};

__device__ __forceinline__ XcdBarrier xcd_barrier_post(unsigned* bar, volatile LAS unsigned* st) {
    XcdBarrier b; b.bar = bar; b.x = xb_xcc_id(); b.st = st;
    if (threadIdx.x == 0) (void)xb_add(&bar[XB_XCNT(b.x)], 1u);
    return b;
}
__device__ __forceinline__ void xcd_barrier_complete(unsigned* bar, unsigned x, unsigned& nloc, unsigned& nx) {
    const unsigned G = gridDim.x * gridDim.y * gridDim.z;
    unsigned sum, cnt, mine, sp = 0u;
    for (;;) {
        sum = 0u; cnt = 0u; mine = 0u;
#pragma unroll
        for (unsigned j = 0; j < 16; ++j) { const unsigned c = xb_ld(&bar[XB_XCNT(j)]); sum += c; cnt += (c > 0u) ? 1u : 0u; mine = (j == x) ? c : mine; }
        if (sum == G) break;
        __builtin_amdgcn_s_sleep(1);
        if ((++sp & 255u) == 0u) { if (xb_ld(&bar[XB_TMO])) break; if (sp > XB_SPIN_CAP) { atomicAdd(&bar[XB_TMO], 1u); break; } }
    }
    nloc = mine > 0u ? mine : 1u; nx = cnt > 0u ? cnt : 1u;
}

__device__ __forceinline__ void xcd_barrier(const XcdBarrier& b) {
    asm volatile("s_waitcnt vmcnt(0)" ::: "memory");
    __syncthreads();
    if (threadIdx.x == 0) {
        unsigned* bar = b.bar;
        __builtin_amdgcn_s_waitcnt(0);
        unsigned nloc = b.st[0], nx = b.st[1];
        if (nloc == 0u) { xcd_barrier_complete(bar, b.x, nloc, nx); b.st[0] = nloc; b.st[1] = nx; }
        const unsigned old = xb_add(&bar[XB_XSUB(b.x)], 1u);
        const unsigned gen = old / nloc;
        if (old + 1u == (gen + 1u) * nloc) {
            __builtin_amdgcn_fence(__ATOMIC_RELEASE, "agent");
            asm volatile("s_waitcnt vmcnt(0)" ::: "memory");
            const unsigned og = xb_add(&bar[XB_TOP], 1u);
            const unsigned tg = og / nx;
            if (og + 1u == (tg + 1u) * nx) xb_add(&bar[XB_TOPGEN], 1u);
            else XB_SPIN(xb_ld(&bar[XB_TOPGEN]) == tg, bar);
            __builtin_amdgcn_fence(__ATOMIC_ACQUIRE, "agent");
            xb_add(&bar[XB_XGEN(b.x)], 1u);
            asm volatile("s_waitcnt vmcnt(0)" ::: "memory");
        } else {
            XB_SPIN(xb_ld(&bar[XB_XGEN(b.x)]) == gen, bar);
            __builtin_amdgcn_fence(__ATOMIC_ACQUIRE, "agent");
            asm volatile("s_waitcnt vmcnt(0)" ::: "memory");
        }
    }
    __syncthreads();
}


namespace pg8 {
#define PG8_LAS __attribute__((address_space(3)))
typedef unsigned short bf16_t;
typedef short bf16x8 __attribute__((ext_vector_type(8)));
typedef float f32x4 __attribute__((ext_vector_type(4)));
typedef unsigned u32x4 __attribute__((ext_vector_type(4)));
constexpr int BM = 256, BK = 64, HALF = 128, HTB = HALF * BK * 2  , STAGE_BYTES = 8 * HTB, NXCD = 8, WGM = 8;

__host__ __device__ __forceinline__ int lds_byte(int r, int c) { const int st = (r >> 4) * 2 + (c >> 5), rr = r & 15, cc = c & 31, ob = rr * 64 + cc * 2; return st * 1024 + (ob ^ (((ob >> 9) & 1) << 5)); }
__host__ __device__ __forceinline__ void stage_rc(int b, int& R, int& C) { const int st = b / 1024, sb = b % 1024, swz = sb ^ (((sb >> 9) & 1) << 5); R = (st >> 1) * 16 + swz / 64; C = (st & 1) * 32 + (swz % 64) / 2; }
__host__ __device__ __forceinline__ int perm32(int rho) { const int n = rho >> 4, i = rho & 15; return 8 * (i >> 2) + 4 * n + (i & 3); }

struct Unit { int pm, pn; };
struct Gemm { const bf16_t* A; const bf16_t* Bt; int M, N, K; };

struct StaticOrder {
    int nM, nN, nwg, G, c;
    __host__ __device__ void init(int M, int N, int G_, int c_) { nM = M / BM; nN = N / BM; nwg = nM * nN; G = G_; c = c_; }
    __host__ __device__ bool next(int i, Unit& u) const {
        const long L = (long)i * G + c; if (L >= nwg) return false;
        int wgid = (int)L; { const int q = nwg / NXCD, r = nwg % NXCD, xcd = wgid % NXCD, off = wgid / NXCD; wgid = (xcd < r ? xcd * (q + 1) : r * (q + 1) + (xcd - r) * q) + off; }
        const int nig = WGM * nN, gid = wgid / nig, fm = gid * WGM, gsz = (nM - fm) < WGM ? (nM - fm) : WGM;
        u.pm = fm + ((wgid % nig) % gsz); u.pn = (wgid % nig) / gsz; return true;
    }
    __device__ __forceinline__ void a_ready(const Unit&) const {}
    __device__ __forceinline__ void done(const Unit&) const {}
};

__device__ __forceinline__ unsigned cvt_pk_bf16(float lo, float hi) { unsigned r; asm volatile("v_cvt_pk_bf16_f32 %0, %1, %2" : "=v"(r) : "v"(lo), "v"(hi)); return r; }
template <class Epi, class Sched, bool ALIGN_EPI = false, bool SP2 = false>
__device__ __forceinline__ void gemm_phase(PG8_LAS unsigned char* lds, const Gemm g, const Sched& S, const Epi& E) {
    const int tid = threadIdx.x, wid = __builtin_amdgcn_readfirstlane(tid >> 6), lane = tid & 63, wr = wid >> 2, wc = wid & 3, fr = lane & 15, fq = lane >> 4;
    const int K = g.K, nt = K / BK;
    unsigned voffA[2], voffB[2];
#pragma unroll
    for (int i = 0; i < 2; ++i) { int R, C; stage_rc(tid * 16 + i * 8192, R, C); const int Rb = Epi::PERM ? ((R & ~31) + perm32(R & 31)) : R;
        voffA[i] = (unsigned)(R * K + C) * 2u; voffB[i] = (unsigned)(Rb * K + C) * 2u; }
    const size_t kstep = (size_t)(BK * 2);
    const size_t hstep = (size_t)HALF * K * 2;
    const size_t tstep = 2 * hstep;
    const unsigned ldsw = (unsigned)wid * 1024u;
    const int aoff = lds_byte(wr * 64 + fr, fq * 8), boff = lds_byte(wc * 32 + fr, fq * 8);
#define PG8_SA(b, h) (((b) * 2 + (h)) * HTB)
#define PG8_SB(b, h) ((4 + (b) * 2 + (h)) * HTB)
#define PG8_STAGE(bufoff, gbase, voff) do { _Pragma("unroll") for (int _i = 0; _i < 2; ++_i) \
        __builtin_amdgcn_global_load_lds((const unsigned*)((const char*)(gbase) + (voff)[_i]), (PG8_LAS unsigned*)(lds + (bufoff) + ldsw + _i * 8192), 16, 0, 0); } while (0)
#define PG8_LDA(dst, b, h) do { _Pragma("unroll") for (int m = 0; m < 4; ++m) _Pragma("unroll") for (int k = 0; k < 2; ++k) dst[m][k] = *(const PG8_LAS bf16x8*)(lds + PG8_SA(b, h) + aoff + m * 2048 + k * 1024); } while (0)
#define PG8_LDB(dst, b, h) do { _Pragma("unroll") for (int n = 0; n < 2; ++n) _Pragma("unroll") for (int k = 0; k < 2; ++k) dst[n][k] = *(const PG8_LAS bf16x8*)(lds + PG8_SB(b, h) + boff + n * 2048 + k * 1024); } while (0)
#define PG8_MMA(ai, bj, At, Bt) do { __builtin_amdgcn_s_setprio(1); _Pragma("unroll") for (int m = 0; m < 4; ++m) _Pragma("unroll") for (int n = 0; n < 2; ++n) _Pragma("unroll") for (int k = 0; k < 2; ++k) \
        acc[ai][bj][m][n] = __builtin_amdgcn_mfma_f32_16x16x32_bf16(Bt[n][k], At[m][k], acc[ai][bj][m][n], 0, 0, 0); __builtin_amdgcn_s_setprio(0); } while (0)
#define PG8_WAIT_V(n) asm volatile("s_waitcnt vmcnt(" #n ")" ::: "memory")
#define PG8_WAIT_L(n) asm volatile("s_waitcnt lgkmcnt(" #n ")" ::: "memory")
#define PG8_BAR __builtin_amdgcn_s_barrier()
#define PG8_SCHED __builtin_amdgcn_sched_barrier(0)
    Unit cur, nxt; int ui = 0;
    if (!S.next(0, cur)) return;
    f32x4 acc[2][2][4][2];
#pragma unroll
    for (int a = 0; a < 2; ++a)
#pragma unroll
        for (int b = 0; b < 2; ++b)
#pragma unroll
            for (int m = 0; m < 4; ++m)
#pragma unroll
                for (int n = 0; n < 2; ++n) acc[a][b][m][n] = (f32x4){0.f, 0.f, 0.f, 0.f};
    bf16x8 At[4][2], B0[2][2], B1[2][2];
    const char* cA = (const char*)g.A + (size_t)cur.pm * tstep; const char* cB = (const char*)g.Bt + (size_t)cur.pn * tstep;
    S.a_ready(cur);
    if constexpr (SP2) {
        PG8_STAGE(PG8_SB(0, 0), cB, voffB); PG8_STAGE(PG8_SB(0, 1), cB + hstep, voffB); PG8_STAGE(PG8_SA(0, 0), cA, voffA); PG8_STAGE(PG8_SA(0, 1), cA + hstep, voffA);
        if (wr == 1) PG8_BAR;
        PG8_WAIT_V(2); PG8_BAR;
        PG8_STAGE(PG8_SB(1, 0), cB + kstep, voffB); PG8_STAGE(PG8_SA(1, 0), cA + kstep, voffA); PG8_STAGE(PG8_SB(1, 1), cB + hstep + kstep, voffB);
        PG8_WAIT_V(6); PG8_BAR;
    } else {
        PG8_STAGE(PG8_SB(0, 0), cB, voffB); PG8_STAGE(PG8_SA(0, 0), cA, voffA); PG8_STAGE(PG8_SB(0, 1), cB + hstep, voffB); PG8_STAGE(PG8_SA(0, 1), cA + hstep, voffA);
        if (wr == 1) PG8_BAR;
        PG8_WAIT_V(4); PG8_BAR;
        PG8_STAGE(PG8_SB(1, 0), cB + kstep, voffB); PG8_STAGE(PG8_SA(1, 0), cA + kstep, voffA); PG8_STAGE(PG8_SB(1, 1), cB + hstep + kstep, voffB);
        PG8_WAIT_V(6); PG8_BAR;
    }
    for (;;) {
        const bool has_next = S.next(ui + 1, nxt);
        const char* nA = has_next ? (const char*)g.A + (size_t)nxt.pm * tstep : cA; const char* nB = has_next ? (const char*)g.Bt + (size_t)nxt.pn * tstep : cB;
        for (int t = 0; t < nt; t += 2) {
            const bool last = (t == nt - 2);
            const char* a1 = cA + (size_t)(t + 1) * kstep;
            const char* a2 = last ? nA : cA + (size_t)(t + 2) * kstep; const char* b2 = last ? nB : cB + (size_t)(t + 2) * kstep;
            const char* a3 = a2 + kstep; const char* b3 = b2 + kstep;
            if (last && has_next) S.a_ready(nxt);
            if constexpr (SP2) {
            PG8_LDB(B0, 0, 0); PG8_LDB(B1, 0, 1); PG8_SCHED; PG8_LDA(At, 0, 0); PG8_STAGE(PG8_SA(1, 1), a1 + hstep, voffA);
            PG8_WAIT_V(8); PG8_WAIT_L(0); PG8_BAR; PG8_MMA(0, 0, At, B0); PG8_MMA(0, 1, At, B1); PG8_BAR; PG8_SCHED;
            PG8_LDA(At, 0, 1); PG8_STAGE(PG8_SB(0, 0), b2, voffB); PG8_STAGE(PG8_SB(0, 1), b2 + hstep, voffB); PG8_STAGE(PG8_SA(0, 0), a2, voffA);
            PG8_WAIT_V(8); PG8_WAIT_L(0); PG8_BAR; PG8_MMA(1, 0, At, B0); PG8_MMA(1, 1, At, B1); PG8_BAR; PG8_SCHED;
            PG8_LDB(B0, 1, 0); PG8_LDB(B1, 1, 1); PG8_SCHED; PG8_LDA(At, 1, 0); PG8_STAGE(PG8_SA(0, 1), a2 + hstep, voffA);
            PG8_WAIT_V(8); PG8_WAIT_L(0); PG8_BAR; PG8_MMA(0, 0, At, B0); PG8_MMA(0, 1, At, B1); PG8_BAR; PG8_SCHED;
            PG8_LDA(At, 1, 1); PG8_STAGE(PG8_SB(1, 0), b3, voffB); PG8_STAGE(PG8_SB(1, 1), b3 + hstep, voffB); PG8_STAGE(PG8_SA(1, 0), a3, voffA);
            PG8_WAIT_V(8); PG8_WAIT_L(0); PG8_BAR; PG8_MMA(1, 0, At, B0); PG8_MMA(1, 1, At, B1); PG8_BAR; PG8_SCHED;
            } else {
            PG8_LDB(B0, 0, 0); PG8_SCHED; PG8_LDA(At, 0, 0); PG8_STAGE(PG8_SA(1, 1), a1 + hstep, voffA);
            PG8_WAIT_L(8); PG8_BAR; PG8_WAIT_L(0); PG8_MMA(0, 0, At, B0); PG8_BAR; PG8_SCHED;
            PG8_LDB(B1, 0, 1); PG8_STAGE(PG8_SB(0, 0), b2, voffB);
            PG8_BAR; PG8_WAIT_L(0); PG8_MMA(0, 1, At, B1); PG8_BAR;
            PG8_LDA(At, 0, 1); PG8_STAGE(PG8_SA(0, 0), a2, voffA);
            PG8_BAR; PG8_WAIT_L(0); PG8_MMA(1, 0, At, B0); PG8_BAR; PG8_SCHED;
            PG8_STAGE(PG8_SB(0, 1), b2 + hstep, voffB);
            PG8_WAIT_V(6); PG8_BAR; PG8_MMA(1, 1, At, B1); PG8_BAR;
            PG8_LDB(B0, 1, 0); PG8_SCHED; PG8_LDA(At, 1, 0); PG8_STAGE(PG8_SA(0, 1), a2 + hstep, voffA);
            PG8_WAIT_L(8); PG8_BAR; PG8_WAIT_L(0); PG8_MMA(0, 0, At, B0); PG8_BAR; PG8_SCHED;
            PG8_LDB(B1, 1, 1); PG8_STAGE(PG8_SB(1, 0), b3, voffB);
            PG8_BAR; PG8_WAIT_L(0); PG8_MMA(0, 1, At, B1); PG8_BAR;
            PG8_LDA(At, 1, 1); PG8_STAGE(PG8_SA(1, 0), a3, voffA);
            PG8_BAR; PG8_WAIT_L(0); PG8_MMA(1, 0, At, B0); PG8_BAR; PG8_SCHED;
            PG8_STAGE(PG8_SB(1, 1), b3 + hstep, voffB);
            PG8_WAIT_V(6); PG8_BAR; PG8_MMA(1, 1, At, B1); PG8_BAR;
            }
        }
        if constexpr (ALIGN_EPI) { if (wr == 0) PG8_BAR; }
        if constexpr (!Epi::AFTER_DRAIN) { E(acc, cur, wr, wc, fr, fq); S.done(cur); }
        if (!has_next) break;
#pragma unroll
        for (int a = 0; a < 2; ++a)
#pragma unroll
            for (int b = 0; b < 2; ++b)
#pragma unroll
                for (int m = 0; m < 4; ++m)
#pragma unroll
                    for (int n = 0; n < 2; ++n) acc[a][b][m][n] = (f32x4){0.f, 0.f, 0.f, 0.f};
        cur = nxt; cA = nA; cB = nB; ++ui;
        if constexpr (ALIGN_EPI) { if (wr == 1) PG8_BAR; }
    }
    PG8_WAIT_V(0);
    if constexpr (!ALIGN_EPI) { if (wr == 0) PG8_BAR; }
    PG8_BAR;
    if constexpr (Epi::AFTER_DRAIN) { E.fused(acc, cur, wr, wc, fr, fq, lds, wid, lane); S.done(cur); }
#undef PG8_SA
#undef PG8_SB
#undef PG8_STAGE
#undef PG8_LDA
#undef PG8_LDB
#undef PG8_MMA
#undef PG8_WAIT_V
#undef PG8_WAIT_L
#undef PG8_BAR
#undef PG8_SCHED
}
}

#define LAS __attribute__((address_space(3)))
typedef float f32x4 __attribute__((ext_vector_type(4)));
typedef unsigned u32x4 __attribute__((ext_vector_type(4)));
typedef unsigned u32x2 __attribute__((ext_vector_type(2)));
constexpr int NTHR = 512, NWAVE = 8;
constexpr int RING_BYTES = 131072, LDS_MISC = 131072, LDS_BYTES = 147456;
constexpr int MI_BAR = 0;
constexpr int MI_NT = 16;
constexpr int MI_TILEE = 64;
constexpr int MI_EBASE = 1024;
constexpr int MI_RSTD = 2048;
constexpr int MI_LOGIT = 4096;
constexpr size_t WS_RWT = WS_TOTAL;
constexpr size_t WS_XS_UNUSED = 0;
constexpr size_t WS_TOTAL2 = WS_RWT + (size_t)2 * 2048 * 48 * 4;
constexpr int CW2_CNT0 = 1024, CW2_CUR0 = 1088, CW2_CNT1 = 1152, CW2_CUR1 = 1216;
constexpr int CW2_BAR = 2048;
constexpr int NBARREG = 4;
constexpr size_t CTL2_BYTES = (size_t)(CW2_BAR + NBARREG * XCD_BAR_WORDS) * 4;
static_assert(CTL2_BYTES <= CTL_BYTES, "ctl");
constexpr size_t U_XS = U_Y;

struct Args { const float* in[20]; float* out; unsigned char* ws; int ph_lo, ph_hi, bar_idx, pad; };

struct Frame {
    LAS unsigned char* lds; int tid, lane, wave, G, bx, vcu;
    unsigned char* ws; unsigned* ctl;
};

DI unsigned pk_bf16(float lo, float hi) { unsigned r; asm volatile("v_cvt_pk_bf16_f32 %0, %1, %2" : "=v"(r) : "v"(lo), "v"(hi)); return r; }
DI float fast_sigmoid(float x) { return __builtin_amdgcn_rcpf(1.0f + __expf(-x)); }

struct EpiProj0F { static constexpr bool PERM = true, AFTER_DRAIN = false;
    bf16_t* hq; float* hlf; bf16_t* hi; bf16_t* hgg; bf16_t* gq; bf16_t* gk; bf16_t* gv; bf16_t* gg; const float* lb;
    DI void operator()(const f32x4 (&acc)[2][2][4][2], const pg8::Unit& u, int wr, int wc, int fr, int fq) const {
        const int colt = u.pn * 256, seg = colt >> 10, row0 = u.pm * 256 + wr * 64 + fr, cl = (colt & 1023) + wc * 32 + 8 * fq;
        if (seg == 1) {
            f32x4 l0[2], l1[2];
#pragma unroll
            for (int bj = 0; bj < 2; ++bj) { l0[bj] = *(const f32x4*)(lb + cl + bj * 128); l1[bj] = *(const f32x4*)(lb + cl + bj * 128 + 4); }
#pragma unroll
            for (int ai = 0; ai < 2; ++ai)
#pragma unroll
                for (int m = 0; m < 4; ++m) { float* rowp = hlf + (size_t)(row0 + ai * 128 + m * 16) * 1024 + cl;
#pragma unroll
                    for (int bj = 0; bj < 2; ++bj) { f32x4 v0 = acc[ai][bj][m][0], v1 = acc[ai][bj][m][1];
#pragma unroll
                        for (int j = 0; j < 4; ++j) { v0[j] = __logf(l0[bj][j] + (1.0f - l0[bj][j]) * fast_sigmoid(v0[j])); v1[j] = __logf(l1[bj][j] + (1.0f - l1[bj][j]) * fast_sigmoid(v1[j])); }
                        *(f32x4*)(rowp + bj * 128) = v0; *(f32x4*)(rowp + bj * 128 + 4) = v1; } }
            return;
        }
        bf16_t* dst; int ld = 1024, co = cl; bool silu = false; float sc = 1.0f;
        if (seg == 0) { dst = hq; silu = true; sc = 0.08838834764831845f; }
        else if (seg == 2) dst = hi;
        else if (seg == 3) { dst = hgg; silu = true; }
        else if (seg == 4) { ld = 512; if ((colt & 1023) < 512) { dst = gq; sc = 0.08838834764831845f; } else { dst = gk; co = cl - 512; } }
        else if (seg == 5) dst = gv;
        else { dst = gg; silu = true; }
#pragma unroll
        for (int ai = 0; ai < 2; ++ai)
#pragma unroll
            for (int m = 0; m < 4; ++m) { bf16_t* rowp = dst + (size_t)(row0 + ai * 128 + m * 16) * ld + co;
#pragma unroll
                for (int bj = 0; bj < 2; ++bj) { f32x4 v0 = acc[ai][bj][m][0], v1 = acc[ai][bj][m][1];
                    if (silu) {
#pragma unroll
                        for (int j = 0; j < 4; ++j) { v0[j] *= fast_sigmoid(v0[j]); v1[j] *= fast_sigmoid(v1[j]); } }
                    v0 = v0 * sc; v1 = v1 * sc;
                    u32x4 w; w.x = pk_bf16(v0[0], v0[1]); w.y = pk_bf16(v0[2], v0[3]); w.z = pk_bf16(v1[0], v1[1]); w.w = pk_bf16(v1[2], v1[3]);
                    *(u32x4*)(rowp + bj * 128) = w; } }
    } };
struct EpiResidF { static constexpr bool PERM = false, AFTER_DRAIN = false;
    const float* res; float* out;
    DI void operator()(const f32x4 (&acc)[2][2][4][2], const pg8::Unit& u, int wr, int wc, int fr, int fq) const {
        const int row0 = u.pm * 256 + wr * 64 + fr, col0 = u.pn * 256 + wc * 32 + 4 * fq;
#pragma unroll
        for (int ai = 0; ai < 2; ++ai)
#pragma unroll
            for (int m = 0; m < 4; ++m) { const size_t ro = (size_t)(row0 + ai * 128 + m * 16) * D + col0;
#pragma unroll
                for (int bj = 0; bj < 2; ++bj)
#pragma unroll
                    for (int n = 0; n < 2; ++n) { const f32x4 r = *(const f32x4*)(res + ro + bj * 128 + n * 16); *(f32x4*)(out + ro + bj * 128 + n * 16) = r + acc[ai][bj][m][n]; } }
    } };
struct EpiBf16F { static constexpr bool PERM = true, AFTER_DRAIN = false;
    bf16_t* O; int ldc, nct, split_tiles; size_t split_stride;
    DI void operator()(const f32x4 (&acc)[2][2][4][2], const pg8::Unit& u, int wr, int wc, int fr, int fq) const {
        int ct = u.pn % nct; bf16_t* base = O; if (split_tiles) { const int t = ct / split_tiles; base += (size_t)t * split_stride; ct -= t * split_tiles; }
        const int row0 = u.pm * 256 + wr * 64 + fr, col0 = ct * 256 + wc * 32 + 8 * fq;
#pragma unroll
        for (int ai = 0; ai < 2; ++ai)
#pragma unroll
            for (int m = 0; m < 4; ++m) { bf16_t* rowp = base + (size_t)(row0 + ai * 128 + m * 16) * ldc + col0;
#pragma unroll
                for (int bj = 0; bj < 2; ++bj) { const f32x4 v0 = acc[ai][bj][m][0], v1 = acc[ai][bj][m][1];
                    u32x4 w; w.x = pk_bf16(v0[0], v0[1]); w.y = pk_bf16(v0[2], v0[3]); w.z = pk_bf16(v1[0], v1[1]); w.w = pk_bf16(v1[2], v1[3]);
                    *(u32x4*)(rowp + bj * 128) = w; } }
    } };
struct EpiSwigluF { static constexpr bool PERM = true, AFTER_DRAIN = false;
    bf16_t* O;
    DI void operator()(const f32x4 (&acc)[2][2][4][2], const pg8::Unit& u, int wr, int wc, int fr, int fq) const {
        const int row0 = u.pm * 256 + wr * 64 + fr, col0 = (u.pn & 3) * 128 + wc * 32 + 8 * fq;
#pragma unroll
        for (int ai = 0; ai < 2; ++ai)
#pragma unroll
            for (int m = 0; m < 4; ++m) { bf16_t* rowp = O + (size_t)(row0 + ai * 128 + m * 16) * DEXP + col0;
                f32x4 a0 = acc[ai][0][m][0], a1 = acc[ai][0][m][1]; const f32x4 b0 = acc[ai][1][m][0], b1 = acc[ai][1][m][1];
#pragma unroll
                for (int j = 0; j < 4; ++j) { a0[j] = a0[j] * fast_sigmoid(a0[j]) * b0[j]; a1[j] = a1[j] * fast_sigmoid(a1[j]) * b1[j]; }
                u32x4 w; w.x = pk_bf16(a0[0], a0[1]); w.y = pk_bf16(a0[2], a0[3]); w.z = pk_bf16(a1[0], a1[1]); w.w = pk_bf16(a1[2], a1[3]);
                *(u32x4*)rowp = w; }
    } };
struct MoeOrder {
    int nN, shift, nunits, G, c; const LAS int* tile_e;
    DI bool next(int i, pg8::Unit& u) const { const long L = (long)i * G + c; if (L >= nunits) return false; const int t = (int)L >> shift, pn = (int)L & (nN - 1);
        u.pm = t; u.pn = tile_e[t] * nN + pn; return true; }
    DI void a_ready(const pg8::Unit&) const {}
    DI void done(const pg8::Unit&) const {}
};

struct TJob { const float* src; bf16_t* dst; int ld, Kd, k0, n0, mode, half; };
DI void tjob_decode(int j, const Args& a, unsigned char* ws, TJob& t) {
    const float* w_in = a.in[4]; const float* w_out = a.in[10]; const float* w_qkv = a.in[11]; const float* w_o = a.in[12];
    const float* ew1 = a.in[17]; const float* ew3 = a.in[18]; const float* ew2 = a.in[19];
    t.mode = 0; t.half = 0;
    if (j < 896) { t.src = w_in; t.dst = (bf16_t*)(ws + WS_WIN); t.ld = EVEN_IN; t.Kd = D; t.k0 = (j / 56) * 128; t.n0 = (j % 56) * 128; return; }
    j -= 896;
    if (j < 256) { t.src = w_out; t.dst = (bf16_t*)(ws + WS_WOUT); t.ld = D; t.Kd = D; t.k0 = (j / 16) * 128; t.n0 = (j % 16) * 128; return; }
    j -= 256;
    if (j < 768) { t.src = w_qkv; t.dst = (bf16_t*)(ws + WS_WQKV); t.ld = 3 * D; t.Kd = D; t.k0 = (j / 48) * 128; t.n0 = (j % 48) * 128; return; }
    j -= 768;
    if (j < 256) { t.src = w_o; t.dst = (bf16_t*)(ws + WS_WO); t.ld = D; t.Kd = D; t.k0 = (j / 16) * 128; t.n0 = (j % 16) * 128; return; }
    j -= 256;
    const int le = j / 192, r = j % 192;
    if (r < 128) { const int hf = r / 64, q = r % 64; t.src = (hf ? ew3 : ew1) + (size_t)le * D * DEXP; t.dst = (bf16_t*)(ws + WS_WUP) + (size_t)le * 1024 * D; t.ld = DEXP; t.Kd = D;
        t.k0 = (q / 4) * 128; t.n0 = (q % 4) * 128; t.mode = 1; t.half = hf; return; }
    { const int q = r - 128; t.src = ew2 + (size_t)le * DEXP * D; t.dst = (bf16_t*)(ws + WS_WDN) + (size_t)le * D * DEXP; t.ld = D; t.Kd = DEXP; t.k0 = (q / 16) * 128; t.n0 = (q % 16) * 128; }
}
constexpr int N_TJOBS = 896 + 256 + 768 + 256 + 64 * 192;
DI void tjob_load(const TJob& t, int tid, f32x4 (&r)[8]) {
    const int c4 = (tid & 31) * 4, r0 = tid >> 5;
#pragma unroll
    for (int i = 0; i < 8; ++i) r[i] = *(const f32x4*)(t.src + (size_t)(t.k0 + r0 + 16 * i) * t.ld + t.n0 + c4);
}
DI void phase_transposes(const Frame& F, const Args& a) {
    LAS float* T = (LAS float*)F.lds;
    const int tid = F.tid; int j = F.bx; if (j >= N_TJOBS) return;
    TJob t; tjob_decode(j, a, F.ws, t); f32x4 r[8]; tjob_load(t, tid, r);
    for (;;) {
        const int c4 = (tid & 31) * 4, r0 = tid >> 5;
#pragma unroll
        for (int i = 0; i < 8; ++i) *(LAS f32x4*)(T + (r0 + 16 * i) * 132 + c4) = r[i];
        const TJob cur = t; const int jn = j + F.G; const bool more = jn < N_TJOBS;
        if (more) { tjob_decode(jn, a, F.ws, t); tjob_load(t, tid, r); }
        __syncthreads();
        { const int n = tid & 127, kg = tid >> 7; const int nn = cur.n0 + n;
          const int drow = cur.mode == 0 ? nn : (nn / 128) * 256 + cur.half * 128 + (nn % 128);
          bf16_t* dp = cur.dst + (size_t)drow * cur.Kd + cur.k0 + kg * 32;
#pragma unroll
          for (int q = 0; q < 4; ++q) { float v[8];
#pragma unroll
              for (int e = 0; e < 8; ++e) v[e] = T[(kg * 32 + q * 8 + e) * 132 + n];
              u32x4 w; w.x = pk_bf16(v[0], v[1]); w.y = pk_bf16(v[2], v[3]); w.z = pk_bf16(v[4], v[5]); w.w = pk_bf16(v[6], v[7]);
              *(u32x4*)(dp + q * 8) = w; } }
        __syncthreads();
        if (!more) break; j = jn;
    }
}
DI void phase_tables(const Frame& F, const Args& a) {
    const int gt = F.bx * NTHR + F.tid, gn = F.G * NTHR;
    float* LB = (float*)(F.ws + SM_LB); const float* lg = a.in[5];
    for (int d = gt; d < HG_QK; d += gn) { const float x = lg[d], y = lg[HG_QK + d], z = lg[2 * HG_QK + d], m = fmaxf(x, fmaxf(y, z));
        const float ex = __expf(x - m), ey = __expf(y - m), ez = __expf(z - m); LB[d] = ex / (ex + ey + ez); }
    float* RWT = (float*)(F.ws + WS_RWT);
    for (int i = gt; i < 2 * 2048 * 48; i += gn) { const int l = i / (2048 * 48), r = i % (2048 * 48); const int jj = r & 3, ln = (r >> 2) & 63, nt = (r >> 8) % 3, s = r / 768;
        const int k = 16 * s + 4 * (ln >> 4) + jj, n = 16 * nt + (ln & 15);
        float w = 0.f; if (n < 4) w = a.in[13][((size_t)l * D + k) * NGRP + n]; else if (n < 36) w = a.in[15][((size_t)l * D + k) * NEXP + (n - 4)];
        RWT[i] = w * a.in[2][l * D + k]; }
}

template <int MODE, bool COMBINE>
DI void phase_norm(const Frame& F, const float* src, float* hdst, const float* gain, bf16_t* xn, float* fout,
                   const bf16_t* Y, const int* slot, const float* wgt,
                   const float* w_in, float* glow, const float* rwt, const float* bg, const float* be, int* eid, float* wgt_out, unsigned* cnt) {
    const int lane = F.lane, w = F.wave;
    LAS float* rs = (LAS float*)(F.lds + LDS_MISC + MI_RSTD); LAS float* lgt = (LAS float*)(F.lds + LDS_MISC + MI_LOGIT);
    LAS f32x4* part = (LAS f32x4*)F.lds;
    for (int rb = F.bx; rb < NTOK / 64; rb += F.G) {
        const int r0 = rb * 64;
#pragma unroll 1
        for (int i = 0; i < 8; ++i) { const int row = r0 + w * 8 + i; const float* hr = src + (size_t)row * D;
            f32x4 v[8];
#pragma unroll
            for (int j = 0; j < 8; ++j) v[j] = *(const f32x4*)(hr + j * 256 + lane * 4);
            if (COMBINE) { const int s0 = slot[row * 2], s1 = slot[row * 2 + 1]; const float w0 = wgt[row * 2], w1 = wgt[row * 2 + 1];
#pragma unroll
                for (int j = 0; j < 8; ++j) { const u32x2 ya = *(const u32x2*)(Y + (size_t)s0 * D + j * 256 + lane * 4), yb = *(const u32x2*)(Y + (size_t)s1 * D + j * 256 + lane * 4);
                    v[j][0] += w0 * __uint_as_float(ya[0] << 16) + w1 * __uint_as_float(yb[0] << 16); v[j][1] += w0 * __uint_as_float(ya[0] & 0xFFFF0000u) + w1 * __uint_as_float(yb[0] & 0xFFFF0000u);
                    v[j][2] += w0 * __uint_as_float(ya[1] << 16) + w1 * __uint_as_float(yb[1] << 16); v[j][3] += w0 * __uint_as_float(ya[1] & 0xFFFF0000u) + w1 * __uint_as_float(yb[1] & 0xFFFF0000u); }
                if (MODE != 3) {
#pragma unroll
                    for (int j = 0; j < 8; ++j) *(f32x4*)(hdst + (size_t)row * D + j * 256 + lane * 4) = v[j]; } }
            float ss = 0.f;
#pragma unroll
            for (int j = 0; j < 8; ++j) ss += v[j][0] * v[j][0] + v[j][1] * v[j][1] + v[j][2] * v[j][2] + v[j][3] * v[j][3];
            ss = wave_sum(ss); const float rstd = rsqrtf(ss * (1.0f / D) + EPS);
            if (MODE == 1 || MODE == 2) { if (lane == 0) rs[w * 8 + i] = rstd; }
#pragma unroll
            for (int j = 0; j < 8; ++j) { const f32x4 g4 = *(const f32x4*)(gain + j * 256 + lane * 4); const f32x4 o = v[j] * g4 * rstd;
                if (MODE == 3) *(f32x4*)(fout + (size_t)row * D + j * 256 + lane * 4) = o;
                else { u32x2 p; p[0] = pk_bf16(o[0], o[1]); p[1] = pk_bf16(o[2], o[3]); *(u32x2*)(xn + (size_t)row * D + j * 256 + lane * 4) = p; } }
        }
        if (MODE == 1 || MODE == 2) {
            constexpr int NT = MODE == 2 ? 3 : 1;
            __builtin_amdgcn_fence(__ATOMIC_RELEASE, "workgroup"); __syncthreads(); __builtin_amdgcn_fence(__ATOMIC_ACQUIRE, "workgroup");
            const int rg = w & 3, kh = w >> 2, m = lane & 15, kq = lane >> 4;
            const float* xr = (COMBINE ? hdst : src) + (size_t)(r0 + rg * 16 + m) * D + 4 * kq;
            f32x4 acc[NT];
#pragma unroll
            for (int t = 0; t < NT; ++t) acc[t] = (f32x4){0.f, 0.f, 0.f, 0.f};
#pragma unroll 2
            for (int s = kh * 64; s < kh * 64 + 64; ++s) {
                const f32x4 xa = *(const f32x4*)(xr + 16 * s);
                f32x4 wb[NT];
                if (MODE == 2) {
#pragma unroll
                    for (int t = 0; t < NT; ++t) wb[t] = *(const f32x4*)(rwt + ((size_t)(s * 3 + t) * 64 + lane) * 4); }
                else {
#pragma unroll
                    for (int j = 0; j < 4; ++j) { const int k = 16 * s + 4 * kq + j; wb[0][j] = w_in[(size_t)k * EVEN_IN + EVEN_MAIN + m] * gain[k]; } }
#pragma unroll
                for (int j = 0; j < 4; ++j)
#pragma unroll
                    for (int t = 0; t < NT; ++t) acc[t] = __builtin_amdgcn_mfma_f32_16x16x4f32(xa[j], wb[t][j], acc[t], 0, 0, 0);
            }
            if (kh == 1) {
#pragma unroll
                for (int t = 0; t < NT; ++t) part[(rg * 3 + t) * 64 + lane] = acc[t]; }
            __syncthreads();
            if (kh == 0) {
#pragma unroll
                for (int t = 0; t < NT; ++t) { const f32x4 p = part[(rg * 3 + t) * 64 + lane];
#pragma unroll
                    for (int q = 0; q < 4; ++q) { const int rl = rg * 16 + 4 * kq + q; const float val = (acc[t][q] + p[q]) * rs[rl];
                        if (MODE == 1) glow[(size_t)(r0 + rl) * 16 + m] = val; else lgt[rl * 48 + t * 16 + m] = val; } } }
            __syncthreads();
            if (MODE == 2 && F.tid < 64) {
                const int row = r0 + F.tid; const LAS float* lr = lgt + F.tid * 48;
                float lg[4], e8[8];
#pragma unroll
                for (int c = 0; c < 4; ++c) lg[c] = lr[c] + bg[c];
                int grp = 0; float mx = lg[0];
#pragma unroll
                for (int c = 1; c < 4; ++c) if (lg[c] > mx) { mx = lg[c]; grp = c; }
                float den = 0.f;
#pragma unroll
                for (int c = 0; c < 4; ++c) den += __expf(lg[c] - mx);
                const float pg = 1.0f / den;
#pragma unroll
                for (int c = 0; c < 8; ++c) e8[c] = lr[4 + grp * 8 + c] + be[grp * 8 + c];
                int j0 = 0; float v0 = e8[0];
#pragma unroll
                for (int c = 1; c < 8; ++c) if (e8[c] > v0) { v0 = e8[c]; j0 = c; }
                int j1 = 0; float v1 = -3.0e38f;
#pragma unroll
                for (int c = 0; c < 8; ++c) if (c != j0 && e8[c] > v1) { v1 = e8[c]; j1 = c; }
                const float e1 = __expf(v1 - v0), sden = 1.0f / (1.0f + e1);
                const int ea = grp * 8 + j0, eb = grp * 8 + j1;
                eid[row * 2] = ea; eid[row * 2 + 1] = eb; wgt_out[row * 2] = pg * sden; wgt_out[row * 2 + 1] = pg * e1 * sden;
                atomicAdd(&cnt[ea], 1u); atomicAdd(&cnt[eb], 1u);
            }
            __syncthreads();
        }
    }
}

DI void moe_plan(const Frame& F, const unsigned* cnt) {
    LAS int* tile_e = (LAS int*)(F.lds + LDS_MISC + MI_TILEE); LAS int* ebase = (LAS int*)(F.lds + LDS_MISC + MI_EBASE); LAS int* ntp = (LAS int*)(F.lds + LDS_MISC + MI_NT);
    if (F.tid == 0) { int t = 0;
        for (int e = 0; e < NEXP; ++e) { const int c = (int)__hip_atomic_load(cnt + e, __ATOMIC_RELAXED, __HIP_MEMORY_SCOPE_AGENT); const int nt = (c + MOE_TILE - 1) / MOE_TILE; ebase[e] = t * MOE_TILE;
            for (int i = 0; i < nt && t + i < MOE_MAXT; ++i) tile_e[t + i] = e; t += nt; }
        if (t > MOE_MAXT) t = MOE_MAXT; *ntp = t; }
    __syncthreads();
}
DI void phase_scatter(const Frame& F, const int* eid, unsigned* cur, int* slot, const bf16_t* xn, bf16_t* xs) {
    const LAS int* ebase = (const LAS int*)(F.lds + LDS_MISC + MI_EBASE);
    for (int blk = F.bx; blk < (2 * NTOK) / 128; blk += F.G) {
        const int i0 = blk * 128 + F.wave * 16; int myslot = 0;
        if (F.lane < 16) { const int e = eid[i0 + F.lane]; const unsigned p = __hip_atomic_fetch_add(cur + e, 1u, __ATOMIC_RELAXED, __HIP_MEMORY_SCOPE_AGENT); myslot = ebase[e] + (int)p; slot[i0 + F.lane] = myslot; }
#pragma unroll 4
        for (int q = 0; q < 16; ++q) { const int s = __shfl(myslot, q); const int tok = (i0 + q) >> 1;
            const u32x4* sp = (const u32x4*)(xn + (size_t)tok * D) + F.lane; u32x4* dp = (u32x4*)(xs + (size_t)s * D) + F.lane;
#pragma unroll
            for (int c = 0; c < 4; ++c) dp[c * 64] = sp[c * 64]; }
    }
}
DI void phase_kmean(const Frame& F, const bf16_t* Kb, float* kmean) {
    LAS float* red = (LAS float*)F.lds;
    for (int it = F.bx; it < NB * MB_H * MB_NBLK; it += F.G) {
        const int n = it % MB_NBLK, hh = (it / MB_NBLK) % MB_H, b = it / (MB_NBLK * MB_H);
        const int kg = F.tid >> 4, d8 = (F.tid & 15) * 8; float s[8];
#pragma unroll
        for (int e = 0; e < 8; ++e) s[e] = 0.f;
        const bf16_t* p = Kb + ((size_t)b * SEQ + n * MB_BLK + kg * 8) * D + hh * MB_DH + d8;
#pragma unroll
        for (int j = 0; j < 8; ++j) { const u32x4 v = *(const u32x4*)(p + (size_t)j * D);
#pragma unroll
            for (int e = 0; e < 4; ++e) { s[2 * e] += __uint_as_float(v[e] << 16); s[2 * e + 1] += __uint_as_float(v[e] & 0xFFFF0000u); } }
#pragma unroll
        for (int e = 0; e < 8; ++e) red[kg * 128 + d8 + e] = s[e];
        __syncthreads();
        if (F.tid < 128) { float t = 0.f;
#pragma unroll
            for (int g = 0; g < 32; ++g) t += red[g * 128 + F.tid];
            kmean[(size_t)it * MB_DH + F.tid] = t * (1.0f / MB_BLK); }
        __syncthreads();
    }
}

enum { PH_PRO = 0, PH_GEMM1 = 1, PH_SCAN = 2, PH_OUTP = 3, PH_NORM_F0 = 4, PH_SCAT0 = 5, PH_UP0 = 6, PH_DN0 = 7, PH_COMB0 = 8, PH_QKV = 9, PH_KMEAN = 10, PH_ATTN = 11,
       PH_OPROJ = 12, PH_NORM_F1 = 13, PH_SCAT1 = 14, PH_UP1 = 15, PH_DN1 = 16, PH_FINAL = 17, PH_END = 18 };

__global__ void __launch_bounds__(NTHR, 2) mk_fwd(Args a) {
    extern __shared__ __attribute__((aligned(16))) unsigned char lds_raw[];
    Frame F; F.lds = (LAS unsigned char*)lds_raw; F.tid = threadIdx.x; F.lane = F.tid & 63; F.wave = __builtin_amdgcn_readfirstlane(F.tid >> 6);
    F.G = gridDim.x; F.bx = blockIdx.x; F.vcu = (F.G % 8 == 0) ? (F.bx % 8) * (F.G / 8) + F.bx / 8 : F.bx;
    F.ws = a.ws; F.ctl = (unsigned*)(a.ws + WS_CTL);
    unsigned char* ws = a.ws;
    if (F.tid < 4) ((LAS unsigned*)(F.lds + LDS_MISC + MI_BAR))[F.tid] = 0u;
    __syncthreads();
    const int lo = a.ph_lo, hi = a.ph_hi;
    XcdBarrier bar; bar.bar = F.ctl + CW2_BAR + a.bar_idx * XCD_BAR_WORDS; bar.x = 0; bar.st = (volatile LAS unsigned*)(F.lds + LDS_MISC + MI_BAR);
    if (hi - lo > 1) bar = xcd_barrier_post(F.ctl + CW2_BAR + a.bar_idx * XCD_BAR_WORDS, (volatile LAS unsigned*)(F.lds + LDS_MISC + MI_BAR));
#define IN(k) (lo <= (k) && (k) < hi)
#define SEAM(k) do { if (IN(k) && IN((k) + 1)) xcd_barrier(bar); } while (0)
    const float* x = a.in[0]; const float* norm_mix = a.in[1]; const float* norm_ffn = a.in[2]; const float* norm_final = a.in[3];
    bf16_t* WinT = (bf16_t*)(ws + WS_WIN); bf16_t* WoutT = (bf16_t*)(ws + WS_WOUT); bf16_t* WqkvT = (bf16_t*)(ws + WS_WQKV); bf16_t* WoT = (bf16_t*)(ws + WS_WO);
    bf16_t* Wup = (bf16_t*)(ws + WS_WUP); bf16_t* Wdn = (bf16_t*)(ws + WS_WDN);
    bf16_t* XN = (bf16_t*)(ws + WS_XN); float* H = (float*)(ws + WS_H);
    float* LB = (float*)(ws + SM_LB); float* KMEAN = (float*)(ws + SM_KMEAN);
    float* GLOW = (float*)(ws + WS_GLOW); int* EID = (int*)(ws + WS_EID); float* WGT = (float*)(ws + WS_WGT); int* SLOT = (int*)(ws + WS_SLOT);
    float* RWT = (float*)(ws + WS_RWT);
    bf16_t* Qb = (bf16_t*)(ws + U_Q); bf16_t* Kb = (bf16_t*)(ws + U_K); bf16_t* Vb = (bf16_t*)(ws + U_V);
    bf16_t* HMID = (bf16_t*)(ws + U_HMID); bf16_t* Y = (bf16_t*)(ws + U_Y); bf16_t* XS = (bf16_t*)(ws + U_XS);
    const LAS int* tile_e = (const LAS int*)(F.lds + LDS_MISC + MI_TILEE); const LAS int* ntp = (const LAS int*)(F.lds + LDS_MISC + MI_NT);

    if (IN(PH_PRO)) {
        phase_tables(F, a);
        phase_norm<1, false>(F, x, nullptr, norm_mix, XN, nullptr, nullptr, nullptr, nullptr, a.in[4], GLOW, nullptr, nullptr, nullptr, nullptr, nullptr, nullptr);
        __syncthreads();
        phase_transposes(F, a);
    }
    SEAM(PH_PRO);
    if (IN(PH_GEMM1)) {
        pg8::Gemm g{XN, WinT, NTOK, EVEN_MAIN, D}; pg8::StaticOrder S; S.init(NTOK, EVEN_MAIN, F.G, F.bx);
        EpiProj0F E{(bf16_t*)(ws + U_HQ), (float*)(ws + U_HLF), (bf16_t*)(ws + U_HI), (bf16_t*)(ws + U_HGG), (bf16_t*)(ws + U_GQ), (bf16_t*)(ws + U_GK), (bf16_t*)(ws + U_GV), (bf16_t*)(ws + U_GG), LB};
        pg8::gemm_phase<EpiProj0F, pg8::StaticOrder, true, true>(F.lds, g, S, E);
    }
    SEAM(PH_GEMM1);
    SEAM(PH_SCAN);
    if (IN(PH_OUTP)) {
        pg8::Gemm g{XN, WoutT, NTOK, D, D}; pg8::StaticOrder S; S.init(NTOK, D, F.G, F.bx);
        EpiResidF E{x, H};
        pg8::gemm_phase<EpiResidF, pg8::StaticOrder, true, true>(F.lds, g, S, E);
    }
    SEAM(PH_OUTP);
#define MOE_LAYER(l, PHN, PHS, PHU, PHD, CNT, CUR)                                                                                              \
    if (IN(PHN)) phase_norm<2, false>(F, H, nullptr, norm_ffn + (l) * D, XN, nullptr, nullptr, nullptr, nullptr, nullptr, nullptr,              \
                                      RWT + (size_t)(l) * 2048 * 48, a.in[14] + (l) * NGRP, a.in[16] + (l) * NEXP, EID, WGT, F.ctl + CNT);        \
    SEAM(PHN);                                                                                                                                  \
    if (IN(PHS)) { moe_plan(F, F.ctl + CNT); phase_scatter(F, EID, F.ctl + CUR, SLOT, XN, XS); }                                                \
    SEAM(PHS);                                                                                                                                  \
    if (IN(PHU)) { moe_plan(F, F.ctl + CNT);                                                                                                    \
        pg8::Gemm g{XS, Wup + (size_t)(l) * NEXP * 1024 * D, MOE_ROWS, NEXP * 1024, D}; MoeOrder S{4, 2, *ntp * 4, F.G, F.vcu, tile_e};          \
        EpiSwigluF E{HMID}; pg8::gemm_phase<EpiSwigluF, MoeOrder, true, true>(F.lds, g, S, E); }                                                \
    SEAM(PHU);                                                                                                                                  \
    if (IN(PHD)) { moe_plan(F, F.ctl + CNT);                                                                                                    \
        pg8::Gemm g{HMID, Wdn + (size_t)(l) * NEXP * D * DEXP, MOE_ROWS, NEXP * D, DEXP}; MoeOrder S{8, 3, *ntp * 8, F.G, F.vcu, tile_e};        \
        EpiBf16F E{Y, D, 8, 0, 0}; pg8::gemm_phase<EpiBf16F, MoeOrder, true, true>(F.lds, g, S, E); }                                           \
    SEAM(PHD);
    MOE_LAYER(0, PH_NORM_F0, PH_SCAT0, PH_UP0, PH_DN0, CW2_CNT0, CW2_CUR0)
    if (IN(PH_COMB0)) phase_norm<0, true>(F, H, H, norm_mix + D, XN, nullptr, Y, SLOT, WGT, nullptr, nullptr, nullptr, nullptr, nullptr, nullptr, nullptr, nullptr);
    SEAM(PH_COMB0);
    if (IN(PH_QKV)) {
        pg8::Gemm g{XN, WqkvT, NTOK, 3 * D, D}; pg8::StaticOrder S; S.init(NTOK, 3 * D, F.G, F.bx);
        EpiBf16F E{Qb, D, 24, 8, (size_t)NTOK * D};
        pg8::gemm_phase<EpiBf16F, pg8::StaticOrder, true, true>(F.lds, g, S, E);
    }
    SEAM(PH_QKV);
    if (IN(PH_KMEAN)) phase_kmean(F, Kb, KMEAN);
    SEAM(PH_KMEAN);
    SEAM(PH_ATTN);
    if (IN(PH_OPROJ)) {
        pg8::Gemm g{XN, WoT, NTOK, D, D}; pg8::StaticOrder S; S.init(NTOK, D, F.G, F.bx);
        EpiResidF E{H, H};
        pg8::gemm_phase<EpiResidF, pg8::StaticOrder, true, true>(F.lds, g, S, E);
    }
    SEAM(PH_OPROJ);
    MOE_LAYER(1, PH_NORM_F1, PH_SCAT1, PH_UP1, PH_DN1, CW2_CNT1, CW2_CUR1)
    if (IN(PH_FINAL)) phase_norm<3, true>(F, H, nullptr, norm_final, nullptr, a.out, Y, SLOT, WGT, nullptr, nullptr, nullptr, nullptr, nullptr, nullptr, nullptr, nullptr);
#undef IN
#undef SEAM
#undef MOE_LAYER
}


extern "C" void kernel_launch(void* const* d_in, const int* in_sizes, int n_in, void* d_out, int out_size, void* d_ws, size_t ws_size, hipStream_t stream) {
    static int grid = 0;
    if (grid == 0) {
        if (n_in != 20 || out_size != NTOK * D || ws_size < WS_TOTAL2) { fprintf(stderr, "kernel_launch: unexpected shapes / workspace (%d inputs, out %d, ws %zu need %zu)\n", n_in, out_size, ws_size, (size_t)WS_TOTAL2); grid = -1; return; }
        int dev = 0, cus = 0;
        if (hipGetDevice(&dev) != hipSuccess || hipDeviceGetAttribute(&cus, hipDeviceAttributeMultiprocessorCount, dev) != hipSuccess || cus <= 0) { grid = -1; return; }
        if (hipFuncSetAttribute((const void*)mk_fwd, hipFuncAttributeMaxDynamicSharedMemorySize, LDS_BYTES) != hipSuccess) { fprintf(stderr, "kernel_launch: hipFuncSetAttribute failed\n"); grid = -1; return; }
        int per_cu = 0; (void)hipOccupancyMaxActiveBlocksPerMultiprocessor(&per_cu, (const void*)mk_fwd, NTHR, LDS_BYTES); (void)hipGetLastError();
        if (per_cu < 1) fprintf(stderr, "kernel_launch: occupancy query reports %d\n", per_cu);
        grid = cus;
    }
    if (grid < 0) return;
    const float* x = (const float*)d_in[0];
    const float* hg_norm = (const float*)d_in[6]; const float* gk2 = (const float*)d_in[7]; const float* gkb = (const float*)d_in[8]; const float* gla_norm = (const float*)d_in[9];
    unsigned char* ws = (unsigned char*)d_ws;
    bf16_t* XN = (bf16_t*)(ws + WS_XN); float* H = (float*)(ws + WS_H);
    float* KMEAN = (float*)(ws + SM_KMEAN); float* GLOW = (float*)(ws + WS_GLOW);
    bf16_t* HQ = (bf16_t*)(ws + U_HQ); float* HLF = (float*)(ws + U_HLF); bf16_t* HI = (bf16_t*)(ws + U_HI); bf16_t* HGG = (bf16_t*)(ws + U_HGG);
    bf16_t* GQ = (bf16_t*)(ws + U_GQ); bf16_t* GK = (bf16_t*)(ws + U_GK); bf16_t* GV = (bf16_t*)(ws + U_GV); bf16_t* GG = (bf16_t*)(ws + U_GG);
    bf16_t* Qb = (bf16_t*)(ws + U_Q); bf16_t* Kb = (bf16_t*)(ws + U_K); bf16_t* Vb = (bf16_t*)(ws + U_V);
    (void)x;
    (void)hipMemsetAsync(ws + WS_CTL, 0, CTL_BYTES, stream);
    Args a{};
    for (int i = 0; i < 20; ++i) a.in[i] = (const float*)d_in[i];
    a.out = (float*)d_out; a.ws = ws;
    auto run = [&](int lo, int hi, int bi) { a.ph_lo = lo; a.ph_hi = hi; a.bar_idx = bi; a.pad = 0; hipLaunchKernelGGL(mk_fwd, dim3(grid), dim3(NTHR), LDS_BYTES, stream, a); };
    run(PH_PRO, PH_SCAN, 0);
    k_scan_naive<128, false><<<NB * HG_H, 128, 0, stream>>>(HQ, HLF, nullptr, HI, nullptr, nullptr, nullptr, H, HG_H, 0);
    k_scan_naive<256, true><<<NB * GL_H, 256, 0, stream>>>(GQ, nullptr, GK, GV, GLOW, gk2, gkb, H, GL_H, 1024);
    k_norm_gate<<<NTOK * 12 / 4, 256, 0, stream>>>(H, hg_norm, gla_norm, HGG, GG, XN);
    run(PH_OUTP, PH_ATTN, 1);
    k_moba_naive<<<NB * MB_H * SEQ / 4, 256, 0, stream>>>(Qb, Kb, Vb, KMEAN, XN);
    run(PH_OPROJ, PH_END, 2);
}
```

```cpp
#include <hip/hip_runtime.h>
#include <cstdio>
#include <cstdint>

typedef unsigned short bf16_t;
#define DI __device__ __forceinline__

constexpr int D = 2048, NB = 4, SEQ = 4096, NTOK = NB * SEQ;
constexpr int HG_H = 8, HG_DK = 128, HG_DV = 128, HG_QK = 1024, HG_V = 1024;
constexpr int GL_H = 4, GL_DK = 128, GL_DV = 256, GL_QK = 512, GL_V = 1024, GL_RANK = 16;
constexpr int EVEN_IN = 7184, EVEN_MAIN = 7168;
constexpr int MB_H = 16, MB_DH = 128, MB_BLK = 256, MB_NBLK = SEQ / MB_BLK;
constexpr int NEXP = 32, NGRP = 4, EPG = 8, DEXP = 512;
constexpr int MOE_TILE = 256, MOE_MAXT = (2 * NTOK) / MOE_TILE + NEXP, MOE_ROWS = MOE_MAXT * MOE_TILE;
constexpr float EPS = 1e-6f;

constexpr size_t MBy = 1024 * 1024;
constexpr size_t WS_CTL   = 0;
constexpr size_t CTL_BYTES = 64 * 1024;
constexpr size_t WS_SMALL = WS_CTL + CTL_BYTES;
constexpr size_t WS_WIN   = WS_SMALL + 1 * MBy;
constexpr size_t WS_WOUT  = WS_WIN + (size_t)EVEN_MAIN * D * 2;
constexpr size_t WS_WQKV  = WS_WOUT + (size_t)D * D * 2;
constexpr size_t WS_WO    = WS_WQKV + (size_t)3 * D * D * 2;
constexpr size_t WS_WUP   = WS_WO + (size_t)D * D * 2;
constexpr size_t WS_WDN   = WS_WUP + (size_t)2 * NEXP * 1024 * D * 2;
constexpr size_t WS_XN    = WS_WDN + (size_t)2 * NEXP * D * DEXP * 2;
constexpr size_t WS_H     = WS_XN + (size_t)NTOK * D * 2;
constexpr size_t WS_U     = WS_H + (size_t)NTOK * D * 4;
constexpr size_t U_HQ  = WS_U;
constexpr size_t U_HLF = U_HQ + (size_t)NTOK * 1024 * 2;
constexpr size_t U_HI  = U_HLF + (size_t)NTOK * 1024 * 4;
constexpr size_t U_HGG = U_HI + (size_t)NTOK * 1024 * 2;
constexpr size_t U_GQ  = U_HGG + (size_t)NTOK * 1024 * 2;
constexpr size_t U_GK  = U_GQ + (size_t)NTOK * 512 * 2;
constexpr size_t U_GV  = U_GK + (size_t)NTOK * 512 * 2;
constexpr size_t U_GG  = U_GV + (size_t)NTOK * 1024 * 2;
constexpr size_t U_END0 = U_GG + (size_t)NTOK * 1024 * 2;
constexpr size_t U_Q = WS_U, U_K = U_Q + (size_t)NTOK * D * 2, U_V = U_K + (size_t)NTOK * D * 2, U_END1 = U_V + (size_t)NTOK * D * 2;
constexpr size_t U_HMID = WS_U;
constexpr size_t U_Y = U_HMID + (size_t)MOE_ROWS * DEXP * 2;
constexpr size_t U_END2 = U_Y + (size_t)MOE_ROWS * D * 2;
constexpr size_t U_BYTES = U_END0 - WS_U;
static_assert(U_END1 - WS_U <= U_BYTES && U_END2 - WS_U <= U_BYTES, "union");
constexpr size_t WS_END = WS_U + U_BYTES;
constexpr size_t SM_LB    = WS_SMALL;
constexpr size_t SM_GLOW  = SM_LB + 4096;
constexpr size_t SM_KMEAN = WS_SMALL + 64 * 1024;
constexpr size_t SM_TILEE = SM_KMEAN + 512 * 1024;
constexpr size_t WS_GLOW  = WS_END;
constexpr size_t WS_EID   = WS_GLOW + (size_t)NTOK * 16 * 4;
constexpr size_t WS_WGT   = WS_EID + (size_t)NTOK * 2 * 4;
constexpr size_t WS_SLOT  = WS_WGT + (size_t)NTOK * 2 * 4;
constexpr size_t WS_ROWTOK = WS_SLOT + (size_t)NTOK * 2 * 4;
constexpr size_t WS_TOTAL = WS_ROWTOK + (size_t)MOE_ROWS * 4;
constexpr int CW_CNT = 0;
constexpr int CW_CUR = 64;
constexpr int CW_BASE = 128;
constexpr int CW_NT = 192;

DI float bf2f(bf16_t b) { return __uint_as_float(((unsigned)b) << 16); }
DI bf16_t f2bf(float f) { unsigned u = __float_as_uint(f); u += 0x7FFFu + ((u >> 16) & 1u); return (bf16_t)(u >> 16); }
DI float sigmoidf_(float x) { return 1.0f / (1.0f + __expf(-x)); }
DI float siluf_(float x) { return x / (1.0f + __expf(-x)); }
DI float wave_sum(float v) { for (int o = 32; o > 0; o >>= 1) v += __shfl_xor(v, o); return v; }

template <int MODE>
__global__ void k_transpose(const float* __restrict__ src, bf16_t* __restrict__ dst, int K, int N, int ld, int c0, int half, size_t src_bstride, size_t dst_bstride) {
    __shared__ float t[64][65];
    src += (size_t)blockIdx.z * src_bstride; dst += (size_t)blockIdx.z * dst_bstride;
    const int k0 = blockIdx.y * 64, n0 = blockIdx.x * 64, tx = threadIdx.x & 63, ty = threadIdx.x >> 6;
    for (int i = ty; i < 64; i += 4) t[i][tx] = src[(size_t)(k0 + i) * ld + c0 + n0 + tx];
    __syncthreads();
    for (int i = ty; i < 64; i += 4) { const int n = n0 + i; const int r = MODE == 0 ? n : (n / 128) * 256 + half * 128 + (n % 128);
        dst[(size_t)r * K + k0 + tx] = f2bf(t[tx][i]); }
}
__global__ void k_lb(const float* __restrict__ lg, float* __restrict__ lb) {
    const int d = blockIdx.x * blockDim.x + threadIdx.x; if (d >= HG_QK) return;
    const float a = lg[d], b = lg[HG_QK + d], c = lg[2 * HG_QK + d], m = fmaxf(a, fmaxf(b, c));
    const float ea = __expf(a - m), eb = __expf(b - m), ec = __expf(c - m); lb[d] = ea / (ea + eb + ec);
}

template <int MODE>
__global__ void k_rmsnorm(const float* __restrict__ h, const float* __restrict__ g, bf16_t* __restrict__ xn, float* __restrict__ fout,
                          const float* __restrict__ w_in, float* __restrict__ glow,
                          const float* __restrict__ wg, const float* __restrict__ bg, const float* __restrict__ we, const float* __restrict__ be,
                          int* __restrict__ eid, float* __restrict__ wgt, unsigned* __restrict__ ctl) {
    const int row = blockIdx.x * 4 + (threadIdx.x >> 6), lane = threadIdx.x & 63;
    const float* hr = h + (size_t)row * D;
    float v[32]; float ss = 0.f;
#pragma unroll
    for (int j = 0; j < 8; ++j) { const float4 x = *(const float4*)(hr + j * 256 + lane * 4); v[4 * j] = x.x; v[4 * j + 1] = x.y; v[4 * j + 2] = x.z; v[4 * j + 3] = x.w; ss += x.x * x.x + x.y * x.y + x.z * x.z + x.w * x.w; }
    ss = wave_sum(ss); const float rstd = rsqrtf(ss * (1.0f / D) + EPS);
#pragma unroll
    for (int j = 0; j < 8; ++j) { const float4 gg = *(const float4*)(g + j * 256 + lane * 4);
        v[4 * j] *= rstd * gg.x; v[4 * j + 1] *= rstd * gg.y; v[4 * j + 2] *= rstd * gg.z; v[4 * j + 3] *= rstd * gg.w; }
    if (MODE == 3) {
#pragma unroll
        for (int j = 0; j < 8; ++j) *(float4*)(fout + (size_t)row * D + j * 256 + lane * 4) = make_float4(v[4 * j], v[4 * j + 1], v[4 * j + 2], v[4 * j + 3]);
        return;
    }
#pragma unroll
    for (int j = 0; j < 8; ++j) { ushort4 o; o.x = f2bf(v[4 * j]); o.y = f2bf(v[4 * j + 1]); o.z = f2bf(v[4 * j + 2]); o.w = f2bf(v[4 * j + 3]);
        *(ushort4*)(xn + (size_t)row * D + j * 256 + lane * 4) = o; }
    if (MODE == 1) {
        float acc[16];
#pragma unroll
        for (int c = 0; c < 16; ++c) acc[c] = 0.f;
#pragma unroll
        for (int j = 0; j < 8; ++j)
#pragma unroll
            for (int e = 0; e < 4; ++e) { const int k = j * 256 + lane * 4 + e; const float* wr = w_in + (size_t)k * EVEN_IN + EVEN_MAIN; const float xv = v[4 * j + e];
#pragma unroll
                for (int c4 = 0; c4 < 4; ++c4) { const float4 w = *(const float4*)(wr + c4 * 4); acc[c4 * 4] += xv * w.x; acc[c4 * 4 + 1] += xv * w.y; acc[c4 * 4 + 2] += xv * w.z; acc[c4 * 4 + 3] += xv * w.w; } }
#pragma unroll
        for (int c = 0; c < 16; ++c) acc[c] = wave_sum(acc[c]);
        if (lane == 0) {
#pragma unroll
            for (int c = 0; c < 16; ++c) glow[(size_t)row * 16 + c] = acc[c]; }
    }
    if (MODE == 2) {
        float lg[4], le[32];
#pragma unroll
        for (int c = 0; c < 4; ++c) lg[c] = 0.f;
#pragma unroll
        for (int c = 0; c < 32; ++c) le[c] = 0.f;
#pragma unroll
        for (int j = 0; j < 8; ++j)
#pragma unroll
            for (int e = 0; e < 4; ++e) { const int k = j * 256 + lane * 4 + e; const float xv = v[4 * j + e];
                const float4 w4 = *(const float4*)(wg + (size_t)k * 4); lg[0] += xv * w4.x; lg[1] += xv * w4.y; lg[2] += xv * w4.z; lg[3] += xv * w4.w;
#pragma unroll
                for (int c4 = 0; c4 < 8; ++c4) { const float4 w = *(const float4*)(we + (size_t)k * 32 + c4 * 4); le[c4 * 4] += xv * w.x; le[c4 * 4 + 1] += xv * w.y; le[c4 * 4 + 2] += xv * w.z; le[c4 * 4 + 3] += xv * w.w; } }
#pragma unroll
        for (int c = 0; c < 4; ++c) lg[c] = wave_sum(lg[c]) + bg[c];
#pragma unroll
        for (int c = 0; c < 32; ++c) le[c] = wave_sum(le[c]) + be[c];
        if (lane == 0) {
            int grp = 0; float mx = lg[0];
#pragma unroll
            for (int c = 1; c < 4; ++c) if (lg[c] > mx) { mx = lg[c]; grp = c; }
            float den = 0.f;
#pragma unroll
            for (int c = 0; c < 4; ++c) den += __expf(lg[c] - mx);
            const float pg = 1.0f / den;
            float e8[8];
#pragma unroll
            for (int c = 0; c < 8; ++c) { e8[c] = grp == 0 ? le[c] : grp == 1 ? le[8 + c] : grp == 2 ? le[16 + c] : le[24 + c]; }
            int j0 = 0; float v0 = e8[0];
#pragma unroll
            for (int c = 1; c < 8; ++c) if (e8[c] > v0) { v0 = e8[c]; j0 = c; }
            int j1 = -1; float v1 = -3.0e38f;
#pragma unroll
            for (int c = 0; c < 8; ++c) if (c != j0 && e8[c] > v1) { v1 = e8[c]; j1 = c; }
            const float e1 = __expf(v1 - v0), s = 1.0f / (1.0f + e1);
            const int ea = grp * 8 + j0, eb = grp * 8 + j1;
            eid[row * 2] = ea; eid[row * 2 + 1] = eb; wgt[row * 2] = pg * s; wgt[row * 2 + 1] = pg * e1 * s;
            atomicAdd(&ctl[CW_CNT + ea], 1u); atomicAdd(&ctl[CW_CNT + eb], 1u);
        }
    }
}

struct EpiProj0 { bf16_t* hq; float* hlf; bf16_t* hi; bf16_t* hgg; bf16_t* gq; bf16_t* gk; bf16_t* gv; bf16_t* gg; const float* lb;
    DI void operator()(int r, int c, float v) const {
        const int seg = c >> 10, cc = c & 1023; const float sc = 0.08838834764831845f;
        if (seg == 0) hq[(size_t)r * 1024 + cc] = f2bf(siluf_(v) * sc);
        else if (seg == 1) { const float l = lb[cc]; const float f = l + (1.0f - l) * sigmoidf_(v); hlf[(size_t)r * 1024 + cc] = __logf(f); }
        else if (seg == 2) hi[(size_t)r * 1024 + cc] = f2bf(v);
        else if (seg == 3) hgg[(size_t)r * 1024 + cc] = f2bf(siluf_(v));
        else if (seg == 4) { if (cc < 512) gq[(size_t)r * 512 + cc] = f2bf(v * sc); else gk[(size_t)r * 512 + cc - 512] = f2bf(v); }
        else if (seg == 5) gv[(size_t)r * 1024 + cc] = f2bf(v);
        else gg[(size_t)r * 1024 + cc] = f2bf(siluf_(v));
    } };
struct EpiResid { const float* res; float* out;
    DI void operator()(int r, int c, float v) const { out[(size_t)r * D + c] = res[(size_t)r * D + c] + v; } };
struct EpiQKV { bf16_t* q; bf16_t* k; bf16_t* v_;
    DI void operator()(int r, int c, float v) const { const int s = c >> 11, cc = c & 2047; bf16_t* o = s == 0 ? q : s == 1 ? k : v_; o[(size_t)r * D + cc] = f2bf(v); } };
struct EpiBf { bf16_t* o; int ld; int pad;
    DI void operator()(int r, int c, float v) const { o[(size_t)r * ld + c] = f2bf(v); } };
struct EpiSwiglu { bf16_t* o;
    DI void operator()(int r, int j, float a, float b) const { o[(size_t)r * DEXP + j] = f2bf(siluf_(a) * b); } };

template <class Epi, bool DUAL>
__global__ void k_gemm_naive(const bf16_t* __restrict__ A, const int* __restrict__ rowidx, const bf16_t* __restrict__ Bt, int K, int lda,
                             const int* __restrict__ tile_e, size_t b_estride, Epi epi) {
    __shared__ float As[32][65], Bs[32][65], Bs2[DUAL ? 32 : 1][65];
    const int m0 = blockIdx.y * 64, n0 = blockIdx.x * 64, tid = threadIdx.x, tx = tid & 15, ty = tid >> 4;
    if (tile_e) { const int e = tile_e[m0 / MOE_TILE]; if (e < 0) return; Bt += (size_t)e * b_estride; }
    float acc[4][4], acc2[4][4];
#pragma unroll
    for (int i = 0; i < 4; ++i)
#pragma unroll
        for (int j = 0; j < 4; ++j) { acc[i][j] = 0.f; acc2[i][j] = 0.f; }
    const int lr = tid >> 2, lk = (tid & 3) * 8;
    const int arow = rowidx ? rowidx[m0 + lr] : (m0 + lr);
    const bf16_t* ap = A + (size_t)arow * lda + lk;
    const int nl = n0 + lr; const int brow = DUAL ? (nl / 128) * 256 + (nl % 128) : nl;
    const bf16_t* bp = Bt + (size_t)brow * K + lk; const bf16_t* bp2 = bp + (size_t)128 * K;
    for (int k0 = 0; k0 < K; k0 += 32) {
        { const uint4 a = *(const uint4*)(ap + k0); const unsigned w[4] = {a.x, a.y, a.z, a.w};
#pragma unroll
          for (int i = 0; i < 4; ++i) { As[lk + 2 * i][lr] = __uint_as_float(w[i] << 16); As[lk + 2 * i + 1][lr] = __uint_as_float(w[i] & 0xFFFF0000u); } }
        { const uint4 a = *(const uint4*)(bp + k0); const unsigned w[4] = {a.x, a.y, a.z, a.w};
#pragma unroll
          for (int i = 0; i < 4; ++i) { Bs[lk + 2 * i][lr] = __uint_as_float(w[i] << 16); Bs[lk + 2 * i + 1][lr] = __uint_as_float(w[i] & 0xFFFF0000u); } }
        if (DUAL) { const uint4 a = *(const uint4*)(bp2 + k0); const unsigned w[4] = {a.x, a.y, a.z, a.w};
#pragma unroll
          for (int i = 0; i < 4; ++i) { Bs2[lk + 2 * i][lr] = __uint_as_float(w[i] << 16); Bs2[lk + 2 * i + 1][lr] = __uint_as_float(w[i] & 0xFFFF0000u); } }
        __syncthreads();
#pragma unroll 8
        for (int k = 0; k < 32; ++k) {
            float a[4], b[4], b2[4];
#pragma unroll
            for (int i = 0; i < 4; ++i) { a[i] = As[k][ty * 4 + i]; b[i] = Bs[k][tx * 4 + i]; if (DUAL) b2[i] = Bs2[k][tx * 4 + i]; }
#pragma unroll
            for (int i = 0; i < 4; ++i)
#pragma unroll
                for (int j = 0; j < 4; ++j) { acc[i][j] += a[i] * b[j]; if (DUAL) acc2[i][j] += a[i] * b2[j]; }
        }
        __syncthreads();
    }
#pragma unroll
    for (int i = 0; i < 4; ++i)
#pragma unroll
        for (int j = 0; j < 4; ++j) { const int r = m0 + ty * 4 + i, c = n0 + tx * 4 + j;
            if constexpr (DUAL) epi(r, c, acc[i][j], acc2[i][j]); else epi(r, c, acc[i][j]); }
}

template <int DV, bool IS_GLA>
__global__ void __launch_bounds__(DV) k_scan_naive(const bf16_t* __restrict__ Q, const float* __restrict__ LF, const bf16_t* __restrict__ Kx, const bf16_t* __restrict__ V,
                             const float* __restrict__ glow, const float* __restrict__ gk2, const float* __restrict__ gkb, float* __restrict__ oraw, int nheads, int ocol0) {
    constexpr int T = 16;
    __shared__ float sq[T][128], sk[T][128], sa[T][128];
    const int b = blockIdx.x / nheads, hh = blockIdx.x % nheads, v = threadIdx.x;
    const int qld = nheads * 128, vld = nheads * DV;
    float S[128];
#pragma unroll
    for (int d = 0; d < 128; ++d) S[d] = 0.f;
    for (int t0 = 0; t0 < SEQ; t0 += T) {
        __syncthreads();
        for (int i = threadIdx.x; i < T * 128; i += DV) { const int tt = i >> 7, d = i & 127; const size_t tok = (size_t)b * SEQ + t0 + tt;
            sq[tt][d] = bf2f(Q[tok * qld + hh * 128 + d]);
            if (IS_GLA) { float z = gkb[hh * 128 + d];
#pragma unroll
                for (int r = 0; r < GL_RANK; ++r) z += glow[tok * 16 + r] * gk2[r * GL_QK + hh * 128 + d];
                const float ls = fminf(z, 0.f) - log1pf(__expf(-fabsf(z)));
                sa[tt][d] = __expf(ls * (1.0f / 16.0f)); sk[tt][d] = bf2f(Kx[tok * qld + hh * 128 + d]); }
            else { const float a = __expf(LF[tok * qld + hh * 128 + d]); sa[tt][d] = a; sk[tt][d] = 1.0f - a; } }
        __syncthreads();
        for (int tt = 0; tt < T; ++tt) { const size_t tok = (size_t)b * SEQ + t0 + tt;
            const float vv = bf2f(V[tok * vld + hh * DV + v]); float o = 0.f;
#pragma unroll
            for (int d = 0; d < 128; ++d) { S[d] = sa[tt][d] * S[d] + sk[tt][d] * vv; o += sq[tt][d] * S[d]; }
            oraw[tok * D + ocol0 + hh * DV + v] = o; }
    }
}
__global__ void k_norm_gate(const float* __restrict__ oraw, const float* __restrict__ hg_norm, const float* __restrict__ gla_norm,
                            const bf16_t* __restrict__ hgg, const bf16_t* __restrict__ gg, bf16_t* __restrict__ mix) {
    const int w = blockIdx.x * 4 + (threadIdx.x >> 6), lane = threadIdx.x & 63; const int tok = w / 12, s = w % 12;
    const bool gla = s >= 8; const int dv = gla ? 256 : 128, col0 = gla ? 1024 + (s - 8) * 256 : s * 128;
    const float* o = oraw + (size_t)tok * D + col0; float x[4]; float ss = 0.f; const int n = dv / 64;
#pragma unroll
    for (int i = 0; i < 4; ++i) { x[i] = i < n ? o[lane + 64 * i] : 0.f; ss += x[i] * x[i]; }
    ss = wave_sum(ss); const float rstd = rsqrtf(ss / dv + EPS);
#pragma unroll
    for (int i = 0; i < 4; ++i) if (i < n) { const int c = lane + 64 * i; const float gain = gla ? gla_norm[c] : hg_norm[c];
        const float gate = gla ? bf2f(gg[(size_t)tok * 1024 + (s - 8) * 256 + c]) : bf2f(hgg[(size_t)tok * 1024 + s * 128 + c]);
        mix[(size_t)tok * D + col0 + c] = f2bf(x[i] * rstd * gain * gate); }
}

__global__ void k_kmean(const bf16_t* __restrict__ Kb, float* __restrict__ kmean) {
    const int n = blockIdx.x % MB_NBLK, hh = (blockIdx.x / MB_NBLK) % MB_H, b = blockIdx.x / (MB_NBLK * MB_H), d = threadIdx.x;
    float s = 0.f; const bf16_t* p = Kb + ((size_t)b * SEQ + n * MB_BLK) * D + hh * MB_DH + d;
    for (int j = 0; j < MB_BLK; ++j) s += bf2f(p[(size_t)j * D]);
    kmean[(size_t)blockIdx.x * MB_DH + d] = s * (1.0f / MB_BLK);
}
__global__ void k_moba_naive(const bf16_t* __restrict__ Qb, const bf16_t* __restrict__ Kb, const bf16_t* __restrict__ Vb, const float* __restrict__ kmean, bf16_t* __restrict__ AO) {
    __shared__ float sq[4][128]; __shared__ float sp[4][1024]; __shared__ int ssel[4][4];
    const int wv = threadIdx.x >> 6, lane = threadIdx.x & 63;
    const int qi = blockIdx.x * 4 + wv; const int t = qi % SEQ, hh = (qi / SEQ) % MB_H, b = qi / (SEQ * MB_H);
    const size_t tok = (size_t)b * SEQ + t; const int qb = t / MB_BLK;
    sq[wv][lane] = bf2f(Qb[tok * D + hh * MB_DH + lane]); sq[wv][lane + 64] = bf2f(Qb[tok * D + hh * MB_DH + lane + 64]);
    __syncthreads();
    float gate = -3.0e38f;
    if (lane < qb) { const float* km = kmean + ((size_t)(b * MB_H + hh) * MB_NBLK + lane) * MB_DH; float s = 0.f; for (int d = 0; d < 128; ++d) s += sq[wv][d] * km[d]; gate = s; }
    int nsel = qb < 3 ? qb : 3;
    for (int s = 0; s < 3; ++s) { float best = gate; int bi = lane;
        for (int o = 32; o > 0; o >>= 1) { const float ob = __shfl_xor(best, o); const int oi = __shfl_xor(bi, o); if (ob > best || (ob == best && oi < bi)) { best = ob; bi = oi; } }
        if (lane == 0) ssel[wv][s] = bi; if (lane == bi) gate = -3.4e38f; }
    __syncthreads();
    const float scale = 0.08838834764831845f;
    float mx = -3.0e38f;
    for (int sgi = 0; sgi <= nsel; ++sgi) { const int blk = sgi < nsel ? ssel[wv][sgi] : qb;
        for (int i = 0; i < 4; ++i) { const int j = lane + 64 * i, kp = blk * MB_BLK + j; float s = -__builtin_inff();
            if (sgi < nsel || kp <= t) { const bf16_t* kr = Kb + ((size_t)b * SEQ + kp) * D + hh * MB_DH; float a = 0.f;
                for (int d = 0; d < 128; d += 2) { const unsigned w = *(const unsigned*)(kr + d); a += sq[wv][d] * __uint_as_float(w << 16) + sq[wv][d + 1] * __uint_as_float(w & 0xFFFF0000u); }
                s = a * scale; }
            sp[wv][sgi * 256 + j] = s; mx = fmaxf(mx, s); } }
    for (int o = 32; o > 0; o >>= 1) mx = fmaxf(mx, __shfl_xor(mx, o));
    float den = 0.f;
    for (int sgi = 0; sgi <= nsel; ++sgi) for (int i = 0; i < 4; ++i) { const int idx = sgi * 256 + lane + 64 * i; const float p = __expf(sp[wv][idx] - mx); sp[wv][idx] = p; den += p; }
    den = wave_sum(den);
    __syncthreads();
    float o0 = 0.f, o1 = 0.f;
    for (int sgi = 0; sgi <= nsel; ++sgi) { const int blk = sgi < nsel ? ssel[wv][sgi] : qb; const int jmax = sgi < nsel ? 256 : (t - qb * MB_BLK + 1);
        for (int j = 0; j < jmax; ++j) { const float p = sp[wv][sgi * 256 + j]; const unsigned w = *(const unsigned*)(Vb + ((size_t)b * SEQ + blk * MB_BLK + j) * D + hh * MB_DH + lane * 2);
            o0 += p * __uint_as_float(w << 16); o1 += p * __uint_as_float(w & 0xFFFF0000u); } }
    const float inv = 1.0f / den;
    *(unsigned*)(AO + tok * D + hh * MB_DH + lane * 2) = (unsigned)f2bf(o0 * inv) | ((unsigned)f2bf(o1 * inv) << 16);
}

__global__ void k_moe_plan(unsigned* __restrict__ ctl, int* __restrict__ tile_e, int* __restrict__ rowtok) {
    __shared__ int base[NEXP + 1];
    if (threadIdx.x == 0) { int t = 0; for (int e = 0; e < NEXP; ++e) { base[e] = t; const int c = (int)ctl[CW_CNT + e]; const int nt = (c + MOE_TILE - 1) / MOE_TILE;
            for (int i = 0; i < nt; ++i) tile_e[t + i] = e; t += nt; ctl[CW_BASE + e] = (unsigned)(base[e] * MOE_TILE); ctl[CW_CUR + e] = 0u; }
        base[NEXP] = t; ctl[CW_NT] = (unsigned)t; for (int i = t; i < MOE_MAXT; ++i) tile_e[i] = -1; }
    __syncthreads();
    for (int i = threadIdx.x; i < MOE_ROWS; i += blockDim.x) rowtok[i] = 0;
}
__global__ void k_moe_scatter(const int* __restrict__ eid, unsigned* __restrict__ ctl, int* __restrict__ slot, int* __restrict__ rowtok) {
    const int i = blockIdx.x * blockDim.x + threadIdx.x; if (i >= NTOK * 2) return;
    const int e = eid[i]; const unsigned p = atomicAdd(&ctl[CW_CUR + e], 1u); const int s = (int)ctl[CW_BASE + e] + (int)p; slot[i] = s; rowtok[s] = i >> 1;
}
__global__ void k_moe_combine(float* __restrict__ h, const bf16_t* __restrict__ Y, const int* __restrict__ slot, const float* __restrict__ wgt) {
    const int row = blockIdx.x * 4 + (threadIdx.x >> 6), lane = threadIdx.x & 63;
    const int s0 = slot[row * 2], s1 = slot[row * 2 + 1]; const float w0 = wgt[row * 2], w1 = wgt[row * 2 + 1];
    for (int j = 0; j < 8; ++j) { const int c = j * 256 + lane * 4; float4 x = *(float4*)(h + (size_t)row * D + c);
        const ushort4 a = *(const ushort4*)(Y + (size_t)s0 * D + c), bb = *(const ushort4*)(Y + (size_t)s1 * D + c);
        x.x += w0 * bf2f(a.x) + w1 * bf2f(bb.x); x.y += w0 * bf2f(a.y) + w1 * bf2f(bb.y); x.z += w0 * bf2f(a.z) + w1 * bf2f(bb.z); x.w += w0 * bf2f(a.w) + w1 * bf2f(bb.w);
        *(float4*)(h + (size_t)row * D + c) = x; }
}


#define XB_TMO      128
#define XB_XCNT(j)  (256  + 64 * (j))
#define XB_XSUB(j)  (1280 + 64 * (j))
#define XB_XGEN(j)  (2304 + 64 * (j))
#define XB_TOP      3328
#define XB_TOPGEN   3392
#define XCD_BAR_WORDS 3456
#define XB_SPIN_CAP (1u << 18)
#define LAS __attribute__((address_space(3)))

__device__ __forceinline__ unsigned xb_ld(unsigned* p)              { return __hip_atomic_load(p, __ATOMIC_RELAXED, __HIP_MEMORY_SCOPE_AGENT); }
__device__ __forceinline__ unsigned xb_add(unsigned* p, unsigned v) { return __hip_atomic_fetch_add(p, v, __ATOMIC_RELAXED, __HIP_MEMORY_SCOPE_AGENT); }
__device__ __forceinline__ unsigned xb_xcc_id() { return (unsigned)__builtin_amdgcn_s_getreg((3 << 11) | 20) & 0xFu; }
#define XB_SPIN(cond, bar) do { unsigned _sp = 0; while (cond) { __builtin_amdgcn_s_sleep(1); \
    if ((++_sp & 255u) == 0u) { if (xb_ld(&(bar)[XB_TMO])) break; if (_sp > XB_SPIN_CAP) { atomicAdd(&(bar)[XB_TMO], 1u); break; } } } } while (0)

struct XcdBarrier {
    unsigned* bar; unsigned x;
    volatile LAS unsigned* st;
};

__device__ __forceinline__ XcdBarrier xcd_barrier_post(unsigned* bar, volatile LAS unsigned* st) {
    XcdBarrier b; b.bar = bar; b.x = xb_xcc_id(); b.st = st;
    if (threadIdx.x == 0) (void)xb_add(&bar[XB_XCNT(b.x)], 1u);
    return b;
}
__device__ __forceinline__ void xcd_barrier_complete(unsigned* bar, unsigned x, unsigned& nloc, unsigned& nx) {
    const unsigned G = gridDim.x * gridDim.y * gridDim.z;
    unsigned sum, cnt, mine, sp = 0u;
    for (;;) {
        sum = 0u; cnt = 0u; mine = 0u;
#pragma unroll
        for (unsigned j = 0; j < 16; ++j) { const unsigned c = xb_ld(&bar[XB_XCNT(j)]); sum += c; cnt += (c > 0u) ? 1u : 0u; mine = (j == x) ? c : mine; }
        if (sum == G) break;
        __builtin_amdgcn_s_sleep(1);
        if ((++sp & 255u) == 0u) { if (xb_ld(&bar[XB_TMO])) break; if (sp > XB_SPIN_CAP) { atomicAdd(&bar[XB_TMO], 1u); break; } }
    }
    nloc = mine > 0u ? mine : 1u; nx = cnt > 0u ? cnt : 1u;
}

__device__ __forceinline__ void xcd_barrier(const XcdBarrier& b) {
    asm volatile("s_waitcnt vmcnt(0)" ::: "memory");
    __syncthreads();
    if (threadIdx.x == 0) {
        unsigned* bar = b.bar;
        __builtin_amdgcn_s_waitcnt(0);
        unsigned nloc = b.st[0], nx = b.st[1];
        if (nloc == 0u) { xcd_barrier_complete(bar, b.x, nloc, nx); b.st[0] = nloc; b.st[1] = nx; }
        const unsigned old = xb_add(&bar[XB_XSUB(b.x)], 1u);
        const unsigned gen = old / nloc;
        if (old + 1u == (gen + 1u) * nloc) {
            __builtin_amdgcn_fence(__ATOMIC_RELEASE, "agent");
            asm volatile("s_waitcnt vmcnt(0)" ::: "memory");
            const unsigned og = xb_add(&bar[XB_TOP], 1u);
            const unsigned tg = og / nx;
            if (og + 1u == (tg + 1u) * nx) xb_add(&bar[XB_TOPGEN], 1u);
            else XB_SPIN(xb_ld(&bar[XB_TOPGEN]) == tg, bar);
            __builtin_amdgcn_fence(__ATOMIC_ACQUIRE, "agent");
            xb_add(&bar[XB_XGEN(b.x)], 1u);
            asm volatile("s_waitcnt vmcnt(0)" ::: "memory");
        } else {
            XB_SPIN(xb_ld(&bar[XB_XGEN(b.x)]) == gen, bar);
            __builtin_amdgcn_fence(__ATOMIC_ACQUIRE, "agent");
            asm volatile("s_waitcnt vmcnt(0)" ::: "memory");
        }
    }
    __syncthreads();
}


namespace pg8 {
#define PG8_LAS __attribute__((address_space(3)))
typedef unsigned short bf16_t;
typedef short bf16x8 __attribute__((ext_vector_type(8)));
typedef float f32x4 __attribute__((ext_vector_type(4)));
typedef unsigned u32x4 __attribute__((ext_vector_type(4)));
constexpr int BM = 256, BK = 64, HALF = 128, HTB = HALF * BK * 2  , STAGE_BYTES = 8 * HTB, NXCD = 8, WGM = 8;

__host__ __device__ __forceinline__ int lds_byte(int r, int c) { const int st = (r >> 4) * 2 + (c >> 5), rr = r & 15, cc = c & 31, ob = rr * 64 + cc * 2; return st * 1024 + (ob ^ (((ob >> 9) & 1) << 5)); }
__host__ __device__ __forceinline__ void stage_rc(int b, int& R, int& C) { const int st = b / 1024, sb = b % 1024, swz = sb ^ (((sb >> 9) & 1) << 5); R = (st >> 1) * 16 + swz / 64; C = (st & 1) * 32 + (swz % 64) / 2; }
__host__ __device__ __forceinline__ int perm32(int rho) { const int n = rho >> 4, i = rho & 15; return 8 * (i >> 2) + 4 * n + (i & 3); }

struct Unit { int pm, pn; };
struct Gemm { const bf16_t* A; const bf16_t* Bt; int M, N, K; };

struct StaticOrder {
    int nM, nN, nwg, G, c;
    __host__ __device__ void init(int M, int N, int G_, int c_) { nM = M / BM; nN = N / BM; nwg = nM * nN; G = G_; c = c_; }
    __host__ __device__ bool next(int i, Unit& u) const {
        const long L = (long)i * G + c; if (L >= nwg) return false;
        int wgid = (int)L; { const int q = nwg / NXCD, r = nwg % NXCD, xcd = wgid % NXCD, off = wgid / NXCD; wgid = (xcd < r ? xcd * (q + 1) : r * (q + 1) + (xcd - r) * q) + off; }
        const int nig = WGM * nN, gid = wgid / nig, fm = gid * WGM, gsz = (nM - fm) < WGM ? (nM - fm) : WGM;
        u.pm = fm + ((wgid % nig) % gsz); u.pn = (wgid % nig) / gsz; return true;
    }
    __device__ __forceinline__ void a_ready(const Unit&) const {}
    __device__ __forceinline__ void done(const Unit&) const {}
};

__device__ __forceinline__ unsigned cvt_pk_bf16(float lo, float hi) { unsigned r; asm volatile("v_cvt_pk_bf16_f32 %0, %1, %2" : "=v"(r) : "v"(lo), "v"(hi)); return r; }
template <class Epi, class Sched, bool ALIGN_EPI = false, bool SP2 = false>
__device__ __forceinline__ void gemm_phase(PG8_LAS unsigned char* lds, const Gemm g, const Sched& S, const Epi& E) {
    const int tid = threadIdx.x, wid = __builtin_amdgcn_readfirstlane(tid >> 6), lane = tid & 63, wr = wid >> 2, wc = wid & 3, fr = lane & 15, fq = lane >> 4;
    const int K = g.K, nt = K / BK;
    unsigned voffA[2], voffB[2];
#pragma unroll
    for (int i = 0; i < 2; ++i) { int R, C; stage_rc(tid * 16 + i * 8192, R, C); const int Rb = Epi::PERM ? ((R & ~31) + perm32(R & 31)) : R;
        voffA[i] = (unsigned)(R * K + C) * 2u; voffB[i] = (unsigned)(Rb * K + C) * 2u; }
    const size_t kstep = (size_t)(BK * 2);
    const size_t hstep = (size_t)HALF * K * 2;
    const size_t tstep = 2 * hstep;
    const unsigned ldsw = (unsigned)wid * 1024u;
    const int aoff = lds_byte(wr * 64 + fr, fq * 8), boff = lds_byte(wc * 32 + fr, fq * 8);
#define PG8_SA(b, h) (((b) * 2 + (h)) * HTB)
#define PG8_SB(b, h) ((4 + (b) * 2 + (h)) * HTB)
#define PG8_STAGE(bufoff, gbase, voff) do { _Pragma("unroll") for (int _i = 0; _i < 2; ++_i) \
        __builtin_amdgcn_global_load_lds((const unsigned*)((const char*)(gbase) + (voff)[_i]), (PG8_LAS unsigned*)(lds + (bufoff) + ldsw + _i * 8192), 16, 0, 0); } while (0)
#define PG8_LDA(dst, b, h) do { _Pragma("unroll") for (int m = 0; m < 4; ++m) _Pragma("unroll") for (int k = 0; k < 2; ++k) dst[m][k] = *(const PG8_LAS bf16x8*)(lds + PG8_SA(b, h) + aoff + m * 2048 + k * 1024); } while (0)
#define PG8_LDB(dst, b, h) do { _Pragma("unroll") for (int n = 0; n < 2; ++n) _Pragma("unroll") for (int k = 0; k < 2; ++k) dst[n][k] = *(const PG8_LAS bf16x8*)(lds + PG8_SB(b, h) + boff + n * 2048 + k * 1024); } while (0)
#define PG8_MMA(ai, bj, At, Bt) do { __builtin_amdgcn_s_setprio(1); _Pragma("unroll") for (int m = 0; m < 4; ++m) _Pragma("unroll") for (int n = 0; n < 2; ++n) _Pragma("unroll") for (int k = 0; k < 2; ++k) \
        acc[ai][bj][m][n] = __builtin_amdgcn_mfma_f32_16x16x32_bf16(Bt[n][k], At[m][k], acc[ai][bj][m][n], 0, 0, 0); __builtin_amdgcn_s_setprio(0); } while (0)
#define PG8_WAIT_V(n) asm volatile("s_waitcnt vmcnt(" #n ")" ::: "memory")
#define PG8_WAIT_L(n) asm volatile("s_waitcnt lgkmcnt(" #n ")" ::: "memory")
#define PG8_BAR __builtin_amdgcn_s_barrier()
#define PG8_SCHED __builtin_amdgcn_sched_barrier(0)
    Unit cur, nxt; int ui = 0;
    if (!S.next(0, cur)) return;
    f32x4 acc[2][2][4][2];
#pragma unroll
    for (int a = 0; a < 2; ++a)
#pragma unroll
        for (int b = 0; b < 2; ++b)
#pragma unroll
            for (int m = 0; m < 4; ++m)
#pragma unroll
                for (int n = 0; n < 2; ++n) acc[a][b][m][n] = (f32x4){0.f, 0.f, 0.f, 0.f};
    bf16x8 At[4][2], B0[2][2], B1[2][2];
    const char* cA = (const char*)g.A + (size_t)cur.pm * tstep; const char* cB = (const char*)g.Bt + (size_t)cur.pn * tstep;
    S.a_ready(cur);
    if constexpr (SP2) {
        PG8_STAGE(PG8_SB(0, 0), cB, voffB); PG8_STAGE(PG8_SB(0, 1), cB + hstep, voffB); PG8_STAGE(PG8_SA(0, 0), cA, voffA); PG8_STAGE(PG8_SA(0, 1), cA + hstep, voffA);
        if (wr == 1) PG8_BAR;
        PG8_WAIT_V(2); PG8_BAR;
        PG8_STAGE(PG8_SB(1, 0), cB + kstep, voffB); PG8_STAGE(PG8_SA(1, 0), cA + kstep, voffA); PG8_STAGE(PG8_SB(1, 1), cB + hstep + kstep, voffB);
        PG8_WAIT_V(6); PG8_BAR;
    } else {
        PG8_STAGE(PG8_SB(0, 0), cB, voffB); PG8_STAGE(PG8_SA(0, 0), cA, voffA); PG8_STAGE(PG8_SB(0, 1), cB + hstep, voffB); PG8_STAGE(PG8_SA(0, 1), cA + hstep, voffA);
        if (wr == 1) PG8_BAR;
        PG8_WAIT_V(4); PG8_BAR;
        PG8_STAGE(PG8_SB(1, 0), cB + kstep, voffB); PG8_STAGE(PG8_SA(1, 0), cA + kstep, voffA); PG8_STAGE(PG8_SB(1, 1), cB + hstep + kstep, voffB);
        PG8_WAIT_V(6); PG8_BAR;
    }
    for (;;) {
        const bool has_next = S.next(ui + 1, nxt);
        const char* nA = has_next ? (const char*)g.A + (size_t)nxt.pm * tstep : cA; const char* nB = has_next ? (const char*)g.Bt + (size_t)nxt.pn * tstep : cB;
        for (int t = 0; t < nt; t += 2) {
            const bool last = (t == nt - 2);
            const char* a1 = cA + (size_t)(t + 1) * kstep;
            const char* a2 = last ? nA : cA + (size_t)(t + 2) * kstep; const char* b2 = last ? nB : cB + (size_t)(t + 2) * kstep;
            const char* a3 = a2 + kstep; const char* b3 = b2 + kstep;
            if (last && has_next) S.a_ready(nxt);
            if constexpr (SP2) {
            PG8_LDB(B0, 0, 0); PG8_LDB(B1, 0, 1); PG8_SCHED; PG8_LDA(At, 0, 0); PG8_STAGE(PG8_SA(1, 1), a1 + hstep, voffA);
            PG8_WAIT_V(8); PG8_WAIT_L(0); PG8_BAR; PG8_MMA(0, 0, At, B0); PG8_MMA(0, 1, At, B1); PG8_BAR; PG8_SCHED;
            PG8_LDA(At, 0, 1); PG8_STAGE(PG8_SB(0, 0), b2, voffB); PG8_STAGE(PG8_SB(0, 1), b2 + hstep, voffB); PG8_STAGE(PG8_SA(0, 0), a2, voffA);
            PG8_WAIT_V(8); PG8_WAIT_L(0); PG8_BAR; PG8_MMA(1, 0, At, B0); PG8_MMA(1, 1, At, B1); PG8_BAR; PG8_SCHED;
            PG8_LDB(B0, 1, 0); PG8_LDB(B1, 1, 1); PG8_SCHED; PG8_LDA(At, 1, 0); PG8_STAGE(PG8_SA(0, 1), a2 + hstep, voffA);
            PG8_WAIT_V(8); PG8_WAIT_L(0); PG8_BAR; PG8_MMA(0, 0, At, B0); PG8_MMA(0, 1, At, B1); PG8_BAR; PG8_SCHED;
            PG8_LDA(At, 1, 1); PG8_STAGE(PG8_SB(1, 0), b3, voffB); PG8_STAGE(PG8_SB(1, 1), b3 + hstep, voffB); PG8_STAGE(PG8_SA(1, 0), a3, voffA);
            PG8_WAIT_V(8); PG8_WAIT_L(0); PG8_BAR; PG8_MMA(1, 0, At, B0); PG8_MMA(1, 1, At, B1); PG8_BAR; PG8_SCHED;
            } else {
            PG8_LDB(B0, 0, 0); PG8_SCHED; PG8_LDA(At, 0, 0); PG8_STAGE(PG8_SA(1, 1), a1 + hstep, voffA);
            PG8_WAIT_L(8); PG8_BAR; PG8_WAIT_L(0); PG8_MMA(0, 0, At, B0); PG8_BAR; PG8_SCHED;
            PG8_LDB(B1, 0, 1); PG8_STAGE(PG8_SB(0, 0), b2, voffB);
            PG8_BAR; PG8_WAIT_L(0); PG8_MMA(0, 1, At, B1); PG8_BAR;
            PG8_LDA(At, 0, 1); PG8_STAGE(PG8_SA(0, 0), a2, voffA);
            PG8_BAR; PG8_WAIT_L(0); PG8_MMA(1, 0, At, B0); PG8_BAR; PG8_SCHED;
            PG8_STAGE(PG8_SB(0, 1), b2 + hstep, voffB);
            PG8_WAIT_V(6); PG8_BAR; PG8_MMA(1, 1, At, B1); PG8_BAR;
            PG8_LDB(B0, 1, 0); PG8_SCHED; PG8_LDA(At, 1, 0); PG8_STAGE(PG8_SA(0, 1), a2 + hstep, voffA);
            PG8_WAIT_L(8); PG8_BAR; PG8_WAIT_L(0); PG8_MMA(0, 0, At, B0); PG8_BAR; PG8_SCHED;
            PG8_LDB(B1, 1, 1); PG8_STAGE(PG8_SB(1, 0), b3, voffB);
            PG8_BAR; PG8_WAIT_L(0); PG8_MMA(0, 1, At, B1); PG8_BAR;
            PG8_LDA(At, 1, 1); PG8_STAGE(PG8_SA(1, 0), a3, voffA);
            PG8_BAR; PG8_WAIT_L(0); PG8_MMA(1, 0, At, B0); PG8_BAR; PG8_SCHED;
            PG8_STAGE(PG8_SB(1, 1), b3 + hstep, voffB);
            PG8_WAIT_V(6); PG8_BAR; PG8_MMA(1, 1, At, B1); PG8_BAR;
            }
        }
        if constexpr (ALIGN_EPI) { if (wr == 0) PG8_BAR; }
        if constexpr (!Epi::AFTER_DRAIN) { E(acc, cur, wr, wc, fr, fq); S.done(cur); }
        if (!has_next) break;
#pragma unroll
        for (int a = 0; a < 2; ++a)
#pragma unroll
            for (int b = 0; b < 2; ++b)
#pragma unroll
                for (int m = 0; m < 4; ++m)
#pragma unroll
                    for (int n = 0; n < 2; ++n) acc[a][b][m][n] = (f32x4){0.f, 0.f, 0.f, 0.f};
        cur = nxt; cA = nA; cB = nB; ++ui;
        if constexpr (ALIGN_EPI) { if (wr == 1) PG8_BAR; }
    }
    PG8_WAIT_V(0);
    if constexpr (!ALIGN_EPI) { if (wr == 0) PG8_BAR; }
    PG8_BAR;
    if constexpr (Epi::AFTER_DRAIN) { E.fused(acc, cur, wr, wc, fr, fq, lds, wid, lane); S.done(cur); }
#undef PG8_SA
#undef PG8_SB
#undef PG8_STAGE
#undef PG8_LDA
#undef PG8_LDB
#undef PG8_MMA
#undef PG8_WAIT_V
#undef PG8_WAIT_L
#undef PG8_BAR
#undef PG8_SCHED
}
}

#define LAS __attribute__((address_space(3)))
typedef float f32x4 __attribute__((ext_vector_type(4)));
typedef unsigned u32x4 __attribute__((ext_vector_type(4)));
typedef unsigned u32x2 __attribute__((ext_vector_type(2)));
constexpr int NTHR = 512, NWAVE = 8;
constexpr int RING_BYTES = 131072, LDS_MISC = 131072, LDS_BYTES = 147456;
constexpr int MI_BAR = 0;
constexpr int MI_NT = 16;
constexpr int MI_TILEE = 64;
constexpr int MI_EBASE = 1024;
constexpr int MI_RSTD = 2048;
constexpr int MI_LOGIT = 4096;
constexpr size_t WS_RWT = WS_TOTAL;
constexpr size_t WS_XS_UNUSED = 0;
constexpr size_t WS_TOTAL2 = WS_RWT + (size_t)2 * 2048 * 48 * 4;
constexpr int CW2_CNT0 = 1024, CW2_CUR0 = 1088, CW2_CNT1 = 1152, CW2_CUR1 = 1216;
constexpr int CW2_BAR = 2048;
constexpr int NBARREG = 4;
constexpr size_t CTL2_BYTES = (size_t)(CW2_BAR + NBARREG * XCD_BAR_WORDS) * 4;
static_assert(CTL2_BYTES <= CTL_BYTES, "ctl");
constexpr size_t U_XS = U_Y;

struct Args { const float* in[20]; float* out; unsigned char* ws; int ph_lo, ph_hi, bar_idx, pad; };

struct Frame {
    LAS unsigned char* lds; int tid, lane, wave, G, bx, vcu;
    unsigned char* ws; unsigned* ctl;
};

DI unsigned pk_bf16(float lo, float hi) { unsigned r; asm volatile("v_cvt_pk_bf16_f32 %0, %1, %2" : "=v"(r) : "v"(lo), "v"(hi)); return r; }
DI float fast_sigmoid(float x) { return __builtin_amdgcn_rcpf(1.0f + __expf(-x)); }

struct EpiProj0F { static constexpr bool PERM = true, AFTER_DRAIN = false;
    bf16_t* hq; float* hlf; bf16_t* hi; bf16_t* hgg; bf16_t* gq; bf16_t* gk; bf16_t* gv; bf16_t* gg; const float* lb;
    DI void operator()(const f32x4 (&acc)[2][2][4][2], const pg8::Unit& u, int wr, int wc, int fr, int fq) const {
        const int colt = u.pn * 256, seg = colt >> 10, row0 = u.pm * 256 + wr * 64 + fr, cl = (colt & 1023) + wc * 32 + 8 * fq;
        if (seg == 1) {
            f32x4 l0[2], l1[2];
#pragma unroll
            for (int bj = 0; bj < 2; ++bj) { l0[bj] = *(const f32x4*)(lb + cl + bj * 128); l1[bj] = *(const f32x4*)(lb + cl + bj * 128 + 4); }
#pragma unroll
            for (int ai = 0; ai < 2; ++ai)
#pragma unroll
                for (int m = 0; m < 4; ++m) { float* rowp = hlf + (size_t)(row0 + ai * 128 + m * 16) * 1024 + cl;
#pragma unroll
                    for (int bj = 0; bj < 2; ++bj) { f32x4 v0 = acc[ai][bj][m][0], v1 = acc[ai][bj][m][1];
#pragma unroll
                        for (int j = 0; j < 4; ++j) { v0[j] = __logf(l0[bj][j] + (1.0f - l0[bj][j]) * fast_sigmoid(v0[j])); v1[j] = __logf(l1[bj][j] + (1.0f - l1[bj][j]) * fast_sigmoid(v1[j])); }
                        *(f32x4*)(rowp + bj * 128) = v0; *(f32x4*)(rowp + bj * 128 + 4) = v1; } }
            return;
        }
        bf16_t* dst; int ld = 1024, co = cl; bool silu = false; float sc = 1.0f;
        if (seg == 0) { dst = hq; silu = true; sc = 0.08838834764831845f; }
        else if (seg == 2) dst = hi;
        else if (seg == 3) { dst = hgg; silu = true; }
        else if (seg == 4) { ld = 512; if ((colt & 1023) < 512) { dst = gq; sc = 0.08838834764831845f; } else { dst = gk; co = cl - 512; } }
        else if (seg == 5) dst = gv;
        else { dst = gg; silu = true; }
#pragma unroll
        for (int ai = 0; ai < 2; ++ai)
#pragma unroll
            for (int m = 0; m < 4; ++m) { bf16_t* rowp = dst + (size_t)(row0 + ai * 128 + m * 16) * ld + co;
#pragma unroll
                for (int bj = 0; bj < 2; ++bj) { f32x4 v0 = acc[ai][bj][m][0], v1 = acc[ai][bj][m][1];
                    if (silu) {
#pragma unroll
                        for (int j = 0; j < 4; ++j) { v0[j] *= fast_sigmoid(v0[j]); v1[j] *= fast_sigmoid(v1[j]); } }
                    v0 = v0 * sc; v1 = v1 * sc;
                    u32x4 w; w.x = pk_bf16(v0[0], v0[1]); w.y = pk_bf16(v0[2], v0[3]); w.z = pk_bf16(v1[0], v1[1]); w.w = pk_bf16(v1[2], v1[3]);
                    *(u32x4*)(rowp + bj * 128) = w; } }
    } };
struct EpiResidF { static constexpr bool PERM = false, AFTER_DRAIN = false;
    const float* res; float* out;
    DI void operator()(const f32x4 (&acc)[2][2][4][2], const pg8::Unit& u, int wr, int wc, int fr, int fq) const {
        const int row0 = u.pm * 256 + wr * 64 + fr, col0 = u.pn * 256 + wc * 32 + 4 * fq;
#pragma unroll
        for (int ai = 0; ai < 2; ++ai)
#pragma unroll
            for (int m = 0; m < 4; ++m) { const size_t ro = (size_t)(row0 + ai * 128 + m * 16) * D + col0;
#pragma unroll
                for (int bj = 0; bj < 2; ++bj)
#pragma unroll
                    for (int n = 0; n < 2; ++n) { const f32x4 r = *(const f32x4*)(res + ro + bj * 128 + n * 16); *(f32x4*)(out + ro + bj * 128 + n * 16) = r + acc[ai][bj][m][n]; } }
    } };
struct EpiBf16F { static constexpr bool PERM = true, AFTER_DRAIN = false;
    bf16_t* O; int ldc, nct, split_tiles; size_t split_stride;
    DI void operator()(const f32x4 (&acc)[2][2][4][2], const pg8::Unit& u, int wr, int wc, int fr, int fq) const {
        int ct = u.pn % nct; bf16_t* base = O; if (split_tiles) { const int t = ct / split_tiles; base += (size_t)t * split_stride; ct -= t * split_tiles; }
        const int row0 = u.pm * 256 + wr * 64 + fr, col0 = ct * 256 + wc * 32 + 8 * fq;
#pragma unroll
        for (int ai = 0; ai < 2; ++ai)
#pragma unroll
            for (int m = 0; m < 4; ++m) { bf16_t* rowp = base + (size_t)(row0 + ai * 128 + m * 16) * ldc + col0;
#pragma unroll
                for (int bj = 0; bj < 2; ++bj) { const f32x4 v0 = acc[ai][bj][m][0], v1 = acc[ai][bj][m][1];
                    u32x4 w; w.x = pk_bf16(v0[0], v0[1]); w.y = pk_bf16(v0[2], v0[3]); w.z = pk_bf16(v1[0], v1[1]); w.w = pk_bf16(v1[2], v1[3]);
                    *(u32x4*)(rowp + bj * 128) = w; } }
    } };
struct EpiSwigluF { static constexpr bool PERM = true, AFTER_DRAIN = false;
    bf16_t* O;
    DI void operator()(const f32x4 (&acc)[2][2][4][2], const pg8::Unit& u, int wr, int wc, int fr, int fq) const {
        const int row0 = u.pm * 256 + wr * 64 + fr, col0 = (u.pn & 3) * 128 + wc * 32 + 8 * fq;
#pragma unroll
        for (int ai = 0; ai < 2; ++ai)
#pragma unroll
            for (int m = 0; m < 4; ++m) { bf16_t* rowp = O + (size_t)(row0 + ai * 128 + m * 16) * DEXP + col0;
                f32x4 a0 = acc[ai][0][m][0], a1 = acc[ai][0][m][1]; const f32x4 b0 = acc[ai][1][m][0], b1 = acc[ai][1][m][1];
#pragma unroll
                for (int j = 0; j < 4; ++j) { a0[j] = a0[j] * fast_sigmoid(a0[j]) * b0[j]; a1[j] = a1[j] * fast_sigmoid(a1[j]) * b1[j]; }
                u32x4 w; w.x = pk_bf16(a0[0], a0[1]); w.y = pk_bf16(a0[2], a0[3]); w.z = pk_bf16(a1[0], a1[1]); w.w = pk_bf16(a1[2], a1[3]);
                *(u32x4*)rowp = w; }
    } };
struct MoeOrder {
    int nN, shift, nunits, G, c; const LAS int* tile_e;
    DI bool next(int i, pg8::Unit& u) const { const long L = (long)i * G + c; if (L >= nunits) return false; const int t = (int)L >> shift, pn = (int)L & (nN - 1);
        u.pm = t; u.pn = tile_e[t] * nN + pn; return true; }
    DI void a_ready(const pg8::Unit&) const {}
    DI void done(const pg8::Unit&) const {}
};

struct TJob { const float* src; bf16_t* dst; int ld, Kd, k0, n0, mode, half; };
DI void tjob_decode(int j, const Args& a, unsigned char* ws, TJob& t) {
    const float* w_in = a.in[4]; const float* w_out = a.in[10]; const float* w_qkv = a.in[11]; const float* w_o = a.in[12];
    const float* ew1 = a.in[17]; const float* ew3 = a.in[18]; const float* ew2 = a.in[19];
    t.mode = 0; t.half = 0;
    if (j < 896) { t.src = w_in; t.dst = (bf16_t*)(ws + WS_WIN); t.ld = EVEN_IN; t.Kd = D; t.k0 = (j / 56) * 128; t.n0 = (j % 56) * 128; return; }
    j -= 896;
    if (j < 256) { t.src = w_out; t.dst = (bf16_t*)(ws + WS_WOUT); t.ld = D; t.Kd = D; t.k0 = (j / 16) * 128; t.n0 = (j % 16) * 128; return; }
    j -= 256;
    if (j < 768) { t.src = w_qkv; t.dst = (bf16_t*)(ws + WS_WQKV); t.ld = 3 * D; t.Kd = D; t.k0 = (j / 48) * 128; t.n0 = (j % 48) * 128; return; }
    j -= 768;
    if (j < 256) { t.src = w_o; t.dst = (bf16_t*)(ws + WS_WO); t.ld = D; t.Kd = D; t.k0 = (j / 16) * 128; t.n0 = (j % 16) * 128; return; }
    j -= 256;
    const int le = j / 192, r = j % 192;
    if (r < 128) { const int hf = r / 64, q = r % 64; t.src = (hf ? ew3 : ew1) + (size_t)le * D * DEXP; t.dst = (bf16_t*)(ws + WS_WUP) + (size_t)le * 1024 * D; t.ld = DEXP; t.Kd = D;
        t.k0 = (q / 4) * 128; t.n0 = (q % 4) * 128; t.mode = 1; t.half = hf; return; }
    { const int q = r - 128; t.src = ew2 + (size_t)le * DEXP * D; t.dst = (bf16_t*)(ws + WS_WDN) + (size_t)le * D * DEXP; t.ld = D; t.Kd = DEXP; t.k0 = (q / 16) * 128; t.n0 = (q % 16) * 128; }
}
constexpr int N_TJOBS = 896 + 256 + 768 + 256 + 64 * 192;
DI void tjob_load(const TJob& t, int tid, f32x4 (&r)[8]) {
    const int c4 = (tid & 31) * 4, r0 = tid >> 5;
#pragma unroll
    for (int i = 0; i < 8; ++i) r[i] = *(const f32x4*)(t.src + (size_t)(t.k0 + r0 + 16 * i) * t.ld + t.n0 + c4);
}
DI void phase_transposes(const Frame& F, const Args& a) {
    LAS float* T = (LAS float*)F.lds;
    const int tid = F.tid; int j = F.bx; if (j >= N_TJOBS) return;
    TJob t; tjob_decode(j, a, F.ws, t); f32x4 r[8]; tjob_load(t, tid, r);
    for (;;) {
        const int c4 = (tid & 31) * 4, r0 = tid >> 5;
#pragma unroll
        for (int i = 0; i < 8; ++i) *(LAS f32x4*)(T + (r0 + 16 * i) * 132 + c4) = r[i];
        const TJob cur = t; const int jn = j + F.G; const bool more = jn < N_TJOBS;
        if (more) { tjob_decode(jn, a, F.ws, t); tjob_load(t, tid, r); }
        __syncthreads();
        { const int n = tid & 127, kg = tid >> 7; const int nn = cur.n0 + n;
          const int drow = cur.mode == 0 ? nn : (nn / 128) * 256 + cur.half * 128 + (nn % 128);
          bf16_t* dp = cur.dst + (size_t)drow * cur.Kd + cur.k0 + kg * 32;
#pragma unroll
          for (int q = 0; q < 4; ++q) { float v[8];
#pragma unroll
              for (int e = 0; e < 8; ++e) v[e] = T[(kg * 32 + q * 8 + e) * 132 + n];
              u32x4 w; w.x = pk_bf16(v[0], v[1]); w.y = pk_bf16(v[2], v[3]); w.z = pk_bf16(v[4], v[5]); w.w = pk_bf16(v[6], v[7]);
              *(u32x4*)(dp + q * 8) = w; } }
        __syncthreads();
        if (!more) break; j = jn;
    }
}
DI void phase_tables(const Frame& F, const Args& a) {
    const int gt = F.bx * NTHR + F.tid, gn = F.G * NTHR;
    float* LB = (float*)(F.ws + SM_LB); const float* lg = a.in[5];
    for (int d = gt; d < HG_QK; d += gn) { const float x = lg[d], y = lg[HG_QK + d], z = lg[2 * HG_QK + d], m = fmaxf(x, fmaxf(y, z));
        const float ex = __expf(x - m), ey = __expf(y - m), ez = __expf(z - m); LB[d] = ex / (ex + ey + ez); }
    float* RWT = (float*)(F.ws + WS_RWT);
    for (int i = gt; i < 2 * 2048 * 48; i += gn) { const int l = i / (2048 * 48), r = i % (2048 * 48); const int jj = r & 3, ln = (r >> 2) & 63, nt = (r >> 8) % 3, s = r / 768;
        const int k = 16 * s + 4 * (ln >> 4) + jj, n = 16 * nt + (ln & 15);
        float w = 0.f; if (n < 4) w = a.in[13][((size_t)l * D + k) * NGRP + n]; else if (n < 36) w = a.in[15][((size_t)l * D + k) * NEXP + (n - 4)];
        RWT[i] = w * a.in[2][l * D + k]; }
}

template <int MODE, bool COMBINE>
DI void phase_norm(const Frame& F, const float* src, float* hdst, const float* gain, bf16_t* xn, float* fout,
                   const bf16_t* Y, const int* slot, const float* wgt,
                   const float* w_in, float* glow, const float* rwt, const float* bg, const float* be, int* eid, float* wgt_out, unsigned* cnt) {
    const int lane = F.lane, w = F.wave;
    LAS float* rs = (LAS float*)(F.lds + LDS_MISC + MI_RSTD); LAS float* lgt = (LAS float*)(F.lds + LDS_MISC + MI_LOGIT);
    LAS f32x4* part = (LAS f32x4*)F.lds;
    for (int rb = F.bx; rb < NTOK / 64; rb += F.G) {
        const int r0 = rb * 64;
#pragma unroll 1
        for (int i = 0; i < 8; ++i) { const int row = r0 + w * 8 + i; const float* hr = src + (size_t)row * D;
            f32x4 v[8];
#pragma unroll
            for (int j = 0; j < 8; ++j) v[j] = *(const f32x4*)(hr + j * 256 + lane * 4);
            if (COMBINE) { const int s0 = slot[row * 2], s1 = slot[row * 2 + 1]; const float w0 = wgt[row * 2], w1 = wgt[row * 2 + 1];
#pragma unroll
                for (int j = 0; j < 8; ++j) { const u32x2 ya = *(const u32x2*)(Y + (size_t)s0 * D + j * 256 + lane * 4), yb = *(const u32x2*)(Y + (size_t)s1 * D + j * 256 + lane * 4);
                    v[j][0] += w0 * __uint_as_float(ya[0] << 16) + w1 * __uint_as_float(yb[0] << 16); v[j][1] += w0 * __uint_as_float(ya[0] & 0xFFFF0000u) + w1 * __uint_as_float(yb[0] & 0xFFFF0000u);
                    v[j][2] += w0 * __uint_as_float(ya[1] << 16) + w1 * __uint_as_float(yb[1] << 16); v[j][3] += w0 * __uint_as_float(ya[1] & 0xFFFF0000u) + w1 * __uint_as_float(yb[1] & 0xFFFF0000u); }
                if (MODE != 3) {
#pragma unroll
                    for (int j = 0; j < 8; ++j) *(f32x4*)(hdst + (size_t)row * D + j * 256 + lane * 4) = v[j]; } }
            float ss = 0.f;
#pragma unroll
            for (int j = 0; j < 8; ++j) ss += v[j][0] * v[j][0] + v[j][1] * v[j][1] + v[j][2] * v[j][2] + v[j][3] * v[j][3];
            ss = wave_sum(ss); const float rstd = rsqrtf(ss * (1.0f / D) + EPS);
            if (MODE == 1 || MODE == 2) { if (lane == 0) rs[w * 8 + i] = rstd; }
#pragma unroll
            for (int j = 0; j < 8; ++j) { const f32x4 g4 = *(const f32x4*)(gain + j * 256 + lane * 4); const f32x4 o = v[j] * g4 * rstd;
                if (MODE == 3) *(f32x4*)(fout + (size_t)row * D + j * 256 + lane * 4) = o;
                else { u32x2 p; p[0] = pk_bf16(o[0], o[1]); p[1] = pk_bf16(o[2], o[3]); *(u32x2*)(xn + (size_t)row * D + j * 256 + lane * 4) = p; } }
        }
        if (MODE == 1 || MODE == 2) {
            constexpr int NT = MODE == 2 ? 3 : 1;
            __builtin_amdgcn_fence(__ATOMIC_RELEASE, "workgroup"); __syncthreads(); __builtin_amdgcn_fence(__ATOMIC_ACQUIRE, "workgroup");
            const int rg = w & 3, kh = w >> 2, m = lane & 15, kq = lane >> 4;
            const float* xr = (COMBINE ? hdst : src) + (size_t)(r0 + rg * 16 + m) * D + 4 * kq;
            f32x4 acc[NT];
#pragma unroll
            for (int t = 0; t < NT; ++t) acc[t] = (f32x4){0.f, 0.f, 0.f, 0.f};
#pragma unroll 2
            for (int s = kh * 64; s < kh * 64 + 64; ++s) {
                const f32x4 xa = *(const f32x4*)(xr + 16 * s);
                f32x4 wb[NT];
                if (MODE == 2) {
#pragma unroll
                    for (int t = 0; t < NT; ++t) wb[t] = *(const f32x4*)(rwt + ((size_t)(s * 3 + t) * 64 + lane) * 4); }
                else {
#pragma unroll
                    for (int j = 0; j < 4; ++j) { const int k = 16 * s + 4 * kq + j; wb[0][j] = w_in[(size_t)k * EVEN_IN + EVEN_MAIN + m] * gain[k]; } }
#pragma unroll
                for (int j = 0; j < 4; ++j)
#pragma unroll
                    for (int t = 0; t < NT; ++t) acc[t] = __builtin_amdgcn_mfma_f32_16x16x4f32(xa[j], wb[t][j], acc[t], 0, 0, 0);
            }
            if (kh == 1) {
#pragma unroll
                for (int t = 0; t < NT; ++t) part[(rg * 3 + t) * 64 + lane] = acc[t]; }
            __syncthreads();
            if (kh == 0) {
#pragma unroll
                for (int t = 0; t < NT; ++t) { const f32x4 p = part[(rg * 3 + t) * 64 + lane];
#pragma unroll
                    for (int q = 0; q < 4; ++q) { const int rl = rg * 16 + 4 * kq + q; const float val = (acc[t][q] + p[q]) * rs[rl];
                        if (MODE == 1) glow[(size_t)(r0 + rl) * 16 + m] = val; else lgt[rl * 48 + t * 16 + m] = val; } } }
            __syncthreads();
            if (MODE == 2 && F.tid < 64) {
                const int row = r0 + F.tid; const LAS float* lr = lgt + F.tid * 48;
                float lg[4], e8[8];
#pragma unroll
                for (int c = 0; c < 4; ++c) lg[c] = lr[c] + bg[c];
                int grp = 0; float mx = lg[0];
#pragma unroll
                for (int c = 1; c < 4; ++c) if (lg[c] > mx) { mx = lg[c]; grp = c; }
                float den = 0.f;
#pragma unroll
                for (int c = 0; c < 4; ++c) den += __expf(lg[c] - mx);
                const float pg = 1.0f / den;
#pragma unroll
                for (int c = 0; c < 8; ++c) e8[c] = lr[4 + grp * 8 + c] + be[grp * 8 + c];
                int j0 = 0; float v0 = e8[0];
#pragma unroll
                for (int c = 1; c < 8; ++c) if (e8[c] > v0) { v0 = e8[c]; j0 = c; }
                int j1 = 0; float v1 = -3.0e38f;
#pragma unroll
                for (int c = 0; c < 8; ++c) if (c != j0 && e8[c] > v1) { v1 = e8[c]; j1 = c; }
                const float e1 = __expf(v1 - v0), sden = 1.0f / (1.0f + e1);
                const int ea = grp * 8 + j0, eb = grp * 8 + j1;
                eid[row * 2] = ea; eid[row * 2 + 1] = eb; wgt_out[row * 2] = pg * sden; wgt_out[row * 2 + 1] = pg * e1 * sden;
                atomicAdd(&cnt[ea], 1u); atomicAdd(&cnt[eb], 1u);
            }
            __syncthreads();
        }
    }
}

DI void moe_plan(const Frame& F, const unsigned* cnt) {
    LAS int* tile_e = (LAS int*)(F.lds + LDS_MISC + MI_TILEE); LAS int* ebase = (LAS int*)(F.lds + LDS_MISC + MI_EBASE); LAS int* ntp = (LAS int*)(F.lds + LDS_MISC + MI_NT);
    if (F.tid == 0) { int t = 0;
        for (int e = 0; e < NEXP; ++e) { const int c = (int)__hip_atomic_load(cnt + e, __ATOMIC_RELAXED, __HIP_MEMORY_SCOPE_AGENT); const int nt = (c + MOE_TILE - 1) / MOE_TILE; ebase[e] = t * MOE_TILE;
            for (int i = 0; i < nt && t + i < MOE_MAXT; ++i) tile_e[t + i] = e; t += nt; }
        if (t > MOE_MAXT) t = MOE_MAXT; *ntp = t; }
    __syncthreads();
}
DI void phase_scatter(const Frame& F, const int* eid, unsigned* cur, int* slot, const bf16_t* xn, bf16_t* xs) {
    const LAS int* ebase = (const LAS int*)(F.lds + LDS_MISC + MI_EBASE);
    for (int blk = F.bx; blk < (2 * NTOK) / 128; blk += F.G) {
        const int i0 = blk * 128 + F.wave * 16; int myslot = 0;
        if (F.lane < 16) { const int e = eid[i0 + F.lane]; const unsigned p = __hip_atomic_fetch_add(cur + e, 1u, __ATOMIC_RELAXED, __HIP_MEMORY_SCOPE_AGENT); myslot = ebase[e] + (int)p; slot[i0 + F.lane] = myslot; }
#pragma unroll 4
        for (int q = 0; q < 16; ++q) { const int s = __shfl(myslot, q); const int tok = (i0 + q) >> 1;
            const u32x4* sp = (const u32x4*)(xn + (size_t)tok * D) + F.lane; u32x4* dp = (u32x4*)(xs + (size_t)s * D) + F.lane;
#pragma unroll
            for (int c = 0; c < 4; ++c) dp[c * 64] = sp[c * 64]; }
    }
}
DI void phase_kmean(const Frame& F, const bf16_t* Kb, float* kmean) {
    LAS float* red = (LAS float*)F.lds;
    for (int it = F.bx; it < NB * MB_H * MB_NBLK; it += F.G) {
        const int n = it % MB_NBLK, hh = (it / MB_NBLK) % MB_H, b = it / (MB_NBLK * MB_H);
        const int kg = F.tid >> 4, d8 = (F.tid & 15) * 8; float s[8];
#pragma unroll
        for (int e = 0; e < 8; ++e) s[e] = 0.f;
        const bf16_t* p = Kb + ((size_t)b * SEQ + n * MB_BLK + kg * 8) * D + hh * MB_DH + d8;
#pragma unroll
        for (int j = 0; j < 8; ++j) { const u32x4 v = *(const u32x4*)(p + (size_t)j * D);
#pragma unroll
            for (int e = 0; e < 4; ++e) { s[2 * e] += __uint_as_float(v[e] << 16); s[2 * e + 1] += __uint_as_float(v[e] & 0xFFFF0000u); } }
#pragma unroll
        for (int e = 0; e < 8; ++e) red[kg * 128 + d8 + e] = s[e];
        __syncthreads();
        if (F.tid < 128) { float t = 0.f;
#pragma unroll
            for (int g = 0; g < 32; ++g) t += red[g * 128 + F.tid];
            kmean[(size_t)it * MB_DH + F.tid] = t * (1.0f / MB_BLK); }
        __syncthreads();
    }
}


template <int DV, bool IS_GLA>
DI void scan_naive_unit(LAS float* sb, int nthr_sub, int stid, int b, int hh, int nheads, const bf16_t* __restrict__ Q, const float* __restrict__ LF, const bf16_t* __restrict__ Kx, const bf16_t* __restrict__ V,
                        const float* __restrict__ glow, const float* __restrict__ gk2, const float* __restrict__ gkb, float* __restrict__ oraw, int ocol0) {
    constexpr int T = 16;
    LAS float* sq = sb; LAS float* sk = sb + T * 128; LAS float* sa = sb + 2 * T * 128;
    const int v = stid, qld = nheads * 128, vld = nheads * DV;
    float S[128];
#pragma unroll
    for (int d = 0; d < 128; ++d) S[d] = 0.f;
    for (int t0 = 0; t0 < SEQ; t0 += T) {
        __syncthreads();
        for (int i = stid; i < T * 128; i += nthr_sub) { const int tt = i >> 7, d = i & 127; const size_t tok = (size_t)b * SEQ + t0 + tt;
            sq[i] = bf2f(Q[tok * qld + hh * 128 + d]);
            if (IS_GLA) { float z = gkb[hh * 128 + d];
#pragma unroll
                for (int r = 0; r < GL_RANK; ++r) z += glow[tok * 16 + r] * gk2[r * GL_QK + hh * 128 + d];
                const float ls = fminf(z, 0.f) - log1pf(__expf(-fabsf(z)));
                sa[i] = __expf(ls * (1.0f / 16.0f)); sk[i] = bf2f(Kx[tok * qld + hh * 128 + d]); }
            else { const float al = __expf(LF[tok * qld + hh * 128 + d]); sa[i] = al; sk[i] = 1.0f - al; } }
        __syncthreads();
        for (int tt = 0; tt < T; ++tt) { const size_t tok = (size_t)b * SEQ + t0 + tt;
            const float vv = bf2f(V[tok * vld + hh * DV + v]); float o = 0.f;
#pragma unroll
            for (int d = 0; d < 128; ++d) { S[d] = sa[tt * 128 + d] * S[d] + sk[tt * 128 + d] * vv; o += sq[tt * 128 + d] * S[d]; }
            oraw[tok * D + ocol0 + hh * DV + v] = o; }
    }
}
DI void phase_scan_naive(const Frame& F, unsigned char* ws, const float* gk2, const float* gkb, float* oraw) {
    LAS float* base = (LAS float*)F.lds;
    if (F.bx < 8) { const int sub = F.tid >> 7, stid = F.tid & 127, unit = F.bx * 4 + sub;
        scan_naive_unit<128, false>(base + sub * 3 * 16 * 128, 128, stid, unit / HG_H, unit % HG_H, HG_H, (const bf16_t*)(ws + U_HQ), (const float*)(ws + U_HLF), nullptr, (const bf16_t*)(ws + U_HI), nullptr, nullptr, nullptr, oraw, 0); }
    else if (F.bx < 16) { const int sub = F.tid >> 8, stid = F.tid & 255, unit = (F.bx - 8) * 2 + sub;
        scan_naive_unit<256, true>(base + sub * 3 * 16 * 128, 256, stid, unit / GL_H, unit % GL_H, GL_H, (const bf16_t*)(ws + U_GQ), nullptr, (const bf16_t*)(ws + U_GK), (const bf16_t*)(ws + U_GV), (const float*)(ws + WS_GLOW), gk2, gkb, oraw, 1024); }
}
DI void phase_ngate(const Frame& F, const float* oraw, const float* hg_norm, const float* gla_norm, const bf16_t* hgg, const bf16_t* gg, bf16_t* mix) {
    const int lane = F.lane;
    for (int w = F.bx * NWAVE + F.wave; w < NTOK * 12; w += F.G * NWAVE) {
        const int tok = w / 12, s = w % 12; const bool gla = s >= 8; const int dv = gla ? 256 : 128, col0 = gla ? 1024 + (s - 8) * 256 : s * 128;
        const float* o = oraw + (size_t)tok * D + col0; float x[4]; float ss = 0.f; const int n = dv / 64;
#pragma unroll
        for (int i = 0; i < 4; ++i) { x[i] = i < n ? o[lane + 64 * i] : 0.f; ss += x[i] * x[i]; }
        ss = wave_sum(ss); const float rstd = rsqrtf(ss / dv + EPS);
#pragma unroll
        for (int i = 0; i < 4; ++i) if (i < n) { const int c = lane + 64 * i; const float gain = gla ? gla_norm[c] : hg_norm[c];
            const float gate = gla ? bf2f(gg[(size_t)tok * 1024 + (s - 8) * 256 + c]) : bf2f(hgg[(size_t)tok * 1024 + s * 128 + c]);
            mix[(size_t)tok * D + col0 + c] = f2bf(x[i] * rstd * gain * gate); }
    }
}
DI void phase_moba_naive(const Frame& F, const bf16_t* __restrict__ Qb, const bf16_t* __restrict__ Kb, const bf16_t* __restrict__ Vb, const float* __restrict__ kmean, bf16_t* __restrict__ AO) {
    LAS float* sq = (LAS float*)F.lds + F.wave * 128;
    LAS float* sp = (LAS float*)F.lds + 8 * 128 + F.wave * 1024;
    LAS int* ssel = (LAS int*)((LAS float*)F.lds + 8 * 128 + 8 * 1024) + F.wave * 4;
    const int lane = F.lane;
    for (int qg = F.bx; qg < NB * MB_H * SEQ / NWAVE; qg += F.G) {
        const int qi = qg * NWAVE + F.wave; const int t = qi % SEQ, hh = (qi / SEQ) % MB_H, b = qi / (SEQ * MB_H);
        const size_t tok = (size_t)b * SEQ + t; const int qb = t / MB_BLK;
        __syncthreads();
        sq[lane] = bf2f(Qb[tok * D + hh * MB_DH + lane]); sq[lane + 64] = bf2f(Qb[tok * D + hh * MB_DH + lane + 64]);
        __syncthreads();
        float gate = -3.0e38f;
        if (lane < qb) { const float* km = kmean + ((size_t)(b * MB_H + hh) * MB_NBLK + lane) * MB_DH; float s = 0.f; for (int d = 0; d < 128; ++d) s += sq[d] * km[d]; gate = s; }
        const int nsel = qb < 3 ? qb : 3;
        for (int s = 0; s < 3; ++s) { float best = gate; int bi = lane;
            for (int o = 32; o > 0; o >>= 1) { const float ob = __shfl_xor(best, o); const int oi = __shfl_xor(bi, o); if (ob > best || (ob == best && oi < bi)) { best = ob; bi = oi; } }
            if (lane == 0) ssel[s] = bi; if (lane == bi) gate = -3.4e38f; }
        __syncthreads();
        const float scale = 0.08838834764831845f; float mx = -3.0e38f;
        for (int sgi = 0; sgi <= nsel; ++sgi) { const int blk = sgi < nsel ? ssel[sgi] : qb;
            for (int i = 0; i < 4; ++i) { const int j = lane + 64 * i, kp = blk * MB_BLK + j; float s = -__builtin_inff();
                if (sgi < nsel || kp <= t) { const bf16_t* kr = Kb + ((size_t)b * SEQ + kp) * D + hh * MB_DH; float acc = 0.f;
                    for (int d = 0; d < 128; d += 2) { const unsigned w = *(const unsigned*)(kr + d); acc += sq[d] * __uint_as_float(w << 16) + sq[d + 1] * __uint_as_float(w & 0xFFFF0000u); }
                    s = acc * scale; }
                sp[sgi * 256 + j] = s; mx = fmaxf(mx, s); } }
        for (int o = 32; o > 0; o >>= 1) mx = fmaxf(mx, __shfl_xor(mx, o));
        float den = 0.f;
        for (int sgi = 0; sgi <= nsel; ++sgi) for (int i = 0; i < 4; ++i) { const int idx = sgi * 256 + lane + 64 * i; const float p = __expf(sp[idx] - mx); sp[idx] = p; den += p; }
        den = wave_sum(den);
        __syncthreads();
        float o0 = 0.f, o1 = 0.f;
        for (int sgi = 0; sgi <= nsel; ++sgi) { const int blk = sgi < nsel ? ssel[sgi] : qb; const int jmax = sgi < nsel ? 256 : (t - qb * MB_BLK + 1);
            for (int j = 0; j < jmax; ++j) { const float p = sp[sgi * 256 + j]; const unsigned w = *(const unsigned*)(Vb + ((size_t)b * SEQ + blk * MB_BLK + j) * D + hh * MB_DH + lane * 2);
                o0 += p * __uint_as_float(w << 16); o1 += p * __uint_as_float(w & 0xFFFF0000u); } }
        const float inv = 1.0f / den;
        *(unsigned*)(AO + tok * D + hh * MB_DH + lane * 2) = (unsigned)f2bf(o0 * inv) | ((unsigned)f2bf(o1 * inv) << 16);
    }
}

enum { PH_PRO = 0, PH_GEMM1 = 1, PH_SCAN = 2, PH_NGATE = 3, PH_OUTP = 4, PH_NORM_F0 = 5, PH_SCAT0 = 6, PH_UP0 = 7, PH_DN0 = 8, PH_COMB0 = 9, PH_QKV = 10, PH_KMEAN = 11, PH_ATTN = 12,
       PH_OPROJ = 13, PH_NORM_F1 = 14, PH_SCAT1 = 15, PH_UP1 = 16, PH_DN1 = 17, PH_FINAL = 18, PH_END = 19 };

__global__ void __launch_bounds__(NTHR, 2) mk_fwd(Args a) {
    extern __shared__ __attribute__((aligned(16))) unsigned char lds_raw[];
    Frame F; F.lds = (LAS unsigned char*)lds_raw; F.tid = threadIdx.x; F.lane = F.tid & 63; F.wave = __builtin_amdgcn_readfirstlane(F.tid >> 6);
    F.G = gridDim.x; F.bx = blockIdx.x; F.vcu = (F.G % 8 == 0) ? (F.bx % 8) * (F.G / 8) + F.bx / 8 : F.bx;
    F.ws = a.ws; F.ctl = (unsigned*)(a.ws + WS_CTL);
    unsigned char* ws = a.ws;
    if (F.tid < 4) ((LAS unsigned*)(F.lds + LDS_MISC + MI_BAR))[F.tid] = 0u;
    __syncthreads();
    const int lo = a.ph_lo, hi = a.ph_hi;
    XcdBarrier bar; bar.bar = F.ctl + CW2_BAR + a.bar_idx * XCD_BAR_WORDS; bar.x = 0; bar.st = (volatile LAS unsigned*)(F.lds + LDS_MISC + MI_BAR);
    if (hi - lo > 1) bar = xcd_barrier_post(F.ctl + CW2_BAR + a.bar_idx * XCD_BAR_WORDS, (volatile LAS unsigned*)(F.lds + LDS_MISC + MI_BAR));
#define IN(k) (lo <= (k) && (k) < hi)
#define SEAM(k) do { if (IN(k) && IN((k) + 1)) xcd_barrier(bar); } while (0)
    const float* x = a.in[0]; const float* norm_mix = a.in[1]; const float* norm_ffn = a.in[2]; const float* norm_final = a.in[3];
    bf16_t* WinT = (bf16_t*)(ws + WS_WIN); bf16_t* WoutT = (bf16_t*)(ws + WS_WOUT); bf16_t* WqkvT = (bf16_t*)(ws + WS_WQKV); bf16_t* WoT = (bf16_t*)(ws + WS_WO);
    bf16_t* Wup = (bf16_t*)(ws + WS_WUP); bf16_t* Wdn = (bf16_t*)(ws + WS_WDN);
    bf16_t* XN = (bf16_t*)(ws + WS_XN); float* H = (float*)(ws + WS_H);
    float* LB = (float*)(ws + SM_LB); float* KMEAN = (float*)(ws + SM_KMEAN);
    float* GLOW = (float*)(ws + WS_GLOW); int* EID = (int*)(ws + WS_EID); float* WGT = (float*)(ws + WS_WGT); int* SLOT = (int*)(ws + WS_SLOT);
    float* RWT = (float*)(ws + WS_RWT);
    bf16_t* Qb = (bf16_t*)(ws + U_Q); bf16_t* Kb = (bf16_t*)(ws + U_K); bf16_t* Vb = (bf16_t*)(ws + U_V);
    bf16_t* HMID = (bf16_t*)(ws + U_HMID); bf16_t* Y = (bf16_t*)(ws + U_Y); bf16_t* XS = (bf16_t*)(ws + U_XS);
    const LAS int* tile_e = (const LAS int*)(F.lds + LDS_MISC + MI_TILEE); const LAS int* ntp = (const LAS int*)(F.lds + LDS_MISC + MI_NT);

    if (IN(PH_PRO)) {
        phase_tables(F, a);
        phase_norm<1, false>(F, x, nullptr, norm_mix, XN, nullptr, nullptr, nullptr, nullptr, a.in[4], GLOW, nullptr, nullptr, nullptr, nullptr, nullptr, nullptr);
        __syncthreads();
        phase_transposes(F, a);
    }
    SEAM(PH_PRO);
    if (IN(PH_GEMM1)) {
        pg8::Gemm g{XN, WinT, NTOK, EVEN_MAIN, D}; pg8::StaticOrder S; S.init(NTOK, EVEN_MAIN, F.G, F.bx);
        EpiProj0F E{(bf16_t*)(ws + U_HQ), (float*)(ws + U_HLF), (bf16_t*)(ws + U_HI), (bf16_t*)(ws + U_HGG), (bf16_t*)(ws + U_GQ), (bf16_t*)(ws + U_GK), (bf16_t*)(ws + U_GV), (bf16_t*)(ws + U_GG), LB};
        pg8::gemm_phase<EpiProj0F, pg8::StaticOrder, true, true>(F.lds, g, S, E);
    }
    SEAM(PH_GEMM1);
    if (IN(PH_SCAN)) phase_scan_naive(F, ws, a.in[7], a.in[8], H);
    SEAM(PH_SCAN);
    if (IN(PH_NGATE)) phase_ngate(F, H, a.in[6], a.in[9], (const bf16_t*)(ws + U_HGG), (const bf16_t*)(ws + U_GG), XN);
    SEAM(PH_NGATE);
    if (IN(PH_OUTP)) {
        pg8::Gemm g{XN, WoutT, NTOK, D, D}; pg8::StaticOrder S; S.init(NTOK, D, F.G, F.bx);
        EpiResidF E{x, H};
        pg8::gemm_phase<EpiResidF, pg8::StaticOrder, true, true>(F.lds, g, S, E);
    }
    SEAM(PH_OUTP);
#define MOE_LAYER(l, PHN, PHS, PHU, PHD, CNT, CUR)                                                                                              \
    if (IN(PHN)) phase_norm<2, false>(F, H, nullptr, norm_ffn + (l) * D, XN, nullptr, nullptr, nullptr, nullptr, nullptr, nullptr,              \
                                      RWT + (size_t)(l) * 2048 * 48, a.in[14] + (l) * NGRP, a.in[16] + (l) * NEXP, EID, WGT, F.ctl + CNT);        \
    SEAM(PHN);                                                                                                                                  \
    if (IN(PHS)) { moe_plan(F, F.ctl + CNT); phase_scatter(F, EID, F.ctl + CUR, SLOT, XN, XS); }                                                \
    SEAM(PHS);                                                                                                                                  \
    if (IN(PHU)) { moe_plan(F, F.ctl + CNT);                                                                                                    \
        pg8::Gemm g{XS, Wup + (size_t)(l) * NEXP * 1024 * D, MOE_ROWS, NEXP * 1024, D}; MoeOrder S{4, 2, *ntp * 4, F.G, F.vcu, tile_e};          \
        EpiSwigluF E{HMID}; pg8::gemm_phase<EpiSwigluF, MoeOrder, true, true>(F.lds, g, S, E); }                                                \
    SEAM(PHU);                                                                                                                                  \
    if (IN(PHD)) { moe_plan(F, F.ctl + CNT);                                                                                                    \
        pg8::Gemm g{HMID, Wdn + (size_t)(l) * NEXP * D * DEXP, MOE_ROWS, NEXP * D, DEXP}; MoeOrder S{8, 3, *ntp * 8, F.G, F.vcu, tile_e};        \
        EpiBf16F E{Y, D, 8, 0, 0}; pg8::gemm_phase<EpiBf16F, MoeOrder, true, true>(F.lds, g, S, E); }                                           \
    SEAM(PHD);
    MOE_LAYER(0, PH_NORM_F0, PH_SCAT0, PH_UP0, PH_DN0, CW2_CNT0, CW2_CUR0)
    if (IN(PH_COMB0)) phase_norm<0, true>(F, H, H, norm_mix + D, XN, nullptr, Y, SLOT, WGT, nullptr, nullptr, nullptr, nullptr, nullptr, nullptr, nullptr, nullptr);
    SEAM(PH_COMB0);
    if (IN(PH_QKV)) {
        pg8::Gemm g{XN, WqkvT, NTOK, 3 * D, D}; pg8::StaticOrder S; S.init(NTOK, 3 * D, F.G, F.bx);
        EpiBf16F E{Qb, D, 24, 8, (size_t)NTOK * D};
        pg8::gemm_phase<EpiBf16F, pg8::StaticOrder, true, true>(F.lds, g, S, E);
    }
    SEAM(PH_QKV);
    if (IN(PH_KMEAN)) phase_kmean(F, Kb, KMEAN);
    SEAM(PH_KMEAN);
    if (IN(PH_ATTN)) phase_moba_naive(F, Qb, Kb, Vb, KMEAN, XN);
    SEAM(PH_ATTN);
    if (IN(PH_OPROJ)) {
        pg8::Gemm g{XN, WoT, NTOK, D, D}; pg8::StaticOrder S; S.init(NTOK, D, F.G, F.bx);
        EpiResidF E{H, H};
        pg8::gemm_phase<EpiResidF, pg8::StaticOrder, true, true>(F.lds, g, S, E);
    }
    SEAM(PH_OPROJ);
    MOE_LAYER(1, PH_NORM_F1, PH_SCAT1, PH_UP1, PH_DN1, CW2_CNT1, CW2_CUR1)
    if (IN(PH_FINAL)) phase_norm<3, true>(F, H, nullptr, norm_final, nullptr, a.out, Y, SLOT, WGT, nullptr, nullptr, nullptr, nullptr, nullptr, nullptr, nullptr, nullptr);
#undef IN
#undef SEAM
#undef MOE_LAYER
}


extern "C" void kernel_launch(void* const* d_in, const int* in_sizes, int n_in, void* d_out, int out_size, void* d_ws, size_t ws_size, hipStream_t stream) {
    static int grid = 0;
    if (grid == 0) {
        if (n_in != 20 || out_size != NTOK * D || ws_size < WS_TOTAL2) { fprintf(stderr, "kernel_launch: unexpected shapes / workspace (%d inputs, out %d, ws %zu need %zu)\n", n_in, out_size, ws_size, (size_t)WS_TOTAL2); grid = -1; return; }
        int dev = 0, cus = 0;
        if (hipGetDevice(&dev) != hipSuccess || hipDeviceGetAttribute(&cus, hipDeviceAttributeMultiprocessorCount, dev) != hipSuccess || cus <= 0) { grid = -1; return; }
        if (hipFuncSetAttribute((const void*)mk_fwd, hipFuncAttributeMaxDynamicSharedMemorySize, LDS_BYTES) != hipSuccess) { fprintf(stderr, "kernel_launch: hipFuncSetAttribute failed\n"); grid = -1; return; }
        int per_cu = 0; (void)hipOccupancyMaxActiveBlocksPerMultiprocessor(&per_cu, (const void*)mk_fwd, NTHR, LDS_BYTES); (void)hipGetLastError();
        if (per_cu < 1) fprintf(stderr, "kernel_launch: occupancy query reports %d\n", per_cu);
        grid = cus;
    }
    if (grid < 0) return;
    const float* x = (const float*)d_in[0];
    const float* hg_norm = (const float*)d_in[6]; const float* gk2 = (const float*)d_in[7]; const float* gkb = (const float*)d_in[8]; const float* gla_norm = (const float*)d_in[9];
    unsigned char* ws = (unsigned char*)d_ws;
    bf16_t* XN = (bf16_t*)(ws + WS_XN); float* H = (float*)(ws + WS_H);
    float* KMEAN = (float*)(ws + SM_KMEAN); float* GLOW = (float*)(ws + WS_GLOW);
    bf16_t* HQ = (bf16_t*)(ws + U_HQ); float* HLF = (float*)(ws + U_HLF); bf16_t* HI = (bf16_t*)(ws + U_HI); bf16_t* HGG = (bf16_t*)(ws + U_HGG);
    bf16_t* GQ = (bf16_t*)(ws + U_GQ); bf16_t* GK = (bf16_t*)(ws + U_GK); bf16_t* GV = (bf16_t*)(ws + U_GV); bf16_t* GG = (bf16_t*)(ws + U_GG);
    bf16_t* Qb = (bf16_t*)(ws + U_Q); bf16_t* Kb = (bf16_t*)(ws + U_K); bf16_t* Vb = (bf16_t*)(ws + U_V);
    (void)x;
    (void)hipMemsetAsync(ws + WS_CTL, 0, CTL_BYTES, stream);
    Args a{};
    for (int i = 0; i < 20; ++i) a.in[i] = (const float*)d_in[i];
    a.out = (float*)d_out; a.ws = ws;
    auto run = [&](int lo, int hi, int bi) { a.ph_lo = lo; a.ph_hi = hi; a.bar_idx = bi; a.pad = 0; hipLaunchKernelGGL(mk_fwd, dim3(grid), dim3(NTHR), LDS_BYTES, stream, a); };
    run(PH_PRO, PH_END, 0);
}
```

```cpp
#include <hip/hip_runtime.h>
#include <cstdio>
#include <cstdint>

typedef unsigned short bf16_t;
#define DI __device__ __forceinline__

constexpr int D = 2048, NB = 4, SEQ = 4096, NTOK = NB * SEQ;
constexpr int HG_H = 8, HG_DK = 128, HG_DV = 128, HG_QK = 1024, HG_V = 1024;
constexpr int GL_H = 4, GL_DK = 128, GL_DV = 256, GL_QK = 512, GL_V = 1024, GL_RANK = 16;
constexpr int EVEN_IN = 7184, EVEN_MAIN = 7168;
constexpr int MB_H = 16, MB_DH = 128, MB_BLK = 256, MB_NBLK = SEQ / MB_BLK;
constexpr int NEXP = 32, NGRP = 4, EPG = 8, DEXP = 512;
constexpr int MOE_TILE = 256, MOE_MAXT = (2 * NTOK) / MOE_TILE + NEXP, MOE_ROWS = MOE_MAXT * MOE_TILE;
constexpr float EPS = 1e-6f;

constexpr size_t MBy = 1024 * 1024;
constexpr size_t WS_CTL   = 0;
constexpr size_t CTL_BYTES = 64 * 1024;
constexpr size_t WS_SMALL = WS_CTL + CTL_BYTES;
constexpr size_t WS_WIN   = WS_SMALL + 1 * MBy;
constexpr size_t WS_WOUT  = WS_WIN + (size_t)EVEN_MAIN * D * 2;
constexpr size_t WS_WQKV  = WS_WOUT + (size_t)D * D * 2;
constexpr size_t WS_WO    = WS_WQKV + (size_t)3 * D * D * 2;
constexpr size_t WS_WUP   = WS_WO + (size_t)D * D * 2;
constexpr size_t WS_WDN   = WS_WUP + (size_t)2 * NEXP * 1024 * D * 2;
constexpr size_t WS_XN    = WS_WDN + (size_t)2 * NEXP * D * DEXP * 2;
constexpr size_t WS_H     = WS_XN + (size_t)NTOK * D * 2;
constexpr size_t WS_U     = WS_H + (size_t)NTOK * D * 4;
constexpr size_t U_HQ  = WS_U;
constexpr size_t U_HLF = U_HQ + (size_t)NTOK * 1024 * 2;
constexpr size_t U_HI  = U_HLF + (size_t)NTOK * 1024 * 4;
constexpr size_t U_HGG = U_HI + (size_t)NTOK * 1024 * 2;
constexpr size_t U_GQ  = U_HGG + (size_t)NTOK * 1024 * 2;
constexpr size_t U_GK  = U_GQ + (size_t)NTOK * 512 * 2;
constexpr size_t U_GV  = U_GK + (size_t)NTOK * 512 * 2;
constexpr size_t U_GG  = U_GV + (size_t)NTOK * 1024 * 2;
constexpr size_t U_END0 = U_GG + (size_t)NTOK * 1024 * 2;
constexpr size_t U_Q = WS_U, U_K = U_Q + (size_t)NTOK * D * 2, U_V = U_K + (size_t)NTOK * D * 2, U_END1 = U_V + (size_t)NTOK * D * 2;
constexpr size_t U_HMID = WS_U;
constexpr size_t U_Y = U_HMID + (size_t)MOE_ROWS * DEXP * 2;
constexpr size_t U_END2 = U_Y + (size_t)MOE_ROWS * D * 2;
constexpr size_t U_BYTES = U_END0 - WS_U;
static_assert(U_END1 - WS_U <= U_BYTES && U_END2 - WS_U <= U_BYTES, "union");
constexpr size_t WS_END = WS_U + U_BYTES;
constexpr size_t SM_LB    = WS_SMALL;
constexpr size_t SM_GLOW  = SM_LB + 4096;
constexpr size_t SM_KMEAN = WS_SMALL + 64 * 1024;
constexpr size_t SM_TILEE = SM_KMEAN + 512 * 1024;
constexpr size_t WS_GLOW  = WS_END;
constexpr size_t WS_EID   = WS_GLOW + (size_t)NTOK * 16 * 4;
constexpr size_t WS_WGT   = WS_EID + (size_t)NTOK * 2 * 4;
constexpr size_t WS_SLOT  = WS_WGT + (size_t)NTOK * 2 * 4;
constexpr size_t WS_ROWTOK = WS_SLOT + (size_t)NTOK * 2 * 4;
constexpr size_t WS_TOTAL = WS_ROWTOK + (size_t)MOE_ROWS * 4;
constexpr int CW_CNT = 0;
constexpr int CW_CUR = 64;
constexpr int CW_BASE = 128;
constexpr int CW_NT = 192;

DI float bf2f(bf16_t b) { return __uint_as_float(((unsigned)b) << 16); }
DI bf16_t f2bf(float f) { unsigned u = __float_as_uint(f); u += 0x7FFFu + ((u >> 16) & 1u); return (bf16_t)(u >> 16); }
DI float sigmoidf_(float x) { return 1.0f / (1.0f + __expf(-x)); }
DI float siluf_(float x) { return x / (1.0f + __expf(-x)); }
DI float wave_sum(float v) { for (int o = 32; o > 0; o >>= 1) v += __shfl_xor(v, o); return v; }

template <int MODE>
__global__ void k_transpose(const float* __restrict__ src, bf16_t* __restrict__ dst, int K, int N, int ld, int c0, int half, size_t src_bstride, size_t dst_bstride) {
    __shared__ float t[64][65];
    src += (size_t)blockIdx.z * src_bstride; dst += (size_t)blockIdx.z * dst_bstride;
    const int k0 = blockIdx.y * 64, n0 = blockIdx.x * 64, tx = threadIdx.x & 63, ty = threadIdx.x >> 6;
    for (int i = ty; i < 64; i += 4) t[i][tx] = src[(size_t)(k0 + i) * ld + c0 + n0 + tx];
    __syncthreads();
    for (int i = ty; i < 64; i += 4) { const int n = n0 + i; const int r = MODE == 0 ? n : (n / 128) * 256 + half * 128 + (n % 128);
        dst[(size_t)r * K + k0 + tx] = f2bf(t[tx][i]); }
}
__global__ void k_lb(const float* __restrict__ lg, float* __restrict__ lb) {
    const int d = blockIdx.x * blockDim.x + threadIdx.x; if (d >= HG_QK) return;
    const float a = lg[d], b = lg[HG_QK + d], c = lg[2 * HG_QK + d], m = fmaxf(a, fmaxf(b, c));
    const float ea = __expf(a - m), eb = __expf(b - m), ec = __expf(c - m); lb[d] = ea / (ea + eb + ec);
}

template <int MODE>
__global__ void k_rmsnorm(const float* __restrict__ h, const float* __restrict__ g, bf16_t* __restrict__ xn, float* __restrict__ fout,
                          const float* __restrict__ w_in, float* __restrict__ glow,
                          const float* __restrict__ wg, const float* __restrict__ bg, const float* __restrict__ we, const float* __restrict__ be,
                          int* __restrict__ eid, float* __restrict__ wgt, unsigned* __restrict__ ctl) {
    const int row = blockIdx.x * 4 + (threadIdx.x >> 6), lane = threadIdx.x & 63;
    const float* hr = h + (size_t)row * D;
    float v[32]; float ss = 0.f;
#pragma unroll
    for (int j = 0; j < 8; ++j) { const float4 x = *(const float4*)(hr + j * 256 + lane * 4); v[4 * j] = x.x; v[4 * j + 1] = x.y; v[4 * j + 2] = x.z; v[4 * j + 3] = x.w; ss += x.x * x.x + x.y * x.y + x.z * x.z + x.w * x.w; }
    ss = wave_sum(ss); const float rstd = rsqrtf(ss * (1.0f / D) + EPS);
#pragma unroll
    for (int j = 0; j < 8; ++j) { const float4 gg = *(const float4*)(g + j * 256 + lane * 4);
        v[4 * j] *= rstd * gg.x; v[4 * j + 1] *= rstd * gg.y; v[4 * j + 2] *= rstd * gg.z; v[4 * j + 3] *= rstd * gg.w; }
    if (MODE == 3) {
#pragma unroll
        for (int j = 0; j < 8; ++j) *(float4*)(fout + (size_t)row * D + j * 256 + lane * 4) = make_float4(v[4 * j], v[4 * j + 1], v[4 * j + 2], v[4 * j + 3]);
        return;
    }
#pragma unroll
    for (int j = 0; j < 8; ++j) { ushort4 o; o.x = f2bf(v[4 * j]); o.y = f2bf(v[4 * j + 1]); o.z = f2bf(v[4 * j + 2]); o.w = f2bf(v[4 * j + 3]);
        *(ushort4*)(xn + (size_t)row * D + j * 256 + lane * 4) = o; }
    if (MODE == 1) {
        float acc[16];
#pragma unroll
        for (int c = 0; c < 16; ++c) acc[c] = 0.f;
#pragma unroll
        for (int j = 0; j < 8; ++j)
#pragma unroll
            for (int e = 0; e < 4; ++e) { const int k = j * 256 + lane * 4 + e; const float* wr = w_in + (size_t)k * EVEN_IN + EVEN_MAIN; const float xv = v[4 * j + e];
#pragma unroll
                for (int c4 = 0; c4 < 4; ++c4) { const float4 w = *(const float4*)(wr + c4 * 4); acc[c4 * 4] += xv * w.x; acc[c4 * 4 + 1] += xv * w.y; acc[c4 * 4 + 2] += xv * w.z; acc[c4 * 4 + 3] += xv * w.w; } }
#pragma unroll
        for (int c = 0; c < 16; ++c) acc[c] = wave_sum(acc[c]);
        if (lane == 0) {
#pragma unroll
            for (int c = 0; c < 16; ++c) glow[(size_t)row * 16 + c] = acc[c]; }
    }
    if (MODE == 2) {
        float lg[4], le[32];
#pragma unroll
        for (int c = 0; c < 4; ++c) lg[c] = 0.f;
#pragma unroll
        for (int c = 0; c < 32; ++c) le[c] = 0.f;
#pragma unroll
        for (int j = 0; j < 8; ++j)
#pragma unroll
            for (int e = 0; e < 4; ++e) { const int k = j * 256 + lane * 4 + e; const float xv = v[4 * j + e];
                const float4 w4 = *(const float4*)(wg + (size_t)k * 4); lg[0] += xv * w4.x; lg[1] += xv * w4.y; lg[2] += xv * w4.z; lg[3] += xv * w4.w;
#pragma unroll
                for (int c4 = 0; c4 < 8; ++c4) { const float4 w = *(const float4*)(we + (size_t)k * 32 + c4 * 4); le[c4 * 4] += xv * w.x; le[c4 * 4 + 1] += xv * w.y; le[c4 * 4 + 2] += xv * w.z; le[c4 * 4 + 3] += xv * w.w; } }
#pragma unroll
        for (int c = 0; c < 4; ++c) lg[c] = wave_sum(lg[c]) + bg[c];
#pragma unroll
        for (int c = 0; c < 32; ++c) le[c] = wave_sum(le[c]) + be[c];
        if (lane == 0) {
            int grp = 0; float mx = lg[0];
#pragma unroll
            for (int c = 1; c < 4; ++c) if (lg[c] > mx) { mx = lg[c]; grp = c; }
            float den = 0.f;
#pragma unroll
            for (int c = 0; c < 4; ++c) den += __expf(lg[c] - mx);
            const float pg = 1.0f / den;
            float e8[8];
#pragma unroll
            for (int c = 0; c < 8; ++c) { e8[c] = grp == 0 ? le[c] : grp == 1 ? le[8 + c] : grp == 2 ? le[16 + c] : le[24 + c]; }
            int j0 = 0; float v0 = e8[0];
#pragma unroll
            for (int c = 1; c < 8; ++c) if (e8[c] > v0) { v0 = e8[c]; j0 = c; }
            int j1 = -1; float v1 = -3.0e38f;
#pragma unroll
            for (int c = 0; c < 8; ++c) if (c != j0 && e8[c] > v1) { v1 = e8[c]; j1 = c; }
            const float e1 = __expf(v1 - v0), s = 1.0f / (1.0f + e1);
            const int ea = grp * 8 + j0, eb = grp * 8 + j1;
            eid[row * 2] = ea; eid[row * 2 + 1] = eb; wgt[row * 2] = pg * s; wgt[row * 2 + 1] = pg * e1 * s;
            atomicAdd(&ctl[CW_CNT + ea], 1u); atomicAdd(&ctl[CW_CNT + eb], 1u);
        }
    }
}

struct EpiProj0 { bf16_t* hq; float* hlf; bf16_t* hi; bf16_t* hgg; bf16_t* gq; bf16_t* gk; bf16_t* gv; bf16_t* gg; const float* lb;
    DI void operator()(int r, int c, float v) const {
        const int seg = c >> 10, cc = c & 1023; const float sc = 0.08838834764831845f;
        if (seg == 0) hq[(size_t)r * 1024 + cc] = f2bf(siluf_(v) * sc);
        else if (seg == 1) { const float l = lb[cc]; const float f = l + (1.0f - l) * sigmoidf_(v); hlf[(size_t)r * 1024 + cc] = __logf(f); }
        else if (seg == 2) hi[(size_t)r * 1024 + cc] = f2bf(v);
        else if (seg == 3) hgg[(size_t)r * 1024 + cc] = f2bf(siluf_(v));
        else if (seg == 4) { if (cc < 512) gq[(size_t)r * 512 + cc] = f2bf(v * sc); else gk[(size_t)r * 512 + cc - 512] = f2bf(v); }
        else if (seg == 5) gv[(size_t)r * 1024 + cc] = f2bf(v);
        else gg[(size_t)r * 1024 + cc] = f2bf(siluf_(v));
    } };
struct EpiResid { const float* res; float* out;
    DI void operator()(int r, int c, float v) const { out[(size_t)r * D + c] = res[(size_t)r * D + c] + v; } };
struct EpiQKV { bf16_t* q; bf16_t* k; bf16_t* v_;
    DI void operator()(int r, int c, float v) const { const int s = c >> 11, cc = c & 2047; bf16_t* o = s == 0 ? q : s == 1 ? k : v_; o[(size_t)r * D + cc] = f2bf(v); } };
struct EpiBf { bf16_t* o; int ld; int pad;
    DI void operator()(int r, int c, float v) const { o[(size_t)r * ld + c] = f2bf(v); } };
struct EpiSwiglu { bf16_t* o;
    DI void operator()(int r, int j, float a, float b) const { o[(size_t)r * DEXP + j] = f2bf(siluf_(a) * b); } };

template <class Epi, bool DUAL>
__global__ void k_gemm_naive(const bf16_t* __restrict__ A, const int* __restrict__ rowidx, const bf16_t* __restrict__ Bt, int K, int lda,
                             const int* __restrict__ tile_e, size_t b_estride, Epi epi) {
    __shared__ float As[32][65], Bs[32][65], Bs2[DUAL ? 32 : 1][65];
    const int m0 = blockIdx.y * 64, n0 = blockIdx.x * 64, tid = threadIdx.x, tx = tid & 15, ty = tid >> 4;
    if (tile_e) { const int e = tile_e[m0 / MOE_TILE]; if (e < 0) return; Bt += (size_t)e * b_estride; }
    float acc[4][4], acc2[4][4];
#pragma unroll
    for (int i = 0; i < 4; ++i)
#pragma unroll
        for (int j = 0; j < 4; ++j) { acc[i][j] = 0.f; acc2[i][j] = 0.f; }
    const int lr = tid >> 2, lk = (tid & 3) * 8;
    const int arow = rowidx ? rowidx[m0 + lr] : (m0 + lr);
    const bf16_t* ap = A + (size_t)arow * lda + lk;
    const int nl = n0 + lr; const int brow = DUAL ? (nl / 128) * 256 + (nl % 128) : nl;
    const bf16_t* bp = Bt + (size_t)brow * K + lk; const bf16_t* bp2 = bp + (size_t)128 * K;
    for (int k0 = 0; k0 < K; k0 += 32) {
        { const uint4 a = *(const uint4*)(ap + k0); const unsigned w[4] = {a.x, a.y, a.z, a.w};
#pragma unroll
          for (int i = 0; i < 4; ++i) { As[lk + 2 * i][lr] = __uint_as_float(w[i] << 16); As[lk + 2 * i + 1][lr] = __uint_as_float(w[i] & 0xFFFF0000u); } }
        { const uint4 a = *(const uint4*)(bp + k0); const unsigned w[4] = {a.x, a.y, a.z, a.w};
#pragma unroll
          for (int i = 0; i < 4; ++i) { Bs[lk + 2 * i][lr] = __uint_as_float(w[i] << 16); Bs[lk + 2 * i + 1][lr] = __uint_as_float(w[i] & 0xFFFF0000u); } }
        if (DUAL) { const uint4 a = *(const uint4*)(bp2 + k0); const unsigned w[4] = {a.x, a.y, a.z, a.w};
#pragma unroll
          for (int i = 0; i < 4; ++i) { Bs2[lk + 2 * i][lr] = __uint_as_float(w[i] << 16); Bs2[lk + 2 * i + 1][lr] = __uint_as_float(w[i] & 0xFFFF0000u); } }
        __syncthreads();
#pragma unroll 8
        for (int k = 0; k < 32; ++k) {
            float a[4], b[4], b2[4];
#pragma unroll
            for (int i = 0; i < 4; ++i) { a[i] = As[k][ty * 4 + i]; b[i] = Bs[k][tx * 4 + i]; if (DUAL) b2[i] = Bs2[k][tx * 4 + i]; }
#pragma unroll
            for (int i = 0; i < 4; ++i)
#pragma unroll
                for (int j = 0; j < 4; ++j) { acc[i][j] += a[i] * b[j]; if (DUAL) acc2[i][j] += a[i] * b2[j]; }
        }
        __syncthreads();
    }
#pragma unroll
    for (int i = 0; i < 4; ++i)
#pragma unroll
        for (int j = 0; j < 4; ++j) { const int r = m0 + ty * 4 + i, c = n0 + tx * 4 + j;
            if constexpr (DUAL) epi(r, c, acc[i][j], acc2[i][j]); else epi(r, c, acc[i][j]); }
}

template <int DV, bool IS_GLA>
__global__ void __launch_bounds__(DV) k_scan_naive(const bf16_t* __restrict__ Q, const float* __restrict__ LF, const bf16_t* __restrict__ Kx, const bf16_t* __restrict__ V,
                             const float* __restrict__ glow, const float* __restrict__ gk2, const float* __restrict__ gkb, float* __restrict__ oraw, int nheads, int ocol0) {
    constexpr int T = 16;
    __shared__ float sq[T][128], sk[T][128], sa[T][128];
    const int b = blockIdx.x / nheads, hh = blockIdx.x % nheads, v = threadIdx.x;
    const int qld = nheads * 128, vld = nheads * DV;
    float S[128];
#pragma unroll
    for (int d = 0; d < 128; ++d) S[d] = 0.f;
    for (int t0 = 0; t0 < SEQ; t0 += T) {
        __syncthreads();
        for (int i = threadIdx.x; i < T * 128; i += DV) { const int tt = i >> 7, d = i & 127; const size_t tok = (size_t)b * SEQ + t0 + tt;
            sq[tt][d] = bf2f(Q[tok * qld + hh * 128 + d]);
            if (IS_GLA) { float z = gkb[hh * 128 + d];
#pragma unroll
                for (int r = 0; r < GL_RANK; ++r) z += glow[tok * 16 + r] * gk2[r * GL_QK + hh * 128 + d];
                const float ls = fminf(z, 0.f) - log1pf(__expf(-fabsf(z)));
                sa[tt][d] = __expf(ls * (1.0f / 16.0f)); sk[tt][d] = bf2f(Kx[tok * qld + hh * 128 + d]); }
            else { const float a = __expf(LF[tok * qld + hh * 128 + d]); sa[tt][d] = a; sk[tt][d] = 1.0f - a; } }
        __syncthreads();
        for (int tt = 0; tt < T; ++tt) { const size_t tok = (size_t)b * SEQ + t0 + tt;
            const float vv = bf2f(V[tok * vld + hh * DV + v]); float o = 0.f;
#pragma unroll
            for (int d = 0; d < 128; ++d) { S[d] = sa[tt][d] * S[d] + sk[tt][d] * vv; o += sq[tt][d] * S[d]; }
            oraw[tok * D + ocol0 + hh * DV + v] = o; }
    }
}
__global__ void k_norm_gate(const float* __restrict__ oraw, const float* __restrict__ hg_norm, const float* __restrict__ gla_norm,
                            const bf16_t* __restrict__ hgg, const bf16_t* __restrict__ gg, bf16_t* __restrict__ mix) {
    const int w = blockIdx.x * 4 + (threadIdx.x >> 6), lane = threadIdx.x & 63; const int tok = w / 12, s = w % 12;
    const bool gla = s >= 8; const int dv = gla ? 256 : 128, col0 = gla ? 1024 + (s - 8) * 256 : s * 128;
    const float* o = oraw + (size_t)tok * D + col0; float x[4]; float ss = 0.f; const int n = dv / 64;
#pragma unroll
    for (int i = 0; i < 4; ++i) { x[i] = i < n ? o[lane + 64 * i] : 0.f; ss += x[i] * x[i]; }
    ss = wave_sum(ss); const float rstd = rsqrtf(ss / dv + EPS);
#pragma unroll
    for (int i = 0; i < 4; ++i) if (i < n) { const int c = lane + 64 * i; const float gain = gla ? gla_norm[c] : hg_norm[c];
        const float gate = gla ? bf2f(gg[(size_t)tok * 1024 + (s - 8) * 256 + c]) : bf2f(hgg[(size_t)tok * 1024 + s * 128 + c]);
        mix[(size_t)tok * D + col0 + c] = f2bf(x[i] * rstd * gain * gate); }
}

__global__ void k_kmean(const bf16_t* __restrict__ Kb, float* __restrict__ kmean) {
    const int n = blockIdx.x % MB_NBLK, hh = (blockIdx.x / MB_NBLK) % MB_H, b = blockIdx.x / (MB_NBLK * MB_H), d = threadIdx.x;
    float s = 0.f; const bf16_t* p = Kb + ((size_t)b * SEQ + n * MB_BLK) * D + hh * MB_DH + d;
    for (int j = 0; j < MB_BLK; ++j) s += bf2f(p[(size_t)j * D]);
    kmean[(size_t)blockIdx.x * MB_DH + d] = s * (1.0f / MB_BLK);
}
__global__ void k_moba_naive(const bf16_t* __restrict__ Qb, const bf16_t* __restrict__ Kb, const bf16_t* __restrict__ Vb, const float* __restrict__ kmean, bf16_t* __restrict__ AO) {
    __shared__ float sq[4][128]; __shared__ float sp[4][1024]; __shared__ int ssel[4][4];
    const int wv = threadIdx.x >> 6, lane = threadIdx.x & 63;
    const int qi = blockIdx.x * 4 + wv; const int t = qi % SEQ, hh = (qi / SEQ) % MB_H, b = qi / (SEQ * MB_H);
    const size_t tok = (size_t)b * SEQ + t; const int qb = t / MB_BLK;
    sq[wv][lane] = bf2f(Qb[tok * D + hh * MB_DH + lane]); sq[wv][lane + 64] = bf2f(Qb[tok * D + hh * MB_DH + lane + 64]);
    __syncthreads();
    float gate = -3.0e38f;
    if (lane < qb) { const float* km = kmean + ((size_t)(b * MB_H + hh) * MB_NBLK + lane) * MB_DH; float s = 0.f; for (int d = 0; d < 128; ++d) s += sq[wv][d] * km[d]; gate = s; }
    int nsel = qb < 3 ? qb : 3;
    for (int s = 0; s < 3; ++s) { float best = gate; int bi = lane;
        for (int o = 32; o > 0; o >>= 1) { const float ob = __shfl_xor(best, o); const int oi = __shfl_xor(bi, o); if (ob > best || (ob == best && oi < bi)) { best = ob; bi = oi; } }
        if (lane == 0) ssel[wv][s] = bi; if (lane == bi) gate = -3.4e38f; }
    __syncthreads();
    const float scale = 0.08838834764831845f;
    float mx = -3.0e38f;
    for (int sgi = 0; sgi <= nsel; ++sgi) { const int blk = sgi < nsel ? ssel[wv][sgi] : qb;
        for (int i = 0; i < 4; ++i) { const int j = lane + 64 * i, kp = blk * MB_BLK + j; float s = -__builtin_inff();
            if (sgi < nsel || kp <= t) { const bf16_t* kr = Kb + ((size_t)b * SEQ + kp) * D + hh * MB_DH; float a = 0.f;
                for (int d = 0; d < 128; d += 2) { const unsigned w = *(const unsigned*)(kr + d); a += sq[wv][d] * __uint_as_float(w << 16) + sq[wv][d + 1] * __uint_as_float(w & 0xFFFF0000u); }
                s = a * scale; }
            sp[wv][sgi * 256 + j] = s; mx = fmaxf(mx, s); } }
    for (int o = 32; o > 0; o >>= 1) mx = fmaxf(mx, __shfl_xor(mx, o));
    float den = 0.f;
    for (int sgi = 0; sgi <= nsel; ++sgi) for (int i = 0; i < 4; ++i) { const int idx = sgi * 256 + lane + 64 * i; const float p = __expf(sp[wv][idx] - mx); sp[wv][idx] = p; den += p; }
    den = wave_sum(den);
    __syncthreads();
    float o0 = 0.f, o1 = 0.f;
    for (int sgi = 0; sgi <= nsel; ++sgi) { const int blk = sgi < nsel ? ssel[wv][sgi] : qb; const int jmax = sgi < nsel ? 256 : (t - qb * MB_BLK + 1);
        for (int j = 0; j < jmax; ++j) { const float p = sp[wv][sgi * 256 + j]; const unsigned w = *(const unsigned*)(Vb + ((size_t)b * SEQ + blk * MB_BLK + j) * D + hh * MB_DH + lane * 2);
            o0 += p * __uint_as_float(w << 16); o1 += p * __uint_as_float(w & 0xFFFF0000u); } }
    const float inv = 1.0f / den;
    *(unsigned*)(AO + tok * D + hh * MB_DH + lane * 2) = (unsigned)f2bf(o0 * inv) | ((unsigned)f2bf(o1 * inv) << 16);
}

__global__ void k_moe_plan(unsigned* __restrict__ ctl, int* __restrict__ tile_e, int* __restrict__ rowtok) {
    __shared__ int base[NEXP + 1];
    if (threadIdx.x == 0) { int t = 0; for (int e = 0; e < NEXP; ++e) { base[e] = t; const int c = (int)ctl[CW_CNT + e]; const int nt = (c + MOE_TILE - 1) / MOE_TILE;
            for (int i = 0; i < nt; ++i) tile_e[t + i] = e; t += nt; ctl[CW_BASE + e] = (unsigned)(base[e] * MOE_TILE); ctl[CW_CUR + e] = 0u; }
        base[NEXP] = t; ctl[CW_NT] = (unsigned)t; for (int i = t; i < MOE_MAXT; ++i) tile_e[i] = -1; }
    __syncthreads();
    for (int i = threadIdx.x; i < MOE_ROWS; i += blockDim.x) rowtok[i] = 0;
}
__global__ void k_moe_scatter(const int* __restrict__ eid, unsigned* __restrict__ ctl, int* __restrict__ slot, int* __restrict__ rowtok) {
    const int i = blockIdx.x * blockDim.x + threadIdx.x; if (i >= NTOK * 2) return;
    const int e = eid[i]; const unsigned p = atomicAdd(&ctl[CW_CUR + e], 1u); const int s = (int)ctl[CW_BASE + e] + (int)p; slot[i] = s; rowtok[s] = i >> 1;
}
__global__ void k_moe_combine(float* __restrict__ h, const bf16_t* __restrict__ Y, const int* __restrict__ slot, const float* __restrict__ wgt) {
    const int row = blockIdx.x * 4 + (threadIdx.x >> 6), lane = threadIdx.x & 63;
    const int s0 = slot[row * 2], s1 = slot[row * 2 + 1]; const float w0 = wgt[row * 2], w1 = wgt[row * 2 + 1];
    for (int j = 0; j < 8; ++j) { const int c = j * 256 + lane * 4; float4 x = *(float4*)(h + (size_t)row * D + c);
        const ushort4 a = *(const ushort4*)(Y + (size_t)s0 * D + c), bb = *(const ushort4*)(Y + (size_t)s1 * D + c);
        x.x += w0 * bf2f(a.x) + w1 * bf2f(bb.x); x.y += w0 * bf2f(a.y) + w1 * bf2f(bb.y); x.z += w0 * bf2f(a.z) + w1 * bf2f(bb.z); x.w += w0 * bf2f(a.w) + w1 * bf2f(bb.w);
        *(float4*)(h + (size_t)row * D + c) = x; }
}


#define XB_TMO      128
#define XB_XCNT(j)  (256  + 64 * (j))
#define XB_XSUB(j)  (1280 + 64 * (j))
#define XB_XGEN(j)  (2304 + 64 * (j))
#define XB_TOP      3328
#define XB_TOPGEN   3392
#define XCD_BAR_WORDS 3456
#define XB_SPIN_CAP (1u << 18)
#define LAS __attribute__((address_space(3)))

__device__ __forceinline__ unsigned xb_ld(unsigned* p)              { return __hip_atomic_load(p, __ATOMIC_RELAXED, __HIP_MEMORY_SCOPE_AGENT); }
__device__ __forceinline__ unsigned xb_add(unsigned* p, unsigned v) { return __hip_atomic_fetch_add(p, v, __ATOMIC_RELAXED, __HIP_MEMORY_SCOPE_AGENT); }
__device__ __forceinline__ unsigned xb_xcc_id() { return (unsigned)__builtin_amdgcn_s_getreg((3 << 11) | 20) & 0xFu; }
#define XB_SPIN(cond, bar) do { unsigned _sp = 0; while (cond) { __builtin_amdgcn_s_sleep(1); \
    if ((++_sp & 255u) == 0u) { if (xb_ld(&(bar)[XB_TMO])) break; if (_sp > XB_SPIN_CAP) { atomicAdd(&(bar)[XB_TMO], 1u); break; } } } } while (0)

struct XcdBarrier {
    unsigned* bar; unsigned x;
    volatile LAS unsigned* st;
};

__device__ __forceinline__ XcdBarrier xcd_barrier_post(unsigned* bar, volatile LAS unsigned* st) {
    XcdBarrier b; b.bar = bar; b.x = xb_xcc_id(); b.st = st;
    if (threadIdx.x == 0) (void)xb_add(&bar[XB_XCNT(b.x)], 1u);
    return b;
}
__device__ __forceinline__ void xcd_barrier_complete(unsigned* bar, unsigned x, unsigned& nloc, unsigned& nx) {
    const unsigned G = gridDim.x * gridDim.y * gridDim.z;
    unsigned sum, cnt, mine, sp = 0u;
    for (;;) {
        sum = 0u; cnt = 0u; mine = 0u;
#pragma unroll
        for (unsigned j = 0; j < 16; ++j) { const unsigned c = xb_ld(&bar[XB_XCNT(j)]); sum += c; cnt += (c > 0u) ? 1u : 0u; mine = (j == x) ? c : mine; }
        if (sum == G) break;
        __builtin_amdgcn_s_sleep(1);
        if ((++sp & 255u) == 0u) { if (xb_ld(&bar[XB_TMO])) break; if (sp > XB_SPIN_CAP) { atomicAdd(&bar[XB_TMO], 1u); break; } }
    }
    nloc = mine > 0u ? mine : 1u; nx = cnt > 0u ? cnt : 1u;
}

__device__ __forceinline__ void xcd_barrier(const XcdBarrier& b) {
    asm volatile("s_waitcnt vmcnt(0)" ::: "memory");
    __syncthreads();
    if (threadIdx.x == 0) {
        unsigned* bar = b.bar;
        __builtin_amdgcn_s_waitcnt(0);
        unsigned nloc = b.st[0], nx = b.st[1];
        if (nloc == 0u) { xcd_barrier_complete(bar, b.x, nloc, nx); b.st[0] = nloc; b.st[1] = nx; }
        const unsigned old = xb_add(&bar[XB_XSUB(b.x)], 1u);
        const unsigned gen = old / nloc;
        if (old + 1u == (gen + 1u) * nloc) {
            __builtin_amdgcn_fence(__ATOMIC_RELEASE, "agent");
            asm volatile("s_waitcnt vmcnt(0)" ::: "memory");
            const unsigned og = xb_add(&bar[XB_TOP], 1u);
            const unsigned tg = og / nx;
            if (og + 1u == (tg + 1u) * nx) xb_add(&bar[XB_TOPGEN], 1u);
            else XB_SPIN(xb_ld(&bar[XB_TOPGEN]) == tg, bar);
            __builtin_amdgcn_fence(__ATOMIC_ACQUIRE, "agent");
            xb_add(&bar[XB_XGEN(b.x)], 1u);
            asm volatile("s_waitcnt vmcnt(0)" ::: "memory");
        } else {
            XB_SPIN(xb_ld(&bar[XB_XGEN(b.x)]) == gen, bar);
            __builtin_amdgcn_fence(__ATOMIC_ACQUIRE, "agent");
            asm volatile("s_waitcnt vmcnt(0)" ::: "memory");
        }
    }
    __syncthreads();
}


namespace pg8 {
#define PG8_LAS __attribute__((address_space(3)))
typedef unsigned short bf16_t;
typedef short bf16x8 __attribute__((ext_vector_type(8)));
typedef float f32x4 __attribute__((ext_vector_type(4)));
typedef unsigned u32x4 __attribute__((ext_vector_type(4)));
constexpr int BM = 256, BK = 64, HALF = 128, HTB = HALF * BK * 2  , STAGE_BYTES = 8 * HTB, NXCD = 8, WGM = 8;

__host__ __device__ __forceinline__ int lds_byte(int r, int c) { const int st = (r >> 4) * 2 + (c >> 5), rr = r & 15, cc = c & 31, ob = rr * 64 + cc * 2; return st * 1024 + (ob ^ (((ob >> 9) & 1) << 5)); }
__host__ __device__ __forceinline__ void stage_rc(int b, int& R, int& C) { const int st = b / 1024, sb = b % 1024, swz = sb ^ (((sb >> 9) & 1) << 5); R = (st >> 1) * 16 + swz / 64; C = (st & 1) * 32 + (swz % 64) / 2; }
__host__ __device__ __forceinline__ int perm32(int rho) { const int n = rho >> 4, i = rho & 15; return 8 * (i >> 2) + 4 * n + (i & 3); }

struct Unit { int pm, pn; };
struct Gemm { const bf16_t* A; const bf16_t* Bt; int M, N, K; };

struct StaticOrder {
    int nM, nN, nwg, G, c;
    __host__ __device__ void init(int M, int N, int G_, int c_) { nM = M / BM; nN = N / BM; nwg = nM * nN; G = G_; c = c_; }
    __host__ __device__ bool next(int i, Unit& u) const {
        const long L = (long)i * G + c; if (L >= nwg) return false;
        int wgid = (int)L; { const int q = nwg / NXCD, r = nwg % NXCD, xcd = wgid % NXCD, off = wgid / NXCD; wgid = (xcd < r ? xcd * (q + 1) : r * (q + 1) + (xcd - r) * q) + off; }
        const int nig = WGM * nN, gid = wgid / nig, fm = gid * WGM, gsz = (nM - fm) < WGM ? (nM - fm) : WGM;
        u.pm = fm + ((wgid % nig) % gsz); u.pn = (wgid % nig) / gsz; return true;
    }
    __device__ __forceinline__ void a_ready(const Unit&) const {}
    __device__ __forceinline__ void done(const Unit&) const {}
};

__device__ __forceinline__ unsigned cvt_pk_bf16(float lo, float hi) { unsigned r; asm volatile("v_cvt_pk_bf16_f32 %0, %1, %2" : "=v"(r) : "v"(lo), "v"(hi)); return r; }
template <class Epi, class Sched, bool ALIGN_EPI = false, bool SP2 = false>
__device__ __forceinline__ void gemm_phase(PG8_LAS unsigned char* lds, const Gemm g, const Sched& S, const Epi& E) {
    const int tid = threadIdx.x, wid = __builtin_amdgcn_readfirstlane(tid >> 6), lane = tid & 63, wr = wid >> 2, wc = wid & 3, fr = lane & 15, fq = lane >> 4;
    const int K = g.K, nt = K / BK;
    unsigned voffA[2], voffB[2];
#pragma unroll
    for (int i = 0; i < 2; ++i) { int R, C; stage_rc(tid * 16 + i * 8192, R, C); const int Rb = Epi::PERM ? ((R & ~31) + perm32(R & 31)) : R;
        voffA[i] = (unsigned)(R * K + C) * 2u; voffB[i] = (unsigned)(Rb * K + C) * 2u; }
    const size_t kstep = (size_t)(BK * 2);
    const size_t hstep = (size_t)HALF * K * 2;
    const size_t tstep = 2 * hstep;
    const unsigned ldsw = (unsigned)wid * 1024u;
    const int aoff = lds_byte(wr * 64 + fr, fq * 8), boff = lds_byte(wc * 32 + fr, fq * 8);
#define PG8_SA(b, h) (((b) * 2 + (h)) * HTB)
#define PG8_SB(b, h) ((4 + (b) * 2 + (h)) * HTB)
#define PG8_STAGE(bufoff, gbase, voff) do { _Pragma("unroll") for (int _i = 0; _i < 2; ++_i) \
        __builtin_amdgcn_global_load_lds((const unsigned*)((const char*)(gbase) + (voff)[_i]), (PG8_LAS unsigned*)(lds + (bufoff) + ldsw + _i * 8192), 16, 0, 0); } while (0)
#define PG8_LDA(dst, b, h) do { _Pragma("unroll") for (int m = 0; m < 4; ++m) _Pragma("unroll") for (int k = 0; k < 2; ++k) dst[m][k] = *(const PG8_LAS bf16x8*)(lds + PG8_SA(b, h) + aoff + m * 2048 + k * 1024); } while (0)
#define PG8_LDB(dst, b, h) do { _Pragma("unroll") for (int n = 0; n < 2; ++n) _Pragma("unroll") for (int k = 0; k < 2; ++k) dst[n][k] = *(const PG8_LAS bf16x8*)(lds + PG8_SB(b, h) + boff + n * 2048 + k * 1024); } while (0)
#define PG8_MMA(ai, bj, At, Bt) do { __builtin_amdgcn_s_setprio(1); _Pragma("unroll") for (int m = 0; m < 4; ++m) _Pragma("unroll") for (int n = 0; n < 2; ++n) _Pragma("unroll") for (int k = 0; k < 2; ++k) \
        acc[ai][bj][m][n] = __builtin_amdgcn_mfma_f32_16x16x32_bf16(Bt[n][k], At[m][k], acc[ai][bj][m][n], 0, 0, 0); __builtin_amdgcn_s_setprio(0); } while (0)
#define PG8_WAIT_V(n) asm volatile("s_waitcnt vmcnt(" #n ")" ::: "memory")
#define PG8_WAIT_L(n) asm volatile("s_waitcnt lgkmcnt(" #n ")" ::: "memory")
#define PG8_BAR __builtin_amdgcn_s_barrier()
#define PG8_SCHED __builtin_amdgcn_sched_barrier(0)
    Unit cur, nxt; int ui = 0;
    if (!S.next(0, cur)) return;
    f32x4 acc[2][2][4][2];
#pragma unroll
    for (int a = 0; a < 2; ++a)
#pragma unroll
        for (int b = 0; b < 2; ++b)
#pragma unroll
            for (int m = 0; m < 4; ++m)
#pragma unroll
                for (int n = 0; n < 2; ++n) acc[a][b][m][n] = (f32x4){0.f, 0.f, 0.f, 0.f};
    bf16x8 At[4][2], B0[2][2], B1[2][2];
    const char* cA = (const char*)g.A + (size_t)cur.pm * tstep; const char* cB = (const char*)g.Bt + (size_t)cur.pn * tstep;
    S.a_ready(cur);
    if constexpr (SP2) {
        PG8_STAGE(PG8_SB(0, 0), cB, voffB); PG8_STAGE(PG8_SB(0, 1), cB + hstep, voffB); PG8_STAGE(PG8_SA(0, 0), cA, voffA); PG8_STAGE(PG8_SA(0, 1), cA + hstep, voffA);
        if (wr == 1) PG8_BAR;
        PG8_WAIT_V(2); PG8_BAR;
        PG8_STAGE(PG8_SB(1, 0), cB + kstep, voffB); PG8_STAGE(PG8_SA(1, 0), cA + kstep, voffA); PG8_STAGE(PG8_SB(1, 1), cB + hstep + kstep, voffB);
        PG8_WAIT_V(6); PG8_BAR;
    } else {
        PG8_STAGE(PG8_SB(0, 0), cB, voffB); PG8_STAGE(PG8_SA(0, 0), cA, voffA); PG8_STAGE(PG8_SB(0, 1), cB + hstep, voffB); PG8_STAGE(PG8_SA(0, 1), cA + hstep, voffA);
        if (wr == 1) PG8_BAR;
        PG8_WAIT_V(4); PG8_BAR;
        PG8_STAGE(PG8_SB(1, 0), cB + kstep, voffB); PG8_STAGE(PG8_SA(1, 0), cA + kstep, voffA); PG8_STAGE(PG8_SB(1, 1), cB + hstep + kstep, voffB);
        PG8_WAIT_V(6); PG8_BAR;
    }
    for (;;) {
        const bool has_next = S.next(ui + 1, nxt);
        const char* nA = has_next ? (const char*)g.A + (size_t)nxt.pm * tstep : cA; const char* nB = has_next ? (const char*)g.Bt + (size_t)nxt.pn * tstep : cB;
        for (int t = 0; t < nt; t += 2) {
            const bool last = (t == nt - 2);
            const char* a1 = cA + (size_t)(t + 1) * kstep;
            const char* a2 = last ? nA : cA + (size_t)(t + 2) * kstep; const char* b2 = last ? nB : cB + (size_t)(t + 2) * kstep;
            const char* a3 = a2 + kstep; const char* b3 = b2 + kstep;
            if (last && has_next) S.a_ready(nxt);
            if constexpr (SP2) {
            PG8_LDB(B0, 0, 0); PG8_LDB(B1, 0, 1); PG8_SCHED; PG8_LDA(At, 0, 0); PG8_STAGE(PG8_SA(1, 1), a1 + hstep, voffA);
            PG8_WAIT_V(8); PG8_WAIT_L(0); PG8_BAR; PG8_MMA(0, 0, At, B0); PG8_MMA(0, 1, At, B1); PG8_BAR; PG8_SCHED;
            PG8_LDA(At, 0, 1); PG8_STAGE(PG8_SB(0, 0), b2, voffB); PG8_STAGE(PG8_SB(0, 1), b2 + hstep, voffB); PG8_STAGE(PG8_SA(0, 0), a2, voffA);
            PG8_WAIT_V(8); PG8_WAIT_L(0); PG8_BAR; PG8_MMA(1, 0, At, B0); PG8_MMA(1, 1, At, B1); PG8_BAR; PG8_SCHED;
            PG8_LDB(B0, 1, 0); PG8_LDB(B1, 1, 1); PG8_SCHED; PG8_LDA(At, 1, 0); PG8_STAGE(PG8_SA(0, 1), a2 + hstep, voffA);
            PG8_WAIT_V(8); PG8_WAIT_L(0); PG8_BAR; PG8_MMA(0, 0, At, B0); PG8_MMA(0, 1, At, B1); PG8_BAR; PG8_SCHED;
            PG8_LDA(At, 1, 1); PG8_STAGE(PG8_SB(1, 0), b3, voffB); PG8_STAGE(PG8_SB(1, 1), b3 + hstep, voffB); PG8_STAGE(PG8_SA(1, 0), a3, voffA);
            PG8_WAIT_V(8); PG8_WAIT_L(0); PG8_BAR; PG8_MMA(1, 0, At, B0); PG8_MMA(1, 1, At, B1); PG8_BAR; PG8_SCHED;
            } else {
            PG8_LDB(B0, 0, 0); PG8_SCHED; PG8_LDA(At, 0, 0); PG8_STAGE(PG8_SA(1, 1), a1 + hstep, voffA);
            PG8_WAIT_L(8); PG8_BAR; PG8_WAIT_L(0); PG8_MMA(0, 0, At, B0); PG8_BAR; PG8_SCHED;
            PG8_LDB(B1, 0, 1); PG8_STAGE(PG8_SB(0, 0), b2, voffB);
            PG8_BAR; PG8_WAIT_L(0); PG8_MMA(0, 1, At, B1); PG8_BAR;
            PG8_LDA(At, 0, 1); PG8_STAGE(PG8_SA(0, 0), a2, voffA);
            PG8_BAR; PG8_WAIT_L(0); PG8_MMA(1, 0, At, B0); PG8_BAR; PG8_SCHED;
            PG8_STAGE(PG8_SB(0, 1), b2 + hstep, voffB);
            PG8_WAIT_V(6); PG8_BAR; PG8_MMA(1, 1, At, B1); PG8_BAR;
            PG8_LDB(B0, 1, 0); PG8_SCHED; PG8_LDA(At, 1, 0); PG8_STAGE(PG8_SA(0, 1), a2 + hstep, voffA);
            PG8_WAIT_L(8); PG8_BAR; PG8_WAIT_L(0); PG8_MMA(0, 0, At, B0); PG8_BAR; PG8_SCHED;
            PG8_LDB(B1, 1, 1); PG8_STAGE(PG8_SB(1, 0), b3, voffB);
            PG8_BAR; PG8_WAIT_L(0); PG8_MMA(0, 1, At, B1); PG8_BAR;
            PG8_LDA(At, 1, 1); PG8_STAGE(PG8_SA(1, 0), a3, voffA);
            PG8_BAR; PG8_WAIT_L(0); PG8_MMA(1, 0, At, B0); PG8_BAR; PG8_SCHED;
            PG8_STAGE(PG8_SB(1, 1), b3 + hstep, voffB);
            PG8_WAIT_V(6); PG8_BAR; PG8_MMA(1, 1, At, B1); PG8_BAR;
            }
        }
        if constexpr (ALIGN_EPI) { if (wr == 0) PG8_BAR; }
        if constexpr (!Epi::AFTER_DRAIN) { E(acc, cur, wr, wc, fr, fq); S.done(cur); }
        if (!has_next) break;
#pragma unroll
        for (int a = 0; a < 2; ++a)
#pragma unroll
            for (int b = 0; b < 2; ++b)
#pragma unroll
                for (int m = 0; m < 4; ++m)
#pragma unroll
                    for (int n = 0; n < 2; ++n) acc[a][b][m][n] = (f32x4){0.f, 0.f, 0.f, 0.f};
        cur = nxt; cA = nA; cB = nB; ++ui;
        if constexpr (ALIGN_EPI) { if (wr == 1) PG8_BAR; }
    }
    PG8_WAIT_V(0);
    if constexpr (!ALIGN_EPI) { if (wr == 0) PG8_BAR; }
    PG8_BAR;
    if constexpr (Epi::AFTER_DRAIN) { E.fused(acc, cur, wr, wc, fr, fq, lds, wid, lane); S.done(cur); }
#undef PG8_SA
#undef PG8_SB
#undef PG8_STAGE
#undef PG8_LDA
#undef PG8_LDB
#undef PG8_MMA
#undef PG8_WAIT_V
#undef PG8_WAIT_L
#undef PG8_BAR
#undef PG8_SCHED
}
}

namespace moba {
constexpr int D = 128, LD = 2048;
constexpr bool WSKIP = false;
constexpr float THR = 8.f;
constexpr float SCALE = 0.08838834764831845f;
constexpr int NW = 8, QBLK = 32, KVBLK = 64, QB = NW * QBLK;
constexpr int SHM_V = KVBLK * D * 2, SHM_K = KVBLK * D * 2;
constexpr int ATT_LDS_BYTES = 2 * SHM_V + 2 * SHM_K + NW * 64 * 4;

using bf16 = unsigned short;
typedef short bf16x8 __attribute__((ext_vector_type(8)));
typedef short s16x4 __attribute__((ext_vector_type(4)));
typedef float f32x16 __attribute__((ext_vector_type(16)));
typedef float f32x4 __attribute__((ext_vector_type(4)));
typedef unsigned u32x4 __attribute__((ext_vector_type(4)));
template <class A, class Bt> struct same_t { static constexpr bool v = false; };
template <class A> struct same_t<A, A> { static constexpr bool v = true; };

#define KSWZ(row, colB) ((row) * 256 + ((colB) ^ (((row) & 7) << 4)))
#define SBAR() __builtin_amdgcn_sched_barrier(0)
__device__ __forceinline__ int v_st(int k, int c) { const int kk = (k & ~0xC) | ((k & 4) << 1) | ((k & 8) >> 1); return ((kk >> 3) * 4 + (c >> 5)) * 512 + ((kk & 7) * 32 + (c & 31)) * 2; }
__device__ __forceinline__ int v_rd_base(int lane) { return ((lane & 3) << 3) | (((lane >> 2) & 3) << 6) | (((lane >> 4) & 1) << 5) | (((lane >> 5) & 1) << 8); }
constexpr int v_rd_off(int d0, int ks, int half) { return d0 * 512 + ks * 4096 + half * 2048; }
__device__ __forceinline__ int crow(int r, int hi) { return (r & 3) + 8 * (r >> 2) + 4 * hi; }
__device__ __forceinline__ unsigned cvtpk(float lo, float hi) {
    unsigned r; asm volatile("v_cvt_pk_bf16_f32 %0, %1, %2" : "=v"(r) : "v"(lo), "v"(hi)); return r;
}
__device__ __forceinline__ bf16x8 pack8(f32x4 a, f32x4 b) {
    u32x4 w = {cvtpk(a[0], a[1]), cvtpk(a[2], a[3]), cvtpk(b[0], b[1]), cvtpk(b[2], b[3])};
    return *reinterpret_cast<bf16x8*>(&w);
}
template <class T> __device__ __forceinline__ bf16x8 load8(const T* p) {
    if constexpr (same_t<T, float>::v) { return pack8(*(const f32x4*)p, *(const f32x4*)(p + 4)); }
    else { return *reinterpret_cast<const bf16x8*>(p); }
}
__device__ __forceinline__ void mask_tile(f32x16& p0, f32x16& p1, int dq, unsigned W) {
    const float NEG = -__builtin_inff();
#pragma unroll
    for (int r = 0; r < 16; ++r) {
        const int c = (r & 3) + 8 * (r >> 2);
        if ((unsigned)(dq - c) >= W) p0[r] = NEG;
        if ((unsigned)(dq - c - 32) >= W) p1[r] = NEG;
    }
}
__device__ __forceinline__ void mask_block(f32x16& p0, f32x16& p1, bool keep) {
    const float NEG = -__builtin_inff();
#pragma unroll
    for (int r = 0; r < 16; ++r) { p0[r] = keep ? p0[r] : NEG; p1[r] = keep ? p1[r] : NEG; }
}
__device__ __forceinline__ void partialSM(f32x16& p0, f32x16& p1, float& m_reg, float& mn, float& alpha) {
    float pmax = p0[0]; for (int r = 1; r < 16; ++r) pmax = fmaxf(pmax, p0[r]); for (int r = 0; r < 16; ++r) pmax = fmaxf(pmax, p1[r]);
    { auto rr = __builtin_amdgcn_permlane32_swap(__float_as_uint(pmax), __float_as_uint(pmax), false, false);
      pmax = fmaxf(__uint_as_float(rr[0]), __uint_as_float(rr[1])); }
    constexpr float C2 = 1.4426950408889634f * SCALE;
    if (__builtin_expect(__all((pmax - m_reg) * SCALE <= THR), 1)) { mn = m_reg; alpha = 1.f; }
    else { mn = fmaxf(m_reg, pmax); alpha = __builtin_amdgcn_exp2f((m_reg - mn) * C2); m_reg = mn; }
    const float mnL = -mn * C2;
    for (int r = 0; r < 16; ++r) p0[r] = fmaf(p0[r], C2, mnL); for (int r = 0; r < 16; ++r) p1[r] = fmaf(p1[r], C2, mnL);
    for (int r = 0; r < 16; ++r) p0[r] = __builtin_amdgcn_exp2f(p0[r]);
}
__device__ __forceinline__ void finishSM(f32x16& p0, f32x16& p1, float alpha, float& l_reg, bf16x8& pa0, bf16x8& pa1, bf16x8& pa2, bf16x8& pa3) {
    for (int r = 0; r < 16; ++r) p1[r] = __builtin_amdgcn_exp2f(p1[r]);
    float ps = 0; for (int r = 0; r < 16; ++r) ps += p0[r]; for (int r = 0; r < 16; ++r) ps += p1[r];
    { auto rr = __builtin_amdgcn_permlane32_swap(__float_as_uint(ps), __float_as_uint(ps), false, false);
      ps = __uint_as_float(rr[0]) + __uint_as_float(rr[1]); }
    l_reg = l_reg * alpha + ps;
#define PK4(P, B_, OUT) do { unsigned a0 = cvtpk(P[B_+0], P[B_+1]), a1 = cvtpk(P[B_+2], P[B_+3]);                          \
        unsigned b0 = cvtpk(P[B_+4], P[B_+5]), b1 = cvtpk(P[B_+6], P[B_+7]);                                             \
        auto r0 = __builtin_amdgcn_permlane32_swap(a0, b0, false, false); auto r1 = __builtin_amdgcn_permlane32_swap(a1, b1, false, false); \
        u32x4 w = {r0[0], r1[0], r0[1], r1[1]}; OUT = *reinterpret_cast<bf16x8*>(&w); } while (0)
    PK4(p0, 0, pa0); PK4(p0, 8, pa1); PK4(p1, 0, pa2); PK4(p1, 8, pa3);
#undef PK4
}
template <int KB, bool SK>
__device__ __forceinline__ void qkt(f32x16& p0, f32x16& p1, const char* K_lds, int r32, int hi, const bf16x8* qr, bool act) {
    if (SK && !act) { const float NEG = -__builtin_inff();
#pragma unroll
        for (int r = 0; r < 16; ++r) { p0[r] = NEG; p1[r] = NEG; } return; }
    p0 = f32x16{}; p1 = f32x16{};
    const char* kb[4];
#pragma unroll
    for (int dd = 0; dd < 4; ++dd) kb[dd] = K_lds + KB * SHM_K + KSWZ(r32, (dd * 16 + hi * 8) * 2);
#pragma unroll
    for (int d0 = 0; d0 < 8; ++d0) { const char* a = kb[d0 & 3] + (d0 >> 2) * 128;
        bf16x8 b0 = *reinterpret_cast<const bf16x8*>(a);
        bf16x8 b1 = *reinterpret_cast<const bf16x8*>(a + 32 * 256);
        p0 = __builtin_amdgcn_mfma_f32_32x32x16_bf16(b0, qr[d0], p0, 0, 0, 0);
        p1 = __builtin_amdgcn_mfma_f32_32x32x16_bf16(b1, qr[d0], p1, 0, 0, 0); }
}
template <int VB, bool SK>
__device__ __forceinline__ void pv_tile(f32x16* o, int vb0, bf16x8 pa0, bf16x8 pa1, bf16x8 pa2, bf16x8 pa3, bool act) {
    if (SK && !act) return;
#define TRRD(dst, off) asm volatile("ds_read_b64_tr_b16 %0, %1 offset:%2" : "=&v"(dst) : "v"(vb0), "i"(off) : "memory")
#define PV_D0(d0) do { s16x4 l0, l1, l2, l3, h0, h1, h2, h3; constexpr int b_ = VB * SHM_V + v_rd_off(d0, 0, 0);     \
        TRRD(l0, b_); TRRD(h0, b_ + 2048); TRRD(l1, b_ + 4096); TRRD(h1, b_ + 6144); TRRD(l2, b_ + 8192); TRRD(h2, b_ + 10240); TRRD(l3, b_ + 12288); TRRD(h3, b_ + 14336); \
        asm volatile("s_waitcnt lgkmcnt(0)" ::: "memory"); SBAR();                 \
        o[d0] = __builtin_amdgcn_mfma_f32_32x32x16_bf16(pa0, (bf16x8){l0[0], l0[1], l0[2], l0[3], h0[0], h0[1], h0[2], h0[3]}, o[d0], 0, 0, 0);   \
        o[d0] = __builtin_amdgcn_mfma_f32_32x32x16_bf16(pa1, (bf16x8){l1[0], l1[1], l1[2], l1[3], h1[0], h1[1], h1[2], h1[3]}, o[d0], 0, 0, 0);   \
        o[d0] = __builtin_amdgcn_mfma_f32_32x32x16_bf16(pa2, (bf16x8){l2[0], l2[1], l2[2], l2[3], h2[0], h2[1], h2[2], h2[3]}, o[d0], 0, 0, 0);   \
        o[d0] = __builtin_amdgcn_mfma_f32_32x32x16_bf16(pa3, (bf16x8){l3[0], l3[1], l3[2], l3[3], h3[0], h3[1], h3[2], h3[3]}, o[d0], 0, 0, 0); } while (0)
    PV_D0(0); PV_D0(1); PV_D0(2); PV_D0(3);
#undef PV_D0
#undef TRRD
}

template <class TIn, class TOut> struct BlockRef { const TIn* Q; const TIn* K; const TIn* V; TOut* O; const float* KM; int P0; };
template <class TIn> struct Seam {
    bf16x8 qr[8];
    bf16x8 st_v0, st_v1, st_k0, st_k1; f32x4 sf0, sf1, sf2, sf3;
    f32x4 tq[16];
};
__device__ __forceinline__ int swa_jlo(int P0, int W) { const int lowk = P0 - W + 1; return lowk > 0 ? lowk / KVBLK : 0; }
#define ROW(p, k0, rr) ((p) + (size_t)((k0) + (rr)) * LD + sc)
#define VMW() asm volatile("s_waitcnt vmcnt(0)" ::: "memory")
#define VMWN(n) asm volatile("s_waitcnt vmcnt(%0)" :: "i"(n) : "memory")
#define SLOAD_H(Kp, Vp, k0) do { S.st_v0 = load8<TIn>(ROW(Vp, k0, sr)); S.st_v1 = load8<TIn>(ROW(Vp, k0, 32 + sr));              \
                         S.st_k0 = load8<TIn>(ROW(Kp, k0, sr)); S.st_k1 = load8<TIn>(ROW(Kp, k0, 32 + sr)); } while (0)
#define SWRITE_HK(bf) do { *(bf16x8*)(K_lds + (bf) * SHM_K + kws) = S.st_k0; *(bf16x8*)(K_lds + (bf) * SHM_K + kws + 32 * 256) = S.st_k1; } while (0)
#define SWRITE_HV(bf) do { *(bf16x8*)(V_lds + (bf) * SHM_V + vst0) = S.st_v0; *(bf16x8*)(V_lds + (bf) * SHM_V + vst1) = S.st_v1; } while (0)
#define SWRITE_H(bf) do { SWRITE_HV(bf); SWRITE_HK(bf); } while (0)
#define SLOAD_F(p, k0) do { S.sf0 = *(const f32x4*)ROW(p, k0, sr); S.sf1 = *(const f32x4*)(ROW(p, k0, sr) + 4);                \
                            S.sf2 = *(const f32x4*)ROW(p, k0, 32 + sr); S.sf3 = *(const f32x4*)(ROW(p, k0, 32 + sr) + 4); } while (0)
#define SWRITE_KF(bf) do { *(bf16x8*)(K_lds + (bf) * SHM_K + kws) = pack8(S.sf0, S.sf1); *(bf16x8*)(K_lds + (bf) * SHM_K + kws + 32 * 256) = pack8(S.sf2, S.sf3); } while (0)
#define SWRITE_VF(bf) do { *(bf16x8*)(V_lds + (bf) * SHM_V + vst0) = pack8(S.sf0, S.sf1); *(bf16x8*)(V_lds + (bf) * SHM_V + vst1) = pack8(S.sf2, S.sf3); } while (0)
template <class TIn, class TOut>
__device__ __forceinline__ void causal_swa_prime(const BlockRef<TIn, TOut>& cur, int W, char* lds, Seam<TIn>& S) {
    constexpr bool F32 = same_t<TIn, float>::v;
    const int tid = threadIdx.x, wid = __builtin_amdgcn_readfirstlane(tid >> 6), lane = tid & 63, r32 = lane & 31, hi = lane >> 5;
    const int sr = tid >> 4, sc = (tid & 15) * 8, kws = KSWZ(sr, sc * 2); char* K_lds = lds + 2 * SHM_V;
    const int kb0 = swa_jlo(cur.P0, W) * KVBLK;
    for (int d0 = 0; d0 < 8; ++d0) S.qr[d0] = load8<TIn>(cur.Q + (size_t)(wid * QBLK + r32) * LD + d0 * 16 + hi * 8);
    if constexpr (F32) { SLOAD_F((const float*)cur.K, kb0); VMW(); SWRITE_KF(0); SBAR(); SLOAD_F((const float*)cur.V, kb0); }
    else { SLOAD_H(cur.K, cur.V, kb0); VMW(); SWRITE_HK(0); }
    __syncthreads();
}
template <class TIn, class TOut>
__device__ __forceinline__ void causal_swa_block(const BlockRef<TIn, TOut>& cur, const BlockRef<TIn, TOut>& nxt, int skv, int W, char* lds, Seam<TIn>& S) {
    constexpr bool F32 = same_t<TIn, float>::v;
    const int tid = threadIdx.x, wid = __builtin_amdgcn_readfirstlane(tid >> 6), lane = tid & 63, r32 = lane & 31, hi = lane >> 5;
    const int j_lo = swa_jlo(cur.P0, W);
    int j_hi = (cur.P0 + QB - 1) / KVBLK + 1; if (j_hi > skv / KVBLK) j_hi = skv / KVBLK;
    const int NT = j_hi - j_lo;
    const int kbn = swa_jlo(nxt.P0, W) * KVBLK;
    const int qlo = cur.P0 + wid * QBLK, qm = qlo + r32 - 4 * hi;
    char* V_lds = lds; char* K_lds = lds + 2 * SHM_V;
    float* ws = (float*)(lds + 2 * SHM_V + 2 * SHM_K) + wid * 64; float* li_l = ws, * al_l = ws + 32;
    unsigned selmask;
    { const int nqb = cur.P0 >> 8;
      if (nqb <= 3) selmask = (1u << nqb) - 1u;
      else { float b0 = -__builtin_inff(), b1 = b0, b2 = b0; int i0 = 0, i1 = 0, i2 = 0;
        for (int n = 0; n < nqb; ++n) { const float* kp = cur.KM + n * 128 + hi * 8; float s = 0.f;
#pragma unroll
            for (int d0 = 0; d0 < 8; ++d0) { const f32x4 ka = *(const f32x4*)(kp + d0 * 16), kb = *(const f32x4*)(kp + d0 * 16 + 4); const u32x4 qw = __builtin_bit_cast(u32x4, S.qr[d0]);
                s += __uint_as_float(qw[0] << 16) * ka[0] + __uint_as_float(qw[0] & 0xFFFF0000u) * ka[1] + __uint_as_float(qw[1] << 16) * ka[2] + __uint_as_float(qw[1] & 0xFFFF0000u) * ka[3]
                   + __uint_as_float(qw[2] << 16) * kb[0] + __uint_as_float(qw[2] & 0xFFFF0000u) * kb[1] + __uint_as_float(qw[3] << 16) * kb[2] + __uint_as_float(qw[3] & 0xFFFF0000u) * kb[3]; }
            s += __shfl_xor(s, 32);
            if (s > b0) { b2 = b1; i2 = i1; b1 = b0; i1 = i0; b0 = s; i0 = n; } else if (s > b1) { b2 = b1; i2 = i1; b1 = s; i1 = n; } else if (s > b2) { b2 = s; i2 = n; } }
        selmask = (1u << i0) | (1u << i1) | (1u << i2); } }
    float m_reg = -1e30f, l_reg = 0; f32x16 o[4] = {};
    const int sr = tid >> 4, sc = (tid & 15) * 8, vst0 = v_st(sr, sc), vst1 = v_st(32 + sr, sc), kws = KSWZ(sr, sc * 2);
    const int vb0 = (int)(uintptr_t)V_lds + v_rd_base(lane);
    const TIn* Kh = cur.K; const TIn* Vh = cur.V;
#define RESC(a) do { if (__any((a) < 1.f)) { if (hi == 0) al_l[r32] = (a); asm volatile("s_waitcnt lgkmcnt(0)" ::: "memory");              \
                     for (int d_ = 0; d_ < 4; ++d_) for (int r = 0; r < 16; ++r) o[d_][r] *= al_l[crow(r, hi)]; } } while (0)
#define KBASE(t) ((j_lo + (t)) * KVBLK)
#define ACT(t) (KBASE(t) <= qlo + QBLK - 1 && KBASE(t) + KVBLK - 1 >= qlo - W + 1)
#define MASKT(P0_, P1_, t) do { const int kb_ = KBASE(t); if (kb_ + KVBLK - 1 > qlo) mask_tile(P0_, P1_, qm - kb_, (unsigned)W); \
        else if (kb_ < cur.P0 && cur.P0 > 3 * 256) mask_block(P0_, P1_, ((selmask >> (kb_ >> 8)) & 1u) != 0u); } while (0)
    constexpr int NQL = F32 ? 16 : 8;
    constexpr bool SK = WSKIP && !F32;
#define SEAM_K0() do { VMWN(NQL); if constexpr (F32) { SWRITE_KF(0); SBAR(); SLOAD_F((const float*)nxt.V, kbn); } else { SWRITE_HK(0); } SBAR(); } while (0)
    f32x16 pA0, pA1, pB0, pB1; float mnA, mnB, alA, alB; bf16x8 pa0, pa1, pa2, pa3;
    if constexpr (F32) { VMW(); SWRITE_VF(0); SBAR(); } else { SWRITE_HV(0); SBAR(); }
    if (NT > 1) { if constexpr (F32) SLOAD_F((const float*)Kh, KBASE(1)); else SLOAD_H(Kh, Vh, KBASE(1)); }
    SBAR(); qkt<0, SK>(pA0, pA1, K_lds, r32, hi, S.qr, ACT(0));
    if constexpr (F32) { if (NT > 1) { VMW(); SWRITE_KF(1); SBAR(); SLOAD_F((const float*)Vh, KBASE(1)); } }
    MASKT(pA0, pA1, 0); partialSM(pA0, pA1, m_reg, mnA, alA);
    if (NT > 1) { VMW(); if constexpr (F32) { SWRITE_VF(1); SBAR(); if (NT > 2) SLOAD_F((const float*)Kh, KBASE(2)); } else SWRITE_H(1); }
    __syncthreads();
#define HALF_STEP(PX0, PX1, mnX, alX, PY0, PY1, alY, t, KB, VB, SB) do {                                                      \
        SBAR(); qkt<KB, SK>(PX0, PX1, K_lds, r32, hi, S.qr, ACT(t));                                             \
        finishSM(PY0, PY1, alY, l_reg, pa0, pa1, pa2, pa3); SBAR();                                                           \
        if ((t) + 1 < NT) { if constexpr (F32) { VMW(); SWRITE_KF(SB); SBAR(); SLOAD_F((const float*)Vh, KBASE((t) + 1)); }  \
                            else { SLOAD_H(Kh, Vh, KBASE((t) + 1)); } SBAR(); }                                               \
        pv_tile<VB, SK>(o, vb0, pa0, pa1, pa2, pa3, ACT((t) - 1)); MASKT(PX0, PX1, (t)); partialSM(PX0, PX1, m_reg, mnX, alX);                                        \
        __syncthreads();                                                                                                      \
        if ((t) + 1 < NT) { VMW(); if constexpr (F32) { SWRITE_VF(SB); SBAR(); if ((t) + 2 < NT) SLOAD_F((const float*)Kh, KBASE((t) + 2)); } \
                            else { SWRITE_H(SB); } }                                                                          \
        RESC(alX); __syncthreads(); } while (0)
    for (int t = 1; t + 1 < NT; t += 2) {
        HALF_STEP(pB0, pB1, mnB, alB, pA0, pA1, alA, t, 1, 0, 0);
        HALF_STEP(pA0, pA1, mnA, alA, pB0, pB1, alB, t + 1, 0, 1, 1);
    }
    const bool even = (NT & 1) == 0;
    if (even) { SBAR(); qkt<1, SK>(pB0, pB1, K_lds, r32, hi, S.qr, ACT(NT - 1)); SBAR(); }
#define QROW(e) (nxt.Q + (size_t)(wid * QBLK + r32) * LD + ((e) >> 1) * 16 + hi * 8 + ((e) & 1) * 4)
    if constexpr (F32) { SLOAD_F((const float*)nxt.K, kbn); SBAR();
#pragma unroll
        for (int e = 0; e < 8; ++e) S.tq[e] = *(const f32x4*)QROW(e); }
    else { SLOAD_H(nxt.K, nxt.V, kbn); SBAR();
#pragma unroll
        for (int d0 = 0; d0 < 8; ++d0) S.qr[d0] = load8<TIn>(nxt.Q + (size_t)(wid * QBLK + r32) * LD + d0 * 16 + hi * 8); }
    SBAR();
    finishSM(pA0, pA1, alA, l_reg, pa0, pa1, pa2, pa3); SBAR();
    if constexpr (F32) {
#pragma unroll
        for (int e = 8; e < 16; ++e) S.tq[e] = *(const f32x4*)QROW(e); SBAR(); }
#undef QROW
    pv_tile<0, SK>(o, vb0, pa0, pa1, pa2, pa3, ACT(even ? NT - 2 : NT - 1));
    if (even) { MASKT(pB0, pB1, NT - 1); partialSM(pB0, pB1, m_reg, mnB, alB); __syncthreads(); RESC(alB);
        finishSM(pB0, pB1, alB, l_reg, pa0, pa1, pa2, pa3); SBAR(); pv_tile<1, SK>(o, vb0, pa0, pa1, pa2, pa3, ACT(NT - 1)); }
    SBAR(); SEAM_K0();
    if (hi == 0) li_l[r32] = l_reg; asm volatile("s_waitcnt lgkmcnt(0)" ::: "memory");
    float rli[16];
#pragma unroll
    for (int r = 0; r < 16; ++r) rli[r] = __builtin_amdgcn_rcpf(li_l[crow(r, hi)]);
    TOut* Ow = cur.O + (size_t)(wid * QBLK) * LD;
#pragma unroll
    for (int r = 0; r < 16; ++r) { const int orow = crow(r, hi);
#pragma unroll
        for (int d0 = 0; d0 < 4; ++d0) { const float v = o[d0][r] * rli[r];
            if constexpr (same_t<TOut, float>::v) { Ow[(size_t)orow * LD + d0 * 32 + r32] = v; }
            else { const float vn = __shfl_xor(v, 1);
                   if ((r32 & 1) == 0) *(unsigned*)(Ow + (size_t)orow * LD + d0 * 32 + r32) = cvtpk(v, vn); } } }
    if constexpr (F32) {
#pragma unroll
        for (int d0 = 0; d0 < 8; ++d0) S.qr[d0] = pack8(S.tq[2 * d0], S.tq[2 * d0 + 1]); }
    __syncthreads();
#undef RESC
#undef KBASE
#undef ACT
#undef MASKT
#undef SEAM_K0
#undef HALF_STEP
}
#undef ROW
#undef VMW
#undef VMWN
#undef SLOAD_H
#undef SWRITE_HK
#undef SWRITE_HV
#undef SWRITE_H
#undef SLOAD_F
#undef SWRITE_KF
#undef SWRITE_VF
}

#define LAS __attribute__((address_space(3)))
typedef float f32x4 __attribute__((ext_vector_type(4)));
typedef unsigned u32x4 __attribute__((ext_vector_type(4)));
typedef unsigned u32x2 __attribute__((ext_vector_type(2)));
constexpr int NTHR = 512, NWAVE = 8;
constexpr int RING_BYTES = 131072, LDS_MISC = 131072, LDS_BYTES = 147456;
constexpr int MI_BAR = 0;
constexpr int MI_NT = 16;
constexpr int MI_TILEE = 64;
constexpr int MI_EBASE = 1024;
constexpr int MI_RSTD = 2048;
constexpr int MI_LOGIT = 4096;
constexpr size_t WS_RWT = WS_TOTAL;
constexpr size_t WS_XS_UNUSED = 0;
constexpr size_t WS_TOTAL2 = WS_RWT + (size_t)2 * 2048 * 48 * 4;
constexpr int CW2_CNT0 = 1024, CW2_CUR0 = 1088, CW2_CNT1 = 1152, CW2_CUR1 = 1216;
constexpr int CW2_BAR = 2048;
constexpr int NBARREG = 4;
constexpr size_t CTL2_BYTES = (size_t)(CW2_BAR + NBARREG * XCD_BAR_WORDS) * 4;
static_assert(CTL2_BYTES <= CTL_BYTES, "ctl");
constexpr size_t U_XS = U_Y;

struct Args { const float* in[20]; float* out; unsigned char* ws; int ph_lo, ph_hi, bar_idx, pad; };

struct Frame {
    LAS unsigned char* lds; int tid, lane, wave, G, bx, vcu;
    unsigned char* ws; unsigned* ctl;
};

DI unsigned pk_bf16(float lo, float hi) { unsigned r; asm volatile("v_cvt_pk_bf16_f32 %0, %1, %2" : "=v"(r) : "v"(lo), "v"(hi)); return r; }
DI float fast_sigmoid(float x) { return __builtin_amdgcn_rcpf(1.0f + __expf(-x)); }

struct EpiProj0F { static constexpr bool PERM = true, AFTER_DRAIN = false;
    bf16_t* hq; float* hlf; bf16_t* hi; bf16_t* hgg; bf16_t* gq; bf16_t* gk; bf16_t* gv; bf16_t* gg; const float* lb;
    DI void operator()(const f32x4 (&acc)[2][2][4][2], const pg8::Unit& u, int wr, int wc, int fr, int fq) const {
        const int colt = u.pn * 256, seg = colt >> 10, row0 = u.pm * 256 + wr * 64 + fr, cl = (colt & 1023) + wc * 32 + 8 * fq;
        if (seg == 1) {
            f32x4 l0[2], l1[2];
#pragma unroll
            for (int bj = 0; bj < 2; ++bj) { l0[bj] = *(const f32x4*)(lb + cl + bj * 128); l1[bj] = *(const f32x4*)(lb + cl + bj * 128 + 4); }
#pragma unroll
            for (int ai = 0; ai < 2; ++ai)
#pragma unroll
                for (int m = 0; m < 4; ++m) { float* rowp = hlf + (size_t)(row0 + ai * 128 + m * 16) * 1024 + cl;
#pragma unroll
                    for (int bj = 0; bj < 2; ++bj) { f32x4 v0 = acc[ai][bj][m][0], v1 = acc[ai][bj][m][1];
#pragma unroll
                        for (int j = 0; j < 4; ++j) { v0[j] = __logf(l0[bj][j] + (1.0f - l0[bj][j]) * fast_sigmoid(v0[j])); v1[j] = __logf(l1[bj][j] + (1.0f - l1[bj][j]) * fast_sigmoid(v1[j])); }
                        *(f32x4*)(rowp + bj * 128) = v0; *(f32x4*)(rowp + bj * 128 + 4) = v1; } }
            return;
        }
        bf16_t* dst; int ld = 1024, co = cl; bool silu = false; float sc = 1.0f;
        if (seg == 0) { dst = hq; silu = true; sc = 0.08838834764831845f; }
        else if (seg == 2) dst = hi;
        else if (seg == 3) { dst = hgg; silu = true; }
        else if (seg == 4) { ld = 512; if ((colt & 1023) < 512) { dst = gq; sc = 0.08838834764831845f; } else { dst = gk; co = cl - 512; } }
        else if (seg == 5) dst = gv;
        else { dst = gg; silu = true; }
#pragma unroll
        for (int ai = 0; ai < 2; ++ai)
#pragma unroll
            for (int m = 0; m < 4; ++m) { bf16_t* rowp = dst + (size_t)(row0 + ai * 128 + m * 16) * ld + co;
#pragma unroll
                for (int bj = 0; bj < 2; ++bj) { f32x4 v0 = acc[ai][bj][m][0], v1 = acc[ai][bj][m][1];
                    if (silu) {
#pragma unroll
                        for (int j = 0; j < 4; ++j) { v0[j] *= fast_sigmoid(v0[j]); v1[j] *= fast_sigmoid(v1[j]); } }
                    v0 = v0 * sc; v1 = v1 * sc;
                    u32x4 w; w.x = pk_bf16(v0[0], v0[1]); w.y = pk_bf16(v0[2], v0[3]); w.z = pk_bf16(v1[0], v1[1]); w.w = pk_bf16(v1[2], v1[3]);
                    *(u32x4*)(rowp + bj * 128) = w; } }
    } };
struct EpiResidF { static constexpr bool PERM = false, AFTER_DRAIN = false;
    const float* res; float* out;
    DI void operator()(const f32x4 (&acc)[2][2][4][2], const pg8::Unit& u, int wr, int wc, int fr, int fq) const {
        const int row0 = u.pm * 256 + wr * 64 + fr, col0 = u.pn * 256 + wc * 32 + 4 * fq;
#pragma unroll
        for (int ai = 0; ai < 2; ++ai)
#pragma unroll
            for (int m = 0; m < 4; ++m) { const size_t ro = (size_t)(row0 + ai * 128 + m * 16) * D + col0;
#pragma unroll
                for (int bj = 0; bj < 2; ++bj)
#pragma unroll
                    for (int n = 0; n < 2; ++n) { const f32x4 r = *(const f32x4*)(res + ro + bj * 128 + n * 16); *(f32x4*)(out + ro + bj * 128 + n * 16) = r + acc[ai][bj][m][n]; } }
    } };
struct EpiBf16F { static constexpr bool PERM = true, AFTER_DRAIN = false;
    bf16_t* O; int ldc, nct, split_tiles; size_t split_stride;
    DI void operator()(const f32x4 (&acc)[2][2][4][2], const pg8::Unit& u, int wr, int wc, int fr, int fq) const {
        int ct = u.pn % nct; bf16_t* base = O; if (split_tiles) { const int t = ct / split_tiles; base += (size_t)t * split_stride; ct -= t * split_tiles; }
        const int row0 = u.pm * 256 + wr * 64 + fr, col0 = ct * 256 + wc * 32 + 8 * fq;
#pragma unroll
        for (int ai = 0; ai < 2; ++ai)
#pragma unroll
            for (int m = 0; m < 4; ++m) { bf16_t* rowp = base + (size_t)(row0 + ai * 128 + m * 16) * ldc + col0;
#pragma unroll
                for (int bj = 0; bj < 2; ++bj) { const f32x4 v0 = acc[ai][bj][m][0], v1 = acc[ai][bj][m][1];
                    u32x4 w; w.x = pk_bf16(v0[0], v0[1]); w.y = pk_bf16(v0[2], v0[3]); w.z = pk_bf16(v1[0], v1[1]); w.w = pk_bf16(v1[2], v1[3]);
                    *(u32x4*)(rowp + bj * 128) = w; } }
    } };
struct EpiSwigluF { static constexpr bool PERM = true, AFTER_DRAIN = false;
    bf16_t* O;
    DI void operator()(const f32x4 (&acc)[2][2][4][2], const pg8::Unit& u, int wr, int wc, int fr, int fq) const {
        const int row0 = u.pm * 256 + wr * 64 + fr, col0 = (u.pn & 3) * 128 + wc * 32 + 8 * fq;
#pragma unroll
        for (int ai = 0; ai < 2; ++ai)
#pragma unroll
            for (int m = 0; m < 4; ++m) { bf16_t* rowp = O + (size_t)(row0 + ai * 128 + m * 16) * DEXP + col0;
                f32x4 a0 = acc[ai][0][m][0], a1 = acc[ai][0][m][1]; const f32x4 b0 = acc[ai][1][m][0], b1 = acc[ai][1][m][1];
#pragma unroll
                for (int j = 0; j < 4; ++j) { a0[j] = a0[j] * fast_sigmoid(a0[j]) * b0[j]; a1[j] = a1[j] * fast_sigmoid(a1[j]) * b1[j]; }
                u32x4 w; w.x = pk_bf16(a0[0], a0[1]); w.y = pk_bf16(a0[2], a0[3]); w.z = pk_bf16(a1[0], a1[1]); w.w = pk_bf16(a1[2], a1[3]);
                *(u32x4*)rowp = w; }
    } };
struct MoeOrder {
    int nN, shift, nunits, G, c; const LAS int* tile_e;
    DI bool next(int i, pg8::Unit& u) const { const long L = (long)i * G + c; if (L >= nunits) return false; const int t = (int)L >> shift, pn = (int)L & (nN - 1);
        u.pm = t; u.pn = tile_e[t] * nN + pn; return true; }
    DI void a_ready(const pg8::Unit&) const {}
    DI void done(const pg8::Unit&) const {}
};

struct TJob { const float* src; bf16_t* dst; int ld, Kd, k0, n0, mode, half; };
DI void tjob_decode(int j, const Args& a, unsigned char* ws, TJob& t) {
    const float* w_in = a.in[4]; const float* w_out = a.in[10]; const float* w_qkv = a.in[11]; const float* w_o = a.in[12];
    const float* ew1 = a.in[17]; const float* ew3 = a.in[18]; const float* ew2 = a.in[19];
    t.mode = 0; t.half = 0;
    if (j < 896) { t.src = w_in; t.dst = (bf16_t*)(ws + WS_WIN); t.ld = EVEN_IN; t.Kd = D; t.k0 = (j / 56) * 128; t.n0 = (j % 56) * 128; return; }
    j -= 896;
    if (j < 256) { t.src = w_out; t.dst = (bf16_t*)(ws + WS_WOUT); t.ld = D; t.Kd = D; t.k0 = (j / 16) * 128; t.n0 = (j % 16) * 128; return; }
    j -= 256;
    if (j < 768) { t.src = w_qkv; t.dst = (bf16_t*)(ws + WS_WQKV); t.ld = 3 * D; t.Kd = D; t.k0 = (j / 48) * 128; t.n0 = (j % 48) * 128; return; }
    j -= 768;
    if (j < 256) { t.src = w_o; t.dst = (bf16_t*)(ws + WS_WO); t.ld = D; t.Kd = D; t.k0 = (j / 16) * 128; t.n0 = (j % 16) * 128; return; }
    j -= 256;
    const int le = j / 192, r = j % 192;
    if (r < 128) { const int hf = r / 64, q = r % 64; t.src = (hf ? ew3 : ew1) + (size_t)le * D * DEXP; t.dst = (bf16_t*)(ws + WS_WUP) + (size_t)le * 1024 * D; t.ld = DEXP; t.Kd = D;
        t.k0 = (q / 4) * 128; t.n0 = (q % 4) * 128; t.mode = 1; t.half = hf; return; }
    { const int q = r - 128; t.src = ew2 + (size_t)le * DEXP * D; t.dst = (bf16_t*)(ws + WS_WDN) + (size_t)le * D * DEXP; t.ld = D; t.Kd = DEXP; t.k0 = (q / 16) * 128; t.n0 = (q % 16) * 128; }
}
constexpr int N_TJOBS = 896 + 256 + 768 + 256 + 64 * 192;
DI void tjob_load(const TJob& t, int tid, f32x4 (&r)[8]) {
    const int c4 = (tid & 31) * 4, r0 = tid >> 5;
#pragma unroll
    for (int i = 0; i < 8; ++i) r[i] = *(const f32x4*)(t.src + (size_t)(t.k0 + r0 + 16 * i) * t.ld + t.n0 + c4);
}
DI void phase_transposes(const Frame& F, const Args& a) {
    LAS float* T = (LAS float*)F.lds;
    const int tid = F.tid; int j = F.bx; if (j >= N_TJOBS) return;
    TJob t; tjob_decode(j, a, F.ws, t); f32x4 r[8]; tjob_load(t, tid, r);
    for (;;) {
        const int c4 = (tid & 31) * 4, r0 = tid >> 5;
#pragma unroll
        for (int i = 0; i < 8; ++i) *(LAS f32x4*)(T + (r0 + 16 * i) * 132 + c4) = r[i];
        const TJob cur = t; const int jn = j + F.G; const bool more = jn < N_TJOBS;
        if (more) { tjob_decode(jn, a, F.ws, t); tjob_load(t, tid, r); }
        __syncthreads();
        { const int n = tid & 127, kg = tid >> 7; const int nn = cur.n0 + n;
          const int drow = cur.mode == 0 ? nn : (nn / 128) * 256 + cur.half * 128 + (nn % 128);
          bf16_t* dp = cur.dst + (size_t)drow * cur.Kd + cur.k0 + kg * 32;
#pragma unroll
          for (int q = 0; q < 4; ++q) { float v[8];
#pragma unroll
              for (int e = 0; e < 8; ++e) v[e] = T[(kg * 32 + q * 8 + e) * 132 + n];
              u32x4 w; w.x = pk_bf16(v[0], v[1]); w.y = pk_bf16(v[2], v[3]); w.z = pk_bf16(v[4], v[5]); w.w = pk_bf16(v[6], v[7]);
              *(u32x4*)(dp + q * 8) = w; } }
        __syncthreads();
        if (!more) break; j = jn;
    }
}
DI void phase_tables(const Frame& F, const Args& a) {
    const int gt = F.bx * NTHR + F.tid, gn = F.G * NTHR;
    float* LB = (float*)(F.ws + SM_LB); const float* lg = a.in[5];
    for (int d = gt; d < HG_QK; d += gn) { const float x = lg[d], y = lg[HG_QK + d], z = lg[2 * HG_QK + d], m = fmaxf(x, fmaxf(y, z));
        const float ex = __expf(x - m), ey = __expf(y - m), ez = __expf(z - m); LB[d] = ex / (ex + ey + ez); }
    float* RWT = (float*)(F.ws + WS_RWT);
    for (int i = gt; i < 2 * 2048 * 48; i += gn) { const int l = i / (2048 * 48), r = i % (2048 * 48); const int jj = r & 3, ln = (r >> 2) & 63, nt = (r >> 8) % 3, s = r / 768;
        const int k = 16 * s + 4 * (ln >> 4) + jj, n = 16 * nt + (ln & 15);
        float w = 0.f; if (n < 4) w = a.in[13][((size_t)l * D + k) * NGRP + n]; else if (n < 36) w = a.in[15][((size_t)l * D + k) * NEXP + (n - 4)];
        RWT[i] = w * a.in[2][l * D + k]; }
}

template <int MODE, bool COMBINE>
DI void phase_norm(const Frame& F, const float* src, float* hdst, const float* gain, bf16_t* xn, float* fout,
                   const bf16_t* Y, const int* slot, const float* wgt,
                   const float* w_in, float* glow, const float* rwt, const float* bg, const float* be, int* eid, float* wgt_out, unsigned* cnt) {
    const int lane = F.lane, w = F.wave;
    LAS float* rs = (LAS float*)(F.lds + LDS_MISC + MI_RSTD); LAS float* lgt = (LAS float*)(F.lds + LDS_MISC + MI_LOGIT);
    LAS f32x4* part = (LAS f32x4*)F.lds;
    for (int rb = F.bx; rb < NTOK / 64; rb += F.G) {
        const int r0 = rb * 64;
#pragma unroll 1
        for (int i = 0; i < 8; ++i) { const int row = r0 + w * 8 + i; const float* hr = src + (size_t)row * D;
            f32x4 v[8];
#pragma unroll
            for (int j = 0; j < 8; ++j) v[j] = *(const f32x4*)(hr + j * 256 + lane * 4);
            if (COMBINE) { const int s0 = slot[row * 2], s1 = slot[row * 2 + 1]; const float w0 = wgt[row * 2], w1 = wgt[row * 2 + 1];
#pragma unroll
                for (int j = 0; j < 8; ++j) { const u32x2 ya = *(const u32x2*)(Y + (size_t)s0 * D + j * 256 + lane * 4), yb = *(const u32x2*)(Y + (size_t)s1 * D + j * 256 + lane * 4);
                    v[j][0] += w0 * __uint_as_float(ya[0] << 16) + w1 * __uint_as_float(yb[0] << 16); v[j][1] += w0 * __uint_as_float(ya[0] & 0xFFFF0000u) + w1 * __uint_as_float(yb[0] & 0xFFFF0000u);
                    v[j][2] += w0 * __uint_as_float(ya[1] << 16) + w1 * __uint_as_float(yb[1] << 16); v[j][3] += w0 * __uint_as_float(ya[1] & 0xFFFF0000u) + w1 * __uint_as_float(yb[1] & 0xFFFF0000u); }
                if (MODE != 3) {
#pragma unroll
                    for (int j = 0; j < 8; ++j) *(f32x4*)(hdst + (size_t)row * D + j * 256 + lane * 4) = v[j]; } }
            float ss = 0.f;
#pragma unroll
            for (int j = 0; j < 8; ++j) ss += v[j][0] * v[j][0] + v[j][1] * v[j][1] + v[j][2] * v[j][2] + v[j][3] * v[j][3];
            ss = wave_sum(ss); const float rstd = rsqrtf(ss * (1.0f / D) + EPS);
            if (MODE == 1 || MODE == 2) { if (lane == 0) rs[w * 8 + i] = rstd; }
#pragma unroll
            for (int j = 0; j < 8; ++j) { const f32x4 g4 = *(const f32x4*)(gain + j * 256 + lane * 4); const f32x4 o = v[j] * g4 * rstd;
                if (MODE == 3) *(f32x4*)(fout + (size_t)row * D + j * 256 + lane * 4) = o;
                else { u32x2 p; p[0] = pk_bf16(o[0], o[1]); p[1] = pk_bf16(o[2], o[3]); *(u32x2*)(xn + (size_t)row * D + j * 256 + lane * 4) = p; } }
        }
        if (MODE == 1 || MODE == 2) {
            constexpr int NT = MODE == 2 ? 3 : 1;
            __builtin_amdgcn_fence(__ATOMIC_RELEASE, "workgroup"); __syncthreads(); __builtin_amdgcn_fence(__ATOMIC_ACQUIRE, "workgroup");
            const int rg = w & 3, kh = w >> 2, m = lane & 15, kq = lane >> 4;
            const float* xr = (COMBINE ? hdst : src) + (size_t)(r0 + rg * 16 + m) * D + 4 * kq;
            f32x4 acc[NT];
#pragma unroll
            for (int t = 0; t < NT; ++t) acc[t] = (f32x4){0.f, 0.f, 0.f, 0.f};
#pragma unroll 2
            for (int s = kh * 64; s < kh * 64 + 64; ++s) {
                const f32x4 xa = *(const f32x4*)(xr + 16 * s);
                f32x4 wb[NT];
                if (MODE == 2) {
#pragma unroll
                    for (int t = 0; t < NT; ++t) wb[t] = *(const f32x4*)(rwt + ((size_t)(s * 3 + t) * 64 + lane) * 4); }
                else {
#pragma unroll
                    for (int j = 0; j < 4; ++j) { const int k = 16 * s + 4 * kq + j; wb[0][j] = w_in[(size_t)k * EVEN_IN + EVEN_MAIN + m] * gain[k]; } }
#pragma unroll
                for (int j = 0; j < 4; ++j)
#pragma unroll
                    for (int t = 0; t < NT; ++t) acc[t] = __builtin_amdgcn_mfma_f32_16x16x4f32(xa[j], wb[t][j], acc[t], 0, 0, 0);
            }
            if (kh == 1) {
#pragma unroll
                for (int t = 0; t < NT; ++t) part[(rg * 3 + t) * 64 + lane] = acc[t]; }
            __syncthreads();
            if (kh == 0) {
#pragma unroll
                for (int t = 0; t < NT; ++t) { const f32x4 p = part[(rg * 3 + t) * 64 + lane];
#pragma unroll
                    for (int q = 0; q < 4; ++q) { const int rl = rg * 16 + 4 * kq + q; const float val = (acc[t][q] + p[q]) * rs[rl];
                        if (MODE == 1) glow[(size_t)(r0 + rl) * 16 + m] = val; else lgt[rl * 48 + t * 16 + m] = val; } } }
            __syncthreads();
            if (MODE == 2 && F.tid < 64) {
                const int row = r0 + F.tid; const LAS float* lr = lgt + F.tid * 48;
                float lg[4], e8[8];
#pragma unroll
                for (int c = 0; c < 4; ++c) lg[c] = lr[c] + bg[c];
                int grp = 0; float mx = lg[0];
#pragma unroll
                for (int c = 1; c < 4; ++c) if (lg[c] > mx) { mx = lg[c]; grp = c; }
                float den = 0.f;
#pragma unroll
                for (int c = 0; c < 4; ++c) den += __expf(lg[c] - mx);
                const float pg = 1.0f / den;
#pragma unroll
                for (int c = 0; c < 8; ++c) e8[c] = lr[4 + grp * 8 + c] + be[grp * 8 + c];
                int j0 = 0; float v0 = e8[0];
#pragma unroll
                for (int c = 1; c < 8; ++c) if (e8[c] > v0) { v0 = e8[c]; j0 = c; }
                int j1 = 0; float v1 = -3.0e38f;
#pragma unroll
                for (int c = 0; c < 8; ++c) if (c != j0 && e8[c] > v1) { v1 = e8[c]; j1 = c; }
                const float e1 = __expf(v1 - v0), sden = 1.0f / (1.0f + e1);
                const int ea = grp * 8 + j0, eb = grp * 8 + j1;
                eid[row * 2] = ea; eid[row * 2 + 1] = eb; wgt_out[row * 2] = pg * sden; wgt_out[row * 2 + 1] = pg * e1 * sden;
                atomicAdd(&cnt[ea], 1u); atomicAdd(&cnt[eb], 1u);
            }
            __syncthreads();
        }
    }
}

DI void moe_plan(const Frame& F, const unsigned* cnt) {
    LAS int* tile_e = (LAS int*)(F.lds + LDS_MISC + MI_TILEE); LAS int* ebase = (LAS int*)(F.lds + LDS_MISC + MI_EBASE); LAS int* ntp = (LAS int*)(F.lds + LDS_MISC + MI_NT);
    if (F.tid == 0) { int t = 0;
        for (int e = 0; e < NEXP; ++e) { const int c = (int)__hip_atomic_load(cnt + e, __ATOMIC_RELAXED, __HIP_MEMORY_SCOPE_AGENT); const int nt = (c + MOE_TILE - 1) / MOE_TILE; ebase[e] = t * MOE_TILE;
            for (int i = 0; i < nt && t + i < MOE_MAXT; ++i) tile_e[t + i] = e; t += nt; }
        if (t > MOE_MAXT) t = MOE_MAXT; *ntp = t; }
    __syncthreads();
}
DI void phase_scatter(const Frame& F, const int* eid, unsigned* cur, int* slot, const bf16_t* xn, bf16_t* xs) {
    const LAS int* ebase = (const LAS int*)(F.lds + LDS_MISC + MI_EBASE);
    for (int blk = F.bx; blk < (2 * NTOK) / 128; blk += F.G) {
        const int i0 = blk * 128 + F.wave * 16; int myslot = 0;
        if (F.lane < 16) { const int e = eid[i0 + F.lane]; const unsigned p = __hip_atomic_fetch_add(cur + e, 1u, __ATOMIC_RELAXED, __HIP_MEMORY_SCOPE_AGENT); myslot = ebase[e] + (int)p; slot[i0 + F.lane] = myslot; }
#pragma unroll 4
        for (int q = 0; q < 16; ++q) { const int s = __shfl(myslot, q); const int tok = (i0 + q) >> 1;
            const u32x4* sp = (const u32x4*)(xn + (size_t)tok * D) + F.lane; u32x4* dp = (u32x4*)(xs + (size_t)s * D) + F.lane;
#pragma unroll
            for (int c = 0; c < 4; ++c) dp[c * 64] = sp[c * 64]; }
    }
}
DI void phase_kmean(const Frame& F, const bf16_t* Kb, float* kmean) {
    LAS float* red = (LAS float*)F.lds;
    for (int it = F.bx; it < NB * MB_H * MB_NBLK; it += F.G) {
        const int n = it % MB_NBLK, hh = (it / MB_NBLK) % MB_H, b = it / (MB_NBLK * MB_H);
        const int kg = F.tid >> 4, d8 = (F.tid & 15) * 8; float s[8];
#pragma unroll
        for (int e = 0; e < 8; ++e) s[e] = 0.f;
        const bf16_t* p = Kb + ((size_t)b * SEQ + n * MB_BLK + kg * 8) * D + hh * MB_DH + d8;
#pragma unroll
        for (int j = 0; j < 8; ++j) { const u32x4 v = *(const u32x4*)(p + (size_t)j * D);
#pragma unroll
            for (int e = 0; e < 4; ++e) { s[2 * e] += __uint_as_float(v[e] << 16); s[2 * e + 1] += __uint_as_float(v[e] & 0xFFFF0000u); } }
#pragma unroll
        for (int e = 0; e < 8; ++e) red[kg * 128 + d8 + e] = s[e];
        __syncthreads();
        if (F.tid < 128) { float t = 0.f;
#pragma unroll
            for (int g = 0; g < 32; ++g) t += red[g * 128 + F.tid];
            kmean[(size_t)it * MB_DH + F.tid] = t * (1.0f / MB_BLK); }
        __syncthreads();
    }
}


template <int DV, bool IS_GLA>
DI void scan_naive_unit(LAS float* sb, int nthr_sub, int stid, int b, int hh, int nheads, const bf16_t* __restrict__ Q, const float* __restrict__ LF, const bf16_t* __restrict__ Kx, const bf16_t* __restrict__ V,
                        const float* __restrict__ glow, const float* __restrict__ gk2, const float* __restrict__ gkb, float* __restrict__ oraw, int ocol0) {
    constexpr int T = 16;
    LAS float* sq = sb; LAS float* sk = sb + T * 128; LAS float* sa = sb + 2 * T * 128;
    const int v = stid, qld = nheads * 128, vld = nheads * DV;
    float S[128];
#pragma unroll
    for (int d = 0; d < 128; ++d) S[d] = 0.f;
    for (int t0 = 0; t0 < SEQ; t0 += T) {
        __syncthreads();
        for (int i = stid; i < T * 128; i += nthr_sub) { const int tt = i >> 7, d = i & 127; const size_t tok = (size_t)b * SEQ + t0 + tt;
            sq[i] = bf2f(Q[tok * qld + hh * 128 + d]);
            if (IS_GLA) { float z = gkb[hh * 128 + d];
#pragma unroll
                for (int r = 0; r < GL_RANK; ++r) z += glow[tok * 16 + r] * gk2[r * GL_QK + hh * 128 + d];
                const float ls = fminf(z, 0.f) - log1pf(__expf(-fabsf(z)));
                sa[i] = __expf(ls * (1.0f / 16.0f)); sk[i] = bf2f(Kx[tok * qld + hh * 128 + d]); }
            else { const float al = __expf(LF[tok * qld + hh * 128 + d]); sa[i] = al; sk[i] = 1.0f - al; } }
        __syncthreads();
        for (int tt = 0; tt < T; ++tt) { const size_t tok = (size_t)b * SEQ + t0 + tt;
            const float vv = bf2f(V[tok * vld + hh * DV + v]); float o = 0.f;
#pragma unroll
            for (int d = 0; d < 128; ++d) { S[d] = sa[tt * 128 + d] * S[d] + sk[tt * 128 + d] * vv; o += sq[tt * 128 + d] * S[d]; }
            oraw[tok * D + ocol0 + hh * DV + v] = o; }
    }
}
DI void phase_scan_naive(const Frame& F, unsigned char* ws, const float* gk2, const float* gkb, float* oraw) {
    LAS float* base = (LAS float*)F.lds;
    if (F.bx < 8) { const int sub = F.tid >> 7, stid = F.tid & 127, unit = F.bx * 4 + sub;
        scan_naive_unit<128, false>(base + sub * 3 * 16 * 128, 128, stid, unit / HG_H, unit % HG_H, HG_H, (const bf16_t*)(ws + U_HQ), (const float*)(ws + U_HLF), nullptr, (const bf16_t*)(ws + U_HI), nullptr, nullptr, nullptr, oraw, 0); }
    else if (F.bx < 16) { const int sub = F.tid >> 8, stid = F.tid & 255, unit = (F.bx - 8) * 2 + sub;
        scan_naive_unit<256, true>(base + sub * 3 * 16 * 128, 256, stid, unit / GL_H, unit % GL_H, GL_H, (const bf16_t*)(ws + U_GQ), nullptr, (const bf16_t*)(ws + U_GK), (const bf16_t*)(ws + U_GV), (const float*)(ws + WS_GLOW), gk2, gkb, oraw, 1024); }
}
DI void phase_ngate(const Frame& F, const float* oraw, const float* hg_norm, const float* gla_norm, const bf16_t* hgg, const bf16_t* gg, bf16_t* mix) {
    const int lane = F.lane;
    for (int w = F.bx * NWAVE + F.wave; w < NTOK * 12; w += F.G * NWAVE) {
        const int tok = w / 12, s = w % 12; const bool gla = s >= 8; const int dv = gla ? 256 : 128, col0 = gla ? 1024 + (s - 8) * 256 : s * 128;
        const float* o = oraw + (size_t)tok * D + col0; float x[4]; float ss = 0.f; const int n = dv / 64;
#pragma unroll
        for (int i = 0; i < 4; ++i) { x[i] = i < n ? o[lane + 64 * i] : 0.f; ss += x[i] * x[i]; }
        ss = wave_sum(ss); const float rstd = rsqrtf(ss / dv + EPS);
#pragma unroll
        for (int i = 0; i < 4; ++i) if (i < n) { const int c = lane + 64 * i; const float gain = gla ? gla_norm[c] : hg_norm[c];
            const float gate = gla ? bf2f(gg[(size_t)tok * 1024 + (s - 8) * 256 + c]) : bf2f(hgg[(size_t)tok * 1024 + s * 128 + c]);
            mix[(size_t)tok * D + col0 + c] = f2bf(x[i] * rstd * gain * gate); }
    }
}
DI void phase_moba_naive(const Frame& F, const bf16_t* __restrict__ Qb, const bf16_t* __restrict__ Kb, const bf16_t* __restrict__ Vb, const float* __restrict__ kmean, bf16_t* __restrict__ AO) {
    LAS float* sq = (LAS float*)F.lds + F.wave * 128;
    LAS float* sp = (LAS float*)F.lds + 8 * 128 + F.wave * 1024;
    LAS int* ssel = (LAS int*)((LAS float*)F.lds + 8 * 128 + 8 * 1024) + F.wave * 4;
    const int lane = F.lane;
    for (int qg = F.bx; qg < NB * MB_H * SEQ / NWAVE; qg += F.G) {
        const int qi = qg * NWAVE + F.wave; const int t = qi % SEQ, hh = (qi / SEQ) % MB_H, b = qi / (SEQ * MB_H);
        const size_t tok = (size_t)b * SEQ + t; const int qb = t / MB_BLK;
        __syncthreads();
        sq[lane] = bf2f(Qb[tok * D + hh * MB_DH + lane]); sq[lane + 64] = bf2f(Qb[tok * D + hh * MB_DH + lane + 64]);
        __syncthreads();
        float gate = -3.0e38f;
        if (lane < qb) { const float* km = kmean + ((size_t)(b * MB_H + hh) * MB_NBLK + lane) * MB_DH; float s = 0.f; for (int d = 0; d < 128; ++d) s += sq[d] * km[d]; gate = s; }
        const int nsel = qb < 3 ? qb : 3;
        for (int s = 0; s < 3; ++s) { float best = gate; int bi = lane;
            for (int o = 32; o > 0; o >>= 1) { const float ob = __shfl_xor(best, o); const int oi = __shfl_xor(bi, o); if (ob > best || (ob == best && oi < bi)) { best = ob; bi = oi; } }
            if (lane == 0) ssel[s] = bi; if (lane == bi) gate = -3.4e38f; }
        __syncthreads();
        const float scale = 0.08838834764831845f; float mx = -3.0e38f;
        for (int sgi = 0; sgi <= nsel; ++sgi) { const int blk = sgi < nsel ? ssel[sgi] : qb;
            for (int i = 0; i < 4; ++i) { const int j = lane + 64 * i, kp = blk * MB_BLK + j; float s = -__builtin_inff();
                if (sgi < nsel || kp <= t) { const bf16_t* kr = Kb + ((size_t)b * SEQ + kp) * D + hh * MB_DH; float acc = 0.f;
                    for (int d = 0; d < 128; d += 2) { const unsigned w = *(const unsigned*)(kr + d); acc += sq[d] * __uint_as_float(w << 16) + sq[d + 1] * __uint_as_float(w & 0xFFFF0000u); }
                    s = acc * scale; }
                sp[sgi * 256 + j] = s; mx = fmaxf(mx, s); } }
        for (int o = 32; o > 0; o >>= 1) mx = fmaxf(mx, __shfl_xor(mx, o));
        float den = 0.f;
        for (int sgi = 0; sgi <= nsel; ++sgi) for (int i = 0; i < 4; ++i) { const int idx = sgi * 256 + lane + 64 * i; const float p = __expf(sp[idx] - mx); sp[idx] = p; den += p; }
        den = wave_sum(den);
        __syncthreads();
        float o0 = 0.f, o1 = 0.f;
        for (int sgi = 0; sgi <= nsel; ++sgi) { const int blk = sgi < nsel ? ssel[sgi] : qb; const int jmax = sgi < nsel ? 256 : (t - qb * MB_BLK + 1);
            for (int j = 0; j < jmax; ++j) { const float p = sp[sgi * 256 + j]; const unsigned w = *(const unsigned*)(Vb + ((size_t)b * SEQ + blk * MB_BLK + j) * D + hh * MB_DH + lane * 2);
                o0 += p * __uint_as_float(w << 16); o1 += p * __uint_as_float(w & 0xFFFF0000u); } }
        const float inv = 1.0f / den;
        *(unsigned*)(AO + tok * D + hh * MB_DH + lane * 2) = (unsigned)f2bf(o0 * inv) | ((unsigned)f2bf(o1 * inv) << 16);
    }
}


DI moba::BlockRef<bf16_t, bf16_t> moba_ref(int L, int pass, const bf16_t* Q, const bf16_t* K, const bf16_t* V, bf16_t* O, const float* kmean) {
    const int bh = L >> 3, x = L & 7, qb = pass ? 15 - x : x, b = bh >> 4, h = bh & 15;
    moba::BlockRef<bf16_t, bf16_t> r; const size_t base = ((size_t)b * SEQ) * D + h * MB_DH;
    r.Q = Q + base + (size_t)qb * 256 * D; r.O = O + base + (size_t)qb * 256 * D; r.K = K + base; r.V = V + base; r.KM = kmean + (size_t)bh * MB_NBLK * MB_DH; r.P0 = qb * 256;
    return r;
}
DI void phase_attn(char* lds, int G, int c, const bf16_t* Q, const bf16_t* K, const bf16_t* V, bf16_t* O, const float* kmean) {
    constexpr int TOTAL = 8 * NB * MB_H;
    int L = c; if (L >= TOTAL) return;
    int pass = 0;
    moba::BlockRef<bf16_t, bf16_t> cur = moba_ref(L, 0, Q, K, V, O, kmean);
    moba::Seam<bf16_t> S;
    moba::causal_swa_prime<bf16_t, bf16_t>(cur, SEQ, lds, S);
    for (;;) {
        const bool more_pass = pass == 0, more_item = L + G < TOTAL, last = !more_pass && !more_item;
        int passn = pass + 1, Ln = L;
        if (!more_pass) { passn = 0; Ln = more_item ? L + G : L; }
        const moba::BlockRef<bf16_t, bf16_t> nxt = last ? cur : moba_ref(Ln, passn, Q, K, V, O, kmean);
        moba::causal_swa_block<bf16_t, bf16_t>(cur, nxt, SEQ, SEQ, lds, S);
        if (last) break;
        cur = nxt; pass = passn; L = Ln;
    }
}

enum { PH_PRO = 0, PH_GEMM1 = 1, PH_SCAN = 2, PH_NGATE = 3, PH_OUTP = 4, PH_NORM_F0 = 5, PH_SCAT0 = 6, PH_UP0 = 7, PH_DN0 = 8, PH_COMB0 = 9, PH_QKV = 10, PH_KMEAN = 11, PH_ATTN = 12,
       PH_OPROJ = 13, PH_NORM_F1 = 14, PH_SCAT1 = 15, PH_UP1 = 16, PH_DN1 = 17, PH_FINAL = 18, PH_END = 19 };

__global__ void __launch_bounds__(NTHR, 2) mk_fwd(Args a) {
    extern __shared__ __attribute__((aligned(16))) unsigned char lds_raw[];
    Frame F; F.lds = (LAS unsigned char*)lds_raw; F.tid = threadIdx.x; F.lane = F.tid & 63; F.wave = __builtin_amdgcn_readfirstlane(F.tid >> 6);
    F.G = gridDim.x; F.bx = blockIdx.x; F.vcu = (F.G % 8 == 0) ? (F.bx % 8) * (F.G / 8) + F.bx / 8 : F.bx;
    F.ws = a.ws; F.ctl = (unsigned*)(a.ws + WS_CTL);
    unsigned char* ws = a.ws;
    if (F.tid < 4) ((LAS unsigned*)(F.lds + LDS_MISC + MI_BAR))[F.tid] = 0u;
    __syncthreads();
    const int lo = a.ph_lo, hi = a.ph_hi;
    XcdBarrier bar; bar.bar = F.ctl + CW2_BAR + a.bar_idx * XCD_BAR_WORDS; bar.x = 0; bar.st = (volatile LAS unsigned*)(F.lds + LDS_MISC + MI_BAR);
    if (hi - lo > 1) bar = xcd_barrier_post(F.ctl + CW2_BAR + a.bar_idx * XCD_BAR_WORDS, (volatile LAS unsigned*)(F.lds + LDS_MISC + MI_BAR));
#define IN(k) (lo <= (k) && (k) < hi)
#define SEAM(k) do { if (IN(k) && IN((k) + 1)) xcd_barrier(bar); } while (0)
    const float* x = a.in[0]; const float* norm_mix = a.in[1]; const float* norm_ffn = a.in[2]; const float* norm_final = a.in[3];
    bf16_t* WinT = (bf16_t*)(ws + WS_WIN); bf16_t* WoutT = (bf16_t*)(ws + WS_WOUT); bf16_t* WqkvT = (bf16_t*)(ws + WS_WQKV); bf16_t* WoT = (bf16_t*)(ws + WS_WO);
    bf16_t* Wup = (bf16_t*)(ws + WS_WUP); bf16_t* Wdn = (bf16_t*)(ws + WS_WDN);
    bf16_t* XN = (bf16_t*)(ws + WS_XN); float* H = (float*)(ws + WS_H);
    float* LB = (float*)(ws + SM_LB); float* KMEAN = (float*)(ws + SM_KMEAN);
    float* GLOW = (float*)(ws + WS_GLOW); int* EID = (int*)(ws + WS_EID); float* WGT = (float*)(ws + WS_WGT); int* SLOT = (int*)(ws + WS_SLOT);
    float* RWT = (float*)(ws + WS_RWT);
    bf16_t* Qb = (bf16_t*)(ws + U_Q); bf16_t* Kb = (bf16_t*)(ws + U_K); bf16_t* Vb = (bf16_t*)(ws + U_V);
    bf16_t* HMID = (bf16_t*)(ws + U_HMID); bf16_t* Y = (bf16_t*)(ws + U_Y); bf16_t* XS = (bf16_t*)(ws + U_XS);
    const LAS int* tile_e = (const LAS int*)(F.lds + LDS_MISC + MI_TILEE); const LAS int* ntp = (const LAS int*)(F.lds + LDS_MISC + MI_NT);

    if (IN(PH_PRO)) {
        phase_tables(F, a);
        phase_norm<1, false>(F, x, nullptr, norm_mix, XN, nullptr, nullptr, nullptr, nullptr, a.in[4], GLOW, nullptr, nullptr, nullptr, nullptr, nullptr, nullptr);
        __syncthreads();
        phase_transposes(F, a);
    }
    SEAM(PH_PRO);
    if (IN(PH_GEMM1)) {
        pg8::Gemm g{XN, WinT, NTOK, EVEN_MAIN, D}; pg8::StaticOrder S; S.init(NTOK, EVEN_MAIN, F.G, F.bx);
        EpiProj0F E{(bf16_t*)(ws + U_HQ), (float*)(ws + U_HLF), (bf16_t*)(ws + U_HI), (bf16_t*)(ws + U_HGG), (bf16_t*)(ws + U_GQ), (bf16_t*)(ws + U_GK), (bf16_t*)(ws + U_GV), (bf16_t*)(ws + U_GG), LB};
        pg8::gemm_phase<EpiProj0F, pg8::StaticOrder, true, true>(F.lds, g, S, E);
    }
    SEAM(PH_GEMM1);
    if (IN(PH_SCAN)) phase_scan_naive(F, ws, a.in[7], a.in[8], H);
    SEAM(PH_SCAN);
    if (IN(PH_NGATE)) phase_ngate(F, H, a.in[6], a.in[9], (const bf16_t*)(ws + U_HGG), (const bf16_t*)(ws + U_GG), XN);
    SEAM(PH_NGATE);
    if (IN(PH_OUTP)) {
        pg8::Gemm g{XN, WoutT, NTOK, D, D}; pg8::StaticOrder S; S.init(NTOK, D, F.G, F.bx);
        EpiResidF E{x, H};
        pg8::gemm_phase<EpiResidF, pg8::StaticOrder, true, true>(F.lds, g, S, E);
    }
    SEAM(PH_OUTP);
#define MOE_LAYER(l, PHN, PHS, PHU, PHD, CNT, CUR)                                                                                              \
    if (IN(PHN)) phase_norm<2, false>(F, H, nullptr, norm_ffn + (l) * D, XN, nullptr, nullptr, nullptr, nullptr, nullptr, nullptr,              \
                                      RWT + (size_t)(l) * 2048 * 48, a.in[14] + (l) * NGRP, a.in[16] + (l) * NEXP, EID, WGT, F.ctl + CNT);        \
    SEAM(PHN);                                                                                                                                  \
    if (IN(PHS)) { moe_plan(F, F.ctl + CNT); phase_scatter(F, EID, F.ctl + CUR, SLOT, XN, XS); }                                                \
    SEAM(PHS);                                                                                                                                  \
    if (IN(PHU)) { moe_plan(F, F.ctl + CNT);                                                                                                    \
        pg8::Gemm g{XS, Wup + (size_t)(l) * NEXP * 1024 * D, MOE_ROWS, NEXP * 1024, D}; MoeOrder S{4, 2, *ntp * 4, F.G, F.vcu, tile_e};          \
        EpiSwigluF E{HMID}; pg8::gemm_phase<EpiSwigluF, MoeOrder, true, true>(F.lds, g, S, E); }                                                \
    SEAM(PHU);                                                                                                                                  \
    if (IN(PHD)) { moe_plan(F, F.ctl + CNT);                                                                                                    \
        pg8::Gemm g{HMID, Wdn + (size_t)(l) * NEXP * D * DEXP, MOE_ROWS, NEXP * D, DEXP}; MoeOrder S{8, 3, *ntp * 8, F.G, F.vcu, tile_e};        \
        EpiBf16F E{Y, D, 8, 0, 0}; pg8::gemm_phase<EpiBf16F, MoeOrder, true, true>(F.lds, g, S, E); }                                           \
    SEAM(PHD);
    MOE_LAYER(0, PH_NORM_F0, PH_SCAT0, PH_UP0, PH_DN0, CW2_CNT0, CW2_CUR0)
    if (IN(PH_COMB0)) phase_norm<0, true>(F, H, H, norm_mix + D, XN, nullptr, Y, SLOT, WGT, nullptr, nullptr, nullptr, nullptr, nullptr, nullptr, nullptr, nullptr);
    SEAM(PH_COMB0);
    if (IN(PH_QKV)) {
        pg8::Gemm g{XN, WqkvT, NTOK, 3 * D, D}; pg8::StaticOrder S; S.init(NTOK, 3 * D, F.G, F.bx);
        EpiBf16F E{Qb, D, 24, 8, (size_t)NTOK * D};
        pg8::gemm_phase<EpiBf16F, pg8::StaticOrder, true, true>(F.lds, g, S, E);
    }
    SEAM(PH_QKV);
    if (IN(PH_KMEAN)) phase_kmean(F, Kb, KMEAN);
    SEAM(PH_KMEAN);
    if (IN(PH_ATTN)) phase_attn((char*)lds_raw, F.G, F.vcu, Qb, Kb, Vb, XN, KMEAN);
    SEAM(PH_ATTN);
    if (IN(PH_OPROJ)) {
        pg8::Gemm g{XN, WoT, NTOK, D, D}; pg8::StaticOrder S; S.init(NTOK, D, F.G, F.bx);
        EpiResidF E{H, H};
        pg8::gemm_phase<EpiResidF, pg8::StaticOrder, true, true>(F.lds, g, S, E);
    }
    SEAM(PH_OPROJ);
    MOE_LAYER(1, PH_NORM_F1, PH_SCAT1, PH_UP1, PH_DN1, CW2_CNT1, CW2_CUR1)
    if (IN(PH_FINAL)) phase_norm<3, true>(F, H, nullptr, norm_final, nullptr, a.out, Y, SLOT, WGT, nullptr, nullptr, nullptr, nullptr, nullptr, nullptr, nullptr, nullptr);
#undef IN
#undef SEAM
#undef MOE_LAYER
}


extern "C" void kernel_launch(void* const* d_in, const int* in_sizes, int n_in, void* d_out, int out_size, void* d_ws, size_t ws_size, hipStream_t stream) {
    static int grid = 0;
    if (grid == 0) {
        if (n_in != 20 || out_size != NTOK * D || ws_size < WS_TOTAL2) { fprintf(stderr, "kernel_launch: unexpected shapes / workspace (%d inputs, out %d, ws %zu need %zu)\n", n_in, out_size, ws_size, (size_t)WS_TOTAL2); grid = -1; return; }
        int dev = 0, cus = 0;
        if (hipGetDevice(&dev) != hipSuccess || hipDeviceGetAttribute(&cus, hipDeviceAttributeMultiprocessorCount, dev) != hipSuccess || cus <= 0) { grid = -1; return; }
        if (hipFuncSetAttribute((const void*)mk_fwd, hipFuncAttributeMaxDynamicSharedMemorySize, LDS_BYTES) != hipSuccess) { fprintf(stderr, "kernel_launch: hipFuncSetAttribute failed\n"); grid = -1; return; }
        int per_cu = 0; (void)hipOccupancyMaxActiveBlocksPerMultiprocessor(&per_cu, (const void*)mk_fwd, NTHR, LDS_BYTES); (void)hipGetLastError();
        if (per_cu < 1) fprintf(stderr, "kernel_launch: occupancy query reports %d\n", per_cu);
        grid = cus;
    }
    if (grid < 0) return;
    const float* x = (const float*)d_in[0];
    const float* hg_norm = (const float*)d_in[6]; const float* gk2 = (const float*)d_in[7]; const float* gkb = (const float*)d_in[8]; const float* gla_norm = (const float*)d_in[9];
    unsigned char* ws = (unsigned char*)d_ws;
    bf16_t* XN = (bf16_t*)(ws + WS_XN); float* H = (float*)(ws + WS_H);
    float* KMEAN = (float*)(ws + SM_KMEAN); float* GLOW = (float*)(ws + WS_GLOW);
    bf16_t* HQ = (bf16_t*)(ws + U_HQ); float* HLF = (float*)(ws + U_HLF); bf16_t* HI = (bf16_t*)(ws + U_HI); bf16_t* HGG = (bf16_t*)(ws + U_HGG);
    bf16_t* GQ = (bf16_t*)(ws + U_GQ); bf16_t* GK = (bf16_t*)(ws + U_GK); bf16_t* GV = (bf16_t*)(ws + U_GV); bf16_t* GG = (bf16_t*)(ws + U_GG);
    bf16_t* Qb = (bf16_t*)(ws + U_Q); bf16_t* Kb = (bf16_t*)(ws + U_K); bf16_t* Vb = (bf16_t*)(ws + U_V);
    (void)x;
    (void)hipMemsetAsync(ws + WS_CTL, 0, CTL_BYTES, stream);
    Args a{};
    for (int i = 0; i < 20; ++i) a.in[i] = (const float*)d_in[i];
    a.out = (float*)d_out; a.ws = ws;
    auto run = [&](int lo, int hi, int bi) { a.ph_lo = lo; a.ph_hi = hi; a.bar_idx = bi; a.pad = 0; hipLaunchKernelGGL(mk_fwd, dim3(grid), dim3(NTHR), LDS_BYTES, stream, a); };
    run(PH_PRO, PH_END, 0);
}
```

```cpp
#include <hip/hip_runtime.h>
#include <cstdio>
#include <cstdint>

typedef unsigned short bf16_t;
#define DI __device__ __forceinline__

constexpr int D = 2048, NB = 4, SEQ = 4096, NTOK = NB * SEQ;
constexpr int HG_H = 8, HG_DK = 128, HG_DV = 128, HG_QK = 1024, HG_V = 1024;
constexpr int GL_H = 4, GL_DK = 128, GL_DV = 256, GL_QK = 512, GL_V = 1024, GL_RANK = 16;
constexpr int EVEN_IN = 7184, EVEN_MAIN = 7168;
constexpr int MB_H = 16, MB_DH = 128, MB_BLK = 256, MB_NBLK = SEQ / MB_BLK;
constexpr int NEXP = 32, NGRP = 4, EPG = 8, DEXP = 512;
constexpr int MOE_TILE = 256, MOE_MAXT = (2 * NTOK) / MOE_TILE + NEXP, MOE_ROWS = MOE_MAXT * MOE_TILE;
constexpr float EPS = 1e-6f;

constexpr size_t MBy = 1024 * 1024;
constexpr size_t WS_CTL   = 0;
constexpr size_t CTL_BYTES = 64 * 1024;
constexpr size_t WS_SMALL = WS_CTL + CTL_BYTES;
constexpr size_t WS_WIN   = WS_SMALL + 1 * MBy;
constexpr size_t WS_WOUT  = WS_WIN + (size_t)EVEN_MAIN * D * 2;
constexpr size_t WS_WQKV  = WS_WOUT + (size_t)D * D * 2;
constexpr size_t WS_WO    = WS_WQKV + (size_t)3 * D * D * 2;
constexpr size_t WS_WUP   = WS_WO + (size_t)D * D * 2;
constexpr size_t WS_WDN   = WS_WUP + (size_t)2 * NEXP * 1024 * D * 2;
constexpr size_t WS_XN    = WS_WDN + (size_t)2 * NEXP * D * DEXP * 2;
constexpr size_t WS_H     = WS_XN + (size_t)NTOK * D * 2;
constexpr size_t WS_U     = WS_H + (size_t)NTOK * D * 4;
constexpr size_t U_HQ  = WS_U;
constexpr size_t U_HLF = U_HQ + (size_t)NTOK * 1024 * 2;
constexpr size_t U_HI  = U_HLF + (size_t)NTOK * 1024 * 4;
constexpr size_t U_HGG = U_HI + (size_t)NTOK * 1024 * 2;
constexpr size_t U_GQ  = U_HGG + (size_t)NTOK * 1024 * 2;
constexpr size_t U_GK  = U_GQ + (size_t)NTOK * 512 * 2;
constexpr size_t U_GV  = U_GK + (size_t)NTOK * 512 * 2;
constexpr size_t U_GG  = U_GV + (size_t)NTOK * 1024 * 2;
constexpr size_t U_END0 = U_GG + (size_t)NTOK * 1024 * 2;
constexpr size_t U_Q = WS_U, U_K = U_Q + (size_t)NTOK * D * 2, U_V = U_K + (size_t)NTOK * D * 2, U_END1 = U_V + (size_t)NTOK * D * 2;
constexpr size_t U_HMID = WS_U;
constexpr size_t U_Y = U_HMID + (size_t)MOE_ROWS * DEXP * 2;
constexpr size_t U_END2 = U_Y + (size_t)MOE_ROWS * D * 2;
constexpr size_t U_BYTES = U_END0 - WS_U;
static_assert(U_END1 - WS_U <= U_BYTES && U_END2 - WS_U <= U_BYTES, "union");
constexpr size_t WS_END = WS_U + U_BYTES;
constexpr size_t SM_LB    = WS_SMALL;
constexpr size_t SM_GLOW  = SM_LB + 4096;
constexpr size_t SM_KMEAN = WS_SMALL + 64 * 1024;
constexpr size_t SM_TILEE = SM_KMEAN + 512 * 1024;
constexpr size_t WS_GLOW  = WS_END;
constexpr size_t WS_EID   = WS_GLOW + (size_t)NTOK * 16 * 4;
constexpr size_t WS_WGT   = WS_EID + (size_t)NTOK * 2 * 4;
constexpr size_t WS_SLOT  = WS_WGT + (size_t)NTOK * 2 * 4;
constexpr size_t WS_ROWTOK = WS_SLOT + (size_t)NTOK * 2 * 4;
constexpr size_t WS_TOTAL = WS_ROWTOK + (size_t)MOE_ROWS * 4;
constexpr int CW_CNT = 0;
constexpr int CW_CUR = 64;
constexpr int CW_BASE = 128;
constexpr int CW_NT = 192;

DI float bf2f(bf16_t b) { return __uint_as_float(((unsigned)b) << 16); }
DI bf16_t f2bf(float f) { unsigned u = __float_as_uint(f); u += 0x7FFFu + ((u >> 16) & 1u); return (bf16_t)(u >> 16); }
DI float sigmoidf_(float x) { return 1.0f / (1.0f + __expf(-x)); }
DI float siluf_(float x) { return x / (1.0f + __expf(-x)); }
DI float wave_sum(float v) { for (int o = 32; o > 0; o >>= 1) v += __shfl_xor(v, o); return v; }

template <int MODE>
__global__ void k_transpose(const float* __restrict__ src, bf16_t* __restrict__ dst, int K, int N, int ld, int c0, int half, size_t src_bstride, size_t dst_bstride) {
    __shared__ float t[64][65];
    src += (size_t)blockIdx.z * src_bstride; dst += (size_t)blockIdx.z * dst_bstride;
    const int k0 = blockIdx.y * 64, n0 = blockIdx.x * 64, tx = threadIdx.x & 63, ty = threadIdx.x >> 6;
    for (int i = ty; i < 64; i += 4) t[i][tx] = src[(size_t)(k0 + i) * ld + c0 + n0 + tx];
    __syncthreads();
    for (int i = ty; i < 64; i += 4) { const int n = n0 + i; const int r = MODE == 0 ? n : (n / 128) * 256 + half * 128 + (n % 128);
        dst[(size_t)r * K + k0 + tx] = f2bf(t[tx][i]); }
}
__global__ void k_lb(const float* __restrict__ lg, float* __restrict__ lb) {
    const int d = blockIdx.x * blockDim.x + threadIdx.x; if (d >= HG_QK) return;
    const float a = lg[d], b = lg[HG_QK + d], c = lg[2 * HG_QK + d], m = fmaxf(a, fmaxf(b, c));
    const float ea = __expf(a - m), eb = __expf(b - m), ec = __expf(c - m); lb[d] = ea / (ea + eb + ec);
}

template <int MODE>
__global__ void k_rmsnorm(const float* __restrict__ h, const float* __restrict__ g, bf16_t* __restrict__ xn, float* __restrict__ fout,
                          const float* __restrict__ w_in, float* __restrict__ glow,
                          const float* __restrict__ wg, const float* __restrict__ bg, const float* __restrict__ we, const float* __restrict__ be,
                          int* __restrict__ eid, float* __restrict__ wgt, unsigned* __restrict__ ctl) {
    const int row = blockIdx.x * 4 + (threadIdx.x >> 6), lane = threadIdx.x & 63;
    const float* hr = h + (size_t)row * D;
    float v[32]; float ss = 0.f;
#pragma unroll
    for (int j = 0; j < 8; ++j) { const float4 x = *(const float4*)(hr + j * 256 + lane * 4); v[4 * j] = x.x; v[4 * j + 1] = x.y; v[4 * j + 2] = x.z; v[4 * j + 3] = x.w; ss += x.x * x.x + x.y * x.y + x.z * x.z + x.w * x.w; }
    ss = wave_sum(ss); const float rstd = rsqrtf(ss * (1.0f / D) + EPS);
#pragma unroll
    for (int j = 0; j < 8; ++j) { const float4 gg = *(const float4*)(g + j * 256 + lane * 4);
        v[4 * j] *= rstd * gg.x; v[4 * j + 1] *= rstd * gg.y; v[4 * j + 2] *= rstd * gg.z; v[4 * j + 3] *= rstd * gg.w; }
    if (MODE == 3) {
#pragma unroll
        for (int j = 0; j < 8; ++j) *(float4*)(fout + (size_t)row * D + j * 256 + lane * 4) = make_float4(v[4 * j], v[4 * j + 1], v[4 * j + 2], v[4 * j + 3]);
        return;
    }
#pragma unroll
    for (int j = 0; j < 8; ++j) { ushort4 o; o.x = f2bf(v[4 * j]); o.y = f2bf(v[4 * j + 1]); o.z = f2bf(v[4 * j + 2]); o.w = f2bf(v[4 * j + 3]);
        *(ushort4*)(xn + (size_t)row * D + j * 256 + lane * 4) = o; }
    if (MODE == 1) {
        float acc[16];
#pragma unroll
        for (int c = 0; c < 16; ++c) acc[c] = 0.f;
#pragma unroll
        for (int j = 0; j < 8; ++j)
#pragma unroll
            for (int e = 0; e < 4; ++e) { const int k = j * 256 + lane * 4 + e; const float* wr = w_in + (size_t)k * EVEN_IN + EVEN_MAIN; const float xv = v[4 * j + e];
#pragma unroll
                for (int c4 = 0; c4 < 4; ++c4) { const float4 w = *(const float4*)(wr + c4 * 4); acc[c4 * 4] += xv * w.x; acc[c4 * 4 + 1] += xv * w.y; acc[c4 * 4 + 2] += xv * w.z; acc[c4 * 4 + 3] += xv * w.w; } }
#pragma unroll
        for (int c = 0; c < 16; ++c) acc[c] = wave_sum(acc[c]);
        if (lane == 0) {
#pragma unroll
            for (int c = 0; c < 16; ++c) glow[(size_t)row * 16 + c] = acc[c]; }
    }
    if (MODE == 2) {
        float lg[4], le[32];
#pragma unroll
        for (int c = 0; c < 4; ++c) lg[c] = 0.f;
#pragma unroll
        for (int c = 0; c < 32; ++c) le[c] = 0.f;
#pragma unroll
        for (int j = 0; j < 8; ++j)
#pragma unroll
            for (int e = 0; e < 4; ++e) { const int k = j * 256 + lane * 4 + e; const float xv = v[4 * j + e];
                const float4 w4 = *(const float4*)(wg + (size_t)k * 4); lg[0] += xv * w4.x; lg[1] += xv * w4.y; lg[2] += xv * w4.z; lg[3] += xv * w4.w;
#pragma unroll
                for (int c4 = 0; c4 < 8; ++c4) { const float4 w = *(const float4*)(we + (size_t)k * 32 + c4 * 4); le[c4 * 4] += xv * w.x; le[c4 * 4 + 1] += xv * w.y; le[c4 * 4 + 2] += xv * w.z; le[c4 * 4 + 3] += xv * w.w; } }
#pragma unroll
        for (int c = 0; c < 4; ++c) lg[c] = wave_sum(lg[c]) + bg[c];
#pragma unroll
        for (int c = 0; c < 32; ++c) le[c] = wave_sum(le[c]) + be[c];
        if (lane == 0) {
            int grp = 0; float mx = lg[0];
#pragma unroll
            for (int c = 1; c < 4; ++c) if (lg[c] > mx) { mx = lg[c]; grp = c; }
            float den = 0.f;
#pragma unroll
            for (int c = 0; c < 4; ++c) den += __expf(lg[c] - mx);
            const float pg = 1.0f / den;
            float e8[8];
#pragma unroll
            for (int c = 0; c < 8; ++c) { e8[c] = grp == 0 ? le[c] : grp == 1 ? le[8 + c] : grp == 2 ? le[16 + c] : le[24 + c]; }
            int j0 = 0; float v0 = e8[0];
#pragma unroll
            for (int c = 1; c < 8; ++c) if (e8[c] > v0) { v0 = e8[c]; j0 = c; }
            int j1 = -1; float v1 = -3.0e38f;
#pragma unroll
            for (int c = 0; c < 8; ++c) if (c != j0 && e8[c] > v1) { v1 = e8[c]; j1 = c; }
            const float e1 = __expf(v1 - v0), s = 1.0f / (1.0f + e1);
            const int ea = grp * 8 + j0, eb = grp * 8 + j1;
            eid[row * 2] = ea; eid[row * 2 + 1] = eb; wgt[row * 2] = pg * s; wgt[row * 2 + 1] = pg * e1 * s;
            atomicAdd(&ctl[CW_CNT + ea], 1u); atomicAdd(&ctl[CW_CNT + eb], 1u);
        }
    }
}

struct EpiProj0 { bf16_t* hq; float* hlf; bf16_t* hi; bf16_t* hgg; bf16_t* gq; bf16_t* gk; bf16_t* gv; bf16_t* gg; const float* lb;
    DI void operator()(int r, int c, float v) const {
        const int seg = c >> 10, cc = c & 1023; const float sc = 0.08838834764831845f;
        if (seg == 0) hq[(size_t)r * 1024 + cc] = f2bf(siluf_(v) * sc);
        else if (seg == 1) { const float l = lb[cc]; const float f = l + (1.0f - l) * sigmoidf_(v); hlf[(size_t)r * 1024 + cc] = __logf(f); }
        else if (seg == 2) hi[(size_t)r * 1024 + cc] = f2bf(v);
        else if (seg == 3) hgg[(size_t)r * 1024 + cc] = f2bf(siluf_(v));
        else if (seg == 4) { if (cc < 512) gq[(size_t)r * 512 + cc] = f2bf(v * sc); else gk[(size_t)r * 512 + cc - 512] = f2bf(v); }
        else if (seg == 5) gv[(size_t)r * 1024 + cc] = f2bf(v);
        else gg[(size_t)r * 1024 + cc] = f2bf(siluf_(v));
    } };
struct EpiResid { const float* res; float* out;
    DI void operator()(int r, int c, float v) const { out[(size_t)r * D + c] = res[(size_t)r * D + c] + v; } };
struct EpiQKV { bf16_t* q; bf16_t* k; bf16_t* v_;
    DI void operator()(int r, int c, float v) const { const int s = c >> 11, cc = c & 2047; bf16_t* o = s == 0 ? q : s == 1 ? k : v_; o[(size_t)r * D + cc] = f2bf(v); } };
struct EpiBf { bf16_t* o; int ld; int pad;
    DI void operator()(int r, int c, float v) const { o[(size_t)r * ld + c] = f2bf(v); } };
struct EpiSwiglu { bf16_t* o;
    DI void operator()(int r, int j, float a, float b) const { o[(size_t)r * DEXP + j] = f2bf(siluf_(a) * b); } };

template <class Epi, bool DUAL>
__global__ void k_gemm_naive(const bf16_t* __restrict__ A, const int* __restrict__ rowidx, const bf16_t* __restrict__ Bt, int K, int lda,
                             const int* __restrict__ tile_e, size_t b_estride, Epi epi) {
    __shared__ float As[32][65], Bs[32][65], Bs2[DUAL ? 32 : 1][65];
    const int m0 = blockIdx.y * 64, n0 = blockIdx.x * 64, tid = threadIdx.x, tx = tid & 15, ty = tid >> 4;
    if (tile_e) { const int e = tile_e[m0 / MOE_TILE]; if (e < 0) return; Bt += (size_t)e * b_estride; }
    float acc[4][4], acc2[4][4];
#pragma unroll
    for (int i = 0; i < 4; ++i)
#pragma unroll
        for (int j = 0; j < 4; ++j) { acc[i][j] = 0.f; acc2[i][j] = 0.f; }
    const int lr = tid >> 2, lk = (tid & 3) * 8;
    const int arow = rowidx ? rowidx[m0 + lr] : (m0 + lr);
    const bf16_t* ap = A + (size_t)arow * lda + lk;
    const int nl = n0 + lr; const int brow = DUAL ? (nl / 128) * 256 + (nl % 128) : nl;
    const bf16_t* bp = Bt + (size_t)brow * K + lk; const bf16_t* bp2 = bp + (size_t)128 * K;
    for (int k0 = 0; k0 < K; k0 += 32) {
        { const uint4 a = *(const uint4*)(ap + k0); const unsigned w[4] = {a.x, a.y, a.z, a.w};
#pragma unroll
          for (int i = 0; i < 4; ++i) { As[lk + 2 * i][lr] = __uint_as_float(w[i] << 16); As[lk + 2 * i + 1][lr] = __uint_as_float(w[i] & 0xFFFF0000u); } }
        { const uint4 a = *(const uint4*)(bp + k0); const unsigned w[4] = {a.x, a.y, a.z, a.w};
#pragma unroll
          for (int i = 0; i < 4; ++i) { Bs[lk + 2 * i][lr] = __uint_as_float(w[i] << 16); Bs[lk + 2 * i + 1][lr] = __uint_as_float(w[i] & 0xFFFF0000u); } }
        if (DUAL) { const uint4 a = *(const uint4*)(bp2 + k0); const unsigned w[4] = {a.x, a.y, a.z, a.w};
#pragma unroll
          for (int i = 0; i < 4; ++i) { Bs2[lk + 2 * i][lr] = __uint_as_float(w[i] << 16); Bs2[lk + 2 * i + 1][lr] = __uint_as_float(w[i] & 0xFFFF0000u); } }
        __syncthreads();
#pragma unroll 8
        for (int k = 0; k < 32; ++k) {
            float a[4], b[4], b2[4];
#pragma unroll
            for (int i = 0; i < 4; ++i) { a[i] = As[k][ty * 4 + i]; b[i] = Bs[k][tx * 4 + i]; if (DUAL) b2[i] = Bs2[k][tx * 4 + i]; }
#pragma unroll
            for (int i = 0; i < 4; ++i)
#pragma unroll
                for (int j = 0; j < 4; ++j) { acc[i][j] += a[i] * b[j]; if (DUAL) acc2[i][j] += a[i] * b2[j]; }
        }
        __syncthreads();
    }
#pragma unroll
    for (int i = 0; i < 4; ++i)
#pragma unroll
        for (int j = 0; j < 4; ++j) { const int r = m0 + ty * 4 + i, c = n0 + tx * 4 + j;
            if constexpr (DUAL) epi(r, c, acc[i][j], acc2[i][j]); else epi(r, c, acc[i][j]); }
}

template <int DV, bool IS_GLA>
__global__ void __launch_bounds__(DV) k_scan_naive(const bf16_t* __restrict__ Q, const float* __restrict__ LF, const bf16_t* __restrict__ Kx, const bf16_t* __restrict__ V,
                             const float* __restrict__ glow, const float* __restrict__ gk2, const float* __restrict__ gkb, float* __restrict__ oraw, int nheads, int ocol0) {
    constexpr int T = 16;
    __shared__ float sq[T][128], sk[T][128], sa[T][128];
    const int b = blockIdx.x / nheads, hh = blockIdx.x % nheads, v = threadIdx.x;
    const int qld = nheads * 128, vld = nheads * DV;
    float S[128];
#pragma unroll
    for (int d = 0; d < 128; ++d) S[d] = 0.f;
    for (int t0 = 0; t0 < SEQ; t0 += T) {
        __syncthreads();
        for (int i = threadIdx.x; i < T * 128; i += DV) { const int tt = i >> 7, d = i & 127; const size_t tok = (size_t)b * SEQ + t0 + tt;
            sq[tt][d] = bf2f(Q[tok * qld + hh * 128 + d]);
            if (IS_GLA) { float z = gkb[hh * 128 + d];
#pragma unroll
                for (int r = 0; r < GL_RANK; ++r) z += glow[tok * 16 + r] * gk2[r * GL_QK + hh * 128 + d];
                const float ls = fminf(z, 0.f) - log1pf(__expf(-fabsf(z)));
                sa[tt][d] = __expf(ls * (1.0f / 16.0f)); sk[tt][d] = bf2f(Kx[tok * qld + hh * 128 + d]); }
            else { const float a = __expf(LF[tok * qld + hh * 128 + d]); sa[tt][d] = a; sk[tt][d] = 1.0f - a; } }
        __syncthreads();
        for (int tt = 0; tt < T; ++tt) { const size_t tok = (size_t)b * SEQ + t0 + tt;
            const float vv = bf2f(V[tok * vld + hh * DV + v]); float o = 0.f;
#pragma unroll
            for (int d = 0; d < 128; ++d) { S[d] = sa[tt][d] * S[d] + sk[tt][d] * vv; o += sq[tt][d] * S[d]; }
            oraw[tok * D + ocol0 + hh * DV + v] = o; }
    }
}
__global__ void k_norm_gate(const float* __restrict__ oraw, const float* __restrict__ hg_norm, const float* __restrict__ gla_norm,
                            const bf16_t* __restrict__ hgg, const bf16_t* __restrict__ gg, bf16_t* __restrict__ mix) {
    const int w = blockIdx.x * 4 + (threadIdx.x >> 6), lane = threadIdx.x & 63; const int tok = w / 12, s = w % 12;
    const bool gla = s >= 8; const int dv = gla ? 256 : 128, col0 = gla ? 1024 + (s - 8) * 256 : s * 128;
    const float* o = oraw + (size_t)tok * D + col0; float x[4]; float ss = 0.f; const int n = dv / 64;
#pragma unroll
    for (int i = 0; i < 4; ++i) { x[i] = i < n ? o[lane + 64 * i] : 0.f; ss += x[i] * x[i]; }
    ss = wave_sum(ss); const float rstd = rsqrtf(ss / dv + EPS);
#pragma unroll
    for (int i = 0; i < 4; ++i) if (i < n) { const int c = lane + 64 * i; const float gain = gla ? gla_norm[c] : hg_norm[c];
        const float gate = gla ? bf2f(gg[(size_t)tok * 1024 + (s - 8) * 256 + c]) : bf2f(hgg[(size_t)tok * 1024 + s * 128 + c]);
        mix[(size_t)tok * D + col0 + c] = f2bf(x[i] * rstd * gain * gate); }
}

__global__ void k_kmean(const bf16_t* __restrict__ Kb, float* __restrict__ kmean) {
    const int n = blockIdx.x % MB_NBLK, hh = (blockIdx.x / MB_NBLK) % MB_H, b = blockIdx.x / (MB_NBLK * MB_H), d = threadIdx.x;
    float s = 0.f; const bf16_t* p = Kb + ((size_t)b * SEQ + n * MB_BLK) * D + hh * MB_DH + d;
    for (int j = 0; j < MB_BLK; ++j) s += bf2f(p[(size_t)j * D]);
    kmean[(size_t)blockIdx.x * MB_DH + d] = s * (1.0f / MB_BLK);
}
__global__ void k_moba_naive(const bf16_t* __restrict__ Qb, const bf16_t* __restrict__ Kb, const bf16_t* __restrict__ Vb, const float* __restrict__ kmean, bf16_t* __restrict__ AO) {
    __shared__ float sq[4][128]; __shared__ float sp[4][1024]; __shared__ int ssel[4][4];
    const int wv = threadIdx.x >> 6, lane = threadIdx.x & 63;
    const int qi = blockIdx.x * 4 + wv; const int t = qi % SEQ, hh = (qi / SEQ) % MB_H, b = qi / (SEQ * MB_H);
    const size_t tok = (size_t)b * SEQ + t; const int qb = t / MB_BLK;
    sq[wv][lane] = bf2f(Qb[tok * D + hh * MB_DH + lane]); sq[wv][lane + 64] = bf2f(Qb[tok * D + hh * MB_DH + lane + 64]);
    __syncthreads();
    float gate = -3.0e38f;
    if (lane < qb) { const float* km = kmean + ((size_t)(b * MB_H + hh) * MB_NBLK + lane) * MB_DH; float s = 0.f; for (int d = 0; d < 128; ++d) s += sq[wv][d] * km[d]; gate = s; }
    int nsel = qb < 3 ? qb : 3;
    for (int s = 0; s < 3; ++s) { float best = gate; int bi = lane;
        for (int o = 32; o > 0; o >>= 1) { const float ob = __shfl_xor(best, o); const int oi = __shfl_xor(bi, o); if (ob > best || (ob == best && oi < bi)) { best = ob; bi = oi; } }
        if (lane == 0) ssel[wv][s] = bi; if (lane == bi) gate = -3.4e38f; }
    __syncthreads();
    const float scale = 0.08838834764831845f;
    float mx = -3.0e38f;
    for (int sgi = 0; sgi <= nsel; ++sgi) { const int blk = sgi < nsel ? ssel[wv][sgi] : qb;
        for (int i = 0; i < 4; ++i) { const int j = lane + 64 * i, kp = blk * MB_BLK + j; float s = -__builtin_inff();
            if (sgi < nsel || kp <= t) { const bf16_t* kr = Kb + ((size_t)b * SEQ + kp) * D + hh * MB_DH; float a = 0.f;
                for (int d = 0; d < 128; d += 2) { const unsigned w = *(const unsigned*)(kr + d); a += sq[wv][d] * __uint_as_float(w << 16) + sq[wv][d + 1] * __uint_as_float(w & 0xFFFF0000u); }
                s = a * scale; }
            sp[wv][sgi * 256 + j] = s; mx = fmaxf(mx, s); } }
    for (int o = 32; o > 0; o >>= 1) mx = fmaxf(mx, __shfl_xor(mx, o));
    float den = 0.f;
    for (int sgi = 0; sgi <= nsel; ++sgi) for (int i = 0; i < 4; ++i) { const int idx = sgi * 256 + lane + 64 * i; const float p = __expf(sp[wv][idx] - mx); sp[wv][idx] = p; den += p; }
    den = wave_sum(den);
    __syncthreads();
    float o0 = 0.f, o1 = 0.f;
    for (int sgi = 0; sgi <= nsel; ++sgi) { const int blk = sgi < nsel ? ssel[wv][sgi] : qb; const int jmax = sgi < nsel ? 256 : (t - qb * MB_BLK + 1);
        for (int j = 0; j < jmax; ++j) { const float p = sp[wv][sgi * 256 + j]; const unsigned w = *(const unsigned*)(Vb + ((size_t)b * SEQ + blk * MB_BLK + j) * D + hh * MB_DH + lane * 2);
            o0 += p * __uint_as_float(w << 16); o1 += p * __uint_as_float(w & 0xFFFF0000u); } }
    const float inv = 1.0f / den;
    *(unsigned*)(AO + tok * D + hh * MB_DH + lane * 2) = (unsigned)f2bf(o0 * inv) | ((unsigned)f2bf(o1 * inv) << 16);
}

__global__ void k_moe_plan(unsigned* __restrict__ ctl, int* __restrict__ tile_e, int* __restrict__ rowtok) {
    __shared__ int base[NEXP + 1];
    if (threadIdx.x == 0) { int t = 0; for (int e = 0; e < NEXP; ++e) { base[e] = t; const int c = (int)ctl[CW_CNT + e]; const int nt = (c + MOE_TILE - 1) / MOE_TILE;
            for (int i = 0; i < nt; ++i) tile_e[t + i] = e; t += nt; ctl[CW_BASE + e] = (unsigned)(base[e] * MOE_TILE); ctl[CW_CUR + e] = 0u; }
        base[NEXP] = t; ctl[CW_NT] = (unsigned)t; for (int i = t; i < MOE_MAXT; ++i) tile_e[i] = -1; }
    __syncthreads();
    for (int i = threadIdx.x; i < MOE_ROWS; i += blockDim.x) rowtok[i] = 0;
}
__global__ void k_moe_scatter(const int* __restrict__ eid, unsigned* __restrict__ ctl, int* __restrict__ slot, int* __restrict__ rowtok) {
    const int i = blockIdx.x * blockDim.x + threadIdx.x; if (i >= NTOK * 2) return;
    const int e = eid[i]; const unsigned p = atomicAdd(&ctl[CW_CUR + e], 1u); const int s = (int)ctl[CW_BASE + e] + (int)p; slot[i] = s; rowtok[s] = i >> 1;
}
__global__ void k_moe_combine(float* __restrict__ h, const bf16_t* __restrict__ Y, const int* __restrict__ slot, const float* __restrict__ wgt) {
    const int row = blockIdx.x * 4 + (threadIdx.x >> 6), lane = threadIdx.x & 63;
    const int s0 = slot[row * 2], s1 = slot[row * 2 + 1]; const float w0 = wgt[row * 2], w1 = wgt[row * 2 + 1];
    for (int j = 0; j < 8; ++j) { const int c = j * 256 + lane * 4; float4 x = *(float4*)(h + (size_t)row * D + c);
        const ushort4 a = *(const ushort4*)(Y + (size_t)s0 * D + c), bb = *(const ushort4*)(Y + (size_t)s1 * D + c);
        x.x += w0 * bf2f(a.x) + w1 * bf2f(bb.x); x.y += w0 * bf2f(a.y) + w1 * bf2f(bb.y); x.z += w0 * bf2f(a.z) + w1 * bf2f(bb.z); x.w += w0 * bf2f(a.w) + w1 * bf2f(bb.w);
        *(float4*)(h + (size_t)row * D + c) = x; }
}


#define XB_TMO      128
#define XB_XCNT(j)  (256  + 64 * (j))
#define XB_XSUB(j)  (1280 + 64 * (j))
#define XB_XGEN(j)  (2304 + 64 * (j))
#define XB_TOP      3328
#define XB_TOPGEN   3392
#define XCD_BAR_WORDS 3456
#define XB_SPIN_CAP (1u << 18)
#define LAS __attribute__((address_space(3)))

__device__ __forceinline__ unsigned xb_ld(unsigned* p)              { return __hip_atomic_load(p, __ATOMIC_RELAXED, __HIP_MEMORY_SCOPE_AGENT); }
__device__ __forceinline__ unsigned xb_add(unsigned* p, unsigned v) { return __hip_atomic_fetch_add(p, v, __ATOMIC_RELAXED, __HIP_MEMORY_SCOPE_AGENT); }
__device__ __forceinline__ unsigned xb_xcc_id() { return (unsigned)__builtin_amdgcn_s_getreg((3 << 11) | 20) & 0xFu; }
#define XB_SPIN(cond, bar) do { unsigned _sp = 0; while (cond) { __builtin_amdgcn_s_sleep(1); \
    if ((++_sp & 255u) == 0u) { if (xb_ld(&(bar)[XB_TMO])) break; if (_sp > XB_SPIN_CAP) { atomicAdd(&(bar)[XB_TMO], 1u); break; } } } } while (0)

struct XcdBarrier {
    unsigned* bar; unsigned x;
    volatile LAS unsigned* st;
};

__device__ __forceinline__ XcdBarrier xcd_barrier_post(unsigned* bar, volatile LAS unsigned* st) {
    XcdBarrier b; b.bar = bar; b.x = xb_xcc_id(); b.st = st;
    if (threadIdx.x == 0) (void)xb_add(&bar[XB_XCNT(b.x)], 1u);
    return b;
}
__device__ __forceinline__ void xcd_barrier_complete(unsigned* bar, unsigned x, unsigned& nloc, unsigned& nx) {
    const unsigned G = gridDim.x * gridDim.y * gridDim.z;
    unsigned sum, cnt, mine, sp = 0u;
    for (;;) {
        sum = 0u; cnt = 0u; mine = 0u;
#pragma unroll
        for (unsigned j = 0; j < 16; ++j) { const unsigned c = xb_ld(&bar[XB_XCNT(j)]); sum += c; cnt += (c > 0u) ? 1u : 0u; mine = (j == x) ? c : mine; }
        if (sum == G) break;
        __builtin_amdgcn_s_sleep(1);
        if ((++sp & 255u) == 0u) { if (xb_ld(&bar[XB_TMO])) break; if (sp > XB_SPIN_CAP) { atomicAdd(&bar[XB_TMO], 1u); break; } }
    }
    nloc = mine > 0u ? mine : 1u; nx = cnt > 0u ? cnt : 1u;
}

__device__ __forceinline__ void xcd_barrier(const XcdBarrier& b) {
    asm volatile("s_waitcnt vmcnt(0)" ::: "memory");
    __syncthreads();
    if (threadIdx.x == 0) {
        unsigned* bar = b.bar;
        __builtin_amdgcn_s_waitcnt(0);
        unsigned nloc = b.st[0], nx = b.st[1];
        if (nloc == 0u) { xcd_barrier_complete(bar, b.x, nloc, nx); b.st[0] = nloc; b.st[1] = nx; }
        const unsigned old = xb_add(&bar[XB_XSUB(b.x)], 1u);
        const unsigned gen = old / nloc;
        if (old + 1u == (gen + 1u) * nloc) {
            __builtin_amdgcn_fence(__ATOMIC_RELEASE, "agent");
            asm volatile("s_waitcnt vmcnt(0)" ::: "memory");
            const unsigned og = xb_add(&bar[XB_TOP], 1u);
            const unsigned tg = og / nx;
            if (og + 1u == (tg + 1u) * nx) xb_add(&bar[XB_TOPGEN], 1u);
            else XB_SPIN(xb_ld(&bar[XB_TOPGEN]) == tg, bar);
            __builtin_amdgcn_fence(__ATOMIC_ACQUIRE, "agent");
            xb_add(&bar[XB_XGEN(b.x)], 1u);
            asm volatile("s_waitcnt vmcnt(0)" ::: "memory");
        } else {
            XB_SPIN(xb_ld(&bar[XB_XGEN(b.x)]) == gen, bar);
            __builtin_amdgcn_fence(__ATOMIC_ACQUIRE, "agent");
            asm volatile("s_waitcnt vmcnt(0)" ::: "memory");
        }
    }
    __syncthreads();
}


namespace pg8 {
#define PG8_LAS __attribute__((address_space(3)))
typedef unsigned short bf16_t;
typedef short bf16x8 __attribute__((ext_vector_type(8)));
typedef float f32x4 __attribute__((ext_vector_type(4)));
typedef unsigned u32x4 __attribute__((ext_vector_type(4)));
constexpr int BM = 256, BK = 64, HALF = 128, HTB = HALF * BK * 2  , STAGE_BYTES = 8 * HTB, NXCD = 8, WGM = 8;

__host__ __device__ __forceinline__ int lds_byte(int r, int c) { const int st = (r >> 4) * 2 + (c >> 5), rr = r & 15, cc = c & 31, ob = rr * 64 + cc * 2; return st * 1024 + (ob ^ (((ob >> 9) & 1) << 5)); }
__host__ __device__ __forceinline__ void stage_rc(int b, int& R, int& C) { const int st = b / 1024, sb = b % 1024, swz = sb ^ (((sb >> 9) & 1) << 5); R = (st >> 1) * 16 + swz / 64; C = (st & 1) * 32 + (swz % 64) / 2; }
__host__ __device__ __forceinline__ int perm32(int rho) { const int n = rho >> 4, i = rho & 15; return 8 * (i >> 2) + 4 * n + (i & 3); }

struct Unit { int pm, pn; };
struct Gemm { const bf16_t* A; const bf16_t* Bt; int M, N, K; };

struct StaticOrder {
    int nM, nN, nwg, G, c;
    __host__ __device__ void init(int M, int N, int G_, int c_) { nM = M / BM; nN = N / BM; nwg = nM * nN; G = G_; c = c_; }
    __host__ __device__ bool next(int i, Unit& u) const {
        const long L = (long)i * G + c; if (L >= nwg) return false;
        int wgid = (int)L; { const int q = nwg / NXCD, r = nwg % NXCD, xcd = wgid % NXCD, off = wgid / NXCD; wgid = (xcd < r ? xcd * (q + 1) : r * (q + 1) + (xcd - r) * q) + off; }
        const int nig = WGM * nN, gid = wgid / nig, fm = gid * WGM, gsz = (nM - fm) < WGM ? (nM - fm) : WGM;
        u.pm = fm + ((wgid % nig) % gsz); u.pn = (wgid % nig) / gsz; return true;
    }
    __device__ __forceinline__ void a_ready(const Unit&) const {}
    __device__ __forceinline__ void done(const Unit&) const {}
};

__device__ __forceinline__ unsigned cvt_pk_bf16(float lo, float hi) { unsigned r; asm volatile("v_cvt_pk_bf16_f32 %0, %1, %2" : "=v"(r) : "v"(lo), "v"(hi)); return r; }
template <class Epi, class Sched, bool ALIGN_EPI = false, bool SP2 = false>
__device__ __forceinline__ void gemm_phase(PG8_LAS unsigned char* lds, const Gemm g, const Sched& S, const Epi& E) {
    const int tid = threadIdx.x, wid = __builtin_amdgcn_readfirstlane(tid >> 6), lane = tid & 63, wr = wid >> 2, wc = wid & 3, fr = lane & 15, fq = lane >> 4;
    const int K = g.K, nt = K / BK;
    unsigned voffA[2], voffB[2];
#pragma unroll
    for (int i = 0; i < 2; ++i) { int R, C; stage_rc(tid * 16 + i * 8192, R, C); const int Rb = Epi::PERM ? ((R & ~31) + perm32(R & 31)) : R;
        voffA[i] = (unsigned)(R * K + C) * 2u; voffB[i] = (unsigned)(Rb * K + C) * 2u; }
    const size_t kstep = (size_t)(BK * 2);
    const size_t hstep = (size_t)HALF * K * 2;
    const size_t tstep = 2 * hstep;
    const unsigned ldsw = (unsigned)wid * 1024u;
    const int aoff = lds_byte(wr * 64 + fr, fq * 8), boff = lds_byte(wc * 32 + fr, fq * 8);
#define PG8_SA(b, h) (((b) * 2 + (h)) * HTB)
#define PG8_SB(b, h) ((4 + (b) * 2 + (h)) * HTB)
#define PG8_STAGE(bufoff, gbase, voff) do { _Pragma("unroll") for (int _i = 0; _i < 2; ++_i) \
        __builtin_amdgcn_global_load_lds((const unsigned*)((const char*)(gbase) + (voff)[_i]), (PG8_LAS unsigned*)(lds + (bufoff) + ldsw + _i * 8192), 16, 0, 0); } while (0)
#define PG8_LDA(dst, b, h) do { _Pragma("unroll") for (int m = 0; m < 4; ++m) _Pragma("unroll") for (int k = 0; k < 2; ++k) dst[m][k] = *(const PG8_LAS bf16x8*)(lds + PG8_SA(b, h) + aoff + m * 2048 + k * 1024); } while (0)
#define PG8_LDB(dst, b, h) do { _Pragma("unroll") for (int n = 0; n < 2; ++n) _Pragma("unroll") for (int k = 0; k < 2; ++k) dst[n][k] = *(const PG8_LAS bf16x8*)(lds + PG8_SB(b, h) + boff + n * 2048 + k * 1024); } while (0)
#define PG8_MMA(ai, bj, At, Bt) do { __builtin_amdgcn_s_setprio(1); _Pragma("unroll") for (int m = 0; m < 4; ++m) _Pragma("unroll") for (int n = 0; n < 2; ++n) _Pragma("unroll") for (int k = 0; k < 2; ++k) \
        acc[ai][bj][m][n] = __builtin_amdgcn_mfma_f32_16x16x32_bf16(Bt[n][k], At[m][k], acc[ai][bj][m][n], 0, 0, 0); __builtin_amdgcn_s_setprio(0); } while (0)
#define PG8_WAIT_V(n) asm volatile("s_waitcnt vmcnt(" #n ")" ::: "memory")
#define PG8_WAIT_L(n) asm volatile("s_waitcnt lgkmcnt(" #n ")" ::: "memory")
#define PG8_BAR __builtin_amdgcn_s_barrier()
#define PG8_SCHED __builtin_amdgcn_sched_barrier(0)
    Unit cur, nxt; int ui = 0;
    if (!S.next(0, cur)) return;
    f32x4 acc[2][2][4][2];
#pragma unroll
    for (int a = 0; a < 2; ++a)
#pragma unroll
        for (int b = 0; b < 2; ++b)
#pragma unroll
            for (int m = 0; m < 4; ++m)
#pragma unroll
                for (int n = 0; n < 2; ++n) acc[a][b][m][n] = (f32x4){0.f, 0.f, 0.f, 0.f};
    bf16x8 At[4][2], B0[2][2], B1[2][2];
    const char* cA = (const char*)g.A + (size_t)cur.pm * tstep; const char* cB = (const char*)g.Bt + (size_t)cur.pn * tstep;
    S.a_ready(cur);
    if constexpr (SP2) {
        PG8_STAGE(PG8_SB(0, 0), cB, voffB); PG8_STAGE(PG8_SB(0, 1), cB + hstep, voffB); PG8_STAGE(PG8_SA(0, 0), cA, voffA); PG8_STAGE(PG8_SA(0, 1), cA + hstep, voffA);
        if (wr == 1) PG8_BAR;
        PG8_WAIT_V(2); PG8_BAR;
        PG8_STAGE(PG8_SB(1, 0), cB + kstep, voffB); PG8_STAGE(PG8_SA(1, 0), cA + kstep, voffA); PG8_STAGE(PG8_SB(1, 1), cB + hstep + kstep, voffB);
        PG8_WAIT_V(6); PG8_BAR;
    } else {
        PG8_STAGE(PG8_SB(0, 0), cB, voffB); PG8_STAGE(PG8_SA(0, 0), cA, voffA); PG8_STAGE(PG8_SB(0, 1), cB + hstep, voffB); PG8_STAGE(PG8_SA(0, 1), cA + hstep, voffA);
        if (wr == 1) PG8_BAR;
        PG8_WAIT_V(4); PG8_BAR;
        PG8_STAGE(PG8_SB(1, 0), cB + kstep, voffB); PG8_STAGE(PG8_SA(1, 0), cA + kstep, voffA); PG8_STAGE(PG8_SB(1, 1), cB + hstep + kstep, voffB);
        PG8_WAIT_V(6); PG8_BAR;
    }
    for (;;) {
        const bool has_next = S.next(ui + 1, nxt);
        const char* nA = has_next ? (const char*)g.A + (size_t)nxt.pm * tstep : cA; const char* nB = has_next ? (const char*)g.Bt + (size_t)nxt.pn * tstep : cB;
        for (int t = 0; t < nt; t += 2) {
            const bool last = (t == nt - 2);
            const char* a1 = cA + (size_t)(t + 1) * kstep;
            const char* a2 = last ? nA : cA + (size_t)(t + 2) * kstep; const char* b2 = last ? nB : cB + (size_t)(t + 2) * kstep;
            const char* a3 = a2 + kstep; const char* b3 = b2 + kstep;
            if (last && has_next) S.a_ready(nxt);
            if constexpr (SP2) {
            PG8_LDB(B0, 0, 0); PG8_LDB(B1, 0, 1); PG8_SCHED; PG8_LDA(At, 0, 0); PG8_STAGE(PG8_SA(1, 1), a1 + hstep, voffA);
            PG8_WAIT_V(8); PG8_WAIT_L(0); PG8_BAR; PG8_MMA(0, 0, At, B0); PG8_MMA(0, 1, At, B1); PG8_BAR; PG8_SCHED;
            PG8_LDA(At, 0, 1); PG8_STAGE(PG8_SB(0, 0), b2, voffB); PG8_STAGE(PG8_SB(0, 1), b2 + hstep, voffB); PG8_STAGE(PG8_SA(0, 0), a2, voffA);
            PG8_WAIT_V(8); PG8_WAIT_L(0); PG8_BAR; PG8_MMA(1, 0, At, B0); PG8_MMA(1, 1, At, B1); PG8_BAR; PG8_SCHED;
            PG8_LDB(B0, 1, 0); PG8_LDB(B1, 1, 1); PG8_SCHED; PG8_LDA(At, 1, 0); PG8_STAGE(PG8_SA(0, 1), a2 + hstep, voffA);
            PG8_WAIT_V(8); PG8_WAIT_L(0); PG8_BAR; PG8_MMA(0, 0, At, B0); PG8_MMA(0, 1, At, B1); PG8_BAR; PG8_SCHED;
            PG8_LDA(At, 1, 1); PG8_STAGE(PG8_SB(1, 0), b3, voffB); PG8_STAGE(PG8_SB(1, 1), b3 + hstep, voffB); PG8_STAGE(PG8_SA(1, 0), a3, voffA);
            PG8_WAIT_V(8); PG8_WAIT_L(0); PG8_BAR; PG8_MMA(1, 0, At, B0); PG8_MMA(1, 1, At, B1); PG8_BAR; PG8_SCHED;
            } else {
            PG8_LDB(B0, 0, 0); PG8_SCHED; PG8_LDA(At, 0, 0); PG8_STAGE(PG8_SA(1, 1), a1 + hstep, voffA);
            PG8_WAIT_L(8); PG8_BAR; PG8_WAIT_L(0); PG8_MMA(0, 0, At, B0); PG8_BAR; PG8_SCHED;
            PG8_LDB(B1, 0, 1); PG8_STAGE(PG8_SB(0, 0), b2, voffB);
            PG8_BAR; PG8_WAIT_L(0); PG8_MMA(0, 1, At, B1); PG8_BAR;
            PG8_LDA(At, 0, 1); PG8_STAGE(PG8_SA(0, 0), a2, voffA);
            PG8_BAR; PG8_WAIT_L(0); PG8_MMA(1, 0, At, B0); PG8_BAR; PG8_SCHED;
            PG8_STAGE(PG8_SB(0, 1), b2 + hstep, voffB);
            PG8_WAIT_V(6); PG8_BAR; PG8_MMA(1, 1, At, B1); PG8_BAR;
            PG8_LDB(B0, 1, 0); PG8_SCHED; PG8_LDA(At, 1, 0); PG8_STAGE(PG8_SA(0, 1), a2 + hstep, voffA);
            PG8_WAIT_L(8); PG8_BAR; PG8_WAIT_L(0); PG8_MMA(0, 0, At, B0); PG8_BAR; PG8_SCHED;
            PG8_LDB(B1, 1, 1); PG8_STAGE(PG8_SB(1, 0), b3, voffB);
            PG8_BAR; PG8_WAIT_L(0); PG8_MMA(0, 1, At, B1); PG8_BAR;
            PG8_LDA(At, 1, 1); PG8_STAGE(PG8_SA(1, 0), a3, voffA);
            PG8_BAR; PG8_WAIT_L(0); PG8_MMA(1, 0, At, B0); PG8_BAR; PG8_SCHED;
            PG8_STAGE(PG8_SB(1, 1), b3 + hstep, voffB);
            PG8_WAIT_V(6); PG8_BAR; PG8_MMA(1, 1, At, B1); PG8_BAR;
            }
        }
        if constexpr (ALIGN_EPI) { if (wr == 0) PG8_BAR; }
        if constexpr (!Epi::AFTER_DRAIN) { E(acc, cur, wr, wc, fr, fq); S.done(cur); }
        if (!has_next) break;
#pragma unroll
        for (int a = 0; a < 2; ++a)
#pragma unroll
            for (int b = 0; b < 2; ++b)
#pragma unroll
                for (int m = 0; m < 4; ++m)
#pragma unroll
                    for (int n = 0; n < 2; ++n) acc[a][b][m][n] = (f32x4){0.f, 0.f, 0.f, 0.f};
        cur = nxt; cA = nA; cB = nB; ++ui;
        if constexpr (ALIGN_EPI) { if (wr == 1) PG8_BAR; }
    }
    PG8_WAIT_V(0);
    if constexpr (!ALIGN_EPI) { if (wr == 0) PG8_BAR; }
    PG8_BAR;
    if constexpr (Epi::AFTER_DRAIN) { E.fused(acc, cur, wr, wc, fr, fq, lds, wid, lane); S.done(cur); }
#undef PG8_SA
#undef PG8_SB
#undef PG8_STAGE
#undef PG8_LDA
#undef PG8_LDB
#undef PG8_MMA
#undef PG8_WAIT_V
#undef PG8_WAIT_L
#undef PG8_BAR
#undef PG8_SCHED
}
}

namespace moba {
constexpr int D = 128, LD = 2048;
constexpr bool WSKIP = false;
constexpr float THR = 8.f;
constexpr float SCALE = 0.08838834764831845f;
constexpr int NW = 8, QBLK = 32, KVBLK = 64, QB = NW * QBLK;
constexpr int SHM_V = KVBLK * D * 2, SHM_K = KVBLK * D * 2;
constexpr int ATT_LDS_BYTES = 2 * SHM_V + 2 * SHM_K + NW * 64 * 4;

using bf16 = unsigned short;
typedef short bf16x8 __attribute__((ext_vector_type(8)));
typedef short s16x4 __attribute__((ext_vector_type(4)));
typedef float f32x16 __attribute__((ext_vector_type(16)));
typedef float f32x4 __attribute__((ext_vector_type(4)));
typedef unsigned u32x4 __attribute__((ext_vector_type(4)));
template <class A, class Bt> struct same_t { static constexpr bool v = false; };
template <class A> struct same_t<A, A> { static constexpr bool v = true; };

#define KSWZ(row, colB) ((row) * 256 + ((colB) ^ (((row) & 7) << 4)))
#define SBAR() __builtin_amdgcn_sched_barrier(0)
__device__ __forceinline__ int v_st(int k, int c) { const int kk = (k & ~0xC) | ((k & 4) << 1) | ((k & 8) >> 1); return ((kk >> 3) * 4 + (c >> 5)) * 512 + ((kk & 7) * 32 + (c & 31)) * 2; }
__device__ __forceinline__ int v_rd_base(int lane) { return ((lane & 3) << 3) | (((lane >> 2) & 3) << 6) | (((lane >> 4) & 1) << 5) | (((lane >> 5) & 1) << 8); }
constexpr int v_rd_off(int d0, int ks, int half) { return d0 * 512 + ks * 4096 + half * 2048; }
__device__ __forceinline__ int crow(int r, int hi) { return (r & 3) + 8 * (r >> 2) + 4 * hi; }
__device__ __forceinline__ unsigned cvtpk(float lo, float hi) {
    unsigned r; asm volatile("v_cvt_pk_bf16_f32 %0, %1, %2" : "=v"(r) : "v"(lo), "v"(hi)); return r;
}
__device__ __forceinline__ bf16x8 pack8(f32x4 a, f32x4 b) {
    u32x4 w = {cvtpk(a[0], a[1]), cvtpk(a[2], a[3]), cvtpk(b[0], b[1]), cvtpk(b[2], b[3])};
    return *reinterpret_cast<bf16x8*>(&w);
}
template <class T> __device__ __forceinline__ bf16x8 load8(const T* p) {
    if constexpr (same_t<T, float>::v) { return pack8(*(const f32x4*)p, *(const f32x4*)(p + 4)); }
    else { return *reinterpret_cast<const bf16x8*>(p); }
}
__device__ __forceinline__ void mask_tile(f32x16& p0, f32x16& p1, int dq, unsigned W) {
    const float NEG = -__builtin_inff();
#pragma unroll
    for (int r = 0; r < 16; ++r) {
        const int c = (r & 3) + 8 * (r >> 2);
        if ((unsigned)(dq - c) >= W) p0[r] = NEG;
        if ((unsigned)(dq - c - 32) >= W) p1[r] = NEG;
    }
}
__device__ __forceinline__ void mask_block(f32x16& p0, f32x16& p1, bool keep) {
    const float NEG = -__builtin_inff();
#pragma unroll
    for (int r = 0; r < 16; ++r) { p0[r] = keep ? p0[r] : NEG; p1[r] = keep ? p1[r] : NEG; }
}
__device__ __forceinline__ void partialSM(f32x16& p0, f32x16& p1, float& m_reg, float& mn, float& alpha) {
    float pmax = p0[0]; for (int r = 1; r < 16; ++r) pmax = fmaxf(pmax, p0[r]); for (int r = 0; r < 16; ++r) pmax = fmaxf(pmax, p1[r]);
    { auto rr = __builtin_amdgcn_permlane32_swap(__float_as_uint(pmax), __float_as_uint(pmax), false, false);
      pmax = fmaxf(__uint_as_float(rr[0]), __uint_as_float(rr[1])); }
    constexpr float C2 = 1.4426950408889634f * SCALE;
    if (__builtin_expect(__all((pmax - m_reg) * SCALE <= THR), 1)) { mn = m_reg; alpha = 1.f; }
    else { mn = fmaxf(m_reg, pmax); alpha = __builtin_amdgcn_exp2f((m_reg - mn) * C2); m_reg = mn; }
    const float mnL = -mn * C2;
    for (int r = 0; r < 16; ++r) p0[r] = fmaf(p0[r], C2, mnL); for (int r = 0; r < 16; ++r) p1[r] = fmaf(p1[r], C2, mnL);
    for (int r = 0; r < 16; ++r) p0[r] = __builtin_amdgcn_exp2f(p0[r]);
}
__device__ __forceinline__ void finishSM(f32x16& p0, f32x16& p1, float alpha, float& l_reg, bf16x8& pa0, bf16x8& pa1, bf16x8& pa2, bf16x8& pa3) {
    for (int r = 0; r < 16; ++r) p1[r] = __builtin_amdgcn_exp2f(p1[r]);
    float ps = 0; for (int r = 0; r < 16; ++r) ps += p0[r]; for (int r = 0; r < 16; ++r) ps += p1[r];
    { auto rr = __builtin_amdgcn_permlane32_swap(__float_as_uint(ps), __float_as_uint(ps), false, false);
      ps = __uint_as_float(rr[0]) + __uint_as_float(rr[1]); }
    l_reg = l_reg * alpha + ps;
#define PK4(P, B_, OUT) do { unsigned a0 = cvtpk(P[B_+0], P[B_+1]), a1 = cvtpk(P[B_+2], P[B_+3]);                          \
        unsigned b0 = cvtpk(P[B_+4], P[B_+5]), b1 = cvtpk(P[B_+6], P[B_+7]);                                             \
        auto r0 = __builtin_amdgcn_permlane32_swap(a0, b0, false, false); auto r1 = __builtin_amdgcn_permlane32_swap(a1, b1, false, false); \
        u32x4 w = {r0[0], r1[0], r0[1], r1[1]}; OUT = *reinterpret_cast<bf16x8*>(&w); } while (0)
    PK4(p0, 0, pa0); PK4(p0, 8, pa1); PK4(p1, 0, pa2); PK4(p1, 8, pa3);
#undef PK4
}
template <int KB, bool SK>
__device__ __forceinline__ void qkt(f32x16& p0, f32x16& p1, const char* K_lds, int r32, int hi, const bf16x8* qr, bool act) {
    if (SK && !act) { const float NEG = -__builtin_inff();
#pragma unroll
        for (int r = 0; r < 16; ++r) { p0[r] = NEG; p1[r] = NEG; } return; }
    p0 = f32x16{}; p1 = f32x16{};
    const char* kb[4];
#pragma unroll
    for (int dd = 0; dd < 4; ++dd) kb[dd] = K_lds + KB * SHM_K + KSWZ(r32, (dd * 16 + hi * 8) * 2);
#pragma unroll
    for (int d0 = 0; d0 < 8; ++d0) { const char* a = kb[d0 & 3] + (d0 >> 2) * 128;
        bf16x8 b0 = *reinterpret_cast<const bf16x8*>(a);
        bf16x8 b1 = *reinterpret_cast<const bf16x8*>(a + 32 * 256);
        p0 = __builtin_amdgcn_mfma_f32_32x32x16_bf16(b0, qr[d0], p0, 0, 0, 0);
        p1 = __builtin_amdgcn_mfma_f32_32x32x16_bf16(b1, qr[d0], p1, 0, 0, 0); }
}
template <int VB, bool SK>
__device__ __forceinline__ void pv_tile(f32x16* o, int vb0, bf16x8 pa0, bf16x8 pa1, bf16x8 pa2, bf16x8 pa3, bool act) {
    if (SK && !act) return;
#define TRRD(dst, off) asm volatile("ds_read_b64_tr_b16 %0, %1 offset:%2" : "=&v"(dst) : "v"(vb0), "i"(off) : "memory")
#define PV_D0(d0) do { s16x4 l0, l1, l2, l3, h0, h1, h2, h3; constexpr int b_ = VB * SHM_V + v_rd_off(d0, 0, 0);     \
        TRRD(l0, b_); TRRD(h0, b_ + 2048); TRRD(l1, b_ + 4096); TRRD(h1, b_ + 6144); TRRD(l2, b_ + 8192); TRRD(h2, b_ + 10240); TRRD(l3, b_ + 12288); TRRD(h3, b_ + 14336); \
        asm volatile("s_waitcnt lgkmcnt(0)" ::: "memory"); SBAR();                 \
        o[d0] = __builtin_amdgcn_mfma_f32_32x32x16_bf16(pa0, (bf16x8){l0[0], l0[1], l0[2], l0[3], h0[0], h0[1], h0[2], h0[3]}, o[d0], 0, 0, 0);   \
        o[d0] = __builtin_amdgcn_mfma_f32_32x32x16_bf16(pa1, (bf16x8){l1[0], l1[1], l1[2], l1[3], h1[0], h1[1], h1[2], h1[3]}, o[d0], 0, 0, 0);   \
        o[d0] = __builtin_amdgcn_mfma_f32_32x32x16_bf16(pa2, (bf16x8){l2[0], l2[1], l2[2], l2[3], h2[0], h2[1], h2[2], h2[3]}, o[d0], 0, 0, 0);   \
        o[d0] = __builtin_amdgcn_mfma_f32_32x32x16_bf16(pa3, (bf16x8){l3[0], l3[1], l3[2], l3[3], h3[0], h3[1], h3[2], h3[3]}, o[d0], 0, 0, 0); } while (0)
    PV_D0(0); PV_D0(1); PV_D0(2); PV_D0(3);
#undef PV_D0
#undef TRRD
}

template <class TIn, class TOut> struct BlockRef { const TIn* Q; const TIn* K; const TIn* V; TOut* O; const float* KM; int P0; };
template <class TIn> struct Seam {
    bf16x8 qr[8];
    bf16x8 st_v0, st_v1, st_k0, st_k1; f32x4 sf0, sf1, sf2, sf3;
    f32x4 tq[16];
};
__device__ __forceinline__ int swa_jlo(int P0, int W) { const int lowk = P0 - W + 1; return lowk > 0 ? lowk / KVBLK : 0; }
#define ROW(p, k0, rr) ((p) + (size_t)((k0) + (rr)) * LD + sc)
#define VMW() asm volatile("s_waitcnt vmcnt(0)" ::: "memory")
#define VMWN(n) asm volatile("s_waitcnt vmcnt(%0)" :: "i"(n) : "memory")
#define SLOAD_H(Kp, Vp, k0) do { S.st_v0 = load8<TIn>(ROW(Vp, k0, sr)); S.st_v1 = load8<TIn>(ROW(Vp, k0, 32 + sr));              \
                         S.st_k0 = load8<TIn>(ROW(Kp, k0, sr)); S.st_k1 = load8<TIn>(ROW(Kp, k0, 32 + sr)); } while (0)
#define SWRITE_HK(bf) do { *(bf16x8*)(K_lds + (bf) * SHM_K + kws) = S.st_k0; *(bf16x8*)(K_lds + (bf) * SHM_K + kws + 32 * 256) = S.st_k1; } while (0)
#define SWRITE_HV(bf) do { *(bf16x8*)(V_lds + (bf) * SHM_V + vst0) = S.st_v0; *(bf16x8*)(V_lds + (bf) * SHM_V + vst1) = S.st_v1; } while (0)
#define SWRITE_H(bf) do { SWRITE_HV(bf); SWRITE_HK(bf); } while (0)
#define SLOAD_F(p, k0) do { S.sf0 = *(const f32x4*)ROW(p, k0, sr); S.sf1 = *(const f32x4*)(ROW(p, k0, sr) + 4);                \
                            S.sf2 = *(const f32x4*)ROW(p, k0, 32 + sr); S.sf3 = *(const f32x4*)(ROW(p, k0, 32 + sr) + 4); } while (0)
#define SWRITE_KF(bf) do { *(bf16x8*)(K_lds + (bf) * SHM_K + kws) = pack8(S.sf0, S.sf1); *(bf16x8*)(K_lds + (bf) * SHM_K + kws + 32 * 256) = pack8(S.sf2, S.sf3); } while (0)
#define SWRITE_VF(bf) do { *(bf16x8*)(V_lds + (bf) * SHM_V + vst0) = pack8(S.sf0, S.sf1); *(bf16x8*)(V_lds + (bf) * SHM_V + vst1) = pack8(S.sf2, S.sf3); } while (0)
template <class TIn, class TOut>
__device__ __forceinline__ void causal_swa_prime(const BlockRef<TIn, TOut>& cur, int W, char* lds, Seam<TIn>& S) {
    constexpr bool F32 = same_t<TIn, float>::v;
    const int tid = threadIdx.x, wid = __builtin_amdgcn_readfirstlane(tid >> 6), lane = tid & 63, r32 = lane & 31, hi = lane >> 5;
    const int sr = tid >> 4, sc = (tid & 15) * 8, kws = KSWZ(sr, sc * 2); char* K_lds = lds + 2 * SHM_V;
    const int kb0 = swa_jlo(cur.P0, W) * KVBLK;
    for (int d0 = 0; d0 < 8; ++d0) S.qr[d0] = load8<TIn>(cur.Q + (size_t)(wid * QBLK + r32) * LD + d0 * 16 + hi * 8);
    if constexpr (F32) { SLOAD_F((const float*)cur.K, kb0); VMW(); SWRITE_KF(0); SBAR(); SLOAD_F((const float*)cur.V, kb0); }
    else { SLOAD_H(cur.K, cur.V, kb0); VMW(); SWRITE_HK(0); }
    __syncthreads();
}
template <class TIn, class TOut>
__device__ __forceinline__ void causal_swa_block(const BlockRef<TIn, TOut>& cur, const BlockRef<TIn, TOut>& nxt, int skv, int W, char* lds, Seam<TIn>& S) {
    constexpr bool F32 = same_t<TIn, float>::v;
    const int tid = threadIdx.x, wid = __builtin_amdgcn_readfirstlane(tid >> 6), lane = tid & 63, r32 = lane & 31, hi = lane >> 5;
    const int j_lo = swa_jlo(cur.P0, W);
    int j_hi = (cur.P0 + QB - 1) / KVBLK + 1; if (j_hi > skv / KVBLK) j_hi = skv / KVBLK;
    const int NT = j_hi - j_lo;
    const int kbn = swa_jlo(nxt.P0, W) * KVBLK;
    const int qlo = cur.P0 + wid * QBLK, qm = qlo + r32 - 4 * hi;
    char* V_lds = lds; char* K_lds = lds + 2 * SHM_V;
    float* ws = (float*)(lds + 2 * SHM_V + 2 * SHM_K) + wid * 64; float* li_l = ws, * al_l = ws + 32;
    unsigned selmask;
    { const int nqb = cur.P0 >> 8;
      if (nqb <= 3) selmask = (1u << nqb) - 1u;
      else { float b0 = -__builtin_inff(), b1 = b0, b2 = b0; int i0 = 0, i1 = 0, i2 = 0;
        for (int n = 0; n < nqb; ++n) { const float* kp = cur.KM + n * 128 + hi * 8; float s = 0.f;
#pragma unroll
            for (int d0 = 0; d0 < 8; ++d0) { const f32x4 ka = *(const f32x4*)(kp + d0 * 16), kb = *(const f32x4*)(kp + d0 * 16 + 4); const u32x4 qw = __builtin_bit_cast(u32x4, S.qr[d0]);
                s += __uint_as_float(qw[0] << 16) * ka[0] + __uint_as_float(qw[0] & 0xFFFF0000u) * ka[1] + __uint_as_float(qw[1] << 16) * ka[2] + __uint_as_float(qw[1] & 0xFFFF0000u) * ka[3]
                   + __uint_as_float(qw[2] << 16) * kb[0] + __uint_as_float(qw[2] & 0xFFFF0000u) * kb[1] + __uint_as_float(qw[3] << 16) * kb[2] + __uint_as_float(qw[3] & 0xFFFF0000u) * kb[3]; }
            s += __shfl_xor(s, 32);
            if (s > b0) { b2 = b1; i2 = i1; b1 = b0; i1 = i0; b0 = s; i0 = n; } else if (s > b1) { b2 = b1; i2 = i1; b1 = s; i1 = n; } else if (s > b2) { b2 = s; i2 = n; } }
        selmask = (1u << i0) | (1u << i1) | (1u << i2); } }
    float m_reg = -1e30f, l_reg = 0; f32x16 o[4] = {};
    const int sr = tid >> 4, sc = (tid & 15) * 8, vst0 = v_st(sr, sc), vst1 = v_st(32 + sr, sc), kws = KSWZ(sr, sc * 2);
    const int vb0 = (int)(uintptr_t)V_lds + v_rd_base(lane);
    const TIn* Kh = cur.K; const TIn* Vh = cur.V;
#define RESC(a) do { if (__any((a) < 1.f)) { if (hi == 0) al_l[r32] = (a); asm volatile("s_waitcnt lgkmcnt(0)" ::: "memory");              \
                     for (int d_ = 0; d_ < 4; ++d_) for (int r = 0; r < 16; ++r) o[d_][r] *= al_l[crow(r, hi)]; } } while (0)
#define KBASE(t) ((j_lo + (t)) * KVBLK)
#define ACT(t) (KBASE(t) <= qlo + QBLK - 1 && KBASE(t) + KVBLK - 1 >= qlo - W + 1)
#define MASKT(P0_, P1_, t) do { const int kb_ = KBASE(t); if (kb_ + KVBLK - 1 > qlo) mask_tile(P0_, P1_, qm - kb_, (unsigned)W); \
        else if (kb_ < cur.P0 && cur.P0 > 3 * 256) mask_block(P0_, P1_, ((selmask >> (kb_ >> 8)) & 1u) != 0u); } while (0)
    constexpr int NQL = F32 ? 16 : 8;
    constexpr bool SK = WSKIP && !F32;
#define SEAM_K0() do { VMWN(NQL); if constexpr (F32) { SWRITE_KF(0); SBAR(); SLOAD_F((const float*)nxt.V, kbn); } else { SWRITE_HK(0); } SBAR(); } while (0)
    f32x16 pA0, pA1, pB0, pB1; float mnA, mnB, alA, alB; bf16x8 pa0, pa1, pa2, pa3;
    if constexpr (F32) { VMW(); SWRITE_VF(0); SBAR(); } else { SWRITE_HV(0); SBAR(); }
    if (NT > 1) { if constexpr (F32) SLOAD_F((const float*)Kh, KBASE(1)); else SLOAD_H(Kh, Vh, KBASE(1)); }
    SBAR(); qkt<0, SK>(pA0, pA1, K_lds, r32, hi, S.qr, ACT(0));
    if constexpr (F32) { if (NT > 1) { VMW(); SWRITE_KF(1); SBAR(); SLOAD_F((const float*)Vh, KBASE(1)); } }
    MASKT(pA0, pA1, 0); partialSM(pA0, pA1, m_reg, mnA, alA);
    if (NT > 1) { VMW(); if constexpr (F32) { SWRITE_VF(1); SBAR(); if (NT > 2) SLOAD_F((const float*)Kh, KBASE(2)); } else SWRITE_H(1); }
    __syncthreads();
#define HALF_STEP(PX0, PX1, mnX, alX, PY0, PY1, alY, t, KB, VB, SB) do {                                                      \
        SBAR(); qkt<KB, SK>(PX0, PX1, K_lds, r32, hi, S.qr, ACT(t));                                             \
        finishSM(PY0, PY1, alY, l_reg, pa0, pa1, pa2, pa3); SBAR();                                                           \
        if ((t) + 1 < NT) { if constexpr (F32) { VMW(); SWRITE_KF(SB); SBAR(); SLOAD_F((const float*)Vh, KBASE((t) + 1)); }  \
                            else { SLOAD_H(Kh, Vh, KBASE((t) + 1)); } SBAR(); }                                               \
        pv_tile<VB, SK>(o, vb0, pa0, pa1, pa2, pa3, ACT((t) - 1)); MASKT(PX0, PX1, (t)); partialSM(PX0, PX1, m_reg, mnX, alX);                                        \
        __syncthreads();                                                                                                      \
        if ((t) + 1 < NT) { VMW(); if constexpr (F32) { SWRITE_VF(SB); SBAR(); if ((t) + 2 < NT) SLOAD_F((const float*)Kh, KBASE((t) + 2)); } \
                            else { SWRITE_H(SB); } }                                                                          \
        RESC(alX); __syncthreads(); } while (0)
    for (int t = 1; t + 1 < NT; t += 2) {
        HALF_STEP(pB0, pB1, mnB, alB, pA0, pA1, alA, t, 1, 0, 0);
        HALF_STEP(pA0, pA1, mnA, alA, pB0, pB1, alB, t + 1, 0, 1, 1);
    }
    const bool even = (NT & 1) == 0;
    if (even) { SBAR(); qkt<1, SK>(pB0, pB1, K_lds, r32, hi, S.qr, ACT(NT - 1)); SBAR(); }
#define QROW(e) (nxt.Q + (size_t)(wid * QBLK + r32) * LD + ((e) >> 1) * 16 + hi * 8 + ((e) & 1) * 4)
    if constexpr (F32) { SLOAD_F((const float*)nxt.K, kbn); SBAR();
#pragma unroll
        for (int e = 0; e < 8; ++e) S.tq[e] = *(const f32x4*)QROW(e); }
    else { SLOAD_H(nxt.K, nxt.V, kbn); SBAR();
#pragma unroll
        for (int d0 = 0; d0 < 8; ++d0) S.qr[d0] = load8<TIn>(nxt.Q + (size_t)(wid * QBLK + r32) * LD + d0 * 16 + hi * 8); }
    SBAR();
    finishSM(pA0, pA1, alA, l_reg, pa0, pa1, pa2, pa3); SBAR();
    if constexpr (F32) {
#pragma unroll
        for (int e = 8; e < 16; ++e) S.tq[e] = *(const f32x4*)QROW(e); SBAR(); }
#undef QROW
    pv_tile<0, SK>(o, vb0, pa0, pa1, pa2, pa3, ACT(even ? NT - 2 : NT - 1));
    if (even) { MASKT(pB0, pB1, NT - 1); partialSM(pB0, pB1, m_reg, mnB, alB); __syncthreads(); RESC(alB);
        finishSM(pB0, pB1, alB, l_reg, pa0, pa1, pa2, pa3); SBAR(); pv_tile<1, SK>(o, vb0, pa0, pa1, pa2, pa3, ACT(NT - 1)); }
    SBAR(); SEAM_K0();
    if (hi == 0) li_l[r32] = l_reg; asm volatile("s_waitcnt lgkmcnt(0)" ::: "memory");
    float rli[16];
#pragma unroll
    for (int r = 0; r < 16; ++r) rli[r] = __builtin_amdgcn_rcpf(li_l[crow(r, hi)]);
    TOut* Ow = cur.O + (size_t)(wid * QBLK) * LD;
#pragma unroll
    for (int r = 0; r < 16; ++r) { const int orow = crow(r, hi);
#pragma unroll
        for (int d0 = 0; d0 < 4; ++d0) { const float v = o[d0][r] * rli[r];
            if constexpr (same_t<TOut, float>::v) { Ow[(size_t)orow * LD + d0 * 32 + r32] = v; }
            else { const float vn = __shfl_xor(v, 1);
                   if ((r32 & 1) == 0) *(unsigned*)(Ow + (size_t)orow * LD + d0 * 32 + r32) = cvtpk(v, vn); } } }
    if constexpr (F32) {
#pragma unroll
        for (int d0 = 0; d0 < 8; ++d0) S.qr[d0] = pack8(S.tq[2 * d0], S.tq[2 * d0 + 1]); }
    __syncthreads();
#undef RESC
#undef KBASE
#undef ACT
#undef MASKT
#undef SEAM_K0
#undef HALF_STEP
}
#undef ROW
#undef VMW
#undef VMWN
#undef SLOAD_H
#undef SWRITE_HK
#undef SWRITE_HV
#undef SWRITE_H
#undef SLOAD_F
#undef SWRITE_KF
#undef SWRITE_VF
}

#define LAS __attribute__((address_space(3)))
typedef float f32x4 __attribute__((ext_vector_type(4)));
typedef unsigned u32x4 __attribute__((ext_vector_type(4)));
typedef unsigned u32x2 __attribute__((ext_vector_type(2)));
constexpr int NTHR = 512, NWAVE = 8;
constexpr int RING_BYTES = 131072, LDS_MISC = 131072, LDS_BYTES = 147456;
constexpr int MI_BAR = 0;
constexpr int MI_NT = 16;
constexpr int MI_TILEE = 64;
constexpr int MI_EBASE = 1024;
constexpr int MI_RSTD = 2048;
constexpr int MI_LOGIT = 4096;
constexpr size_t WS_RWT = WS_TOTAL;
constexpr size_t WS_XS_UNUSED = 0;
constexpr size_t WS_TOTAL2 = WS_RWT + (size_t)2 * 2048 * 48 * 4;
constexpr size_t WS_LA = WS_TOTAL2;
constexpr size_t WS_TOTAL3 = WS_LA + (size_t)NTOK * GL_QK * 4;
constexpr int CW2_CNT0 = 1024, CW2_CUR0 = 1088, CW2_CNT1 = 1152, CW2_CUR1 = 1216;
constexpr int CW2_BAR = 2048;
constexpr int NBARREG = 4;
constexpr size_t CTL2_BYTES = (size_t)(CW2_BAR + NBARREG * XCD_BAR_WORDS) * 4;
static_assert(CTL2_BYTES <= CTL_BYTES, "ctl");
constexpr size_t U_XS = U_Y;

struct Args { const float* in[20]; float* out; unsigned char* ws; int ph_lo, ph_hi, bar_idx, pad; };

struct Frame {
    LAS unsigned char* lds; int tid, lane, wave, G, bx, vcu;
    unsigned char* ws; unsigned* ctl;
};

DI unsigned pk_bf16(float lo, float hi) { unsigned r; asm volatile("v_cvt_pk_bf16_f32 %0, %1, %2" : "=v"(r) : "v"(lo), "v"(hi)); return r; }
DI float fast_sigmoid(float x) { return __builtin_amdgcn_rcpf(1.0f + __expf(-x)); }

struct EpiProj0F { static constexpr bool PERM = true, AFTER_DRAIN = false;
    bf16_t* hq; float* hlf; bf16_t* hi; bf16_t* hgg; bf16_t* gq; bf16_t* gk; bf16_t* gv; bf16_t* gg; const float* lb;
    DI void operator()(const f32x4 (&acc)[2][2][4][2], const pg8::Unit& u, int wr, int wc, int fr, int fq) const {
        const int colt = u.pn * 256, seg = colt >> 10, row0 = u.pm * 256 + wr * 64 + fr, cl = (colt & 1023) + wc * 32 + 8 * fq;
        if (seg == 1) {
            f32x4 l0[2], l1[2];
#pragma unroll
            for (int bj = 0; bj < 2; ++bj) { l0[bj] = *(const f32x4*)(lb + cl + bj * 128); l1[bj] = *(const f32x4*)(lb + cl + bj * 128 + 4); }
#pragma unroll
            for (int ai = 0; ai < 2; ++ai)
#pragma unroll
                for (int m = 0; m < 4; ++m) { float* rowp = hlf + (size_t)(row0 + ai * 128 + m * 16) * 1024 + cl;
#pragma unroll
                    for (int bj = 0; bj < 2; ++bj) { f32x4 v0 = acc[ai][bj][m][0], v1 = acc[ai][bj][m][1];
#pragma unroll
                        for (int j = 0; j < 4; ++j) { v0[j] = __logf(l0[bj][j] + (1.0f - l0[bj][j]) * fast_sigmoid(v0[j])); v1[j] = __logf(l1[bj][j] + (1.0f - l1[bj][j]) * fast_sigmoid(v1[j])); }
                        *(f32x4*)(rowp + bj * 128) = v0; *(f32x4*)(rowp + bj * 128 + 4) = v1; } }
            return;
        }
        bf16_t* dst; int ld = 1024, co = cl; bool silu = false; float sc = 1.0f;
        if (seg == 0) { dst = hq; silu = true; sc = 0.08838834764831845f; }
        else if (seg == 2) dst = hi;
        else if (seg == 3) { dst = hgg; silu = true; }
        else if (seg == 4) { ld = 512; if ((colt & 1023) < 512) { dst = gq; sc = 0.08838834764831845f; } else { dst = gk; co = cl - 512; } }
        else if (seg == 5) dst = gv;
        else { dst = gg; silu = true; }
#pragma unroll
        for (int ai = 0; ai < 2; ++ai)
#pragma unroll
            for (int m = 0; m < 4; ++m) { bf16_t* rowp = dst + (size_t)(row0 + ai * 128 + m * 16) * ld + co;
#pragma unroll
                for (int bj = 0; bj < 2; ++bj) { f32x4 v0 = acc[ai][bj][m][0], v1 = acc[ai][bj][m][1];
                    if (silu) {
#pragma unroll
                        for (int j = 0; j < 4; ++j) { v0[j] *= fast_sigmoid(v0[j]); v1[j] *= fast_sigmoid(v1[j]); } }
                    v0 = v0 * sc; v1 = v1 * sc;
                    u32x4 w; w.x = pk_bf16(v0[0], v0[1]); w.y = pk_bf16(v0[2], v0[3]); w.z = pk_bf16(v1[0], v1[1]); w.w = pk_bf16(v1[2], v1[3]);
                    *(u32x4*)(rowp + bj * 128) = w; } }
    } };
struct EpiResidF { static constexpr bool PERM = false, AFTER_DRAIN = false;
    const float* res; float* out;
    DI void operator()(const f32x4 (&acc)[2][2][4][2], const pg8::Unit& u, int wr, int wc, int fr, int fq) const {
        const int row0 = u.pm * 256 + wr * 64 + fr, col0 = u.pn * 256 + wc * 32 + 4 * fq;
#pragma unroll
        for (int ai = 0; ai < 2; ++ai)
#pragma unroll
            for (int m = 0; m < 4; ++m) { const size_t ro = (size_t)(row0 + ai * 128 + m * 16) * D + col0;
#pragma unroll
                for (int bj = 0; bj < 2; ++bj)
#pragma unroll
                    for (int n = 0; n < 2; ++n) { const f32x4 r = *(const f32x4*)(res + ro + bj * 128 + n * 16); *(f32x4*)(out + ro + bj * 128 + n * 16) = r + acc[ai][bj][m][n]; } }
    } };
struct EpiBf16F { static constexpr bool PERM = true, AFTER_DRAIN = false;
    bf16_t* O; int ldc, nct, split_tiles; size_t split_stride;
    DI void operator()(const f32x4 (&acc)[2][2][4][2], const pg8::Unit& u, int wr, int wc, int fr, int fq) const {
        int ct = u.pn % nct; bf16_t* base = O; if (split_tiles) { const int t = ct / split_tiles; base += (size_t)t * split_stride; ct -= t * split_tiles; }
        const int row0 = u.pm * 256 + wr * 64 + fr, col0 = ct * 256 + wc * 32 + 8 * fq;
#pragma unroll
        for (int ai = 0; ai < 2; ++ai)
#pragma unroll
            for (int m = 0; m < 4; ++m) { bf16_t* rowp = base + (size_t)(row0 + ai * 128 + m * 16) * ldc + col0;
#pragma unroll
                for (int bj = 0; bj < 2; ++bj) { const f32x4 v0 = acc[ai][bj][m][0], v1 = acc[ai][bj][m][1];
                    u32x4 w; w.x = pk_bf16(v0[0], v0[1]); w.y = pk_bf16(v0[2], v0[3]); w.z = pk_bf16(v1[0], v1[1]); w.w = pk_bf16(v1[2], v1[3]);
                    *(u32x4*)(rowp + bj * 128) = w; } }
    } };
struct EpiSwigluF { static constexpr bool PERM = true, AFTER_DRAIN = false;
    bf16_t* O;
    DI void operator()(const f32x4 (&acc)[2][2][4][2], const pg8::Unit& u, int wr, int wc, int fr, int fq) const {
        const int row0 = u.pm * 256 + wr * 64 + fr, col0 = (u.pn & 3) * 128 + wc * 32 + 8 * fq;
#pragma unroll
        for (int ai = 0; ai < 2; ++ai)
#pragma unroll
            for (int m = 0; m < 4; ++m) { bf16_t* rowp = O + (size_t)(row0 + ai * 128 + m * 16) * DEXP + col0;
                f32x4 a0 = acc[ai][0][m][0], a1 = acc[ai][0][m][1]; const f32x4 b0 = acc[ai][1][m][0], b1 = acc[ai][1][m][1];
#pragma unroll
                for (int j = 0; j < 4; ++j) { a0[j] = a0[j] * fast_sigmoid(a0[j]) * b0[j]; a1[j] = a1[j] * fast_sigmoid(a1[j]) * b1[j]; }
                u32x4 w; w.x = pk_bf16(a0[0], a0[1]); w.y = pk_bf16(a0[2], a0[3]); w.z = pk_bf16(a1[0], a1[1]); w.w = pk_bf16(a1[2], a1[3]);
                *(u32x4*)rowp = w; }
    } };
struct MoeOrder {
    int nN, shift, nunits, G, c; const LAS int* tile_e;
    DI bool next(int i, pg8::Unit& u) const { const long L = (long)i * G + c; if (L >= nunits) return false; const int t = (int)L >> shift, pn = (int)L & (nN - 1);
        u.pm = t; u.pn = tile_e[t] * nN + pn; return true; }
    DI void a_ready(const pg8::Unit&) const {}
    DI void done(const pg8::Unit&) const {}
};

struct TJob { const float* src; bf16_t* dst; int ld, Kd, k0, n0, mode, half; };
DI void tjob_decode(int j, const Args& a, unsigned char* ws, TJob& t) {
    const float* w_in = a.in[4]; const float* w_out = a.in[10]; const float* w_qkv = a.in[11]; const float* w_o = a.in[12];
    const float* ew1 = a.in[17]; const float* ew3 = a.in[18]; const float* ew2 = a.in[19];
    t.mode = 0; t.half = 0;
    if (j < 896) { t.src = w_in; t.dst = (bf16_t*)(ws + WS_WIN); t.ld = EVEN_IN; t.Kd = D; t.k0 = (j / 56) * 128; t.n0 = (j % 56) * 128; return; }
    j -= 896;
    if (j < 256) { t.src = w_out; t.dst = (bf16_t*)(ws + WS_WOUT); t.ld = D; t.Kd = D; t.k0 = (j / 16) * 128; t.n0 = (j % 16) * 128; return; }
    j -= 256;
    if (j < 768) { t.src = w_qkv; t.dst = (bf16_t*)(ws + WS_WQKV); t.ld = 3 * D; t.Kd = D; t.k0 = (j / 48) * 128; t.n0 = (j % 48) * 128; return; }
    j -= 768;
    if (j < 256) { t.src = w_o; t.dst = (bf16_t*)(ws + WS_WO); t.ld = D; t.Kd = D; t.k0 = (j / 16) * 128; t.n0 = (j % 16) * 128; return; }
    j -= 256;
    const int le = j / 192, r = j % 192;
    if (r < 128) { const int hf = r / 64, q = r % 64; t.src = (hf ? ew3 : ew1) + (size_t)le * D * DEXP; t.dst = (bf16_t*)(ws + WS_WUP) + (size_t)le * 1024 * D; t.ld = DEXP; t.Kd = D;
        t.k0 = (q / 4) * 128; t.n0 = (q % 4) * 128; t.mode = 1; t.half = hf; return; }
    { const int q = r - 128; t.src = ew2 + (size_t)le * DEXP * D; t.dst = (bf16_t*)(ws + WS_WDN) + (size_t)le * D * DEXP; t.ld = D; t.Kd = DEXP; t.k0 = (q / 16) * 128; t.n0 = (q % 16) * 128; }
}
constexpr int N_TJOBS = 896 + 256 + 768 + 256 + 64 * 192;
DI void tjob_load(const TJob& t, int tid, f32x4 (&r)[8]) {
    const int c4 = (tid & 31) * 4, r0 = tid >> 5;
#pragma unroll
    for (int i = 0; i < 8; ++i) r[i] = *(const f32x4*)(t.src + (size_t)(t.k0 + r0 + 16 * i) * t.ld + t.n0 + c4);
}
DI void phase_transposes(const Frame& F, const Args& a) {
    LAS float* T = (LAS float*)F.lds;
    const int tid = F.tid; int j = F.bx; if (j >= N_TJOBS) return;
    TJob t; tjob_decode(j, a, F.ws, t); f32x4 r[8]; tjob_load(t, tid, r);
    for (;;) {
        const int c4 = (tid & 31) * 4, r0 = tid >> 5;
#pragma unroll
        for (int i = 0; i < 8; ++i) *(LAS f32x4*)(T + (r0 + 16 * i) * 132 + c4) = r[i];
        const TJob cur = t; const int jn = j + F.G; const bool more = jn < N_TJOBS;
        if (more) { tjob_decode(jn, a, F.ws, t); tjob_load(t, tid, r); }
        __syncthreads();
        { const int n = tid & 127, kg = tid >> 7; const int nn = cur.n0 + n;
          const int drow = cur.mode == 0 ? nn : (nn / 128) * 256 + cur.half * 128 + (nn % 128);
          bf16_t* dp = cur.dst + (size_t)drow * cur.Kd + cur.k0 + kg * 32;
#pragma unroll
          for (int q = 0; q < 4; ++q) { float v[8];
#pragma unroll
              for (int e = 0; e < 8; ++e) v[e] = T[(kg * 32 + q * 8 + e) * 132 + n];
              u32x4 w; w.x = pk_bf16(v[0], v[1]); w.y = pk_bf16(v[2], v[3]); w.z = pk_bf16(v[4], v[5]); w.w = pk_bf16(v[6], v[7]);
              *(u32x4*)(dp + q * 8) = w; } }
        __syncthreads();
        if (!more) break; j = jn;
    }
}
DI void phase_tables(const Frame& F, const Args& a) {
    const int gt = F.bx * NTHR + F.tid, gn = F.G * NTHR;
    float* LB = (float*)(F.ws + SM_LB); const float* lg = a.in[5];
    for (int d = gt; d < HG_QK; d += gn) { const float x = lg[d], y = lg[HG_QK + d], z = lg[2 * HG_QK + d], m = fmaxf(x, fmaxf(y, z));
        const float ex = __expf(x - m), ey = __expf(y - m), ez = __expf(z - m); LB[d] = ex / (ex + ey + ez); }
    float* RWT = (float*)(F.ws + WS_RWT);
    for (int i = gt; i < 2 * 2048 * 48; i += gn) { const int l = i / (2048 * 48), r = i % (2048 * 48); const int jj = r & 3, ln = (r >> 2) & 63, nt = (r >> 8) % 3, s = r / 768;
        const int k = 16 * s + 4 * (ln >> 4) + jj, n = 16 * nt + (ln & 15);
        float w = 0.f; if (n < 4) w = a.in[13][((size_t)l * D + k) * NGRP + n]; else if (n < 36) w = a.in[15][((size_t)l * D + k) * NEXP + (n - 4)];
        RWT[i] = w * a.in[2][l * D + k]; }
}

template <int MODE, bool COMBINE>
DI void phase_norm(const Frame& F, const float* src, float* hdst, const float* gain, bf16_t* xn, float* fout,
                   const bf16_t* Y, const int* slot, const float* wgt,
                   const float* w_in, float* glow, const float* rwt, const float* bg, const float* be, int* eid, float* wgt_out, unsigned* cnt,
                   const float* gk2 = nullptr, const float* gkb = nullptr, float* la = nullptr) {
    const int lane = F.lane, w = F.wave;
    LAS float* rs = (LAS float*)(F.lds + LDS_MISC + MI_RSTD); LAS float* lgt = (LAS float*)(F.lds + LDS_MISC + MI_LOGIT);
    LAS f32x4* part = (LAS f32x4*)F.lds;
    for (int rb = F.bx; rb < NTOK / 64; rb += F.G) {
        const int r0 = rb * 64;
#pragma unroll 1
        for (int i = 0; i < 8; ++i) { const int row = r0 + w * 8 + i; const float* hr = src + (size_t)row * D;
            f32x4 v[8];
#pragma unroll
            for (int j = 0; j < 8; ++j) v[j] = *(const f32x4*)(hr + j * 256 + lane * 4);
            if (COMBINE) { const int s0 = slot[row * 2], s1 = slot[row * 2 + 1]; const float w0 = wgt[row * 2], w1 = wgt[row * 2 + 1];
#pragma unroll
                for (int j = 0; j < 8; ++j) { const u32x2 ya = *(const u32x2*)(Y + (size_t)s0 * D + j * 256 + lane * 4), yb = *(const u32x2*)(Y + (size_t)s1 * D + j * 256 + lane * 4);
                    v[j][0] += w0 * __uint_as_float(ya[0] << 16) + w1 * __uint_as_float(yb[0] << 16); v[j][1] += w0 * __uint_as_float(ya[0] & 0xFFFF0000u) + w1 * __uint_as_float(yb[0] & 0xFFFF0000u);
                    v[j][2] += w0 * __uint_as_float(ya[1] << 16) + w1 * __uint_as_float(yb[1] << 16); v[j][3] += w0 * __uint_as_float(ya[1] & 0xFFFF0000u) + w1 * __uint_as_float(yb[1] & 0xFFFF0000u); }
                if (MODE != 3) {
#pragma unroll
                    for (int j = 0; j < 8; ++j) *(f32x4*)(hdst + (size_t)row * D + j * 256 + lane * 4) = v[j]; } }
            float ss = 0.f;
#pragma unroll
            for (int j = 0; j < 8; ++j) ss += v[j][0] * v[j][0] + v[j][1] * v[j][1] + v[j][2] * v[j][2] + v[j][3] * v[j][3];
            ss = wave_sum(ss); const float rstd = rsqrtf(ss * (1.0f / D) + EPS);
            if (MODE == 1 || MODE == 2) { if (lane == 0) rs[w * 8 + i] = rstd; }
#pragma unroll
            for (int j = 0; j < 8; ++j) { const f32x4 g4 = *(const f32x4*)(gain + j * 256 + lane * 4); const f32x4 o = v[j] * g4 * rstd;
                if (MODE == 3) *(f32x4*)(fout + (size_t)row * D + j * 256 + lane * 4) = o;
                else { u32x2 p; p[0] = pk_bf16(o[0], o[1]); p[1] = pk_bf16(o[2], o[3]); *(u32x2*)(xn + (size_t)row * D + j * 256 + lane * 4) = p; } }
        }
        if (MODE == 1 || MODE == 2) {
            constexpr int NT = MODE == 2 ? 3 : 1;
            __builtin_amdgcn_fence(__ATOMIC_RELEASE, "workgroup"); __syncthreads(); __builtin_amdgcn_fence(__ATOMIC_ACQUIRE, "workgroup");
            const int rg = w & 3, kh = w >> 2, m = lane & 15, kq = lane >> 4;
            const float* xr = (COMBINE ? hdst : src) + (size_t)(r0 + rg * 16 + m) * D + 4 * kq;
            f32x4 acc[NT];
#pragma unroll
            for (int t = 0; t < NT; ++t) acc[t] = (f32x4){0.f, 0.f, 0.f, 0.f};
#pragma unroll 2
            for (int s = kh * 64; s < kh * 64 + 64; ++s) {
                const f32x4 xa = *(const f32x4*)(xr + 16 * s);
                f32x4 wb[NT];
                if (MODE == 2) {
#pragma unroll
                    for (int t = 0; t < NT; ++t) wb[t] = *(const f32x4*)(rwt + ((size_t)(s * 3 + t) * 64 + lane) * 4); }
                else {
#pragma unroll
                    for (int j = 0; j < 4; ++j) { const int k = 16 * s + 4 * kq + j; wb[0][j] = w_in[(size_t)k * EVEN_IN + EVEN_MAIN + m] * gain[k]; } }
#pragma unroll
                for (int j = 0; j < 4; ++j)
#pragma unroll
                    for (int t = 0; t < NT; ++t) acc[t] = __builtin_amdgcn_mfma_f32_16x16x4f32(xa[j], wb[t][j], acc[t], 0, 0, 0);
            }
            if (kh == 1) {
#pragma unroll
                for (int t = 0; t < NT; ++t) part[(rg * 3 + t) * 64 + lane] = acc[t]; }
            __syncthreads();
            if (kh == 0) {
#pragma unroll
                for (int t = 0; t < NT; ++t) { const f32x4 p = part[(rg * 3 + t) * 64 + lane];
#pragma unroll
                    for (int q = 0; q < 4; ++q) { const int rl = rg * 16 + 4 * kq + q; const float val = (acc[t][q] + p[q]) * rs[rl];
                        if (MODE == 1) { glow[(size_t)(r0 + rl) * 16 + m] = val; lgt[rl * 16 + m] = val; } else lgt[rl * 48 + t * 16 + m] = val; } } }
            __syncthreads();
            if (MODE == 1) {
                const int col = F.tid; float g2[GL_RANK];
#pragma unroll
                for (int r = 0; r < GL_RANK; ++r) g2[r] = gk2[r * GL_QK + col];
                const float bias = gkb[col];
                for (int rl = 0; rl < 64; ++rl) { float z = bias;
#pragma unroll
                    for (int r = 0; r < GL_RANK; ++r) z += lgt[rl * 16 + r] * g2[r];
                    const float ls = fminf(z, 0.f) - __logf(1.0f + __expf(-fabsf(z)));
                    la[(size_t)(r0 + rl) * GL_QK + col] = ls * (1.0f / 16.0f); } }
            if (MODE == 2 && F.tid < 64) {
                const int row = r0 + F.tid; const LAS float* lr = lgt + F.tid * 48;
                float lg[4], e8[8];
#pragma unroll
                for (int c = 0; c < 4; ++c) lg[c] = lr[c] + bg[c];
                int grp = 0; float mx = lg[0];
#pragma unroll
                for (int c = 1; c < 4; ++c) if (lg[c] > mx) { mx = lg[c]; grp = c; }
                float den = 0.f;
#pragma unroll
                for (int c = 0; c < 4; ++c) den += __expf(lg[c] - mx);
                const float pg = 1.0f / den;
#pragma unroll
                for (int c = 0; c < 8; ++c) e8[c] = lr[4 + grp * 8 + c] + be[grp * 8 + c];
                int j0 = 0; float v0 = e8[0];
#pragma unroll
                for (int c = 1; c < 8; ++c) if (e8[c] > v0) { v0 = e8[c]; j0 = c; }
                int j1 = 0; float v1 = -3.0e38f;
#pragma unroll
                for (int c = 0; c < 8; ++c) if (c != j0 && e8[c] > v1) { v1 = e8[c]; j1 = c; }
                const float e1 = __expf(v1 - v0), sden = 1.0f / (1.0f + e1);
                const int ea = grp * 8 + j0, eb = grp * 8 + j1;
                eid[row * 2] = ea; eid[row * 2 + 1] = eb; wgt_out[row * 2] = pg * sden; wgt_out[row * 2 + 1] = pg * e1 * sden;
                atomicAdd(&cnt[ea], 1u); atomicAdd(&cnt[eb], 1u);
            }
            __syncthreads();
        }
    }
}

DI void moe_plan(const Frame& F, const unsigned* cnt) {
    LAS int* tile_e = (LAS int*)(F.lds + LDS_MISC + MI_TILEE); LAS int* ebase = (LAS int*)(F.lds + LDS_MISC + MI_EBASE); LAS int* ntp = (LAS int*)(F.lds + LDS_MISC + MI_NT);
    if (F.tid == 0) { int t = 0;
        for (int e = 0; e < NEXP; ++e) { const int c = (int)__hip_atomic_load(cnt + e, __ATOMIC_RELAXED, __HIP_MEMORY_SCOPE_AGENT); const int nt = (c + MOE_TILE - 1) / MOE_TILE; ebase[e] = t * MOE_TILE;
            for (int i = 0; i < nt && t + i < MOE_MAXT; ++i) tile_e[t + i] = e; t += nt; }
        if (t > MOE_MAXT) t = MOE_MAXT; *ntp = t; }
    __syncthreads();
}
DI void phase_scatter(const Frame& F, const int* eid, unsigned* cur, int* slot, const bf16_t* xn, bf16_t* xs) {
    const LAS int* ebase = (const LAS int*)(F.lds + LDS_MISC + MI_EBASE);
    for (int blk = F.bx; blk < (2 * NTOK) / 128; blk += F.G) {
        const int i0 = blk * 128 + F.wave * 16; int myslot = 0;
        if (F.lane < 16) { const int e = eid[i0 + F.lane]; const unsigned p = __hip_atomic_fetch_add(cur + e, 1u, __ATOMIC_RELAXED, __HIP_MEMORY_SCOPE_AGENT); myslot = ebase[e] + (int)p; slot[i0 + F.lane] = myslot; }
#pragma unroll 4
        for (int q = 0; q < 16; ++q) { const int s = __shfl(myslot, q); const int tok = (i0 + q) >> 1;
            const u32x4* sp = (const u32x4*)(xn + (size_t)tok * D) + F.lane; u32x4* dp = (u32x4*)(xs + (size_t)s * D) + F.lane;
#pragma unroll
            for (int c = 0; c < 4; ++c) dp[c * 64] = sp[c * 64]; }
    }
}
DI void phase_kmean(const Frame& F, const bf16_t* Kb, float* kmean) {
    LAS float* red = (LAS float*)F.lds;
    for (int it = F.bx; it < NB * MB_H * MB_NBLK; it += F.G) {
        const int n = it % MB_NBLK, hh = (it / MB_NBLK) % MB_H, b = it / (MB_NBLK * MB_H);
        const int kg = F.tid >> 4, d8 = (F.tid & 15) * 8; float s[8];
#pragma unroll
        for (int e = 0; e < 8; ++e) s[e] = 0.f;
        const bf16_t* p = Kb + ((size_t)b * SEQ + n * MB_BLK + kg * 8) * D + hh * MB_DH + d8;
#pragma unroll
        for (int j = 0; j < 8; ++j) { const u32x4 v = *(const u32x4*)(p + (size_t)j * D);
#pragma unroll
            for (int e = 0; e < 4; ++e) { s[2 * e] += __uint_as_float(v[e] << 16); s[2 * e + 1] += __uint_as_float(v[e] & 0xFFFF0000u); } }
#pragma unroll
        for (int e = 0; e < 8; ++e) red[kg * 128 + d8 + e] = s[e];
        __syncthreads();
        if (F.tid < 128) { float t = 0.f;
#pragma unroll
            for (int g = 0; g < 32; ++g) t += red[g * 128 + F.tid];
            kmean[(size_t)it * MB_DH + F.tid] = t * (1.0f / MB_BLK); }
        __syncthreads();
    }
}


template <int DV, bool IS_GLA>
DI void scan_naive_unit(LAS float* sb, int nthr_sub, int stid, int b, int hh, int nheads, const bf16_t* __restrict__ Q, const float* __restrict__ LF, const bf16_t* __restrict__ Kx, const bf16_t* __restrict__ V,
                        const float* __restrict__ glow, const float* __restrict__ gk2, const float* __restrict__ gkb, float* __restrict__ oraw, int ocol0) {
    constexpr int T = 16;
    LAS float* sq = sb; LAS float* sk = sb + T * 128; LAS float* sa = sb + 2 * T * 128;
    const int v = stid, qld = nheads * 128, vld = nheads * DV;
    float S[128];
#pragma unroll
    for (int d = 0; d < 128; ++d) S[d] = 0.f;
    for (int t0 = 0; t0 < SEQ; t0 += T) {
        __syncthreads();
        for (int i = stid; i < T * 128; i += nthr_sub) { const int tt = i >> 7, d = i & 127; const size_t tok = (size_t)b * SEQ + t0 + tt;
            sq[i] = bf2f(Q[tok * qld + hh * 128 + d]);
            if (IS_GLA) { float z = gkb[hh * 128 + d];
#pragma unroll
                for (int r = 0; r < GL_RANK; ++r) z += glow[tok * 16 + r] * gk2[r * GL_QK + hh * 128 + d];
                const float ls = fminf(z, 0.f) - log1pf(__expf(-fabsf(z)));
                sa[i] = __expf(ls * (1.0f / 16.0f)); sk[i] = bf2f(Kx[tok * qld + hh * 128 + d]); }
            else { const float al = __expf(LF[tok * qld + hh * 128 + d]); sa[i] = al; sk[i] = 1.0f - al; } }
        __syncthreads();
        for (int tt = 0; tt < T; ++tt) { const size_t tok = (size_t)b * SEQ + t0 + tt;
            const float vv = bf2f(V[tok * vld + hh * DV + v]); float o = 0.f;
#pragma unroll
            for (int d = 0; d < 128; ++d) { S[d] = sa[tt * 128 + d] * S[d] + sk[tt * 128 + d] * vv; o += sq[tt * 128 + d] * S[d]; }
            oraw[tok * D + ocol0 + hh * DV + v] = o; }
    }
}
DI void phase_scan_naive(const Frame& F, unsigned char* ws, const float* gk2, const float* gkb, float* oraw) {
    LAS float* base = (LAS float*)F.lds;
    if (F.bx < 8) { const int sub = F.tid >> 7, stid = F.tid & 127, unit = F.bx * 4 + sub;
        scan_naive_unit<128, false>(base + sub * 3 * 16 * 128, 128, stid, unit / HG_H, unit % HG_H, HG_H, (const bf16_t*)(ws + U_HQ), (const float*)(ws + U_HLF), nullptr, (const bf16_t*)(ws + U_HI), nullptr, nullptr, nullptr, oraw, 0); }
    else if (F.bx < 16) { const int sub = F.tid >> 8, stid = F.tid & 255, unit = (F.bx - 8) * 2 + sub;
        scan_naive_unit<256, true>(base + sub * 3 * 16 * 128, 256, stid, unit / GL_H, unit % GL_H, GL_H, (const bf16_t*)(ws + U_GQ), nullptr, (const bf16_t*)(ws + U_GK), (const bf16_t*)(ws + U_GV), (const float*)(ws + WS_GLOW), gk2, gkb, oraw, 1024); }
}
DI void phase_ngate(const Frame& F, const float* oraw, const float* hg_norm, const float* gla_norm, const bf16_t* hgg, const bf16_t* gg, bf16_t* mix) {
    const int lane = F.lane;
    for (int w = F.bx * NWAVE + F.wave; w < NTOK * 12; w += F.G * NWAVE) {
        const int tok = w / 12, s = w % 12; const bool gla = s >= 8; const int dv = gla ? 256 : 128, col0 = gla ? 1024 + (s - 8) * 256 : s * 128;
        const float* o = oraw + (size_t)tok * D + col0; float x[4]; float ss = 0.f; const int n = dv / 64;
#pragma unroll
        for (int i = 0; i < 4; ++i) { x[i] = i < n ? o[lane + 64 * i] : 0.f; ss += x[i] * x[i]; }
        ss = wave_sum(ss); const float rstd = rsqrtf(ss / dv + EPS);
#pragma unroll
        for (int i = 0; i < 4; ++i) if (i < n) { const int c = lane + 64 * i; const float gain = gla ? gla_norm[c] : hg_norm[c];
            const float gate = gla ? bf2f(gg[(size_t)tok * 1024 + (s - 8) * 256 + c]) : bf2f(hgg[(size_t)tok * 1024 + s * 128 + c]);
            mix[(size_t)tok * D + col0 + c] = f2bf(x[i] * rstd * gain * gate); }
    }
}
DI void phase_moba_naive(const Frame& F, const bf16_t* __restrict__ Qb, const bf16_t* __restrict__ Kb, const bf16_t* __restrict__ Vb, const float* __restrict__ kmean, bf16_t* __restrict__ AO) {
    LAS float* sq = (LAS float*)F.lds + F.wave * 128;
    LAS float* sp = (LAS float*)F.lds + 8 * 128 + F.wave * 1024;
    LAS int* ssel = (LAS int*)((LAS float*)F.lds + 8 * 128 + 8 * 1024) + F.wave * 4;
    const int lane = F.lane;
    for (int qg = F.bx; qg < NB * MB_H * SEQ / NWAVE; qg += F.G) {
        const int qi = qg * NWAVE + F.wave; const int t = qi % SEQ, hh = (qi / SEQ) % MB_H, b = qi / (SEQ * MB_H);
        const size_t tok = (size_t)b * SEQ + t; const int qb = t / MB_BLK;
        __syncthreads();
        sq[lane] = bf2f(Qb[tok * D + hh * MB_DH + lane]); sq[lane + 64] = bf2f(Qb[tok * D + hh * MB_DH + lane + 64]);
        __syncthreads();
        float gate = -3.0e38f;
        if (lane < qb) { const float* km = kmean + ((size_t)(b * MB_H + hh) * MB_NBLK + lane) * MB_DH; float s = 0.f; for (int d = 0; d < 128; ++d) s += sq[d] * km[d]; gate = s; }
        const int nsel = qb < 3 ? qb : 3;
        for (int s = 0; s < 3; ++s) { float best = gate; int bi = lane;
            for (int o = 32; o > 0; o >>= 1) { const float ob = __shfl_xor(best, o); const int oi = __shfl_xor(bi, o); if (ob > best || (ob == best && oi < bi)) { best = ob; bi = oi; } }
            if (lane == 0) ssel[s] = bi; if (lane == bi) gate = -3.4e38f; }
        __syncthreads();
        const float scale = 0.08838834764831845f; float mx = -3.0e38f;
        for (int sgi = 0; sgi <= nsel; ++sgi) { const int blk = sgi < nsel ? ssel[sgi] : qb;
            for (int i = 0; i < 4; ++i) { const int j = lane + 64 * i, kp = blk * MB_BLK + j; float s = -__builtin_inff();
                if (sgi < nsel || kp <= t) { const bf16_t* kr = Kb + ((size_t)b * SEQ + kp) * D + hh * MB_DH; float acc = 0.f;
                    for (int d = 0; d < 128; d += 2) { const unsigned w = *(const unsigned*)(kr + d); acc += sq[d] * __uint_as_float(w << 16) + sq[d + 1] * __uint_as_float(w & 0xFFFF0000u); }
                    s = acc * scale; }
                sp[sgi * 256 + j] = s; mx = fmaxf(mx, s); } }
        for (int o = 32; o > 0; o >>= 1) mx = fmaxf(mx, __shfl_xor(mx, o));
        float den = 0.f;
        for (int sgi = 0; sgi <= nsel; ++sgi) for (int i = 0; i < 4; ++i) { const int idx = sgi * 256 + lane + 64 * i; const float p = __expf(sp[idx] - mx); sp[idx] = p; den += p; }
        den = wave_sum(den);
        __syncthreads();
        float o0 = 0.f, o1 = 0.f;
        for (int sgi = 0; sgi <= nsel; ++sgi) { const int blk = sgi < nsel ? ssel[sgi] : qb; const int jmax = sgi < nsel ? 256 : (t - qb * MB_BLK + 1);
            for (int j = 0; j < jmax; ++j) { const float p = sp[sgi * 256 + j]; const unsigned w = *(const unsigned*)(Vb + ((size_t)b * SEQ + blk * MB_BLK + j) * D + hh * MB_DH + lane * 2);
                o0 += p * __uint_as_float(w << 16); o1 += p * __uint_as_float(w & 0xFFFF0000u); } }
        const float inv = 1.0f / den;
        *(unsigned*)(AO + tok * D + hh * MB_DH + lane * 2) = (unsigned)f2bf(o0 * inv) | ((unsigned)f2bf(o1 * inv) << 16);
    }
}


DI moba::BlockRef<bf16_t, bf16_t> moba_ref(int L, int pass, const bf16_t* Q, const bf16_t* K, const bf16_t* V, bf16_t* O, const float* kmean) {
    const int bh = L >> 3, x = L & 7, qb = pass ? 15 - x : x, b = bh >> 4, h = bh & 15;
    moba::BlockRef<bf16_t, bf16_t> r; const size_t base = ((size_t)b * SEQ) * D + h * MB_DH;
    r.Q = Q + base + (size_t)qb * 256 * D; r.O = O + base + (size_t)qb * 256 * D; r.K = K + base; r.V = V + base; r.KM = kmean + (size_t)bh * MB_NBLK * MB_DH; r.P0 = qb * 256;
    return r;
}
DI void phase_attn(char* lds, int G, int c, const bf16_t* Q, const bf16_t* K, const bf16_t* V, bf16_t* O, const float* kmean) {
    constexpr int TOTAL = 8 * NB * MB_H;
    int L = c; if (L >= TOTAL) return;
    int pass = 0;
    moba::BlockRef<bf16_t, bf16_t> cur = moba_ref(L, 0, Q, K, V, O, kmean);
    moba::Seam<bf16_t> S;
    moba::causal_swa_prime<bf16_t, bf16_t>(cur, SEQ, lds, S);
    for (;;) {
        const bool more_pass = pass == 0, more_item = L + G < TOTAL, last = !more_pass && !more_item;
        int passn = pass + 1, Ln = L;
        if (!more_pass) { passn = 0; Ln = more_item ? L + G : L; }
        const moba::BlockRef<bf16_t, bf16_t> nxt = last ? cur : moba_ref(Ln, passn, Q, K, V, O, kmean);
        moba::causal_swa_block<bf16_t, bf16_t>(cur, nxt, SEQ, SEQ, lds, S);
        if (last) break;
        cur = nxt; pass = passn; L = Ln;
    }
}

namespace scan {
typedef short s16x4 __attribute__((ext_vector_type(4)));
typedef short bf16x8 __attribute__((ext_vector_type(8)));
typedef float f32x16 __attribute__((ext_vector_type(16)));
typedef float f32x2 __attribute__((ext_vector_type(2)));
typedef __bf16 bf16x2_t __attribute__((ext_vector_type(2)));
constexpr int RS = 272;
constexpr int QS = 0, KD = 64 * RS, K10 = 2 * 64 * RS, QH = K10 + 32 * RS, KH = QH + 64 * RS, KH_ST = 320, VV = KH + 64 * KH_ST, PF = VV + 64 * 576, DEC = PF + 6144, LDS_END = DEC + 512;
constexpr int TOT = 131072 + 4096;
static_assert(LDS_END <= 131072 && TOT + 8192 <= 147456, "scan LDS");
DI unsigned cvt2(float lo, float hi) { const f32x2 v = {lo, hi}; return __builtin_bit_cast(unsigned, __builtin_convertvector(v, bf16x2_t)); }
DI int crow(int r, int h) { return (r & 3) + 8 * (r >> 2) + 4 * h; }
template <int S_> DI bf16x8 pack_step(const f32x16& x) {
    u32x4 p; p[0] = cvt2(x[8 * S_], x[8 * S_ + 1]); p[1] = cvt2(x[8 * S_ + 2], x[8 * S_ + 3]); p[2] = cvt2(x[8 * S_ + 4], x[8 * S_ + 5]); p[3] = cvt2(x[8 * S_ + 6], x[8 * S_ + 7]);
    return __builtin_bit_cast(bf16x8, p);
}
DI bf16x8 tr2(LAS unsigned char* p, int second_off) {
    const s16x4 lo = __builtin_amdgcn_ds_read_tr16_b64_v4i16((LAS s16x4*)p), hi = __builtin_amdgcn_ds_read_tr16_b64_v4i16((LAS s16x4*)(p + second_off));
    return __builtin_shufflevector(lo, hi, 0, 1, 2, 3, 4, 5, 6, 7);
}
DI float ex(float x) { return __builtin_amdgcn_exp2f(x * 1.4426950408889634f); }

template <int DV, bool IS_GLA>
DI void scan_unit(LAS unsigned char* L, int tid, int lane, int w, int b, int hh,
                  const bf16_t* __restrict__ Q, const float* __restrict__ G, const bf16_t* __restrict__ Kx, int qld, const bf16_t* __restrict__ V, float* __restrict__ oraw, int ocol0) {
    constexpr int VST = DV * 2 + 64, NVP = DV / 64, VPR = DV / 8;
    constexpr int NIH = DV == 256 ? 2 : 1;
    const int c = lane & 31, h = lane >> 5, g16 = (lane >> 4) & 1, q4 = (lane & 15) >> 2, p4 = lane & 3;
    const int vs = DV == 256 ? w : (w & 3), ih0 = DV == 256 ? 0 : (w >> 2);
    const int hq = hh * 128 + 2 * lane;
    const size_t tokb = (size_t)b * SEQ;
    f32x16 S[4];
#pragma unroll
    for (int t = 0; t < 4; ++t) S[t] = f32x16{};
    unsigned rq[8], rk[8]; f32x2 rg[8]; u32x4 rv[NVP];
#define SCAN_LOAD(ch_) do { const size_t t0_ = tokb + (size_t)(ch_) * 64;                                                                  \
        _Pragma("unroll") for (int e = 0; e < 8; ++e) { const size_t ro_ = (t0_ + 8 * w + e) * qld + hq;                                    \
            rq[e] = *(const unsigned*)(Q + ro_); rg[e] = *(const f32x2*)(G + ro_); if (IS_GLA) rk[e] = *(const unsigned*)(Kx + ro_); }      \
        _Pragma("unroll") for (int qq = 0; qq < NVP; ++qq) { const int p_ = tid + 512 * qq; const int row_ = p_ / VPR, c16_ = p_ % VPR;     \
            rv[qq] = *(const u32x4*)(V + (t0_ + row_) * 1024 + hh * DV + 8 * c16_); } } while (0)
#define SCAN_TOT(par_) do { f32x2 s_ = rg[0]; _Pragma("unroll") for (int e = 1; e < 8; ++e) s_ += rg[e];                                    \
        *(LAS f32x2*)(L + TOT + (par_) * 4096 + w * 512 + lane * 8) = s_; } while (0)
#define SCAN_PREP(par_) do {                                                                                                                \
        f32x2 Pw_ = {0.f, 0.f}, R1_ = {0.f, 0.f}, last_ = {0.f, 0.f};                                                                        \
        _Pragma("unroll") for (int w2 = 0; w2 < 8; ++w2) { const f32x2 t_ = *(const LAS f32x2*)(L + TOT + (par_) * 4096 + w2 * 512 + lane * 8); \
            if (w2 < w) Pw_ += t_; if (w2 < 4) R1_ += t_; last_ += t_; }                                                                     \
        const bool sub1_ = w >= 4; const f32x2 Rb_ = sub1_ ? R1_ : (f32x2){0.f, 0.f};                                                        \
        const f32x2 eR1_ = {ex(R1_[0]), ex(R1_[1])}; const f32x2 eLR_ = {ex(last_[0] - Rb_[0]), ex(last_[1] - Rb_[1])};                      \
        if (w == 0) *(LAS f32x2*)(L + DEC + lane * 8) = (f32x2){ex(last_[0]), ex(last_[1])};                                                 \
        f32x2 cum_ = Pw_;                                                                                                                    \
        _Pragma("unroll") for (int e = 0; e < 8; ++e) { cum_ += rg[e]; const int i_ = 8 * w + e;                                             \
            const float x0_ = fmaxf(cum_[0] - Rb_[0], -80.f), x1_ = fmaxf(cum_[1] - Rb_[1], -80.f);                                          \
            const float E0_ = ex(x0_), E1_ = ex(x1_), I0_ = ex(-x0_), I1_ = ex(-x1_);                                                        \
            const float q0_ = __uint_as_float(rq[e] << 16), q1_ = __uint_as_float(rq[e] & 0xFFFF0000u);                                      \
            float k0_, k1_; if (IS_GLA) { k0_ = __uint_as_float(rk[e] << 16); k1_ = __uint_as_float(rk[e] & 0xFFFF0000u); }                  \
            else { k0_ = 1.0f - ex(rg[e][0]); k1_ = 1.0f - ex(rg[e][1]); }                                                                   \
            const float qs0_ = q0_ * E0_, qs1_ = q1_ * E1_, kd0_ = k0_ * I0_, kd1_ = k1_ * I1_;                                              \
            const int asw_ = i_ * RS + 4 * lane;                                                                      \
            *(LAS unsigned*)(L + QS + asw_) = cvt2(qs0_, qs1_); *(LAS unsigned*)(L + KD + asw_) = cvt2(kd0_, kd1_);                          \
            if (sub1_) *(LAS unsigned*)(L + QH + asw_) = cvt2(qs0_ * eR1_[0], qs1_ * eR1_[1]);                                               \
            else { *(LAS unsigned*)(L + QH + asw_) = cvt2(qs0_, qs1_); *(LAS unsigned*)(L + K10 + asw_) = cvt2(kd0_ * eR1_[0], kd1_ * eR1_[1]); } \
            *(LAS unsigned*)(L + KH + i_ * KH_ST + 4 * lane) = cvt2(kd0_ * eLR_[0], kd1_ * eLR_[1]); }                                       \
        _Pragma("unroll") for (int qq = 0; qq < NVP; ++qq) { const int p_ = tid + 512 * qq; const int row_ = p_ / VPR, c16_ = p_ % VPR;     \
            *(LAS u32x4*)(L + VV + row_ * VST + c16_ * 16) = rv[qq]; } } while (0)

    SCAN_LOAD(0);
    __syncthreads();
    SCAN_TOT(0);
    __syncthreads();
    SCAN_PREP(0);
    SCAN_LOAD(1);
    for (int ch = 0; ch < SEQ / 64; ++ch) {
        const bool has_next = ch + 1 < SEQ / 64;
        __syncthreads();
        if (w < 3) { const int t = w; const int rowj = (t == 2 ? 32 : 0) + c, rowi = (t == 0 ? 0 : 32) + c; const int kimg = t == 1 ? K10 : KD;
            f32x16 pt = f32x16{};
#pragma unroll
            for (int s = 0; s < 8; ++s) { const int colB = 32 * s + 16 * h;
                const bf16x8 ak = *(const LAS bf16x8*)(L + kimg + rowj * RS + colB), bq = *(const LAS bf16x8*)(L + QS + rowi * RS + colB);
                pt = __builtin_amdgcn_mfma_f32_32x32x16_bf16(ak, bq, pt, 0, 0, 0); }
            if (t != 1) {
#pragma unroll
                for (int r = 0; r < 16; ++r) pt[r] = (crow(r, h) > c) ? 0.f : pt[r]; }
            *(LAS bf16x8*)(L + PF + ((t * 2 + 0) * 64 + lane) * 16) = pack_step<0>(pt);
            *(LAS bf16x8*)(L + PF + ((t * 2 + 1) * 64 + lane) * 16) = pack_step<1>(pt); }
        f32x16 O[NIH];
#pragma unroll
        for (int x = 0; x < NIH; ++x) O[x] = f32x16{};
#pragma unroll
        for (int dt = 0; dt < 4; ++dt) {
            const bf16x8 bS0 = pack_step<0>(S[dt]), bS1 = pack_step<1>(S[dt]);
#pragma unroll
            for (int x = 0; x < NIH; ++x) { const int i = 32 * (ih0 + x) + c; LAS unsigned char* qrow = L + QH + i * RS;
                { const int cb = 64 * dt + 8 * h; const s16x4 lo = *(const LAS s16x4*)(qrow + cb), hi4 = *(const LAS s16x4*)(qrow + cb + 16);
                  O[x] = __builtin_amdgcn_mfma_f32_32x32x16_bf16(__builtin_shufflevector(lo, hi4, 0, 1, 2, 3, 4, 5, 6, 7), bS0, O[x], 0, 0, 0); }
                { const int cb = 64 * dt + 32 + 8 * h; const s16x4 lo = *(const LAS s16x4*)(qrow + cb), hi4 = *(const LAS s16x4*)(qrow + cb + 16);
                  O[x] = __builtin_amdgcn_mfma_f32_32x32x16_bf16(__builtin_shufflevector(lo, hi4, 0, 1, 2, 3, 4, 5, 6, 7), bS1, O[x], 0, 0, 0); } }
        }
#pragma unroll
        for (int dt = 0; dt < 4; ++dt)
#pragma unroll
            for (int g4 = 0; g4 < 4; ++g4) { const f32x4 dv = *(const LAS f32x4*)(L + DEC + (32 * dt + 8 * g4 + 4 * h) * 4);
#pragma unroll
                for (int jj = 0; jj < 4; ++jj) S[dt][4 * g4 + jj] *= dv[jj]; }
#pragma unroll
        for (int s = 0; s < 4; ++s) {
            const bf16x8 bV = tr2(L + VV + (16 * s + 8 * h + q4) * VST + (32 * vs + 16 * g16 + 4 * p4) * 2, 4 * VST);
#pragma unroll
            for (int dt = 0; dt < 4; ++dt) { const bf16x8 aK = tr2(L + KH + (16 * s + 8 * h + q4) * KH_ST + (32 * dt + 16 * g16 + 4 * p4) * 2, 4 * KH_ST);
                S[dt] = __builtin_amdgcn_mfma_f32_32x32x16_bf16(aK, bV, S[dt], 0, 0, 0); }
        }
        if (has_next) SCAN_TOT((ch + 1) & 1);
        __syncthreads();
#define SCAN_PV(x_, t_, jb_) do { _Pragma("unroll") for (int s2 = 0; s2 < 2; ++s2) {                                                        \
            const bf16x8 aP_ = *(const LAS bf16x8*)(L + PF + (((t_) * 2 + s2) * 64 + lane) * 16);                                            \
            const bf16x8 bV_ = tr2(L + VV + (32 * (jb_) + 16 * s2 + 4 * h + q4) * VST + (32 * vs + 16 * g16 + 4 * p4) * 2, 8 * VST);         \
            O[x_] = __builtin_amdgcn_mfma_f32_32x32x16_bf16(aP_, bV_, O[x_], 0, 0, 0); } } while (0)
        if (NIH == 2) { SCAN_PV(0, 0, 0); SCAN_PV(NIH - 1, 1, 0); SCAN_PV(NIH - 1, 2, 1); }
        else { if (ih0 == 0) { SCAN_PV(0, 0, 0); } else { SCAN_PV(0, 1, 0); SCAN_PV(0, 2, 1); } }
#undef SCAN_PV
        { float* op = oraw + (tokb + (size_t)ch * 64) * D + ocol0 + hh * DV + 32 * vs + c;
#pragma unroll
          for (int x = 0; x < NIH; ++x)
#pragma unroll
              for (int r = 0; r < 16; ++r) op[(size_t)(32 * (ih0 + x) + crow(r, h)) * D] = O[x][r]; }
        __syncthreads();
        if (has_next) { SCAN_PREP((ch + 1) & 1); if (ch + 2 < SEQ / 64) SCAN_LOAD(ch + 2); }
    }
#undef SCAN_LOAD
#undef SCAN_TOT
#undef SCAN_PREP
}
}

DI void phase_scan_fast(LAS unsigned char* L, int tid, int lane, int w, int G, int bx, unsigned char* ws, float* oraw) {
    for (int u = bx; u < NB * HG_H + NB * GL_H; u += G) {
        if (u < NB * HG_H) scan::scan_unit<128, false>(L, tid, lane, w, u / HG_H, u % HG_H, (const bf16_t*)(ws + U_HQ), (const float*)(ws + U_HLF), nullptr, 1024, (const bf16_t*)(ws + U_HI), oraw, 0);
        else { const int v = u - NB * HG_H; scan::scan_unit<256, true>(L, tid, lane, w, v / GL_H, v % GL_H, (const bf16_t*)(ws + U_GQ), (const float*)(ws + WS_LA), (const bf16_t*)(ws + U_GK), 512, (const bf16_t*)(ws + U_GV), oraw, 1024); }
        __syncthreads();
    }
}

enum { PH_PRO = 0, PH_GEMM1 = 1, PH_SCAN = 2, PH_NGATE = 3, PH_OUTP = 4, PH_NORM_F0 = 5, PH_SCAT0 = 6, PH_UP0 = 7, PH_DN0 = 8, PH_COMB0 = 9, PH_QKV = 10, PH_KMEAN = 11, PH_ATTN = 12,
       PH_OPROJ = 13, PH_NORM_F1 = 14, PH_SCAT1 = 15, PH_UP1 = 16, PH_DN1 = 17, PH_FINAL = 18, PH_END = 19 };

__global__ void __launch_bounds__(NTHR, 2) mk_fwd(Args a) {
    extern __shared__ __attribute__((aligned(16))) unsigned char lds_raw[];
    Frame F; F.lds = (LAS unsigned char*)lds_raw; F.tid = threadIdx.x; F.lane = F.tid & 63; F.wave = __builtin_amdgcn_readfirstlane(F.tid >> 6);
    F.G = gridDim.x; F.bx = blockIdx.x; F.vcu = (F.G % 8 == 0) ? (F.bx % 8) * (F.G / 8) + F.bx / 8 : F.bx;
    F.ws = a.ws; F.ctl = (unsigned*)(a.ws + WS_CTL);
    unsigned char* ws = a.ws;
    if (F.tid < 4) ((LAS unsigned*)(F.lds + LDS_MISC + MI_BAR))[F.tid] = 0u;
    __syncthreads();
    const int lo = a.ph_lo, hi = a.ph_hi;
    XcdBarrier bar; bar.bar = F.ctl + CW2_BAR + a.bar_idx * XCD_BAR_WORDS; bar.x = 0; bar.st = (volatile LAS unsigned*)(F.lds + LDS_MISC + MI_BAR);
    if (hi - lo > 1) bar = xcd_barrier_post(F.ctl + CW2_BAR + a.bar_idx * XCD_BAR_WORDS, (volatile LAS unsigned*)(F.lds + LDS_MISC + MI_BAR));
#define IN(k) (lo <= (k) && (k) < hi)
#define SEAM(k) do { if (IN(k) && IN((k) + 1)) xcd_barrier(bar); } while (0)
    const float* x = a.in[0]; const float* norm_mix = a.in[1]; const float* norm_ffn = a.in[2]; const float* norm_final = a.in[3];
    bf16_t* WinT = (bf16_t*)(ws + WS_WIN); bf16_t* WoutT = (bf16_t*)(ws + WS_WOUT); bf16_t* WqkvT = (bf16_t*)(ws + WS_WQKV); bf16_t* WoT = (bf16_t*)(ws + WS_WO);
    bf16_t* Wup = (bf16_t*)(ws + WS_WUP); bf16_t* Wdn = (bf16_t*)(ws + WS_WDN);
    bf16_t* XN = (bf16_t*)(ws + WS_XN); float* H = (float*)(ws + WS_H);
    float* LB = (float*)(ws + SM_LB); float* KMEAN = (float*)(ws + SM_KMEAN);
    float* GLOW = (float*)(ws + WS_GLOW); int* EID = (int*)(ws + WS_EID); float* WGT = (float*)(ws + WS_WGT); int* SLOT = (int*)(ws + WS_SLOT);
    float* RWT = (float*)(ws + WS_RWT);
    bf16_t* Qb = (bf16_t*)(ws + U_Q); bf16_t* Kb = (bf16_t*)(ws + U_K); bf16_t* Vb = (bf16_t*)(ws + U_V);
    bf16_t* HMID = (bf16_t*)(ws + U_HMID); bf16_t* Y = (bf16_t*)(ws + U_Y); bf16_t* XS = (bf16_t*)(ws + U_XS);
    const LAS int* tile_e = (const LAS int*)(F.lds + LDS_MISC + MI_TILEE); const LAS int* ntp = (const LAS int*)(F.lds + LDS_MISC + MI_NT);

    if (IN(PH_PRO)) {
        phase_tables(F, a);
        phase_norm<1, false>(F, x, nullptr, norm_mix, XN, nullptr, nullptr, nullptr, nullptr, a.in[4], GLOW, nullptr, nullptr, nullptr, nullptr, nullptr, nullptr, a.in[7], a.in[8], (float*)(ws + WS_LA));
        __syncthreads();
        phase_transposes(F, a);
    }
    SEAM(PH_PRO);
    if (IN(PH_GEMM1)) {
        pg8::Gemm g{XN, WinT, NTOK, EVEN_MAIN, D}; pg8::StaticOrder S; S.init(NTOK, EVEN_MAIN, F.G, F.bx);
        EpiProj0F E{(bf16_t*)(ws + U_HQ), (float*)(ws + U_HLF), (bf16_t*)(ws + U_HI), (bf16_t*)(ws + U_HGG), (bf16_t*)(ws + U_GQ), (bf16_t*)(ws + U_GK), (bf16_t*)(ws + U_GV), (bf16_t*)(ws + U_GG), LB};
        pg8::gemm_phase<EpiProj0F, pg8::StaticOrder, true, true>(F.lds, g, S, E);
    }
    SEAM(PH_GEMM1);
    if (IN(PH_SCAN)) phase_scan_fast(F.lds, F.tid, F.lane, F.wave, F.G, F.bx, ws, H);
    SEAM(PH_SCAN);
    if (IN(PH_NGATE)) phase_ngate(F, H, a.in[6], a.in[9], (const bf16_t*)(ws + U_HGG), (const bf16_t*)(ws + U_GG), XN);
    SEAM(PH_NGATE);
    if (IN(PH_OUTP)) {
        pg8::Gemm g{XN, WoutT, NTOK, D, D}; pg8::StaticOrder S; S.init(NTOK, D, F.G, F.bx);
        EpiResidF E{x, H};
        pg8::gemm_phase<EpiResidF, pg8::StaticOrder, true, true>(F.lds, g, S, E);
    }
    SEAM(PH_OUTP);
#define MOE_LAYER(l, PHN, PHS, PHU, PHD, CNT, CUR)                                                                                              \
    if (IN(PHN)) phase_norm<2, false>(F, H, nullptr, norm_ffn + (l) * D, XN, nullptr, nullptr, nullptr, nullptr, nullptr, nullptr,              \
                                      RWT + (size_t)(l) * 2048 * 48, a.in[14] + (l) * NGRP, a.in[16] + (l) * NEXP, EID, WGT, F.ctl + CNT);        \
    SEAM(PHN);                                                                                                                                  \
    if (IN(PHS)) { moe_plan(F, F.ctl + CNT); phase_scatter(F, EID, F.ctl + CUR, SLOT, XN, XS); }                                                \
    SEAM(PHS);                                                                                                                                  \
    if (IN(PHU)) { moe_plan(F, F.ctl + CNT);                                                                                                    \
        pg8::Gemm g{XS, Wup + (size_t)(l) * NEXP * 1024 * D, MOE_ROWS, NEXP * 1024, D}; MoeOrder S{4, 2, *ntp * 4, F.G, F.vcu, tile_e};          \
        EpiSwigluF E{HMID}; pg8::gemm_phase<EpiSwigluF, MoeOrder, true, true>(F.lds, g, S, E); }                                                \
    SEAM(PHU);                                                                                                                                  \
    if (IN(PHD)) { moe_plan(F, F.ctl + CNT);                                                                                                    \
        pg8::Gemm g{HMID, Wdn + (size_t)(l) * NEXP * D * DEXP, MOE_ROWS, NEXP * D, DEXP}; MoeOrder S{8, 3, *ntp * 8, F.G, F.vcu, tile_e};        \
        EpiBf16F E{Y, D, 8, 0, 0}; pg8::gemm_phase<EpiBf16F, MoeOrder, true, true>(F.lds, g, S, E); }                                           \
    SEAM(PHD);
    MOE_LAYER(0, PH_NORM_F0, PH_SCAT0, PH_UP0, PH_DN0, CW2_CNT0, CW2_CUR0)
    if (IN(PH_COMB0)) phase_norm<0, true>(F, H, H, norm_mix + D, XN, nullptr, Y, SLOT, WGT, nullptr, nullptr, nullptr, nullptr, nullptr, nullptr, nullptr, nullptr);
    SEAM(PH_COMB0);
    if (IN(PH_QKV)) {
        pg8::Gemm g{XN, WqkvT, NTOK, 3 * D, D}; pg8::StaticOrder S; S.init(NTOK, 3 * D, F.G, F.bx);
        EpiBf16F E{Qb, D, 24, 8, (size_t)NTOK * D};
        pg8::gemm_phase<EpiBf16F, pg8::StaticOrder, true, true>(F.lds, g, S, E);
    }
    SEAM(PH_QKV);
    if (IN(PH_KMEAN)) phase_kmean(F, Kb, KMEAN);
    SEAM(PH_KMEAN);
    if (IN(PH_ATTN)) phase_attn((char*)lds_raw, F.G, F.vcu, Qb, Kb, Vb, XN, KMEAN);
    SEAM(PH_ATTN);
    if (IN(PH_OPROJ)) {
        pg8::Gemm g{XN, WoT, NTOK, D, D}; pg8::StaticOrder S; S.init(NTOK, D, F.G, F.bx);
        EpiResidF E{H, H};
        pg8::gemm_phase<EpiResidF, pg8::StaticOrder, true, true>(F.lds, g, S, E);
    }
    SEAM(PH_OPROJ);
    MOE_LAYER(1, PH_NORM_F1, PH_SCAT1, PH_UP1, PH_DN1, CW2_CNT1, CW2_CUR1)
    if (IN(PH_FINAL)) phase_norm<3, true>(F, H, nullptr, norm_final, nullptr, a.out, Y, SLOT, WGT, nullptr, nullptr, nullptr, nullptr, nullptr, nullptr, nullptr, nullptr);
#undef IN
#undef SEAM
#undef MOE_LAYER
}


extern "C" void kernel_launch(void* const* d_in, const int* in_sizes, int n_in, void* d_out, int out_size, void* d_ws, size_t ws_size, hipStream_t stream) {
    static int grid = 0;
    if (grid == 0) {
        if (n_in != 20 || out_size != NTOK * D || ws_size < WS_TOTAL3) { fprintf(stderr, "kernel_launch: unexpected shapes / workspace (%d inputs, out %d, ws %zu need %zu)\n", n_in, out_size, ws_size, (size_t)WS_TOTAL3); grid = -1; return; }
        int dev = 0, cus = 0;
        if (hipGetDevice(&dev) != hipSuccess || hipDeviceGetAttribute(&cus, hipDeviceAttributeMultiprocessorCount, dev) != hipSuccess || cus <= 0) { grid = -1; return; }
        if (hipFuncSetAttribute((const void*)mk_fwd, hipFuncAttributeMaxDynamicSharedMemorySize, LDS_BYTES) != hipSuccess) { fprintf(stderr, "kernel_launch: hipFuncSetAttribute failed\n"); grid = -1; return; }
        int per_cu = 0; (void)hipOccupancyMaxActiveBlocksPerMultiprocessor(&per_cu, (const void*)mk_fwd, NTHR, LDS_BYTES); (void)hipGetLastError();
        if (per_cu < 1) fprintf(stderr, "kernel_launch: occupancy query reports %d\n", per_cu);
        grid = cus;
    }
    if (grid < 0) return;
    const float* x = (const float*)d_in[0];
    const float* hg_norm = (const float*)d_in[6]; const float* gk2 = (const float*)d_in[7]; const float* gkb = (const float*)d_in[8]; const float* gla_norm = (const float*)d_in[9];
    unsigned char* ws = (unsigned char*)d_ws;
    bf16_t* XN = (bf16_t*)(ws + WS_XN); float* H = (float*)(ws + WS_H);
    float* KMEAN = (float*)(ws + SM_KMEAN); float* GLOW = (float*)(ws + WS_GLOW);
    bf16_t* HQ = (bf16_t*)(ws + U_HQ); float* HLF = (float*)(ws + U_HLF); bf16_t* HI = (bf16_t*)(ws + U_HI); bf16_t* HGG = (bf16_t*)(ws + U_HGG);
    bf16_t* GQ = (bf16_t*)(ws + U_GQ); bf16_t* GK = (bf16_t*)(ws + U_GK); bf16_t* GV = (bf16_t*)(ws + U_GV); bf16_t* GG = (bf16_t*)(ws + U_GG);
    bf16_t* Qb = (bf16_t*)(ws + U_Q); bf16_t* Kb = (bf16_t*)(ws + U_K); bf16_t* Vb = (bf16_t*)(ws + U_V);
    (void)x;
    (void)hipMemsetAsync(ws + WS_CTL, 0, CTL_BYTES, stream);
    Args a{};
    for (int i = 0; i < 20; ++i) a.in[i] = (const float*)d_in[i];
    a.out = (float*)d_out; a.ws = ws;
    auto run = [&](int lo, int hi, int bi) { a.ph_lo = lo; a.ph_hi = hi; a.bar_idx = bi; a.pad = 0; hipLaunchKernelGGL(mk_fwd, dim3(grid), dim3(NTHR), LDS_BYTES, stream, a); };
    run(PH_PRO, PH_END, 0);
}
```

```cpp
#include <hip/hip_runtime.h>
#include <cstdio>
#include <cstdint>

typedef unsigned short bf16_t;
#define DI __device__ __forceinline__

constexpr int D = 2048, NB = 4, SEQ = 4096, NTOK = NB * SEQ;
constexpr int HG_H = 8, HG_DK = 128, HG_DV = 128, HG_QK = 1024, HG_V = 1024;
constexpr int GL_H = 4, GL_DK = 128, GL_DV = 256, GL_QK = 512, GL_V = 1024, GL_RANK = 16;
constexpr int EVEN_IN = 7184, EVEN_MAIN = 7168;
constexpr int MB_H = 16, MB_DH = 128, MB_BLK = 256, MB_NBLK = SEQ / MB_BLK;
constexpr int NEXP = 32, NGRP = 4, EPG = 8, DEXP = 512;
constexpr int MOE_TILE = 256, MOE_MAXT = (2 * NTOK) / MOE_TILE + NEXP, MOE_ROWS = MOE_MAXT * MOE_TILE;
constexpr float EPS = 1e-6f;

constexpr size_t MBy = 1024 * 1024;
constexpr size_t WS_CTL   = 0;
constexpr size_t CTL_BYTES = 64 * 1024;
constexpr size_t WS_SMALL = WS_CTL + CTL_BYTES;
constexpr size_t WS_WIN   = WS_SMALL + 1 * MBy;
constexpr size_t WS_WOUT  = WS_WIN + (size_t)EVEN_MAIN * D * 2;
constexpr size_t WS_WQKV  = WS_WOUT + (size_t)D * D * 2;
constexpr size_t WS_WO    = WS_WQKV + (size_t)3 * D * D * 2;
constexpr size_t WS_WUP   = WS_WO + (size_t)D * D * 2;
constexpr size_t WS_WDN   = WS_WUP + (size_t)2 * NEXP * 1024 * D * 2;
constexpr size_t WS_XN    = WS_WDN + (size_t)2 * NEXP * D * DEXP * 2;
constexpr size_t WS_H     = WS_XN + (size_t)NTOK * D * 2;
constexpr size_t WS_U     = WS_H + (size_t)NTOK * D * 4;
constexpr size_t U_HQ  = WS_U;
constexpr size_t U_HLF = U_HQ + (size_t)NTOK * 1024 * 2;
constexpr size_t U_HI  = U_HLF + (size_t)NTOK * 1024 * 4;
constexpr size_t U_HGG = U_HI + (size_t)NTOK * 1024 * 2;
constexpr size_t U_GQ  = U_HGG + (size_t)NTOK * 1024 * 2;
constexpr size_t U_GK  = U_GQ + (size_t)NTOK * 512 * 2;
constexpr size_t U_GV  = U_GK + (size_t)NTOK * 512 * 2;
constexpr size_t U_GG  = U_GV + (size_t)NTOK * 1024 * 2;
constexpr size_t U_END0 = U_GG + (size_t)NTOK * 1024 * 2;
constexpr size_t U_Q = WS_U, U_K = U_Q + (size_t)NTOK * D * 2, U_V = U_K + (size_t)NTOK * D * 2, U_END1 = U_V + (size_t)NTOK * D * 2;
constexpr size_t U_HMID = WS_U;
constexpr size_t U_Y = U_HMID + (size_t)MOE_ROWS * DEXP * 2;
constexpr size_t U_END2 = U_Y + (size_t)MOE_ROWS * D * 2;
constexpr size_t U_BYTES = U_END0 - WS_U;
static_assert(U_END1 - WS_U <= U_BYTES && U_END2 - WS_U <= U_BYTES, "union");
constexpr size_t WS_END = WS_U + U_BYTES;
constexpr size_t SM_LB    = WS_SMALL;
constexpr size_t SM_GLOW  = SM_LB + 4096;
constexpr size_t SM_KMEAN = WS_SMALL + 64 * 1024;
constexpr size_t SM_TILEE = SM_KMEAN + 512 * 1024;
constexpr size_t WS_GLOW  = WS_END;
constexpr size_t WS_EID   = WS_GLOW + (size_t)NTOK * 16 * 4;
constexpr size_t WS_WGT   = WS_EID + (size_t)NTOK * 2 * 4;
constexpr size_t WS_SLOT  = WS_WGT + (size_t)NTOK * 2 * 4;
constexpr size_t WS_ROWTOK = WS_SLOT + (size_t)NTOK * 2 * 4;
constexpr size_t WS_TOTAL = WS_ROWTOK + (size_t)MOE_ROWS * 4;
constexpr int CW_CNT = 0;
constexpr int CW_CUR = 64;
constexpr int CW_BASE = 128;
constexpr int CW_NT = 192;

DI float bf2f(bf16_t b) { return __uint_as_float(((unsigned)b) << 16); }
DI bf16_t f2bf(float f) { unsigned u = __float_as_uint(f); u += 0x7FFFu + ((u >> 16) & 1u); return (bf16_t)(u >> 16); }
DI float sigmoidf_(float x) { return 1.0f / (1.0f + __expf(-x)); }
DI float siluf_(float x) { return x / (1.0f + __expf(-x)); }
DI float wave_sum(float v) { for (int o = 32; o > 0; o >>= 1) v += __shfl_xor(v, o); return v; }

template <int MODE>
__global__ void k_transpose(const float* __restrict__ src, bf16_t* __restrict__ dst, int K, int N, int ld, int c0, int half, size_t src_bstride, size_t dst_bstride) {
    __shared__ float t[64][65];
    src += (size_t)blockIdx.z * src_bstride; dst += (size_t)blockIdx.z * dst_bstride;
    const int k0 = blockIdx.y * 64, n0 = blockIdx.x * 64, tx = threadIdx.x & 63, ty = threadIdx.x >> 6;
    for (int i = ty; i < 64; i += 4) t[i][tx] = src[(size_t)(k0 + i) * ld + c0 + n0 + tx];
    __syncthreads();
    for (int i = ty; i < 64; i += 4) { const int n = n0 + i; const int r = MODE == 0 ? n : (n / 128) * 256 + half * 128 + (n % 128);
        dst[(size_t)r * K + k0 + tx] = f2bf(t[tx][i]); }
}
__global__ void k_lb(const float* __restrict__ lg, float* __restrict__ lb) {
    const int d = blockIdx.x * blockDim.x + threadIdx.x; if (d >= HG_QK) return;
    const float a = lg[d], b = lg[HG_QK + d], c = lg[2 * HG_QK + d], m = fmaxf(a, fmaxf(b, c));
    const float ea = __expf(a - m), eb = __expf(b - m), ec = __expf(c - m); lb[d] = ea / (ea + eb + ec);
}

template <int MODE>
__global__ void k_rmsnorm(const float* __restrict__ h, const float* __restrict__ g, bf16_t* __restrict__ xn, float* __restrict__ fout,
                          const float* __restrict__ w_in, float* __restrict__ glow,
                          const float* __restrict__ wg, const float* __restrict__ bg, const float* __restrict__ we, const float* __restrict__ be,
                          int* __restrict__ eid, float* __restrict__ wgt, unsigned* __restrict__ ctl) {
    const int row = blockIdx.x * 4 + (threadIdx.x >> 6), lane = threadIdx.x & 63;
    const float* hr = h + (size_t)row * D;
    float v[32]; float ss = 0.f;
#pragma unroll
    for (int j = 0; j < 8; ++j) { const float4 x = *(const float4*)(hr + j * 256 + lane * 4); v[4 * j] = x.x; v[4 * j + 1] = x.y; v[4 * j + 2] = x.z; v[4 * j + 3] = x.w; ss += x.x * x.x + x.y * x.y + x.z * x.z + x.w * x.w; }
    ss = wave_sum(ss); const float rstd = rsqrtf(ss * (1.0f / D) + EPS);
#pragma unroll
    for (int j = 0; j < 8; ++j) { const float4 gg = *(const float4*)(g + j * 256 + lane * 4);
        v[4 * j] *= rstd * gg.x; v[4 * j + 1] *= rstd * gg.y; v[4 * j + 2] *= rstd * gg.z; v[4 * j + 3] *= rstd * gg.w; }
    if (MODE == 3) {
#pragma unroll
        for (int j = 0; j < 8; ++j) *(float4*)(fout + (size_t)row * D + j * 256 + lane * 4) = make_float4(v[4 * j], v[4 * j + 1], v[4 * j + 2], v[4 * j + 3]);
        return;
    }
#pragma unroll
    for (int j = 0; j < 8; ++j) { ushort4 o; o.x = f2bf(v[4 * j]); o.y = f2bf(v[4 * j + 1]); o.z = f2bf(v[4 * j + 2]); o.w = f2bf(v[4 * j + 3]);
        *(ushort4*)(xn + (size_t)row * D + j * 256 + lane * 4) = o; }
    if (MODE == 1) {
        float acc[16];
#pragma unroll
        for (int c = 0; c < 16; ++c) acc[c] = 0.f;
#pragma unroll
        for (int j = 0; j < 8; ++j)
#pragma unroll
            for (int e = 0; e < 4; ++e) { const int k = j * 256 + lane * 4 + e; const float* wr = w_in + (size_t)k * EVEN_IN + EVEN_MAIN; const float xv = v[4 * j + e];
#pragma unroll
                for (int c4 = 0; c4 < 4; ++c4) { const float4 w = *(const float4*)(wr + c4 * 4); acc[c4 * 4] += xv * w.x; acc[c4 * 4 + 1] += xv * w.y; acc[c4 * 4 + 2] += xv * w.z; acc[c4 * 4 + 3] += xv * w.w; } }
#pragma unroll
        for (int c = 0; c < 16; ++c) acc[c] = wave_sum(acc[c]);
        if (lane == 0) {
#pragma unroll
            for (int c = 0; c < 16; ++c) glow[(size_t)row * 16 + c] = acc[c]; }
    }
    if (MODE == 2) {
        float lg[4], le[32];
#pragma unroll
        for (int c = 0; c < 4; ++c) lg[c] = 0.f;
#pragma unroll
        for (int c = 0; c < 32; ++c) le[c] = 0.f;
#pragma unroll
        for (int j = 0; j < 8; ++j)
#pragma unroll
            for (int e = 0; e < 4; ++e) { const int k = j * 256 + lane * 4 + e; const float xv = v[4 * j + e];
                const float4 w4 = *(const float4*)(wg + (size_t)k * 4); lg[0] += xv * w4.x; lg[1] += xv * w4.y; lg[2] += xv * w4.z; lg[3] += xv * w4.w;
#pragma unroll
                for (int c4 = 0; c4 < 8; ++c4) { const float4 w = *(const float4*)(we + (size_t)k * 32 + c4 * 4); le[c4 * 4] += xv * w.x; le[c4 * 4 + 1] += xv * w.y; le[c4 * 4 + 2] += xv * w.z; le[c4 * 4 + 3] += xv * w.w; } }
#pragma unroll
        for (int c = 0; c < 4; ++c) lg[c] = wave_sum(lg[c]) + bg[c];
#pragma unroll
        for (int c = 0; c < 32; ++c) le[c] = wave_sum(le[c]) + be[c];
        if (lane == 0) {
            int grp = 0; float mx = lg[0];
#pragma unroll
            for (int c = 1; c < 4; ++c) if (lg[c] > mx) { mx = lg[c]; grp = c; }
            float den = 0.f;
#pragma unroll
            for (int c = 0; c < 4; ++c) den += __expf(lg[c] - mx);
            const float pg = 1.0f / den;
            float e8[8];
#pragma unroll
            for (int c = 0; c < 8; ++c) { e8[c] = grp == 0 ? le[c] : grp == 1 ? le[8 + c] : grp == 2 ? le[16 + c] : le[24 + c]; }
            int j0 = 0; float v0 = e8[0];
#pragma unroll
            for (int c = 1; c < 8; ++c) if (e8[c] > v0) { v0 = e8[c]; j0 = c; }
            int j1 = -1; float v1 = -3.0e38f;
#pragma unroll
            for (int c = 0; c < 8; ++c) if (c != j0 && e8[c] > v1) { v1 = e8[c]; j1 = c; }
            const float e1 = __expf(v1 - v0), s = 1.0f / (1.0f + e1);
            const int ea = grp * 8 + j0, eb = grp * 8 + j1;
            eid[row * 2] = ea; eid[row * 2 + 1] = eb; wgt[row * 2] = pg * s; wgt[row * 2 + 1] = pg * e1 * s;
            atomicAdd(&ctl[CW_CNT + ea], 1u); atomicAdd(&ctl[CW_CNT + eb], 1u);
        }
    }
}

struct EpiProj0 { bf16_t* hq; float* hlf; bf16_t* hi; bf16_t* hgg; bf16_t* gq; bf16_t* gk; bf16_t* gv; bf16_t* gg; const float* lb;
    DI void operator()(int r, int c, float v) const {
        const int seg = c >> 10, cc = c & 1023; const float sc = 0.08838834764831845f;
        if (seg == 0) hq[(size_t)r * 1024 + cc] = f2bf(siluf_(v) * sc);
        else if (seg == 1) { const float l = lb[cc]; const float f = l + (1.0f - l) * sigmoidf_(v); hlf[(size_t)r * 1024 + cc] = __logf(f); }
        else if (seg == 2) hi[(size_t)r * 1024 + cc] = f2bf(v);
        else if (seg == 3) hgg[(size_t)r * 1024 + cc] = f2bf(siluf_(v));
        else if (seg == 4) { if (cc < 512) gq[(size_t)r * 512 + cc] = f2bf(v * sc); else gk[(size_t)r * 512 + cc - 512] = f2bf(v); }
        else if (seg == 5) gv[(size_t)r * 1024 + cc] = f2bf(v);
        else gg[(size_t)r * 1024 + cc] = f2bf(siluf_(v));
    } };
struct EpiResid { const float* res; float* out;
    DI void operator()(int r, int c, float v) const { out[(size_t)r * D + c] = res[(size_t)r * D + c] + v; } };
struct EpiQKV { bf16_t* q; bf16_t* k; bf16_t* v_;
    DI void operator()(int r, int c, float v) const { const int s = c >> 11, cc = c & 2047; bf16_t* o = s == 0 ? q : s == 1 ? k : v_; o[(size_t)r * D + cc] = f2bf(v); } };
struct EpiBf { bf16_t* o; int ld; int pad;
    DI void operator()(int r, int c, float v) const { o[(size_t)r * ld + c] = f2bf(v); } };
struct EpiSwiglu { bf16_t* o;
    DI void operator()(int r, int j, float a, float b) const { o[(size_t)r * DEXP + j] = f2bf(siluf_(a) * b); } };

template <class Epi, bool DUAL>
__global__ void k_gemm_naive(const bf16_t* __restrict__ A, const int* __restrict__ rowidx, const bf16_t* __restrict__ Bt, int K, int lda,
                             const int* __restrict__ tile_e, size_t b_estride, Epi epi) {
    __shared__ float As[32][65], Bs[32][65], Bs2[DUAL ? 32 : 1][65];
    const int m0 = blockIdx.y * 64, n0 = blockIdx.x * 64, tid = threadIdx.x, tx = tid & 15, ty = tid >> 4;
    if (tile_e) { const int e = tile_e[m0 / MOE_TILE]; if (e < 0) return; Bt += (size_t)e * b_estride; }
    float acc[4][4], acc2[4][4];
#pragma unroll
    for (int i = 0; i < 4; ++i)
#pragma unroll
        for (int j = 0; j < 4; ++j) { acc[i][j] = 0.f; acc2[i][j] = 0.f; }
    const int lr = tid >> 2, lk = (tid & 3) * 8;
    const int arow = rowidx ? rowidx[m0 + lr] : (m0 + lr);
    const bf16_t* ap = A + (size_t)arow * lda + lk;
    const int nl = n0 + lr; const int brow = DUAL ? (nl / 128) * 256 + (nl % 128) : nl;
    const bf16_t* bp = Bt + (size_t)brow * K + lk; const bf16_t* bp2 = bp + (size_t)128 * K;
    for (int k0 = 0; k0 < K; k0 += 32) {
        { const uint4 a = *(const uint4*)(ap + k0); const unsigned w[4] = {a.x, a.y, a.z, a.w};
#pragma unroll
          for (int i = 0; i < 4; ++i) { As[lk + 2 * i][lr] = __uint_as_float(w[i] << 16); As[lk + 2 * i + 1][lr] = __uint_as_float(w[i] & 0xFFFF0000u); } }
        { const uint4 a = *(const uint4*)(bp + k0); const unsigned w[4] = {a.x, a.y, a.z, a.w};
#pragma unroll
          for (int i = 0; i < 4; ++i) { Bs[lk + 2 * i][lr] = __uint_as_float(w[i] << 16); Bs[lk + 2 * i + 1][lr] = __uint_as_float(w[i] & 0xFFFF0000u); } }
        if (DUAL) { const uint4 a = *(const uint4*)(bp2 + k0); const unsigned w[4] = {a.x, a.y, a.z, a.w};
#pragma unroll
          for (int i = 0; i < 4; ++i) { Bs2[lk + 2 * i][lr] = __uint_as_float(w[i] << 16); Bs2[lk + 2 * i + 1][lr] = __uint_as_float(w[i] & 0xFFFF0000u); } }
        __syncthreads();
#pragma unroll 8
        for (int k = 0; k < 32; ++k) {
            float a[4], b[4], b2[4];
#pragma unroll
            for (int i = 0; i < 4; ++i) { a[i] = As[k][ty * 4 + i]; b[i] = Bs[k][tx * 4 + i]; if (DUAL) b2[i] = Bs2[k][tx * 4 + i]; }
#pragma unroll
            for (int i = 0; i < 4; ++i)
#pragma unroll
                for (int j = 0; j < 4; ++j) { acc[i][j] += a[i] * b[j]; if (DUAL) acc2[i][j] += a[i] * b2[j]; }
        }
        __syncthreads();
    }
#pragma unroll
    for (int i = 0; i < 4; ++i)
#pragma unroll
        for (int j = 0; j < 4; ++j) { const int r = m0 + ty * 4 + i, c = n0 + tx * 4 + j;
            if constexpr (DUAL) epi(r, c, acc[i][j], acc2[i][j]); else epi(r, c, acc[i][j]); }
}

template <int DV, bool IS_GLA>
__global__ void __launch_bounds__(DV) k_scan_naive(const bf16_t* __restrict__ Q, const float* __restrict__ LF, const bf16_t* __restrict__ Kx, const bf16_t* __restrict__ V,
                             const float* __restrict__ glow, const float* __restrict__ gk2, const float* __restrict__ gkb, float* __restrict__ oraw, int nheads, int ocol0) {
    constexpr int T = 16;
    __shared__ float sq[T][128], sk[T][128], sa[T][128];
    const int b = blockIdx.x / nheads, hh = blockIdx.x % nheads, v = threadIdx.x;
    const int qld = nheads * 128, vld = nheads * DV;
    float S[128];
#pragma unroll
    for (int d = 0; d < 128; ++d) S[d] = 0.f;
    for (int t0 = 0; t0 < SEQ; t0 += T) {
        __syncthreads();
        for (int i = threadIdx.x; i < T * 128; i += DV) { const int tt = i >> 7, d = i & 127; const size_t tok = (size_t)b * SEQ + t0 + tt;
            sq[tt][d] = bf2f(Q[tok * qld + hh * 128 + d]);
            if (IS_GLA) { float z = gkb[hh * 128 + d];
#pragma unroll
                for (int r = 0; r < GL_RANK; ++r) z += glow[tok * 16 + r] * gk2[r * GL_QK + hh * 128 + d];
                const float ls = fminf(z, 0.f) - log1pf(__expf(-fabsf(z)));
                sa[tt][d] = __expf(ls * (1.0f / 16.0f)); sk[tt][d] = bf2f(Kx[tok * qld + hh * 128 + d]); }
            else { const float a = __expf(LF[tok * qld + hh * 128 + d]); sa[tt][d] = a; sk[tt][d] = 1.0f - a; } }
        __syncthreads();
        for (int tt = 0; tt < T; ++tt) { const size_t tok = (size_t)b * SEQ + t0 + tt;
            const float vv = bf2f(V[tok * vld + hh * DV + v]); float o = 0.f;
#pragma unroll
            for (int d = 0; d < 128; ++d) { S[d] = sa[tt][d] * S[d] + sk[tt][d] * vv; o += sq[tt][d] * S[d]; }
            oraw[tok * D + ocol0 + hh * DV + v] = o; }
    }
}
__global__ void k_norm_gate(const float* __restrict__ oraw, const float* __restrict__ hg_norm, const float* __restrict__ gla_norm,
                            const bf16_t* __restrict__ hgg, const bf16_t* __restrict__ gg, bf16_t* __restrict__ mix) {
    const int w = blockIdx.x * 4 + (threadIdx.x >> 6), lane = threadIdx.x & 63; const int tok = w / 12, s = w % 12;
    const bool gla = s >= 8; const int dv = gla ? 256 : 128, col0 = gla ? 1024 + (s - 8) * 256 : s * 128;
    const float* o = oraw + (size_t)tok * D + col0; float x[4]; float ss = 0.f; const int n = dv / 64;
#pragma unroll
    for (int i = 0; i < 4; ++i) { x[i] = i < n ? o[lane + 64 * i] : 0.f; ss += x[i] * x[i]; }
    ss = wave_sum(ss); const float rstd = rsqrtf(ss / dv + EPS);
#pragma unroll
    for (int i = 0; i < 4; ++i) if (i < n) { const int c = lane + 64 * i; const float gain = gla ? gla_norm[c] : hg_norm[c];
        const float gate = gla ? bf2f(gg[(size_t)tok * 1024 + (s - 8) * 256 + c]) : bf2f(hgg[(size_t)tok * 1024 + s * 128 + c]);
        mix[(size_t)tok * D + col0 + c] = f2bf(x[i] * rstd * gain * gate); }
}

__global__ void k_kmean(const bf16_t* __restrict__ Kb, float* __restrict__ kmean) {
    const int n = blockIdx.x % MB_NBLK, hh = (blockIdx.x / MB_NBLK) % MB_H, b = blockIdx.x / (MB_NBLK * MB_H), d = threadIdx.x;
    float s = 0.f; const bf16_t* p = Kb + ((size_t)b * SEQ + n * MB_BLK) * D + hh * MB_DH + d;
    for (int j = 0; j < MB_BLK; ++j) s += bf2f(p[(size_t)j * D]);
    kmean[(size_t)blockIdx.x * MB_DH + d] = s * (1.0f / MB_BLK);
}
__global__ void k_moba_naive(const bf16_t* __restrict__ Qb, const bf16_t* __restrict__ Kb, const bf16_t* __restrict__ Vb, const float* __restrict__ kmean, bf16_t* __restrict__ AO) {
    __shared__ float sq[4][128]; __shared__ float sp[4][1024]; __shared__ int ssel[4][4];
    const int wv = threadIdx.x >> 6, lane = threadIdx.x & 63;
    const int qi = blockIdx.x * 4 + wv; const int t = qi % SEQ, hh = (qi / SEQ) % MB_H, b = qi / (SEQ * MB_H);
    const size_t tok = (size_t)b * SEQ + t; const int qb = t / MB_BLK;
    sq[wv][lane] = bf2f(Qb[tok * D + hh * MB_DH + lane]); sq[wv][lane + 64] = bf2f(Qb[tok * D + hh * MB_DH + lane + 64]);
    __syncthreads();
    float gate = -3.0e38f;
    if (lane < qb) { const float* km = kmean + ((size_t)(b * MB_H + hh) * MB_NBLK + lane) * MB_DH; float s = 0.f; for (int d = 0; d < 128; ++d) s += sq[wv][d] * km[d]; gate = s; }
    int nsel = qb < 3 ? qb : 3;
    for (int s = 0; s < 3; ++s) { float best = gate; int bi = lane;
        for (int o = 32; o > 0; o >>= 1) { const float ob = __shfl_xor(best, o); const int oi = __shfl_xor(bi, o); if (ob > best || (ob == best && oi < bi)) { best = ob; bi = oi; } }
        if (lane == 0) ssel[wv][s] = bi; if (lane == bi) gate = -3.4e38f; }
    __syncthreads();
    const float scale = 0.08838834764831845f;
    float mx = -3.0e38f;
    for (int sgi = 0; sgi <= nsel; ++sgi) { const int blk = sgi < nsel ? ssel[wv][sgi] : qb;
        for (int i = 0; i < 4; ++i) { const int j = lane + 64 * i, kp = blk * MB_BLK + j; float s = -__builtin_inff();
            if (sgi < nsel || kp <= t) { const bf16_t* kr = Kb + ((size_t)b * SEQ + kp) * D + hh * MB_DH; float a = 0.f;
                for (int d = 0; d < 128; d += 2) { const unsigned w = *(const unsigned*)(kr + d); a += sq[wv][d] * __uint_as_float(w << 16) + sq[wv][d + 1] * __uint_as_float(w & 0xFFFF0000u); }
                s = a * scale; }
            sp[wv][sgi * 256 + j] = s; mx = fmaxf(mx, s); } }
    for (int o = 32; o > 0; o >>= 1) mx = fmaxf(mx, __shfl_xor(mx, o));
    float den = 0.f;
    for (int sgi = 0; sgi <= nsel; ++sgi) for (int i = 0; i < 4; ++i) { const int idx = sgi * 256 + lane + 64 * i; const float p = __expf(sp[wv][idx] - mx); sp[wv][idx] = p; den += p; }
    den = wave_sum(den);
    __syncthreads();
    float o0 = 0.f, o1 = 0.f;
    for (int sgi = 0; sgi <= nsel; ++sgi) { const int blk = sgi < nsel ? ssel[wv][sgi] : qb; const int jmax = sgi < nsel ? 256 : (t - qb * MB_BLK + 1);
        for (int j = 0; j < jmax; ++j) { const float p = sp[wv][sgi * 256 + j]; const unsigned w = *(const unsigned*)(Vb + ((size_t)b * SEQ + blk * MB_BLK + j) * D + hh * MB_DH + lane * 2);
            o0 += p * __uint_as_float(w << 16); o1 += p * __uint_as_float(w & 0xFFFF0000u); } }
    const float inv = 1.0f / den;
    *(unsigned*)(AO + tok * D + hh * MB_DH + lane * 2) = (unsigned)f2bf(o0 * inv) | ((unsigned)f2bf(o1 * inv) << 16);
}

__global__ void k_moe_plan(unsigned* __restrict__ ctl, int* __restrict__ tile_e, int* __restrict__ rowtok) {
    __shared__ int base[NEXP + 1];
    if (threadIdx.x == 0) { int t = 0; for (int e = 0; e < NEXP; ++e) { base[e] = t; const int c = (int)ctl[CW_CNT + e]; const int nt = (c + MOE_TILE - 1) / MOE_TILE;
            for (int i = 0; i < nt; ++i) tile_e[t + i] = e; t += nt; ctl[CW_BASE + e] = (unsigned)(base[e] * MOE_TILE); ctl[CW_CUR + e] = 0u; }
        base[NEXP] = t; ctl[CW_NT] = (unsigned)t; for (int i = t; i < MOE_MAXT; ++i) tile_e[i] = -1; }
    __syncthreads();
    for (int i = threadIdx.x; i < MOE_ROWS; i += blockDim.x) rowtok[i] = 0;
}
__global__ void k_moe_scatter(const int* __restrict__ eid, unsigned* __restrict__ ctl, int* __restrict__ slot, int* __restrict__ rowtok) {
    const int i = blockIdx.x * blockDim.x + threadIdx.x; if (i >= NTOK * 2) return;
    const int e = eid[i]; const unsigned p = atomicAdd(&ctl[CW_CUR + e], 1u); const int s = (int)ctl[CW_BASE + e] + (int)p; slot[i] = s; rowtok[s] = i >> 1;
}
__global__ void k_moe_combine(float* __restrict__ h, const bf16_t* __restrict__ Y, const int* __restrict__ slot, const float* __restrict__ wgt) {
    const int row = blockIdx.x * 4 + (threadIdx.x >> 6), lane = threadIdx.x & 63;
    const int s0 = slot[row * 2], s1 = slot[row * 2 + 1]; const float w0 = wgt[row * 2], w1 = wgt[row * 2 + 1];
    for (int j = 0; j < 8; ++j) { const int c = j * 256 + lane * 4; float4 x = *(float4*)(h + (size_t)row * D + c);
        const ushort4 a = *(const ushort4*)(Y + (size_t)s0 * D + c), bb = *(const ushort4*)(Y + (size_t)s1 * D + c);
        x.x += w0 * bf2f(a.x) + w1 * bf2f(bb.x); x.y += w0 * bf2f(a.y) + w1 * bf2f(bb.y); x.z += w0 * bf2f(a.z) + w1 * bf2f(bb.z); x.w += w0 * bf2f(a.w) + w1 * bf2f(bb.w);
        *(float4*)(h + (size_t)row * D + c) = x; }
}


__device__ __forceinline__ int mk_lane() { int l; asm volatile("v_mbcnt_lo_u32_b32 %0, -1, 0\n\tv_mbcnt_hi_u32_b32 %0, -1, %0" : "=v"(l)); return l; }
#define XB_TMO      128
#define XB_XCNT(j)  (256  + 64 * (j))
#define XB_XSUB(j)  (1280 + 64 * (j))
#define XB_XGEN(j)  (2304 + 64 * (j))
#define XB_TOP      3328
#define XB_TOPGEN   3392
#define XCD_BAR_WORDS 3456
#define XB_SPIN_CAP (1u << 18)
#define LAS __attribute__((address_space(3)))

__device__ __forceinline__ unsigned xb_ld(unsigned* p)              { return __hip_atomic_load(p, __ATOMIC_RELAXED, __HIP_MEMORY_SCOPE_AGENT); }
__device__ __forceinline__ unsigned xb_add(unsigned* p, unsigned v) { return __hip_atomic_fetch_add(p, v, __ATOMIC_RELAXED, __HIP_MEMORY_SCOPE_AGENT); }
__device__ __forceinline__ unsigned xb_xcc_id() { return (unsigned)__builtin_amdgcn_s_getreg((3 << 11) | 20) & 0xFu; }
#define XB_SPIN(cond, bar) do { unsigned _sp = 0; while (cond) { __builtin_amdgcn_s_sleep(1); \
    if ((++_sp & 255u) == 0u) { if (xb_ld(&(bar)[XB_TMO])) break; if (_sp > XB_SPIN_CAP) { atomicAdd(&(bar)[XB_TMO], 1u); break; } } } } while (0)

struct XcdBarrier {
    unsigned* bar; unsigned x;
    unsigned w0;
    volatile LAS unsigned* st;
};

__device__ __forceinline__ XcdBarrier xcd_barrier_post(unsigned* bar, volatile LAS unsigned* st) {
    XcdBarrier b; b.bar = bar; b.x = xb_xcc_id(); b.st = st; b.w0 = (unsigned)__builtin_amdgcn_readfirstlane((int)(threadIdx.x < 64u));
    if (threadIdx.x == 0) (void)xb_add(&bar[XB_XCNT(b.x)], 1u);
    return b;
}
__device__ __forceinline__ void xcd_barrier_complete(unsigned* bar, unsigned x, unsigned& nloc, unsigned& nx) {
    const unsigned G = gridDim.x * gridDim.y * gridDim.z;
    unsigned sum, cnt, mine, sp = 0u;
    for (;;) {
        sum = 0u; cnt = 0u; mine = 0u;
#pragma unroll
        for (unsigned j = 0; j < 16; ++j) { const unsigned c = xb_ld(&bar[XB_XCNT(j)]); sum += c; cnt += (c > 0u) ? 1u : 0u; mine = (j == x) ? c : mine; }
        if (sum == G) break;
        __builtin_amdgcn_s_sleep(1);
        if ((++sp & 255u) == 0u) { if (xb_ld(&bar[XB_TMO])) break; if (sp > XB_SPIN_CAP) { atomicAdd(&bar[XB_TMO], 1u); break; } }
    }
    nloc = mine > 0u ? mine : 1u; nx = cnt > 0u ? cnt : 1u;
}

__device__ __forceinline__ void xcd_barrier(const XcdBarrier& b) {
    asm volatile("s_waitcnt vmcnt(0)" ::: "memory");
    __syncthreads();
    if (b.w0 && mk_lane() == 0) {
        unsigned* bar = b.bar;
        __builtin_amdgcn_s_waitcnt(0);
        unsigned nloc = b.st[0], nx = b.st[1];
        if (nloc == 0u) { xcd_barrier_complete(bar, b.x, nloc, nx); b.st[0] = nloc; b.st[1] = nx; }
        const unsigned old = xb_add(&bar[XB_XSUB(b.x)], 1u);
        const unsigned gen = old / nloc;
        if (old + 1u == (gen + 1u) * nloc) {
            __builtin_amdgcn_fence(__ATOMIC_RELEASE, "agent");
            asm volatile("s_waitcnt vmcnt(0)" ::: "memory");
            const unsigned og = xb_add(&bar[XB_TOP], 1u);
            const unsigned tg = og / nx;
            if (og + 1u == (tg + 1u) * nx) xb_add(&bar[XB_TOPGEN], 1u);
            else XB_SPIN(xb_ld(&bar[XB_TOPGEN]) == tg, bar);
            __builtin_amdgcn_fence(__ATOMIC_ACQUIRE, "agent");
            xb_add(&bar[XB_XGEN(b.x)], 1u);
            asm volatile("s_waitcnt vmcnt(0)" ::: "memory");
        } else {
            XB_SPIN(xb_ld(&bar[XB_XGEN(b.x)]) == gen, bar);
            __builtin_amdgcn_fence(__ATOMIC_ACQUIRE, "agent");
            asm volatile("s_waitcnt vmcnt(0)" ::: "memory");
        }
    }
    __syncthreads();
}


namespace pg8 {
#define PG8_LAS __attribute__((address_space(3)))
typedef unsigned short bf16_t;
typedef short bf16x8 __attribute__((ext_vector_type(8)));
typedef float f32x4 __attribute__((ext_vector_type(4)));
typedef unsigned u32x4 __attribute__((ext_vector_type(4)));
constexpr int BM = 256, BK = 64, HALF = 128, HTB = HALF * BK * 2  , STAGE_BYTES = 8 * HTB, NXCD = 8, WGM = 8;

__host__ __device__ __forceinline__ int lds_byte(int r, int c) { const int st = (r >> 4) * 2 + (c >> 5), rr = r & 15, cc = c & 31, ob = rr * 64 + cc * 2; return st * 1024 + (ob ^ (((ob >> 9) & 1) << 5)); }
__host__ __device__ __forceinline__ void stage_rc(int b, int& R, int& C) { const int st = b / 1024, sb = b % 1024, swz = sb ^ (((sb >> 9) & 1) << 5); R = (st >> 1) * 16 + swz / 64; C = (st & 1) * 32 + (swz % 64) / 2; }
__host__ __device__ __forceinline__ int perm32(int rho) { const int n = rho >> 4, i = rho & 15; return 8 * (i >> 2) + 4 * n + (i & 3); }

struct Unit { int pm, pn; };
struct Gemm { const bf16_t* A; const bf16_t* Bt; int M, N, K; const PG8_LAS int* rows = nullptr; };

struct StaticOrder {
    int nM, nN, nwg, G, c;
    __host__ __device__ void init(int M, int N, int G_, int c_) { nM = M / BM; nN = N / BM; nwg = nM * nN; G = G_; c = c_; }
    __host__ __device__ bool next(int i, Unit& u) const {
        const long L = (long)i * G + c; if (L >= nwg) return false;
        int wgid = (int)L; { const int q = nwg / NXCD, r = nwg % NXCD, xcd = wgid % NXCD, off = wgid / NXCD; wgid = (xcd < r ? xcd * (q + 1) : r * (q + 1) + (xcd - r) * q) + off; }
        const int nig = WGM * nN, gid = wgid / nig, fm = gid * WGM, gsz = (nM - fm) < WGM ? (nM - fm) : WGM;
        u.pm = fm + ((wgid % nig) % gsz); u.pn = (wgid % nig) / gsz; return true;
    }
    __device__ __forceinline__ void a_ready(const Unit&) const {}
    __device__ __forceinline__ void done(const Unit&) const {}
};

__device__ __forceinline__ unsigned cvt_pk_bf16(float lo, float hi) { unsigned r; asm volatile("v_cvt_pk_bf16_f32 %0, %1, %2" : "=v"(r) : "v"(lo), "v"(hi)); return r; }
template <class Epi, class Sched, bool ALIGN_EPI = false, bool SP2 = false, bool GATHER = false>
__device__ __forceinline__ void gemm_phase(PG8_LAS unsigned char* lds, const Gemm g, const Sched& S, const Epi& E, const int wid) {
    const int lane = mk_lane(), tid = wid * 64 + lane, wr = wid >> 2, wc = wid & 3, fr = lane & 15, fq = lane >> 4;
    const int K = g.K, nt = K / BK;
    unsigned voffA[2], voffB[2];
#pragma unroll
    for (int i = 0; i < 2; ++i) { int R, C; stage_rc(tid * 16 + i * 8192, R, C); const int Rb = Epi::PERM ? ((R & ~31) + perm32(R & 31)) : R;
        voffA[i] = (unsigned)(R * K + C) * 2u; voffB[i] = (unsigned)(Rb * K + C) * 2u; }
    unsigned vC[2][2], vN[2][2];
#define PG8_GROWS(V, UI) do { _Pragma("unroll") for (int _i = 0; _i < 2; ++_i) { int _R, _C; stage_rc(tid * 16 + _i * 8192, _R, _C); _Pragma("unroll") for (int _h = 0; _h < 2; ++_h) \
        V[_h][_i] = (unsigned)(g.rows[(UI) * 256 + _h * HALF + _R] * K + _C) * 2u; } } while (0)
#define PG8_STAGE_A(bufoff, gbase, h, NX) do { if constexpr (GATHER) { _Pragma("unroll") for (int _i = 0; _i < 2; ++_i) { const unsigned _o = (NX) ? vN[h][_i] : vC[h][_i]; \
        __builtin_amdgcn_global_load_lds((const unsigned*)((const char*)(gbase) + _o), (PG8_LAS unsigned*)(lds + (bufoff) + ldsw + _i * 8192), 16, 0, 0); } } \
        else { PG8_STAGE(bufoff, (gbase) + (h) * hstep, voffA); } } while (0)
    const size_t kstep = (size_t)(BK * 2);
    const size_t hstep = (size_t)HALF * K * 2;
    const size_t tstep = 2 * hstep;
    const unsigned ldsw = (unsigned)wid * 1024u;
    const int aoff = lds_byte(wr * 64 + fr, fq * 8), boff = lds_byte(wc * 32 + fr, fq * 8);
#define PG8_SA(b, h) (((b) * 2 + (h)) * HTB)
#define PG8_SB(b, h) ((4 + (b) * 2 + (h)) * HTB)
#define PG8_STAGE(bufoff, gbase, voff) do { _Pragma("unroll") for (int _i = 0; _i < 2; ++_i) \
        __builtin_amdgcn_global_load_lds((const unsigned*)((const char*)(gbase) + (voff)[_i]), (PG8_LAS unsigned*)(lds + (bufoff) + ldsw + _i * 8192), 16, 0, 0); } while (0)
#define PG8_LDA(dst, b, h) do { _Pragma("unroll") for (int m = 0; m < 4; ++m) _Pragma("unroll") for (int k = 0; k < 2; ++k) dst[m][k] = *(const PG8_LAS bf16x8*)(lds + PG8_SA(b, h) + aoff + m * 2048 + k * 1024); } while (0)
#define PG8_LDB(dst, b, h) do { _Pragma("unroll") for (int n = 0; n < 2; ++n) _Pragma("unroll") for (int k = 0; k < 2; ++k) dst[n][k] = *(const PG8_LAS bf16x8*)(lds + PG8_SB(b, h) + boff + n * 2048 + k * 1024); } while (0)
#define PG8_MMA(ai, bj, At, Bt) do { __builtin_amdgcn_s_setprio(1); _Pragma("unroll") for (int m = 0; m < 4; ++m) _Pragma("unroll") for (int n = 0; n < 2; ++n) _Pragma("unroll") for (int k = 0; k < 2; ++k) \
        acc[ai][bj][m][n] = __builtin_amdgcn_mfma_f32_16x16x32_bf16(Bt[n][k], At[m][k], acc[ai][bj][m][n], 0, 0, 0); __builtin_amdgcn_s_setprio(0); } while (0)
#define PG8_WAIT_V(n) asm volatile("s_waitcnt vmcnt(" #n ")" ::: "memory")
#define PG8_WAIT_L(n) asm volatile("s_waitcnt lgkmcnt(" #n ")" ::: "memory")
#define PG8_BAR __builtin_amdgcn_s_barrier()
#define PG8_SCHED __builtin_amdgcn_sched_barrier(0)
    Unit cur, nxt; int ui = 0;
    if (!S.next(0, cur)) return;
    f32x4 acc[2][2][4][2];
#pragma unroll
    for (int a = 0; a < 2; ++a)
#pragma unroll
        for (int b = 0; b < 2; ++b)
#pragma unroll
            for (int m = 0; m < 4; ++m)
#pragma unroll
                for (int n = 0; n < 2; ++n) acc[a][b][m][n] = (f32x4){0.f, 0.f, 0.f, 0.f};
    bf16x8 At[4][2], B0[2][2], B1[2][2];
    const char* cA = GATHER ? (const char*)g.A : (const char*)g.A + (size_t)cur.pm * tstep; const char* cB = (const char*)g.Bt + (size_t)cur.pn * tstep;
    if constexpr (GATHER) { PG8_GROWS(vC, 0); }
    S.a_ready(cur);
    if constexpr (SP2) {
        PG8_STAGE(PG8_SB(0, 0), cB, voffB); PG8_STAGE(PG8_SB(0, 1), cB + hstep, voffB); PG8_STAGE_A(PG8_SA(0, 0), cA, 0, false); PG8_STAGE_A(PG8_SA(0, 1), cA, 1, false);
        if (wr == 1) PG8_BAR;
        PG8_WAIT_V(2); PG8_BAR;
        PG8_STAGE(PG8_SB(1, 0), cB + kstep, voffB); PG8_STAGE_A(PG8_SA(1, 0), cA + kstep, 0, false); PG8_STAGE(PG8_SB(1, 1), cB + hstep + kstep, voffB);
        PG8_WAIT_V(6); PG8_BAR;
    } else {
        PG8_STAGE(PG8_SB(0, 0), cB, voffB); PG8_STAGE_A(PG8_SA(0, 0), cA, 0, false); PG8_STAGE(PG8_SB(0, 1), cB + hstep, voffB); PG8_STAGE_A(PG8_SA(0, 1), cA, 1, false);
        if (wr == 1) PG8_BAR;
        PG8_WAIT_V(4); PG8_BAR;
        PG8_STAGE(PG8_SB(1, 0), cB + kstep, voffB); PG8_STAGE_A(PG8_SA(1, 0), cA + kstep, 0, false); PG8_STAGE(PG8_SB(1, 1), cB + hstep + kstep, voffB);
        PG8_WAIT_V(6); PG8_BAR;
    }
    for (;;) {
        const bool has_next = S.next(ui + 1, nxt);
        const char* nA = GATHER ? cA : (has_next ? (const char*)g.A + (size_t)nxt.pm * tstep : cA);
        if constexpr (GATHER) { if (has_next) { PG8_GROWS(vN, ui + 1); } else { _Pragma("unroll") for (int _h = 0; _h < 2; ++_h) _Pragma("unroll") for (int _i = 0; _i < 2; ++_i) vN[_h][_i] = vC[_h][_i]; } }
        const char* nB = has_next ? (const char*)g.Bt + (size_t)nxt.pn * tstep : cB;
        for (int t = 0; t < nt; t += 2) {
            const bool last = (t == nt - 2);
            const char* a1 = cA + (size_t)(t + 1) * kstep;
            const char* a2 = last ? nA : cA + (size_t)(t + 2) * kstep; const char* b2 = last ? nB : cB + (size_t)(t + 2) * kstep;
            const char* a3 = a2 + kstep; const char* b3 = b2 + kstep;
            if (last && has_next) S.a_ready(nxt);
            if constexpr (SP2) {
            PG8_LDB(B0, 0, 0); PG8_LDB(B1, 0, 1); PG8_SCHED; PG8_LDA(At, 0, 0); PG8_STAGE_A(PG8_SA(1, 1), a1, 1, false);
            PG8_WAIT_V(8); PG8_WAIT_L(0); PG8_BAR; PG8_MMA(0, 0, At, B0); PG8_MMA(0, 1, At, B1); PG8_BAR; PG8_SCHED;
            PG8_LDA(At, 0, 1); PG8_STAGE(PG8_SB(0, 0), b2, voffB); PG8_STAGE(PG8_SB(0, 1), b2 + hstep, voffB); PG8_STAGE_A(PG8_SA(0, 0), a2, 0, last);
            PG8_WAIT_V(8); PG8_WAIT_L(0); PG8_BAR; PG8_MMA(1, 0, At, B0); PG8_MMA(1, 1, At, B1); PG8_BAR; PG8_SCHED;
            PG8_LDB(B0, 1, 0); PG8_LDB(B1, 1, 1); PG8_SCHED; PG8_LDA(At, 1, 0); PG8_STAGE_A(PG8_SA(0, 1), a2, 1, last);
            PG8_WAIT_V(8); PG8_WAIT_L(0); PG8_BAR; PG8_MMA(0, 0, At, B0); PG8_MMA(0, 1, At, B1); PG8_BAR; PG8_SCHED;
            PG8_LDA(At, 1, 1); PG8_STAGE(PG8_SB(1, 0), b3, voffB); PG8_STAGE(PG8_SB(1, 1), b3 + hstep, voffB); PG8_STAGE_A(PG8_SA(1, 0), a3, 0, last);
            PG8_WAIT_V(8); PG8_WAIT_L(0); PG8_BAR; PG8_MMA(1, 0, At, B0); PG8_MMA(1, 1, At, B1); PG8_BAR; PG8_SCHED;
            } else {
            PG8_LDB(B0, 0, 0); PG8_SCHED; PG8_LDA(At, 0, 0); PG8_STAGE_A(PG8_SA(1, 1), a1, 1, false);
            PG8_WAIT_L(8); PG8_BAR; PG8_WAIT_L(0); PG8_MMA(0, 0, At, B0); PG8_BAR; PG8_SCHED;
            PG8_LDB(B1, 0, 1); PG8_STAGE(PG8_SB(0, 0), b2, voffB);
            PG8_BAR; PG8_WAIT_L(0); PG8_MMA(0, 1, At, B1); PG8_BAR;
            PG8_LDA(At, 0, 1); PG8_STAGE_A(PG8_SA(0, 0), a2, 0, last);
            PG8_BAR; PG8_WAIT_L(0); PG8_MMA(1, 0, At, B0); PG8_BAR; PG8_SCHED;
            PG8_STAGE(PG8_SB(0, 1), b2 + hstep, voffB);
            PG8_WAIT_V(6); PG8_BAR; PG8_MMA(1, 1, At, B1); PG8_BAR;
            PG8_LDB(B0, 1, 0); PG8_SCHED; PG8_LDA(At, 1, 0); PG8_STAGE_A(PG8_SA(0, 1), a2, 1, last);
            PG8_WAIT_L(8); PG8_BAR; PG8_WAIT_L(0); PG8_MMA(0, 0, At, B0); PG8_BAR; PG8_SCHED;
            PG8_LDB(B1, 1, 1); PG8_STAGE(PG8_SB(1, 0), b3, voffB);
            PG8_BAR; PG8_WAIT_L(0); PG8_MMA(0, 1, At, B1); PG8_BAR;
            PG8_LDA(At, 1, 1); PG8_STAGE_A(PG8_SA(1, 0), a3, 0, last);
            PG8_BAR; PG8_WAIT_L(0); PG8_MMA(1, 0, At, B0); PG8_BAR; PG8_SCHED;
            PG8_STAGE(PG8_SB(1, 1), b3 + hstep, voffB);
            PG8_WAIT_V(6); PG8_BAR; PG8_MMA(1, 1, At, B1); PG8_BAR;
            }
        }
        if constexpr (ALIGN_EPI) { if (wr == 0) PG8_BAR; }
        if constexpr (!Epi::AFTER_DRAIN) { E(acc, cur, wr, wc, fr, fq); S.done(cur); }
        if (!has_next) break;
#pragma unroll
        for (int a = 0; a < 2; ++a)
#pragma unroll
            for (int b = 0; b < 2; ++b)
#pragma unroll
                for (int m = 0; m < 4; ++m)
#pragma unroll
                    for (int n = 0; n < 2; ++n) acc[a][b][m][n] = (f32x4){0.f, 0.f, 0.f, 0.f};
        cur = nxt; cA = nA; cB = nB; ++ui;
        if constexpr (GATHER) { _Pragma("unroll") for (int _h = 0; _h < 2; ++_h) _Pragma("unroll") for (int _i = 0; _i < 2; ++_i) vC[_h][_i] = vN[_h][_i]; }
        if constexpr (ALIGN_EPI) { if (wr == 1) PG8_BAR; }
    }
    PG8_WAIT_V(0);
    if constexpr (!ALIGN_EPI) { if (wr == 0) PG8_BAR; }
    PG8_BAR;
    if constexpr (Epi::AFTER_DRAIN) { E.fused(acc, cur, wr, wc, fr, fq, lds, wid, lane); S.done(cur); }
#undef PG8_SA
#undef PG8_SB
#undef PG8_STAGE
#undef PG8_STAGE_A
#undef PG8_GROWS
#undef PG8_LDA
#undef PG8_LDB
#undef PG8_MMA
#undef PG8_WAIT_V
#undef PG8_WAIT_L
#undef PG8_BAR
#undef PG8_SCHED
}
}

namespace moba {
constexpr int D = 128, LD = 2048;
constexpr bool WSKIP = false;
constexpr float THR = 8.f;
constexpr float SCALE = 0.08838834764831845f;
constexpr int NW = 8, QBLK = 32, KVBLK = 64, QB = NW * QBLK;
constexpr int SHM_V = KVBLK * D * 2, SHM_K = KVBLK * D * 2;
constexpr int ATT_LDS_BYTES = 2 * SHM_V + 2 * SHM_K + NW * 64 * 4;

using bf16 = unsigned short;
typedef short bf16x8 __attribute__((ext_vector_type(8)));
typedef short s16x4 __attribute__((ext_vector_type(4)));
typedef float f32x16 __attribute__((ext_vector_type(16)));
typedef float f32x4 __attribute__((ext_vector_type(4)));
typedef unsigned u32x4 __attribute__((ext_vector_type(4)));
template <class A, class Bt> struct same_t { static constexpr bool v = false; };
template <class A> struct same_t<A, A> { static constexpr bool v = true; };

#define KSWZ(row, colB) ((row) * 256 + ((colB) ^ (((row) & 7) << 4)))
#define SBAR() __builtin_amdgcn_sched_barrier(0)
__device__ __forceinline__ int v_st(int k, int c) { const int kk = (k & ~0xC) | ((k & 4) << 1) | ((k & 8) >> 1); return ((kk >> 3) * 4 + (c >> 5)) * 512 + ((kk & 7) * 32 + (c & 31)) * 2; }
__device__ __forceinline__ int v_rd_base(int lane) { return ((lane & 3) << 3) | (((lane >> 2) & 3) << 6) | (((lane >> 4) & 1) << 5) | (((lane >> 5) & 1) << 8); }
constexpr int v_rd_off(int d0, int ks, int half) { return d0 * 512 + ks * 4096 + half * 2048; }
__device__ __forceinline__ int crow(int r, int hi) { return (r & 3) + 8 * (r >> 2) + 4 * hi; }
__device__ __forceinline__ unsigned cvtpk(float lo, float hi) {
    unsigned r; asm volatile("v_cvt_pk_bf16_f32 %0, %1, %2" : "=v"(r) : "v"(lo), "v"(hi)); return r;
}
__device__ __forceinline__ bf16x8 pack8(f32x4 a, f32x4 b) {
    u32x4 w = {cvtpk(a[0], a[1]), cvtpk(a[2], a[3]), cvtpk(b[0], b[1]), cvtpk(b[2], b[3])};
    return *reinterpret_cast<bf16x8*>(&w);
}
template <class T> __device__ __forceinline__ bf16x8 load8(const T* p) {
    if constexpr (same_t<T, float>::v) { return pack8(*(const f32x4*)p, *(const f32x4*)(p + 4)); }
    else { return *reinterpret_cast<const bf16x8*>(p); }
}
__device__ __forceinline__ void mask_tile(f32x16& p0, f32x16& p1, int dq, unsigned W) {
    const float NEG = -__builtin_inff();
#pragma unroll
    for (int r = 0; r < 16; ++r) {
        const int c = (r & 3) + 8 * (r >> 2);
        if ((unsigned)(dq - c) >= W) p0[r] = NEG;
        if ((unsigned)(dq - c - 32) >= W) p1[r] = NEG;
    }
}
__device__ __forceinline__ void mask_block(f32x16& p0, f32x16& p1, bool keep) {
    const float NEG = -__builtin_inff();
#pragma unroll
    for (int r = 0; r < 16; ++r) { p0[r] = keep ? p0[r] : NEG; p1[r] = keep ? p1[r] : NEG; }
}
__device__ __forceinline__ void partialSM(f32x16& p0, f32x16& p1, float& m_reg, float& mn, float& alpha) {
    float pmax = p0[0]; for (int r = 1; r < 16; ++r) pmax = fmaxf(pmax, p0[r]); for (int r = 0; r < 16; ++r) pmax = fmaxf(pmax, p1[r]);
    { auto rr = __builtin_amdgcn_permlane32_swap(__float_as_uint(pmax), __float_as_uint(pmax), false, false);
      pmax = fmaxf(__uint_as_float(rr[0]), __uint_as_float(rr[1])); }
    constexpr float C2 = 1.4426950408889634f * SCALE;
    if (__builtin_expect(__all((pmax - m_reg) * SCALE <= THR), 1)) { mn = m_reg; alpha = 1.f; }
    else { mn = fmaxf(m_reg, pmax); alpha = __builtin_amdgcn_exp2f((m_reg - mn) * C2); m_reg = mn; }
    const float mnL = -mn * C2;
    for (int r = 0; r < 16; ++r) p0[r] = fmaf(p0[r], C2, mnL); for (int r = 0; r < 16; ++r) p1[r] = fmaf(p1[r], C2, mnL);
    for (int r = 0; r < 16; ++r) p0[r] = __builtin_amdgcn_exp2f(p0[r]);
}
__device__ __forceinline__ void finishSM(f32x16& p0, f32x16& p1, float alpha, float& l_reg, bf16x8& pa0, bf16x8& pa1, bf16x8& pa2, bf16x8& pa3) {
    for (int r = 0; r < 16; ++r) p1[r] = __builtin_amdgcn_exp2f(p1[r]);
    float ps = 0; for (int r = 0; r < 16; ++r) ps += p0[r]; for (int r = 0; r < 16; ++r) ps += p1[r];
    { auto rr = __builtin_amdgcn_permlane32_swap(__float_as_uint(ps), __float_as_uint(ps), false, false);
      ps = __uint_as_float(rr[0]) + __uint_as_float(rr[1]); }
    l_reg = l_reg * alpha + ps;
#define PK4(P, B_, OUT) do { unsigned a0 = cvtpk(P[B_+0], P[B_+1]), a1 = cvtpk(P[B_+2], P[B_+3]);                          \
        unsigned b0 = cvtpk(P[B_+4], P[B_+5]), b1 = cvtpk(P[B_+6], P[B_+7]);                                             \
        auto r0 = __builtin_amdgcn_permlane32_swap(a0, b0, false, false); auto r1 = __builtin_amdgcn_permlane32_swap(a1, b1, false, false); \
        u32x4 w = {r0[0], r1[0], r0[1], r1[1]}; OUT = *reinterpret_cast<bf16x8*>(&w); } while (0)
    PK4(p0, 0, pa0); PK4(p0, 8, pa1); PK4(p1, 0, pa2); PK4(p1, 8, pa3);
#undef PK4
}
template <int KB, bool SK>
__device__ __forceinline__ void qkt(f32x16& p0, f32x16& p1, const char* K_lds, int r32, int hi, const bf16x8* qr, bool act) {
    if (SK && !act) { const float NEG = -__builtin_inff();
#pragma unroll
        for (int r = 0; r < 16; ++r) { p0[r] = NEG; p1[r] = NEG; } return; }
    p0 = f32x16{}; p1 = f32x16{};
    const char* kb[4];
#pragma unroll
    for (int dd = 0; dd < 4; ++dd) kb[dd] = K_lds + KB * SHM_K + KSWZ(r32, (dd * 16 + hi * 8) * 2);
#pragma unroll
    for (int d0 = 0; d0 < 8; ++d0) { const char* a = kb[d0 & 3] + (d0 >> 2) * 128;
        bf16x8 b0 = *reinterpret_cast<const bf16x8*>(a);
        bf16x8 b1 = *reinterpret_cast<const bf16x8*>(a + 32 * 256);
        p0 = __builtin_amdgcn_mfma_f32_32x32x16_bf16(b0, qr[d0], p0, 0, 0, 0);
        p1 = __builtin_amdgcn_mfma_f32_32x32x16_bf16(b1, qr[d0], p1, 0, 0, 0); }
}
template <int VB, bool SK>
__device__ __forceinline__ void pv_tile(f32x16* o, int vb0, bf16x8 pa0, bf16x8 pa1, bf16x8 pa2, bf16x8 pa3, bool act) {
    if (SK && !act) return;
#define TRRD(dst, off) asm volatile("ds_read_b64_tr_b16 %0, %1 offset:%2" : "=&v"(dst) : "v"(vb0), "i"(off) : "memory")
#define PV_D0(d0) do { s16x4 l0, l1, h0, h1; constexpr int b_ = VB * SHM_V + v_rd_off(d0, 0, 0);     \
        TRRD(l0, b_); TRRD(h0, b_ + 2048); TRRD(l1, b_ + 4096); TRRD(h1, b_ + 6144);                                                               \
        asm volatile("s_waitcnt lgkmcnt(0)" ::: "memory"); SBAR();                 \
        o[d0] = __builtin_amdgcn_mfma_f32_32x32x16_bf16(pa0, (bf16x8){l0[0], l0[1], l0[2], l0[3], h0[0], h0[1], h0[2], h0[3]}, o[d0], 0, 0, 0);   \
        o[d0] = __builtin_amdgcn_mfma_f32_32x32x16_bf16(pa1, (bf16x8){l1[0], l1[1], l1[2], l1[3], h1[0], h1[1], h1[2], h1[3]}, o[d0], 0, 0, 0);   \
        SBAR(); TRRD(l0, b_ + 8192); TRRD(h0, b_ + 10240); TRRD(l1, b_ + 12288); TRRD(h1, b_ + 14336);                                             \
        asm volatile("s_waitcnt lgkmcnt(0)" ::: "memory"); SBAR();                                                                                 \
        o[d0] = __builtin_amdgcn_mfma_f32_32x32x16_bf16(pa2, (bf16x8){l0[0], l0[1], l0[2], l0[3], h0[0], h0[1], h0[2], h0[3]}, o[d0], 0, 0, 0);   \
        o[d0] = __builtin_amdgcn_mfma_f32_32x32x16_bf16(pa3, (bf16x8){l1[0], l1[1], l1[2], l1[3], h1[0], h1[1], h1[2], h1[3]}, o[d0], 0, 0, 0); } while (0)
    PV_D0(0); PV_D0(1); PV_D0(2); PV_D0(3);
#undef PV_D0
#undef TRRD
}

template <class TIn, class TOut> struct BlockRef { const TIn* Q; const TIn* K; const TIn* V; TOut* O; const float* KM; int P0; };
template <class TIn> struct Seam {
    bf16x8 qr[8];
    bf16x8 st_v0, st_v1, st_k0, st_k1; f32x4 sf0, sf1, sf2, sf3;
    f32x4 tq[16];
};
__device__ __forceinline__ int swa_jlo(int P0, int W) { const int lowk = P0 - W + 1; return lowk > 0 ? lowk / KVBLK : 0; }
#define ROW(p, k0, rr) ((p) + (size_t)((k0) + (rr)) * LD + sc)
#define VMW() asm volatile("s_waitcnt vmcnt(0)" ::: "memory")
#define VMWN(n) asm volatile("s_waitcnt vmcnt(%0)" :: "i"(n) : "memory")
#define SLOAD_H(Kp, Vp, k0) do { S.st_v0 = load8<TIn>(ROW(Vp, k0, sr)); S.st_v1 = load8<TIn>(ROW(Vp, k0, 32 + sr));              \
                         S.st_k0 = load8<TIn>(ROW(Kp, k0, sr)); S.st_k1 = load8<TIn>(ROW(Kp, k0, 32 + sr)); } while (0)
#define SWRITE_HK(bf) do { *(bf16x8*)(K_lds + (bf) * SHM_K + kws) = S.st_k0; *(bf16x8*)(K_lds + (bf) * SHM_K + kws + 32 * 256) = S.st_k1; } while (0)
#define SWRITE_HV(bf) do { *(bf16x8*)(V_lds + (bf) * SHM_V + vst0) = S.st_v0; *(bf16x8*)(V_lds + (bf) * SHM_V + vst1) = S.st_v1; } while (0)
#define SWRITE_H(bf) do { SWRITE_HV(bf); SWRITE_HK(bf); } while (0)
#define SLOAD_F(p, k0) do { S.sf0 = *(const f32x4*)ROW(p, k0, sr); S.sf1 = *(const f32x4*)(ROW(p, k0, sr) + 4);                \
                            S.sf2 = *(const f32x4*)ROW(p, k0, 32 + sr); S.sf3 = *(const f32x4*)(ROW(p, k0, 32 + sr) + 4); } while (0)
#define SWRITE_KF(bf) do { *(bf16x8*)(K_lds + (bf) * SHM_K + kws) = pack8(S.sf0, S.sf1); *(bf16x8*)(K_lds + (bf) * SHM_K + kws + 32 * 256) = pack8(S.sf2, S.sf3); } while (0)
#define SWRITE_VF(bf) do { *(bf16x8*)(V_lds + (bf) * SHM_V + vst0) = pack8(S.sf0, S.sf1); *(bf16x8*)(V_lds + (bf) * SHM_V + vst1) = pack8(S.sf2, S.sf3); } while (0)
template <class TIn, class TOut>
__device__ __forceinline__ void causal_swa_prime(const BlockRef<TIn, TOut>& cur, int W, char* lds, Seam<TIn>& S, const int wid) {
    constexpr bool F32 = same_t<TIn, float>::v;
    const int lane = mk_lane(), tid = wid * 64 + lane, r32 = lane & 31, hi = lane >> 5;
    const int sr = tid >> 4, sc = (tid & 15) * 8, kws = KSWZ(sr, sc * 2); char* K_lds = lds + 2 * SHM_V;
    const int kb0 = swa_jlo(cur.P0, W) * KVBLK;
    for (int d0 = 0; d0 < 8; ++d0) S.qr[d0] = load8<TIn>(cur.Q + (size_t)(wid * QBLK + r32) * LD + d0 * 16 + hi * 8);
    if constexpr (F32) { SLOAD_F((const float*)cur.K, kb0); VMW(); SWRITE_KF(0); SBAR(); SLOAD_F((const float*)cur.V, kb0); }
    else { SLOAD_H(cur.K, cur.V, kb0); VMW(); SWRITE_HK(0); }
    __syncthreads();
}
template <class TIn, class TOut>
__device__ __forceinline__ void causal_swa_block(const BlockRef<TIn, TOut>& cur, const BlockRef<TIn, TOut>& nxt, int skv, int W, char* lds, Seam<TIn>& S, const int wid) {
    constexpr bool F32 = same_t<TIn, float>::v;
    const int lane = mk_lane(), tid = wid * 64 + lane, r32 = lane & 31, hi = lane >> 5;
    const int j_lo = swa_jlo(cur.P0, W);
    int j_hi = (cur.P0 + QB - 1) / KVBLK + 1; if (j_hi > skv / KVBLK) j_hi = skv / KVBLK;
    const int NT = j_hi - j_lo;
    const int kbn = swa_jlo(nxt.P0, W) * KVBLK;
    const int qlo = cur.P0 + wid * QBLK, qm = qlo + r32 - 4 * hi;
    char* V_lds = lds; char* K_lds = lds + 2 * SHM_V;
    float* ws = (float*)(lds + 2 * SHM_V + 2 * SHM_K) + wid * 64; float* li_l = ws, * al_l = ws + 32;
    unsigned selmask;
    { const int nqb = cur.P0 >> 8;
      if (nqb <= 3) selmask = (1u << nqb) - 1u;
      else { float b0 = -__builtin_inff(), b1 = b0, b2 = b0; int i0 = 0, i1 = 0, i2 = 0;
        for (int n = 0; n < nqb; ++n) { const float* kp = cur.KM + n * 128 + hi * 8; float s = 0.f;
#pragma unroll
            for (int d0 = 0; d0 < 8; ++d0) { const f32x4 ka = *(const f32x4*)(kp + d0 * 16), kb = *(const f32x4*)(kp + d0 * 16 + 4); const u32x4 qw = __builtin_bit_cast(u32x4, S.qr[d0]);
                s += __uint_as_float(qw[0] << 16) * ka[0] + __uint_as_float(qw[0] & 0xFFFF0000u) * ka[1] + __uint_as_float(qw[1] << 16) * ka[2] + __uint_as_float(qw[1] & 0xFFFF0000u) * ka[3]
                   + __uint_as_float(qw[2] << 16) * kb[0] + __uint_as_float(qw[2] & 0xFFFF0000u) * kb[1] + __uint_as_float(qw[3] << 16) * kb[2] + __uint_as_float(qw[3] & 0xFFFF0000u) * kb[3]; }
            s += __shfl_xor(s, 32);
            if (s > b0) { b2 = b1; i2 = i1; b1 = b0; i1 = i0; b0 = s; i0 = n; } else if (s > b1) { b2 = b1; i2 = i1; b1 = s; i1 = n; } else if (s > b2) { b2 = s; i2 = n; } }
        selmask = (1u << i0) | (1u << i1) | (1u << i2); } }
    float m_reg = -1e30f, l_reg = 0; f32x16 o[4] = {};
    const int sr = tid >> 4, sc = (tid & 15) * 8, vst0 = v_st(sr, sc), vst1 = v_st(32 + sr, sc), kws = KSWZ(sr, sc * 2);
    const int vb0 = (int)(uintptr_t)V_lds + v_rd_base(lane);
    const TIn* Kh = cur.K; const TIn* Vh = cur.V;
#define RESC(a) do { if (__any((a) < 1.f)) { if (hi == 0) al_l[r32] = (a); asm volatile("s_waitcnt lgkmcnt(0)" ::: "memory");              \
                     for (int d_ = 0; d_ < 4; ++d_) for (int r = 0; r < 16; ++r) o[d_][r] *= al_l[crow(r, hi)]; } } while (0)
#define KBASE(t) ((j_lo + (t)) * KVBLK)
#define ACT(t) (KBASE(t) <= qlo + QBLK - 1 && KBASE(t) + KVBLK - 1 >= qlo - W + 1)
#define MASKT(P0_, P1_, t) do { const int kb_ = KBASE(t); if (kb_ + KVBLK - 1 > qlo) mask_tile(P0_, P1_, qm - kb_, (unsigned)W); \
        else if (kb_ < cur.P0 && cur.P0 > 3 * 256) mask_block(P0_, P1_, ((selmask >> (kb_ >> 8)) & 1u) != 0u); } while (0)
    constexpr int NQL = F32 ? 16 : 8;
    constexpr bool SK = WSKIP && !F32;
#define SEAM_K0() do { VMWN(NQL); if constexpr (F32) { SWRITE_KF(0); SBAR(); SLOAD_F((const float*)nxt.V, kbn); } else { SWRITE_HK(0); } SBAR(); } while (0)
    f32x16 pA0, pA1, pB0, pB1; float mnA, mnB, alA, alB; bf16x8 pa0, pa1, pa2, pa3;
    if constexpr (F32) { VMW(); SWRITE_VF(0); SBAR(); } else { SWRITE_HV(0); SBAR(); }
    if (NT > 1) { if constexpr (F32) SLOAD_F((const float*)Kh, KBASE(1)); else SLOAD_H(Kh, Vh, KBASE(1)); }
    SBAR(); qkt<0, SK>(pA0, pA1, K_lds, r32, hi, S.qr, ACT(0));
    if constexpr (F32) { if (NT > 1) { VMW(); SWRITE_KF(1); SBAR(); SLOAD_F((const float*)Vh, KBASE(1)); } }
    MASKT(pA0, pA1, 0); partialSM(pA0, pA1, m_reg, mnA, alA);
    if (NT > 1) { VMW(); if constexpr (F32) { SWRITE_VF(1); SBAR(); if (NT > 2) SLOAD_F((const float*)Kh, KBASE(2)); } else SWRITE_H(1); }
    __syncthreads();
#define HALF_STEP(PX0, PX1, mnX, alX, PY0, PY1, alY, t, KB, VB, SB) do {                                                      \
        SBAR(); qkt<KB, SK>(PX0, PX1, K_lds, r32, hi, S.qr, ACT(t));                                             \
        finishSM(PY0, PY1, alY, l_reg, pa0, pa1, pa2, pa3); SBAR();                                                           \
        if ((t) + 1 < NT) { if constexpr (F32) { VMW(); SWRITE_KF(SB); SBAR(); SLOAD_F((const float*)Vh, KBASE((t) + 1)); }  \
                            else { SLOAD_H(Kh, Vh, KBASE((t) + 1)); } SBAR(); }                                               \
        pv_tile<VB, SK>(o, vb0, pa0, pa1, pa2, pa3, ACT((t) - 1)); MASKT(PX0, PX1, (t)); partialSM(PX0, PX1, m_reg, mnX, alX);                                        \
        __syncthreads();                                                                                                      \
        if ((t) + 1 < NT) { VMW(); if constexpr (F32) { SWRITE_VF(SB); SBAR(); if ((t) + 2 < NT) SLOAD_F((const float*)Kh, KBASE((t) + 2)); } \
                            else { SWRITE_H(SB); } }                                                                          \
        RESC(alX); __syncthreads(); } while (0)
    for (int t = 1; t + 1 < NT; t += 2) {
        HALF_STEP(pB0, pB1, mnB, alB, pA0, pA1, alA, t, 1, 0, 0);
        HALF_STEP(pA0, pA1, mnA, alA, pB0, pB1, alB, t + 1, 0, 1, 1);
    }
    const bool even = (NT & 1) == 0;
    if (even) { SBAR(); qkt<1, SK>(pB0, pB1, K_lds, r32, hi, S.qr, ACT(NT - 1)); SBAR(); }
#define QROW(e) (nxt.Q + (size_t)(wid * QBLK + r32) * LD + ((e) >> 1) * 16 + hi * 8 + ((e) & 1) * 4)
    if constexpr (F32) { SLOAD_F((const float*)nxt.K, kbn); SBAR();
#pragma unroll
        for (int e = 0; e < 8; ++e) S.tq[e] = *(const f32x4*)QROW(e); }
    else { SLOAD_H(nxt.K, nxt.V, kbn); SBAR();
#pragma unroll
        for (int d0 = 0; d0 < 8; ++d0) S.qr[d0] = load8<TIn>(nxt.Q + (size_t)(wid * QBLK + r32) * LD + d0 * 16 + hi * 8); }
    SBAR();
    finishSM(pA0, pA1, alA, l_reg, pa0, pa1, pa2, pa3); SBAR();
    if constexpr (F32) {
#pragma unroll
        for (int e = 8; e < 16; ++e) S.tq[e] = *(const f32x4*)QROW(e); SBAR(); }
#undef QROW
    pv_tile<0, SK>(o, vb0, pa0, pa1, pa2, pa3, ACT(even ? NT - 2 : NT - 1));
    if (even) { MASKT(pB0, pB1, NT - 1); partialSM(pB0, pB1, m_reg, mnB, alB); __syncthreads(); RESC(alB);
        finishSM(pB0, pB1, alB, l_reg, pa0, pa1, pa2, pa3); SBAR(); pv_tile<1, SK>(o, vb0, pa0, pa1, pa2, pa3, ACT(NT - 1)); }
    SBAR(); SEAM_K0();
    if (hi == 0) li_l[r32] = l_reg; asm volatile("s_waitcnt lgkmcnt(0)" ::: "memory");
    float rli[16];
#pragma unroll
    for (int r = 0; r < 16; ++r) rli[r] = __builtin_amdgcn_rcpf(li_l[crow(r, hi)]);
    TOut* Ow = cur.O + (size_t)(wid * QBLK) * LD;
#pragma unroll
    for (int r = 0; r < 16; ++r) { const int orow = crow(r, hi);
#pragma unroll
        for (int d0 = 0; d0 < 4; ++d0) { const float v = o[d0][r] * rli[r];
            if constexpr (same_t<TOut, float>::v) { Ow[(size_t)orow * LD + d0 * 32 + r32] = v; }
            else { const float vn = __shfl_xor(v, 1);
                   if ((r32 & 1) == 0) *(unsigned*)(Ow + (size_t)orow * LD + d0 * 32 + r32) = cvtpk(v, vn); } } }
    if constexpr (F32) {
#pragma unroll
        for (int d0 = 0; d0 < 8; ++d0) S.qr[d0] = pack8(S.tq[2 * d0], S.tq[2 * d0 + 1]); }
    __syncthreads();
#undef RESC
#undef KBASE
#undef ACT
#undef MASKT
#undef SEAM_K0
#undef HALF_STEP
}
#undef ROW
#undef VMW
#undef VMWN
#undef SLOAD_H
#undef SWRITE_HK
#undef SWRITE_HV
#undef SWRITE_H
#undef SLOAD_F
#undef SWRITE_KF
#undef SWRITE_VF
}

#define LAS __attribute__((address_space(3)))
typedef float f32x4 __attribute__((ext_vector_type(4)));
typedef unsigned u32x4 __attribute__((ext_vector_type(4)));
typedef unsigned u32x2 __attribute__((ext_vector_type(2)));
constexpr int NTHR = 512, NWAVE = 8;
constexpr int RING_BYTES = 131072, LDS_MISC = 131072, LDS_BYTES = 147456;
constexpr int MI_BAR = 0;
constexpr int MI_NT = 16;
constexpr int MI_TILEE = 64;
constexpr int MI_EBASE = 1024;
constexpr int MI_RSTD = 2048;
constexpr int MI_LCNT = 2432;
constexpr int MI_WGOFF = 2560;
constexpr int MI_PART = 2688;
constexpr int MI_LOGIT = 4096;
constexpr size_t WS_RWT = WS_TOTAL;
constexpr size_t WS_XS_UNUSED = 0;
constexpr size_t WS_TOTAL2 = WS_RWT + (size_t)2 * 2048 * 48 * 4;
constexpr size_t WS_LA = WS_TOTAL2;
constexpr size_t WS_LRANK = WS_LA + (size_t)NTOK * GL_QK * 4;
constexpr size_t WS_WGCNT = WS_LRANK + (size_t)NTOK * 2 * 4;
constexpr size_t WS_TOTAL3 = WS_WGCNT + (size_t)2 * 256 * NEXP * 4;
constexpr int CW2_CNT0 = 1024, CW2_CUR0 = 1088, CW2_CNT1 = 1152, CW2_CUR1 = 1216;
constexpr int CW2_BAR = 2048;
constexpr int NBARREG = 4;
constexpr size_t CTL2_BYTES = (size_t)(CW2_BAR + NBARREG * XCD_BAR_WORDS) * 4;
static_assert(CTL2_BYTES <= CTL_BYTES, "ctl");
constexpr size_t U_XS = U_Y;

#define PROBE_ID (-1)
#define PROBE_BLOCK 0
#define PROBE_MULT 8
constexpr int MI_PROBE = 32;
#define PRB_B(L_, id) do { if (PROBE_ID == (id) && blockIdx.x == PROBE_BLOCK && threadIdx.x == 0) *(volatile LAS unsigned long long*)((L_) + LDS_MISC + MI_PROBE) -= __builtin_amdgcn_s_memrealtime(); } while (0)
#define PRB_E(L_, id) do { if (PROBE_ID == (id) && blockIdx.x == PROBE_BLOCK && threadIdx.x == 0) *(volatile LAS unsigned long long*)((L_) + LDS_MISC + MI_PROBE) += __builtin_amdgcn_s_memrealtime(); } while (0)
#define PRB_BEGIN(id) do { if (PROBE_ID == (id) && blockIdx.x == PROBE_BLOCK && threadIdx.x == 0) *(volatile LAS unsigned long long*)(F.lds + LDS_MISC + MI_PROBE) -= __builtin_amdgcn_s_memrealtime(); } while (0)
#define PRB_END(id)   do { if (PROBE_ID == (id) && blockIdx.x == PROBE_BLOCK && threadIdx.x == 0) *(volatile LAS unsigned long long*)(F.lds + LDS_MISC + MI_PROBE) += __builtin_amdgcn_s_memrealtime(); } while (0)
struct Args { const float* in[20]; float* out; unsigned char* ws; int ph_lo, ph_hi, bar_idx, pad; };

DI const Args* ka_launder() { const Args* p = (const Args*)__builtin_amdgcn_kernarg_segment_ptr(); asm volatile("" : "+s"(p)); return p; }
struct Frame {
    LAS unsigned char* lds; int tid, lane, wave, G, bx, vcu;
    unsigned char* ws; unsigned* ctl;
};

DI unsigned pk_bf16(float lo, float hi) { unsigned r; asm volatile("v_cvt_pk_bf16_f32 %0, %1, %2" : "=v"(r) : "v"(lo), "v"(hi)); return r; }
DI float fast_sigmoid(float x) { return __builtin_amdgcn_rcpf(1.0f + __expf(-x)); }

struct EpiProj0F { static constexpr bool PERM = true, AFTER_DRAIN = false;
    bf16_t* hq; float* hlf; bf16_t* hi; bf16_t* hgg; bf16_t* gq; bf16_t* gk; bf16_t* gv; bf16_t* gg; const float* lb;
    DI void operator()(const f32x4 (&acc)[2][2][4][2], const pg8::Unit& u, int wr, int wc, int fr, int fq) const {
        const int colt = u.pn * 256, seg = colt >> 10, row0 = u.pm * 256 + wr * 64 + fr, cl = (colt & 1023) + wc * 32 + 8 * fq;
        if (seg == 1) {
            f32x4 l0[2], l1[2];
#pragma unroll
            for (int bj = 0; bj < 2; ++bj) { l0[bj] = *(const f32x4*)(lb + cl + bj * 128); l1[bj] = *(const f32x4*)(lb + cl + bj * 128 + 4); }
#pragma unroll
            for (int ai = 0; ai < 2; ++ai)
#pragma unroll
                for (int m = 0; m < 4; ++m) { float* rowp = hlf + (size_t)(row0 + ai * 128 + m * 16) * 1024 + cl;
#pragma unroll
                    for (int bj = 0; bj < 2; ++bj) { f32x4 v0 = acc[ai][bj][m][0], v1 = acc[ai][bj][m][1];
#pragma unroll
                        for (int j = 0; j < 4; ++j) { v0[j] = __logf(l0[bj][j] + (1.0f - l0[bj][j]) * fast_sigmoid(v0[j])); v1[j] = __logf(l1[bj][j] + (1.0f - l1[bj][j]) * fast_sigmoid(v1[j])); }
                        *(f32x4*)(rowp + bj * 128) = v0; *(f32x4*)(rowp + bj * 128 + 4) = v1; } }
            return;
        }
        bf16_t* dst; int ld = 1024, co = cl; bool silu = false; float sc = 1.0f;
        if (seg == 0) { dst = hq; silu = true; sc = 0.08838834764831845f; }
        else if (seg == 2) dst = hi;
        else if (seg == 3) { dst = hgg; silu = true; }
        else if (seg == 4) { ld = 512; if ((colt & 1023) < 512) { dst = gq; sc = 0.08838834764831845f; } else { dst = gk; co = cl - 512; } }
        else if (seg == 5) dst = gv;
        else { dst = gg; silu = true; }
#pragma unroll
        for (int ai = 0; ai < 2; ++ai)
#pragma unroll
            for (int m = 0; m < 4; ++m) { bf16_t* rowp = dst + (size_t)(row0 + ai * 128 + m * 16) * ld + co;
#pragma unroll
                for (int bj = 0; bj < 2; ++bj) { f32x4 v0 = acc[ai][bj][m][0], v1 = acc[ai][bj][m][1];
                    if (silu) {
#pragma unroll
                        for (int j = 0; j < 4; ++j) { v0[j] *= fast_sigmoid(v0[j]); v1[j] *= fast_sigmoid(v1[j]); } }
                    v0 = v0 * sc; v1 = v1 * sc;
                    u32x4 w; w.x = pk_bf16(v0[0], v0[1]); w.y = pk_bf16(v0[2], v0[3]); w.z = pk_bf16(v1[0], v1[1]); w.w = pk_bf16(v1[2], v1[3]);
                    *(u32x4*)(rowp + bj * 128) = w; } }
    } };
struct EpiResidF { static constexpr bool PERM = false, AFTER_DRAIN = false;
    const float* res; float* out;
    DI void operator()(const f32x4 (&acc)[2][2][4][2], const pg8::Unit& u, int wr, int wc, int fr, int fq) const {
        const int row0 = u.pm * 256 + wr * 64 + fr, col0 = u.pn * 256 + wc * 32 + 4 * fq;
#pragma unroll
        for (int ai = 0; ai < 2; ++ai)
#pragma unroll
            for (int m = 0; m < 4; ++m) { const size_t ro = (size_t)(row0 + ai * 128 + m * 16) * D + col0;
#pragma unroll
                for (int bj = 0; bj < 2; ++bj)
#pragma unroll
                    for (int n = 0; n < 2; ++n) { const f32x4 r = *(const f32x4*)(res + ro + bj * 128 + n * 16); *(f32x4*)(out + ro + bj * 128 + n * 16) = r + acc[ai][bj][m][n]; } }
    } };
struct EpiBf16F { static constexpr bool PERM = true, AFTER_DRAIN = false;
    bf16_t* O; int ldc, nct, split_tiles; size_t split_stride;
    DI void operator()(const f32x4 (&acc)[2][2][4][2], const pg8::Unit& u, int wr, int wc, int fr, int fq) const {
        int ct = u.pn % nct; bf16_t* base = O; if (split_tiles) { const int t = ct / split_tiles; base += (size_t)t * split_stride; ct -= t * split_tiles; }
        const int row0 = u.pm * 256 + wr * 64 + fr, col0 = ct * 256 + wc * 32 + 8 * fq;
#pragma unroll
        for (int ai = 0; ai < 2; ++ai)
#pragma unroll
            for (int m = 0; m < 4; ++m) { bf16_t* rowp = base + (size_t)(row0 + ai * 128 + m * 16) * ldc + col0;
#pragma unroll
                for (int bj = 0; bj < 2; ++bj) { const f32x4 v0 = acc[ai][bj][m][0], v1 = acc[ai][bj][m][1];
                    u32x4 w; w.x = pk_bf16(v0[0], v0[1]); w.y = pk_bf16(v0[2], v0[3]); w.z = pk_bf16(v1[0], v1[1]); w.w = pk_bf16(v1[2], v1[3]);
                    *(u32x4*)(rowp + bj * 128) = w; } }
    } };
struct EpiSwigluF { static constexpr bool PERM = true, AFTER_DRAIN = false;
    bf16_t* O;
    DI void operator()(const f32x4 (&acc)[2][2][4][2], const pg8::Unit& u, int wr, int wc, int fr, int fq) const {
        const int row0 = u.pm * 256 + wr * 64 + fr, col0 = (u.pn & 3) * 128 + wc * 32 + 8 * fq;
#pragma unroll
        for (int ai = 0; ai < 2; ++ai)
#pragma unroll
            for (int m = 0; m < 4; ++m) { bf16_t* rowp = O + (size_t)(row0 + ai * 128 + m * 16) * DEXP + col0;
                f32x4 a0 = acc[ai][0][m][0], a1 = acc[ai][0][m][1]; const f32x4 b0 = acc[ai][1][m][0], b1 = acc[ai][1][m][1];
#pragma unroll
                for (int j = 0; j < 4; ++j) { a0[j] = a0[j] * fast_sigmoid(a0[j]) * b0[j]; a1[j] = a1[j] * fast_sigmoid(a1[j]) * b1[j]; }
                u32x4 w; w.x = pk_bf16(a0[0], a0[1]); w.y = pk_bf16(a0[2], a0[3]); w.z = pk_bf16(a1[0], a1[1]); w.w = pk_bf16(a1[2], a1[3]);
                *(u32x4*)rowp = w; }
    } };
struct MoeOrder {
    int nN, shift, nunits, G, c; const LAS int* tile_e;
    DI bool next(int i, pg8::Unit& u) const { const long L = (long)i * G + c; if (L >= nunits) return false; const int t = (int)L >> shift, pn = (int)L & (nN - 1);
        u.pm = t; u.pn = tile_e[t] * nN + pn; return true; }
    DI void a_ready(const pg8::Unit&) const {}
    DI void done(const pg8::Unit&) const {}
};

struct TJob { const float* src; bf16_t* dst; int ld, Kd, k0, n0, mode, half; };
DI void tjob_decode(int j, const Args& a, unsigned char* ws, TJob& t) {
    const float* w_in = a.in[4]; const float* w_out = a.in[10]; const float* w_qkv = a.in[11]; const float* w_o = a.in[12];
    const float* ew1 = a.in[17]; const float* ew3 = a.in[18]; const float* ew2 = a.in[19];
    t.mode = 0; t.half = 0;
    if (j < 896) { t.src = w_in; t.dst = (bf16_t*)(ws + WS_WIN); t.ld = EVEN_IN; t.Kd = D; t.k0 = (j / 56) * 128; t.n0 = (j % 56) * 128; return; }
    j -= 896;
    if (j < 256) { t.src = w_out; t.dst = (bf16_t*)(ws + WS_WOUT); t.ld = D; t.Kd = D; t.k0 = (j / 16) * 128; t.n0 = (j % 16) * 128; return; }
    j -= 256;
    if (j < 768) { t.src = w_qkv; t.dst = (bf16_t*)(ws + WS_WQKV); t.ld = 3 * D; t.Kd = D; t.k0 = (j / 48) * 128; t.n0 = (j % 48) * 128; return; }
    j -= 768;
    if (j < 256) { t.src = w_o; t.dst = (bf16_t*)(ws + WS_WO); t.ld = D; t.Kd = D; t.k0 = (j / 16) * 128; t.n0 = (j % 16) * 128; return; }
    j -= 256;
    const int le = j / 192, r = j % 192;
    if (r < 128) { const int hf = r / 64, q = r % 64; t.src = (hf ? ew3 : ew1) + (size_t)le * D * DEXP; t.dst = (bf16_t*)(ws + WS_WUP) + (size_t)le * 1024 * D; t.ld = DEXP; t.Kd = D;
        t.k0 = (q / 4) * 128; t.n0 = (q % 4) * 128; t.mode = 1; t.half = hf; return; }
    { const int q = r - 128; t.src = ew2 + (size_t)le * DEXP * D; t.dst = (bf16_t*)(ws + WS_WDN) + (size_t)le * D * DEXP; t.ld = D; t.Kd = DEXP; t.k0 = (q / 16) * 128; t.n0 = (q % 16) * 128; }
}
constexpr int N_TJOBS = 896 + 256 + 768 + 256 + 64 * 192;
DI void tjob_load(const TJob& t, int tid, f32x4 (&r)[8]) {
    const int c4 = (tid & 31) * 4, r0 = tid >> 5;
#pragma unroll
    for (int i = 0; i < 8; ++i) r[i] = *(const f32x4*)(t.src + (size_t)(t.k0 + r0 + 16 * i) * t.ld + t.n0 + c4);
}
DI void phase_transposes(const Frame& F, const Args& a, int j_lo, int j_hi, int widx, int nwork) {
    LAS float* T = (LAS float*)F.lds;
    const int tid = F.tid; int ja = j_lo + widx; if (ja >= j_hi) return;
    int jb = ja + nwork;
    TJob ta, tb; f32x4 ra[8], rb[8];
    tjob_decode(ja, a, F.ws, ta); tjob_load(ta, tid, ra);
    if (jb < j_hi) { tjob_decode(jb, a, F.ws, tb); tjob_load(tb, tid, rb); }
#define TR_PROC(R, TJ, J) do {                                                                                                     \
        const int c4_ = (tid & 31) * 4, r0_ = tid >> 5;                                                                           \
        _Pragma("unroll") for (int i = 0; i < 8; ++i) *(LAS f32x4*)(T + (r0_ + 16 * i) * 132 + c4_) = R[i];                        \
        const TJob cur_ = TJ; J += 2 * nwork;                                                                                      \
        if (J < j_hi) { tjob_decode(J, a, F.ws, TJ); tjob_load(TJ, tid, R); }                                                      \
        __syncthreads();                                                                                                           \
        { const int n_ = tid & 127, kg_ = tid >> 7; const int nn_ = cur_.n0 + n_;                                                  \
          const int drow_ = cur_.mode == 0 ? nn_ : (nn_ / 128) * 256 + cur_.half * 128 + (nn_ % 128);                              \
          bf16_t* dp_ = cur_.dst + (size_t)drow_ * cur_.Kd + cur_.k0 + kg_ * 32;                                                   \
          _Pragma("unroll") for (int q = 0; q < 4; ++q) { float v_[8];                                                            \
              _Pragma("unroll") for (int e = 0; e < 8; ++e) v_[e] = T[(kg_ * 32 + q * 8 + e) * 132 + n_];                          \
              u32x4 w_; w_.x = pk_bf16(v_[0], v_[1]); w_.y = pk_bf16(v_[2], v_[3]); w_.z = pk_bf16(v_[4], v_[5]); w_.w = pk_bf16(v_[6], v_[7]); \
              *(u32x4*)(dp_ + q * 8) = w_; } }                                                                                     \
        __syncthreads(); } while (0)
    for (;;) {
        TR_PROC(ra, ta, ja);
        if (jb >= j_hi) break;
        TR_PROC(rb, tb, jb);
        if (ja >= j_hi) break;
    }
#undef TR_PROC
}
DI void phase_tables(const Frame& F, const Args& a) {
    const int gt = F.bx * NTHR + F.tid, gn = F.G * NTHR;
    float* LB = (float*)(F.ws + SM_LB); const float* lg = a.in[5];
    for (int d = gt; d < HG_QK; d += gn) { const float x = lg[d], y = lg[HG_QK + d], z = lg[2 * HG_QK + d], m = fmaxf(x, fmaxf(y, z));
        const float ex = __expf(x - m), ey = __expf(y - m), ez = __expf(z - m); LB[d] = ex / (ex + ey + ez); }
    float* RWT = (float*)(F.ws + WS_RWT);
    for (int i = gt; i < 2 * 2048 * 48; i += gn) { const int l = i / (2048 * 48), r = i % (2048 * 48); const int jj = r & 3, ln = (r >> 2) & 63, nt = (r >> 8) % 3, s = r / 768;
        const int k = 16 * s + 4 * (ln >> 4) + jj, n = 16 * nt + (ln & 15);
        float w = 0.f; if (n < 4) w = a.in[13][((size_t)l * D + k) * NGRP + n]; else if (n < 36) w = a.in[15][((size_t)l * D + k) * NEXP + (n - 4)];
        RWT[i] = w * a.in[2][l * D + k]; }
}

template <int MODE, bool COMBINE>
DI void phase_norm(const Frame& F, const float* src, float* hdst, const float* gain, bf16_t* xn, float* fout,
                   const bf16_t* Y, const int* slot, const float* wgt,
                   const float* w_in, float* glow, const float* rwt, const float* bg, const float* be, int* eid, float* wgt_out, unsigned* cnt,
                   const float* gk2 = nullptr, const float* gkb = nullptr, float* la = nullptr, int* lrank = nullptr) {
    const int lane = F.lane, w = F.wave;
    LAS float* rs = (LAS float*)(F.lds + LDS_MISC + MI_RSTD); LAS float* lgt = (LAS float*)(F.lds + LDS_MISC + MI_LOGIT);
    LAS f32x4* part = MODE == 1 ? (LAS f32x4*)(F.lds + LDS_MISC + MI_LOGIT + 4096) : (LAS f32x4*)F.lds;
    if (MODE == 1) {
        for (int q = 0; q < 64; ++q) { const int idx = F.tid + NTHR * q; const int jj = idx & 3, ln = (idx >> 2) & 63, s = idx >> 8; const int k = 16 * s + 4 * (ln >> 4) + jj;
            ((LAS float*)F.lds)[idx] = w_in[(size_t)k * EVEN_IN + EVEN_MAIN + (ln & 15)] * gain[k]; }
        __syncthreads(); }
    if (MODE == 2) { if (F.tid < NEXP) ((LAS int*)(F.lds + LDS_MISC + MI_LCNT))[F.tid] = 0; __syncthreads(); }
    for (int rb = F.bx; rb < NTOK / 64; rb += F.G) {
        const int r0 = rb * 64;
        PRB_BEGIN(100);
#pragma unroll 1
        for (int i = 0; i < 8; ++i) { const int row = r0 + w * 8 + i; const float* hr = src + (size_t)row * D;
            f32x4 v[8];
#pragma unroll
            for (int j = 0; j < 8; ++j) v[j] = *(const f32x4*)(hr + j * 256 + lane * 4);
            if (COMBINE) { const int s0 = slot[row * 2], s1 = slot[row * 2 + 1]; const float w0 = wgt[row * 2], w1 = wgt[row * 2 + 1];
#pragma unroll
                for (int j = 0; j < 8; ++j) { const u32x2 ya = *(const u32x2*)(Y + (size_t)s0 * D + j * 256 + lane * 4), yb = *(const u32x2*)(Y + (size_t)s1 * D + j * 256 + lane * 4);
                    v[j][0] += w0 * __uint_as_float(ya[0] << 16) + w1 * __uint_as_float(yb[0] << 16); v[j][1] += w0 * __uint_as_float(ya[0] & 0xFFFF0000u) + w1 * __uint_as_float(yb[0] & 0xFFFF0000u);
                    v[j][2] += w0 * __uint_as_float(ya[1] << 16) + w1 * __uint_as_float(yb[1] << 16); v[j][3] += w0 * __uint_as_float(ya[1] & 0xFFFF0000u) + w1 * __uint_as_float(yb[1] & 0xFFFF0000u); }
                if (MODE != 3) {
#pragma unroll
                    for (int j = 0; j < 8; ++j) *(f32x4*)(hdst + (size_t)row * D + j * 256 + lane * 4) = v[j]; } }
            float ss = 0.f;
#pragma unroll
            for (int j = 0; j < 8; ++j) ss += v[j][0] * v[j][0] + v[j][1] * v[j][1] + v[j][2] * v[j][2] + v[j][3] * v[j][3];
            ss = wave_sum(ss); const float rstd = rsqrtf(ss * (1.0f / D) + EPS);
            if (MODE == 1 || MODE == 2) { if (lane == 0) rs[w * 8 + i] = rstd; }
#pragma unroll
            for (int j = 0; j < 8; ++j) { const f32x4 g4 = *(const f32x4*)(gain + j * 256 + lane * 4); const f32x4 o = v[j] * g4 * rstd;
                if (MODE == 3) *(f32x4*)(fout + (size_t)row * D + j * 256 + lane * 4) = o;
                else { u32x2 p; p[0] = pk_bf16(o[0], o[1]); p[1] = pk_bf16(o[2], o[3]); *(u32x2*)(xn + (size_t)row * D + j * 256 + lane * 4) = p; } }
        }
        PRB_END(100);
        if (MODE == 1 || MODE == 2) {
            constexpr int NT = MODE == 2 ? 3 : 1;
            PRB_BEGIN(101);
            __builtin_amdgcn_fence(__ATOMIC_RELEASE, "workgroup"); __syncthreads(); __builtin_amdgcn_fence(__ATOMIC_ACQUIRE, "workgroup");
            const int rg = w & 3, kh = w >> 2, m = lane & 15, kq = lane >> 4;
            const float* xr = (COMBINE ? hdst : src) + (size_t)(r0 + rg * 16 + m) * D + 4 * kq;
            f32x4 acc[NT];
#pragma unroll
            for (int t = 0; t < NT; ++t) acc[t] = (f32x4){0.f, 0.f, 0.f, 0.f};
            constexpr int UN = 4;
#pragma unroll 1
            for (int s0 = kh * 64; s0 < kh * 64 + 64; s0 += UN) {
                f32x4 xa[UN], wb[UN][NT];
#pragma unroll
                for (int u = 0; u < UN; ++u) { xa[u] = *(const f32x4*)(xr + 16 * (s0 + u));
                    if (MODE == 2) {
#pragma unroll
                        for (int t = 0; t < NT; ++t) wb[u][t] = *(const f32x4*)(rwt + ((size_t)((s0 + u) * 3 + t) * 64 + lane) * 4); }
                    else wb[u][0] = *(const LAS f32x4*)(F.lds + ((s0 + u) * 64 + lane) * 16); }
#pragma unroll
                for (int u = 0; u < UN; ++u)
#pragma unroll
                    for (int j = 0; j < 4; ++j)
#pragma unroll
                        for (int t = 0; t < NT; ++t) acc[t] = __builtin_amdgcn_mfma_f32_16x16x4f32(xa[u][j], wb[u][t][j], acc[t], 0, 0, 0);
            }
            PRB_END(101); PRB_BEGIN(102);
            if (kh == 1) {
#pragma unroll
                for (int t = 0; t < NT; ++t) part[(rg * NT + t) * 64 + lane] = acc[t]; }
            __syncthreads();
            if (kh == 0) {
#pragma unroll
                for (int t = 0; t < NT; ++t) { const f32x4 p = part[(rg * NT + t) * 64 + lane];
#pragma unroll
                    for (int q = 0; q < 4; ++q) { const int rl = rg * 16 + 4 * kq + q; const float val = (acc[t][q] + p[q]) * rs[rl];
                        if (MODE == 1) { glow[(size_t)(r0 + rl) * 16 + m] = val; lgt[rl * 16 + m] = val; } else lgt[rl * 48 + t * 16 + m] = val; } } }
            __syncthreads();
            if (MODE == 1) {
                const int col = F.tid; float g2[GL_RANK];
#pragma unroll
                for (int r = 0; r < GL_RANK; ++r) g2[r] = gk2[r * GL_QK + col];
                const float bias = gkb[col];
                for (int rl = 0; rl < 64; ++rl) { float z = bias;
#pragma unroll
                    for (int r = 0; r < GL_RANK; ++r) z += lgt[rl * 16 + r] * g2[r];
                    const float ls = fminf(z, 0.f) - __logf(1.0f + __expf(-fabsf(z)));
                    la[(size_t)(r0 + rl) * GL_QK + col] = ls * (1.0f / 16.0f); } }
            if (MODE == 2 && F.tid < 64) {
                const int row = r0 + F.tid; const LAS float* lr = lgt + F.tid * 48;
                float lg[4], e8[8];
#pragma unroll
                for (int c = 0; c < 4; ++c) lg[c] = lr[c] + bg[c];
                int grp = 0; float mx = lg[0];
#pragma unroll
                for (int c = 1; c < 4; ++c) if (lg[c] > mx) { mx = lg[c]; grp = c; }
                float den = 0.f;
#pragma unroll
                for (int c = 0; c < 4; ++c) den += __expf(lg[c] - mx);
                const float pg = 1.0f / den;
#pragma unroll
                for (int c = 0; c < 8; ++c) e8[c] = lr[4 + grp * 8 + c] + be[grp * 8 + c];
                int j0 = 0; float v0 = e8[0];
#pragma unroll
                for (int c = 1; c < 8; ++c) if (e8[c] > v0) { v0 = e8[c]; j0 = c; }
                int j1 = 0; float v1 = -3.0e38f;
#pragma unroll
                for (int c = 0; c < 8; ++c) if (c != j0 && e8[c] > v1) { v1 = e8[c]; j1 = c; }
                const float e1 = __expf(v1 - v0), sden = 1.0f / (1.0f + e1);
                const int ea = grp * 8 + j0, eb = grp * 8 + j1;
                eid[row * 2] = ea; eid[row * 2 + 1] = eb; wgt_out[row * 2] = pg * sden; wgt_out[row * 2 + 1] = pg * e1 * sden;
                LAS int* lcnt = (LAS int*)(F.lds + LDS_MISC + MI_LCNT);
                lrank[row * 2] = __hip_atomic_fetch_add(lcnt + ea, 1, __ATOMIC_RELAXED, __HIP_MEMORY_SCOPE_WORKGROUP);
                lrank[row * 2 + 1] = __hip_atomic_fetch_add(lcnt + eb, 1, __ATOMIC_RELAXED, __HIP_MEMORY_SCOPE_WORKGROUP);
            }
            __syncthreads();
            if (MODE == 2 && F.tid < NEXP) { LAS int* lcnt = (LAS int*)(F.lds + LDS_MISC + MI_LCNT); ((int*)cnt)[rb * NEXP + F.tid] = lcnt[F.tid]; lcnt[F.tid] = 0; }
            PRB_END(102);
        }
    }
}

DI void moe_plan(const Frame& F, const int* wgcnt, int rb) {
    LAS int* tile_e = (LAS int*)(F.lds + LDS_MISC + MI_TILEE); LAS int* ebase = (LAS int*)(F.lds + LDS_MISC + MI_EBASE); LAS int* ntp = (LAS int*)(F.lds + LDS_MISC + MI_NT);
    LAS int* part = (LAS int*)(F.lds + LDS_MISC + MI_PART); LAS int* wgoff = (LAS int*)(F.lds + LDS_MISC + MI_WGOFF); LAS int* tot = (LAS int*)(F.lds + LDS_MISC + MI_LCNT);
    { const int e = F.tid & 31, pt = F.tid >> 5; int sum = 0, pre = 0;
#pragma unroll
      for (int q = 0; q < 16; ++q) { const int r = pt * 16 + q; const int c = wgcnt[r * NEXP + e]; if (r < rb) pre += c; sum += c; }
      part[pt * 32 + e] = sum; if (rb >= 0 && pt == (rb >> 4)) wgoff[e] = pre; }
    __syncthreads();
    if (F.tid < NEXP) { int t = 0, o = 0;
#pragma unroll
        for (int pt = 0; pt < 16; ++pt) { const int c = part[pt * 32 + F.tid]; if (rb >= 0 && pt < (rb >> 4)) o += c; t += c; }
        tot[F.tid] = t; if (rb >= 0) wgoff[F.tid] += o; }
    __syncthreads();
    if (F.tid == 0) { int t = 0;
        for (int e = 0; e < NEXP; ++e) { const int c = tot[e]; const int nt = (c + MOE_TILE - 1) / MOE_TILE; ebase[e] = t * MOE_TILE;
            for (int i = 0; i < nt && t + i < MOE_MAXT; ++i) tile_e[t + i] = e; t += nt; }
        if (t > MOE_MAXT) t = MOE_MAXT; *ntp = t; }
    __syncthreads();
}
DI void phase_scatter(const Frame& F, const int* wgcnt, const int* eid, const int* lrank, int* slot, int* rowtok) {
    const LAS int* ebase = (const LAS int*)(F.lds + LDS_MISC + MI_EBASE); const LAS int* wgoff = (const LAS int*)(F.lds + LDS_MISC + MI_WGOFF);
    for (int rb = F.bx; rb < NTOK / 64; rb += F.G) {
        moe_plan(F, wgcnt, rb);
        if (F.tid < 128) { const int i = rb * 128 + F.tid; const int e = eid[i]; const int s = ebase[e] + wgoff[e] + lrank[i]; slot[i] = s; rowtok[s] = i >> 1; }
        __syncthreads();
    }
    if (F.tid < NEXP) ((LAS int*)(F.lds + LDS_MISC + MI_LCNT))[F.tid] = 0;
    __syncthreads();
}
constexpr int MOE_MAXU = 3;
DI void moe_rows_to_lds(const Frame& F, const int* rowtok, int nunits) {
    LAS int* rows = (LAS int*)(F.lds + LDS_MISC + MI_LOGIT); const LAS int* tile_e = (const LAS int*)(F.lds + LDS_MISC + MI_TILEE); (void)tile_e;
    for (int q = F.tid; q < MOE_MAXU * 256; q += NTHR) { const int i = q >> 8, r = q & 255; const long L = (long)i * F.G + F.vcu;
        rows[q] = L < nunits ? rowtok[((int)L >> 2) * 256 + r] : 0; }
    __syncthreads();
}
DI void phase_kmean(const Frame& F, const bf16_t* Kb, float* kmean) {
    LAS float* red = (LAS float*)F.lds;
    for (int it = F.bx; it < NB * MB_H * MB_NBLK; it += F.G) {
        const int n = it % MB_NBLK, hh = (it / MB_NBLK) % MB_H, b = it / (MB_NBLK * MB_H);
        const int kg = F.tid >> 4, d8 = (F.tid & 15) * 8; float s[8];
#pragma unroll
        for (int e = 0; e < 8; ++e) s[e] = 0.f;
        const bf16_t* p = Kb + ((size_t)b * SEQ + n * MB_BLK + kg * 8) * D + hh * MB_DH + d8;
#pragma unroll
        for (int j = 0; j < 8; ++j) { const u32x4 v = *(const u32x4*)(p + (size_t)j * D);
#pragma unroll
            for (int e = 0; e < 4; ++e) { s[2 * e] += __uint_as_float(v[e] << 16); s[2 * e + 1] += __uint_as_float(v[e] & 0xFFFF0000u); } }
#pragma unroll
        for (int e = 0; e < 8; ++e) red[kg * 128 + d8 + e] = s[e];
        __syncthreads();
        if (F.tid < 128) { float t = 0.f;
#pragma unroll
            for (int g = 0; g < 32; ++g) t += red[g * 128 + F.tid];
            kmean[(size_t)it * MB_DH + F.tid] = t * (1.0f / MB_BLK); }
        __syncthreads();
    }
}


template <int DV, bool IS_GLA>
DI void scan_naive_unit(LAS float* sb, int nthr_sub, int stid, int b, int hh, int nheads, const bf16_t* __restrict__ Q, const float* __restrict__ LF, const bf16_t* __restrict__ Kx, const bf16_t* __restrict__ V,
                        const float* __restrict__ glow, const float* __restrict__ gk2, const float* __restrict__ gkb, float* __restrict__ oraw, int ocol0) {
    constexpr int T = 16;
    LAS float* sq = sb; LAS float* sk = sb + T * 128; LAS float* sa = sb + 2 * T * 128;
    const int v = stid, qld = nheads * 128, vld = nheads * DV;
    float S[128];
#pragma unroll
    for (int d = 0; d < 128; ++d) S[d] = 0.f;
    for (int t0 = 0; t0 < SEQ; t0 += T) {
        __syncthreads();
        for (int i = stid; i < T * 128; i += nthr_sub) { const int tt = i >> 7, d = i & 127; const size_t tok = (size_t)b * SEQ + t0 + tt;
            sq[i] = bf2f(Q[tok * qld + hh * 128 + d]);
            if (IS_GLA) { float z = gkb[hh * 128 + d];
#pragma unroll
                for (int r = 0; r < GL_RANK; ++r) z += glow[tok * 16 + r] * gk2[r * GL_QK + hh * 128 + d];
                const float ls = fminf(z, 0.f) - log1pf(__expf(-fabsf(z)));
                sa[i] = __expf(ls * (1.0f / 16.0f)); sk[i] = bf2f(Kx[tok * qld + hh * 128 + d]); }
            else { const float al = __expf(LF[tok * qld + hh * 128 + d]); sa[i] = al; sk[i] = 1.0f - al; } }
        __syncthreads();
        for (int tt = 0; tt < T; ++tt) { const size_t tok = (size_t)b * SEQ + t0 + tt;
            const float vv = bf2f(V[tok * vld + hh * DV + v]); float o = 0.f;
#pragma unroll
            for (int d = 0; d < 128; ++d) { S[d] = sa[tt * 128 + d] * S[d] + sk[tt * 128 + d] * vv; o += sq[tt * 128 + d] * S[d]; }
            oraw[tok * D + ocol0 + hh * DV + v] = o; }
    }
}
DI void phase_scan_naive(const Frame& F, unsigned char* ws, const float* gk2, const float* gkb, float* oraw) {
    LAS float* base = (LAS float*)F.lds;
    if (F.bx < 8) { const int sub = F.tid >> 7, stid = F.tid & 127, unit = F.bx * 4 + sub;
        scan_naive_unit<128, false>(base + sub * 3 * 16 * 128, 128, stid, unit / HG_H, unit % HG_H, HG_H, (const bf16_t*)(ws + U_HQ), (const float*)(ws + U_HLF), nullptr, (const bf16_t*)(ws + U_HI), nullptr, nullptr, nullptr, oraw, 0); }
    else if (F.bx < 16) { const int sub = F.tid >> 8, stid = F.tid & 255, unit = (F.bx - 8) * 2 + sub;
        scan_naive_unit<256, true>(base + sub * 3 * 16 * 128, 256, stid, unit / GL_H, unit % GL_H, GL_H, (const bf16_t*)(ws + U_GQ), nullptr, (const bf16_t*)(ws + U_GK), (const bf16_t*)(ws + U_GV), (const float*)(ws + WS_GLOW), gk2, gkb, oraw, 1024); }
}
DI void phase_ngate(const Frame& F, const float* oraw, const float* hg_norm, const float* gla_norm, const bf16_t* hgg, const bf16_t* gg, bf16_t* mix) {
    const int lane = F.lane;
    f32x4 gn[8];
#pragma unroll
    for (int j = 0; j < 8; ++j) gn[j] = j < 4 ? *(const f32x4*)(hg_norm + ((j * 256 + lane * 4) & 127)) : *(const f32x4*)(gla_norm + lane * 4);
    for (int tok = F.bx * NWAVE + F.wave; tok < NTOK; tok += F.G * NWAVE) {
        const float* o = oraw + (size_t)tok * D; f32x4 v[8]; u32x2 gt[8];
#pragma unroll
        for (int j = 0; j < 8; ++j) { v[j] = *(const f32x4*)(o + j * 256 + lane * 4);
            gt[j] = j < 4 ? *(const u32x2*)(hgg + (size_t)tok * 1024 + j * 256 + lane * 4) : *(const u32x2*)(gg + (size_t)tok * 1024 + (j - 4) * 256 + lane * 4); }
#pragma unroll
        for (int j = 0; j < 8; ++j) { float ss = v[j][0] * v[j][0] + v[j][1] * v[j][1] + v[j][2] * v[j][2] + v[j][3] * v[j][3];
#pragma unroll
            for (int o2 = 1; o2 < 32; o2 <<= 1) ss += __shfl_xor(ss, o2);
            if (j >= 4) ss += __shfl_xor(ss, 32);
            const float rstd = rsqrtf(ss * (j < 4 ? 1.0f / 128.0f : 1.0f / 256.0f) + EPS);
            const float g0 = __uint_as_float(gt[j][0] << 16), g1 = __uint_as_float(gt[j][0] & 0xFFFF0000u), g2 = __uint_as_float(gt[j][1] << 16), g3 = __uint_as_float(gt[j][1] & 0xFFFF0000u);
            u32x2 p; p[0] = pk_bf16(v[j][0] * rstd * gn[j][0] * g0, v[j][1] * rstd * gn[j][1] * g1); p[1] = pk_bf16(v[j][2] * rstd * gn[j][2] * g2, v[j][3] * rstd * gn[j][3] * g3);
            *(u32x2*)(mix + (size_t)tok * D + j * 256 + lane * 4) = p; }
    }
}
DI void phase_moba_naive(const Frame& F, const bf16_t* __restrict__ Qb, const bf16_t* __restrict__ Kb, const bf16_t* __restrict__ Vb, const float* __restrict__ kmean, bf16_t* __restrict__ AO) {
    LAS float* sq = (LAS float*)F.lds + F.wave * 128;
    LAS float* sp = (LAS float*)F.lds + 8 * 128 + F.wave * 1024;
    LAS int* ssel = (LAS int*)((LAS float*)F.lds + 8 * 128 + 8 * 1024) + F.wave * 4;
    const int lane = F.lane;
    for (int qg = F.bx; qg < NB * MB_H * SEQ / NWAVE; qg += F.G) {
        const int qi = qg * NWAVE + F.wave; const int t = qi % SEQ, hh = (qi / SEQ) % MB_H, b = qi / (SEQ * MB_H);
        const size_t tok = (size_t)b * SEQ + t; const int qb = t / MB_BLK;
        __syncthreads();
        sq[lane] = bf2f(Qb[tok * D + hh * MB_DH + lane]); sq[lane + 64] = bf2f(Qb[tok * D + hh * MB_DH + lane + 64]);
        __syncthreads();
        float gate = -3.0e38f;
        if (lane < qb) { const float* km = kmean + ((size_t)(b * MB_H + hh) * MB_NBLK + lane) * MB_DH; float s = 0.f; for (int d = 0; d < 128; ++d) s += sq[d] * km[d]; gate = s; }
        const int nsel = qb < 3 ? qb : 3;
        for (int s = 0; s < 3; ++s) { float best = gate; int bi = lane;
            for (int o = 32; o > 0; o >>= 1) { const float ob = __shfl_xor(best, o); const int oi = __shfl_xor(bi, o); if (ob > best || (ob == best && oi < bi)) { best = ob; bi = oi; } }
            if (lane == 0) ssel[s] = bi; if (lane == bi) gate = -3.4e38f; }
        __syncthreads();
        const float scale = 0.08838834764831845f; float mx = -3.0e38f;
        for (int sgi = 0; sgi <= nsel; ++sgi) { const int blk = sgi < nsel ? ssel[sgi] : qb;
            for (int i = 0; i < 4; ++i) { const int j = lane + 64 * i, kp = blk * MB_BLK + j; float s = -__builtin_inff();
                if (sgi < nsel || kp <= t) { const bf16_t* kr = Kb + ((size_t)b * SEQ + kp) * D + hh * MB_DH; float acc = 0.f;
                    for (int d = 0; d < 128; d += 2) { const unsigned w = *(const unsigned*)(kr + d); acc += sq[d] * __uint_as_float(w << 16) + sq[d + 1] * __uint_as_float(w & 0xFFFF0000u); }
                    s = acc * scale; }
                sp[sgi * 256 + j] = s; mx = fmaxf(mx, s); } }
        for (int o = 32; o > 0; o >>= 1) mx = fmaxf(mx, __shfl_xor(mx, o));
        float den = 0.f;
        for (int sgi = 0; sgi <= nsel; ++sgi) for (int i = 0; i < 4; ++i) { const int idx = sgi * 256 + lane + 64 * i; const float p = __expf(sp[idx] - mx); sp[idx] = p; den += p; }
        den = wave_sum(den);
        __syncthreads();
        float o0 = 0.f, o1 = 0.f;
        for (int sgi = 0; sgi <= nsel; ++sgi) { const int blk = sgi < nsel ? ssel[sgi] : qb; const int jmax = sgi < nsel ? 256 : (t - qb * MB_BLK + 1);
            for (int j = 0; j < jmax; ++j) { const float p = sp[sgi * 256 + j]; const unsigned w = *(const unsigned*)(Vb + ((size_t)b * SEQ + blk * MB_BLK + j) * D + hh * MB_DH + lane * 2);
                o0 += p * __uint_as_float(w << 16); o1 += p * __uint_as_float(w & 0xFFFF0000u); } }
        const float inv = 1.0f / den;
        *(unsigned*)(AO + tok * D + hh * MB_DH + lane * 2) = (unsigned)f2bf(o0 * inv) | ((unsigned)f2bf(o1 * inv) << 16);
    }
}


DI moba::BlockRef<bf16_t, bf16_t> moba_ref(int L, int pass, const bf16_t* Q, const bf16_t* K, const bf16_t* V, bf16_t* O, const float* kmean) {
    const int bh = L >> 3, x = L & 7, qb = pass ? 15 - x : x, b = bh >> 4, h = bh & 15;
    moba::BlockRef<bf16_t, bf16_t> r; const size_t base = ((size_t)b * SEQ) * D + h * MB_DH;
    r.Q = Q + base + (size_t)qb * 256 * D; r.O = O + base + (size_t)qb * 256 * D; r.K = K + base; r.V = V + base; r.KM = kmean + (size_t)bh * MB_NBLK * MB_DH; r.P0 = qb * 256;
    return r;
}
DI void phase_attn(char* lds, int G, int c, const int wv, const bf16_t* Q, const bf16_t* K, const bf16_t* V, bf16_t* O, const float* kmean) {
    constexpr int TOTAL = 8 * NB * MB_H;
    int L = c; if (L >= TOTAL) return;
    int pass = 0;
    moba::BlockRef<bf16_t, bf16_t> cur = moba_ref(L, 0, Q, K, V, O, kmean);
    moba::Seam<bf16_t> S;
    moba::causal_swa_prime<bf16_t, bf16_t>(cur, SEQ, lds, S, wv);
    for (;;) {
        const bool more_pass = pass == 0, more_item = L + G < TOTAL, last = !more_pass && !more_item;
        int passn = pass + 1, Ln = L;
        if (!more_pass) { passn = 0; Ln = more_item ? L + G : L; }
        const moba::BlockRef<bf16_t, bf16_t> nxt = last ? cur : moba_ref(Ln, passn, Q, K, V, O, kmean);
        moba::causal_swa_block<bf16_t, bf16_t>(cur, nxt, SEQ, SEQ, lds, S, wv);
        if (last) break;
        cur = nxt; pass = passn; L = Ln;
    }
}

namespace scan {
typedef short s16x4 __attribute__((ext_vector_type(4)));
typedef short bf16x8 __attribute__((ext_vector_type(8)));
typedef float f32x16 __attribute__((ext_vector_type(16)));
typedef float f32x2 __attribute__((ext_vector_type(2)));
typedef __bf16 bf16x2_t __attribute__((ext_vector_type(2)));
constexpr int RS = 272;
constexpr int QS = 0, KD = 64 * RS, K10 = 2 * 64 * RS, QH = K10 + 32 * RS, KH = QH + 64 * RS, KH_ST = 320, VV = KH + 64 * KH_ST, PF = VV + 64 * 576, DEC = PF + 6144, LDS_END = DEC + 512;
constexpr int TOT = 131072 + 4096;
static_assert(LDS_END <= 131072 && TOT + 8192 <= 147456, "scan LDS");
DI unsigned cvt2(float lo, float hi) { const f32x2 v = {lo, hi}; return __builtin_bit_cast(unsigned, __builtin_convertvector(v, bf16x2_t)); }
DI int crow(int r, int h) { return (r & 3) + 8 * (r >> 2) + 4 * h; }
template <int S_> DI bf16x8 pack_step(const f32x16& x) {
    u32x4 p; p[0] = cvt2(x[8 * S_], x[8 * S_ + 1]); p[1] = cvt2(x[8 * S_ + 2], x[8 * S_ + 3]); p[2] = cvt2(x[8 * S_ + 4], x[8 * S_ + 5]); p[3] = cvt2(x[8 * S_ + 6], x[8 * S_ + 7]);
    return __builtin_bit_cast(bf16x8, p);
}
DI bf16x8 tr2(LAS unsigned char* p, int second_off) {
    const s16x4 lo = __builtin_amdgcn_ds_read_tr16_b64_v4i16((LAS s16x4*)p), hi = __builtin_amdgcn_ds_read_tr16_b64_v4i16((LAS s16x4*)(p + second_off));
    return __builtin_shufflevector(lo, hi, 0, 1, 2, 3, 4, 5, 6, 7);
}
DI float ex(float x) { return __builtin_amdgcn_exp2f(x * 1.4426950408889634f); }

template <int DV, bool IS_GLA>
DI void scan_unit(LAS unsigned char* L, int tid, int lane, int w, int b, int hh,
                  const bf16_t* __restrict__ Q, const float* __restrict__ G, const bf16_t* __restrict__ Kx, int qld, const bf16_t* __restrict__ V, float* __restrict__ oraw, int ocol0) {
    constexpr int VST = DV * 2 + 64, NVP = DV / 64, VPR = DV / 8;
    constexpr int NIH = DV == 256 ? 2 : 1;
    const int c = lane & 31, h = lane >> 5, g16 = (lane >> 4) & 1, q4 = (lane & 15) >> 2, p4 = lane & 3;
    const int vs = DV == 256 ? w : (w & 3), ih0 = DV == 256 ? 0 : (w >> 2);
    const int hq = hh * 128 + 2 * lane;
    const size_t tokb = (size_t)b * SEQ;
    f32x16 S[4];
#pragma unroll
    for (int t = 0; t < 4; ++t) S[t] = f32x16{};
    unsigned rq[8], rk[8]; f32x2 rg[8]; u32x4 rv[NVP];
#define SCAN_LOAD(ch_) do { const size_t t0_ = tokb + (size_t)(ch_) * 64;                                                                  \
        _Pragma("unroll") for (int e = 0; e < 8; ++e) { const size_t ro_ = (t0_ + 8 * w + e) * qld + hq;                                    \
            rq[e] = *(const unsigned*)(Q + ro_); rg[e] = *(const f32x2*)(G + ro_); if (IS_GLA) rk[e] = *(const unsigned*)(Kx + ro_); }      \
        _Pragma("unroll") for (int qq = 0; qq < NVP; ++qq) { const int p_ = tid + 512 * qq; const int row_ = p_ / VPR, c16_ = p_ % VPR;     \
            rv[qq] = *(const u32x4*)(V + (t0_ + row_) * 1024 + hh * DV + 8 * c16_); } } while (0)
#define SCAN_TOT(par_) do { f32x2 s_ = rg[0]; _Pragma("unroll") for (int e = 1; e < 8; ++e) s_ += rg[e];                                    \
        *(LAS f32x2*)(L + TOT + (par_) * 4096 + w * 512 + lane * 8) = s_; } while (0)
#define SCAN_PREP(par_) do {                                                                                                                \
        f32x2 Pw_ = {0.f, 0.f}, R1_ = {0.f, 0.f}, last_ = {0.f, 0.f};                                                                        \
        _Pragma("unroll") for (int w2 = 0; w2 < 8; ++w2) { const f32x2 t_ = *(const LAS f32x2*)(L + TOT + (par_) * 4096 + w2 * 512 + lane * 8); \
            if (w2 < w) Pw_ += t_; if (w2 < 4) R1_ += t_; last_ += t_; }                                                                     \
        const bool sub1_ = w >= 4; const f32x2 Rb_ = sub1_ ? R1_ : (f32x2){0.f, 0.f};                                                        \
        const f32x2 eR1_ = {ex(R1_[0]), ex(R1_[1])}; const f32x2 eLR_ = {ex(last_[0] - Rb_[0]), ex(last_[1] - Rb_[1])};                      \
        if (w == 0) *(LAS f32x2*)(L + DEC + lane * 8) = (f32x2){ex(last_[0]), ex(last_[1])};                                                 \
        f32x2 cum_ = Pw_;                                                                                                                    \
        _Pragma("unroll") for (int e = 0; e < 8; ++e) { cum_ += rg[e]; const int i_ = 8 * w + e;                                             \
            const float x0_ = fmaxf(cum_[0] - Rb_[0], -80.f), x1_ = fmaxf(cum_[1] - Rb_[1], -80.f);                                          \
            const float E0_ = ex(x0_), E1_ = ex(x1_), I0_ = ex(-x0_), I1_ = ex(-x1_);                                                        \
            const float q0_ = __uint_as_float(rq[e] << 16), q1_ = __uint_as_float(rq[e] & 0xFFFF0000u);                                      \
            float k0_, k1_; if (IS_GLA) { k0_ = __uint_as_float(rk[e] << 16); k1_ = __uint_as_float(rk[e] & 0xFFFF0000u); }                  \
            else { k0_ = 1.0f - ex(rg[e][0]); k1_ = 1.0f - ex(rg[e][1]); }                                                                   \
            const float qs0_ = q0_ * E0_, qs1_ = q1_ * E1_, kd0_ = k0_ * I0_, kd1_ = k1_ * I1_;                                              \
            const int asw_ = i_ * RS + 4 * lane;                                                                      \
            *(LAS unsigned*)(L + QS + asw_) = cvt2(qs0_, qs1_); *(LAS unsigned*)(L + KD + asw_) = cvt2(kd0_, kd1_);                          \
            if (sub1_) *(LAS unsigned*)(L + QH + asw_) = cvt2(qs0_ * eR1_[0], qs1_ * eR1_[1]);                                               \
            else { *(LAS unsigned*)(L + QH + asw_) = cvt2(qs0_, qs1_); *(LAS unsigned*)(L + K10 + asw_) = cvt2(kd0_ * eR1_[0], kd1_ * eR1_[1]); } \
            *(LAS unsigned*)(L + KH + i_ * KH_ST + 4 * lane) = cvt2(kd0_ * eLR_[0], kd1_ * eLR_[1]); }                                       \
        _Pragma("unroll") for (int qq = 0; qq < NVP; ++qq) { const int p_ = tid + 512 * qq; const int row_ = p_ / VPR, c16_ = p_ % VPR;     \
            *(LAS u32x4*)(L + VV + row_ * VST + c16_ * 16) = rv[qq]; } } while (0)

    SCAN_LOAD(0);
    __syncthreads();
    SCAN_TOT(0);
    __syncthreads();
    SCAN_PREP(0);
    SCAN_LOAD(1);
    for (int ch = 0; ch < SEQ / 64; ++ch) {
        const bool has_next = ch + 1 < SEQ / 64;
        __syncthreads();
        PRB_B(L, 120);
        if (w < 3) { const int t = w; const int rowj = (t == 2 ? 32 : 0) + c, rowi = (t == 0 ? 0 : 32) + c; const int kimg = t == 1 ? K10 : KD;
            f32x16 pt = f32x16{};
#pragma unroll
            for (int s = 0; s < 8; ++s) { const int colB = 32 * s + 16 * h;
                const bf16x8 ak = *(const LAS bf16x8*)(L + kimg + rowj * RS + colB), bq = *(const LAS bf16x8*)(L + QS + rowi * RS + colB);
                pt = __builtin_amdgcn_mfma_f32_32x32x16_bf16(ak, bq, pt, 0, 0, 0); }
            if (t != 1) {
#pragma unroll
                for (int r = 0; r < 16; ++r) pt[r] = (crow(r, h) > c) ? 0.f : pt[r]; }
            *(LAS bf16x8*)(L + PF + ((t * 2 + 0) * 64 + lane) * 16) = pack_step<0>(pt);
            *(LAS bf16x8*)(L + PF + ((t * 2 + 1) * 64 + lane) * 16) = pack_step<1>(pt); }
        f32x16 O[NIH];
#pragma unroll
        for (int x = 0; x < NIH; ++x) O[x] = f32x16{};
#pragma unroll
        for (int dt = 0; dt < 4; ++dt) {
            const bf16x8 bS0 = pack_step<0>(S[dt]), bS1 = pack_step<1>(S[dt]);
#pragma unroll
            for (int x = 0; x < NIH; ++x) { const int i = 32 * (ih0 + x) + c; LAS unsigned char* qrow = L + QH + i * RS;
                { const int cb = 64 * dt + 8 * h; const s16x4 lo = *(const LAS s16x4*)(qrow + cb), hi4 = *(const LAS s16x4*)(qrow + cb + 16);
                  O[x] = __builtin_amdgcn_mfma_f32_32x32x16_bf16(__builtin_shufflevector(lo, hi4, 0, 1, 2, 3, 4, 5, 6, 7), bS0, O[x], 0, 0, 0); }
                { const int cb = 64 * dt + 32 + 8 * h; const s16x4 lo = *(const LAS s16x4*)(qrow + cb), hi4 = *(const LAS s16x4*)(qrow + cb + 16);
                  O[x] = __builtin_amdgcn_mfma_f32_32x32x16_bf16(__builtin_shufflevector(lo, hi4, 0, 1, 2, 3, 4, 5, 6, 7), bS1, O[x], 0, 0, 0); } }
        }
#pragma unroll
        for (int dt = 0; dt < 4; ++dt)
#pragma unroll
            for (int g4 = 0; g4 < 4; ++g4) { const f32x4 dv = *(const LAS f32x4*)(L + DEC + (32 * dt + 8 * g4 + 4 * h) * 4);
#pragma unroll
                for (int jj = 0; jj < 4; ++jj) S[dt][4 * g4 + jj] *= dv[jj]; }
#pragma unroll
        for (int s = 0; s < 4; ++s) {
            const bf16x8 bV = tr2(L + VV + (16 * s + 8 * h + q4) * VST + (32 * vs + 16 * g16 + 4 * p4) * 2, 4 * VST);
#pragma unroll
            for (int dt = 0; dt < 4; ++dt) { const bf16x8 aK = tr2(L + KH + (16 * s + 8 * h + q4) * KH_ST + (32 * dt + 16 * g16 + 4 * p4) * 2, 4 * KH_ST);
                S[dt] = __builtin_amdgcn_mfma_f32_32x32x16_bf16(aK, bV, S[dt], 0, 0, 0); }
        }
        if (has_next) SCAN_TOT((ch + 1) & 1);
        PRB_E(L, 120); PRB_B(L, 123);
        __syncthreads();
        PRB_E(L, 123); PRB_B(L, 121);
#define SCAN_PV(x_, t_, jb_) do { _Pragma("unroll") for (int s2 = 0; s2 < 2; ++s2) {                                                        \
            const bf16x8 aP_ = *(const LAS bf16x8*)(L + PF + (((t_) * 2 + s2) * 64 + lane) * 16);                                            \
            const bf16x8 bV_ = tr2(L + VV + (32 * (jb_) + 16 * s2 + 4 * h + q4) * VST + (32 * vs + 16 * g16 + 4 * p4) * 2, 8 * VST);         \
            O[x_] = __builtin_amdgcn_mfma_f32_32x32x16_bf16(aP_, bV_, O[x_], 0, 0, 0); } } while (0)
        if (NIH == 2) { SCAN_PV(0, 0, 0); SCAN_PV(NIH - 1, 1, 0); SCAN_PV(NIH - 1, 2, 1); }
        else { if (ih0 == 0) { SCAN_PV(0, 0, 0); } else { SCAN_PV(0, 1, 0); SCAN_PV(0, 2, 1); } }
#undef SCAN_PV
        { float* op = oraw + (tokb + (size_t)ch * 64) * D + ocol0 + hh * DV + 32 * vs + c;
#pragma unroll
          for (int x = 0; x < NIH; ++x)
#pragma unroll
              for (int r = 0; r < 16; ++r) op[(size_t)(32 * (ih0 + x) + crow(r, h)) * D] = O[x][r]; }
        PRB_E(L, 121); PRB_B(L, 124);
        __syncthreads();
        PRB_E(L, 124); PRB_B(L, 122);
        if (has_next) { SCAN_PREP((ch + 1) & 1); if (ch + 2 < SEQ / 64) SCAN_LOAD(ch + 2); }
        PRB_E(L, 122);
    }
#undef SCAN_LOAD
#undef SCAN_TOT
#undef SCAN_PREP
}
}

DI void phase_scan_fast(LAS unsigned char* L, int tid, int lane, int w, int G, int bx, unsigned char* ws, float* oraw) {
    for (int u = bx; u < NB * HG_H + NB * GL_H; u += G) {
        if (u < NB * HG_H) scan::scan_unit<128, false>(L, tid, lane, w, u / HG_H, u % HG_H, (const bf16_t*)(ws + U_HQ), (const float*)(ws + U_HLF), nullptr, 1024, (const bf16_t*)(ws + U_HI), oraw, 0);
        else { const int v = u - NB * HG_H; scan::scan_unit<256, true>(L, tid, lane, w, v / GL_H, v % GL_H, (const bf16_t*)(ws + U_GQ), (const float*)(ws + WS_LA), (const bf16_t*)(ws + U_GK), 512, (const bf16_t*)(ws + U_GV), oraw, 1024); }
        __syncthreads();
    }
}

enum { PH_PRO = 0, PH_GEMM1 = 1, PH_SCAN = 2, PH_NGATE = 3, PH_OUTP = 4, PH_NORM_F0 = 5, PH_SCAT0 = 6, PH_UP0 = 7, PH_DN0 = 8, PH_COMB0 = 9, PH_QKV = 10, PH_KMEAN = 11, PH_ATTN = 12,
       PH_OPROJ = 13, PH_NORM_F1 = 14, PH_SCAT1 = 15, PH_UP1 = 16, PH_DN1 = 17, PH_FINAL = 18, PH_END = 19 };

__global__ void __launch_bounds__(NTHR, 2) mk_fwd(Args a) {
#define AIN(k) (ka_launder()->in[k])
    extern __shared__ __attribute__((aligned(16))) unsigned char lds_raw[];
    Frame F; F.lds = (LAS unsigned char*)lds_raw; F.tid = threadIdx.x; F.lane = F.tid & 63; F.wave = __builtin_amdgcn_readfirstlane(F.tid >> 6);
    F.G = gridDim.x; F.bx = blockIdx.x; F.vcu = (F.G % 8 == 0) ? (F.bx % 8) * (F.G / 8) + F.bx / 8 : F.bx;
    F.ws = a.ws; F.ctl = (unsigned*)(a.ws + WS_CTL);
    unsigned char* ws = a.ws;
    if (F.tid < 4) ((LAS unsigned*)(F.lds + LDS_MISC + MI_BAR))[F.tid] = 0u;
    if (F.tid == 0) *(volatile LAS unsigned long long*)(F.lds + LDS_MISC + MI_PROBE) = 0ull;
    __syncthreads();
    const int lo = a.ph_lo, hi = a.ph_hi;
    XcdBarrier bar; bar.bar = F.ctl + CW2_BAR + a.bar_idx * XCD_BAR_WORDS; bar.x = 0; bar.w0 = 0; bar.st = (volatile LAS unsigned*)(F.lds + LDS_MISC + MI_BAR);
    if (hi - lo > 1) bar = xcd_barrier_post(F.ctl + CW2_BAR + a.bar_idx * XCD_BAR_WORDS, (volatile LAS unsigned*)(F.lds + LDS_MISC + MI_BAR));
#define IN(k) (lo <= (k) && (k) < hi)
    if (PROBE_ID >= 0) PRB_BEGIN(0);
#define SEAM(k) do { if (IN(k) && IN((k) + 1)) xcd_barrier(bar); if (PROBE_ID >= 0) { PRB_END(k); PRB_BEGIN((k) + 1); } } while (0)
#define P_x (AIN(0))
#define P_norm_mix (AIN(1))
#define P_norm_ffn (AIN(2))
#define P_norm_final (AIN(3))
#define P_WinT ((bf16_t*)(ws + WS_WIN))
#define P_WoutT ((bf16_t*)(ws + WS_WOUT))
#define P_WqkvT ((bf16_t*)(ws + WS_WQKV))
#define P_WoT ((bf16_t*)(ws + WS_WO))
#define P_Wup ((bf16_t*)(ws + WS_WUP))
#define P_Wdn ((bf16_t*)(ws + WS_WDN))
#define P_XN ((bf16_t*)(ws + WS_XN))
#define P_H ((float*)(ws + WS_H))
#define P_LB ((float*)(ws + SM_LB))
#define P_KMEAN ((float*)(ws + SM_KMEAN))
#define P_GLOW ((float*)(ws + WS_GLOW))
#define P_EID ((int*)(ws + WS_EID))
#define P_WGT ((float*)(ws + WS_WGT))
#define P_SLOT ((int*)(ws + WS_SLOT))
#define P_RWT ((float*)(ws + WS_RWT))
#define P_Qb ((bf16_t*)(ws + U_Q))
#define P_Kb ((bf16_t*)(ws + U_K))
#define P_Vb ((bf16_t*)(ws + U_V))
#define P_HMID ((bf16_t*)(ws + U_HMID))
#define P_Y ((bf16_t*)(ws + U_Y))
#define P_XS ((bf16_t*)(ws + U_XS))
    const LAS int* tile_e = (const LAS int*)(F.lds + LDS_MISC + MI_TILEE); const LAS int* ntp = (const LAS int*)(F.lds + LDS_MISC + MI_NT);

    if (IN(PH_PRO)) {
        phase_tables(F, *ka_launder());
        phase_norm<1, false>(F, P_x, nullptr, P_norm_mix, P_XN, nullptr, nullptr, nullptr, nullptr, AIN(4), P_GLOW, nullptr, nullptr, nullptr, nullptr, nullptr, nullptr, AIN(7), AIN(8), (float*)(ws + WS_LA));
        __syncthreads();
        phase_transposes(F, *ka_launder(), 0, 896, F.bx, F.G);
    }
    SEAM(PH_PRO);
    if (IN(PH_GEMM1)) {
        pg8::Gemm g{P_XN, P_WinT, NTOK, EVEN_MAIN, D}; pg8::StaticOrder S; S.init(NTOK, EVEN_MAIN, F.G, F.bx);
        EpiProj0F E{(bf16_t*)(ws + U_HQ), (float*)(ws + U_HLF), (bf16_t*)(ws + U_HI), (bf16_t*)(ws + U_HGG), (bf16_t*)(ws + U_GQ), (bf16_t*)(ws + U_GK), (bf16_t*)(ws + U_GV), (bf16_t*)(ws + U_GG), P_LB};
        pg8::gemm_phase<EpiProj0F, pg8::StaticOrder, true, true>(F.lds, g, S, E, F.wave);
    }
    SEAM(PH_GEMM1);
    if (IN(PH_SCAN)) { constexpr int NSU = NB * HG_H + NB * GL_H;
        if (F.G > 2 * NSU) { if (F.bx < NSU) { PRB_BEGIN(110); phase_scan_fast(F.lds, F.tid, F.lane, F.wave, NSU, F.bx, ws, P_H); PRB_END(110); } else { PRB_BEGIN(111); phase_transposes(F, *ka_launder(), 896, N_TJOBS, F.bx - NSU, F.G - NSU); PRB_END(111); } }
        else { phase_scan_fast(F.lds, F.tid, F.lane, F.wave, F.G, F.bx, ws, P_H); __syncthreads(); phase_transposes(F, *ka_launder(), 896, N_TJOBS, F.bx, F.G); } }
    SEAM(PH_SCAN);
    if (IN(PH_NGATE)) phase_ngate(F, P_H, AIN(6), AIN(9), (const bf16_t*)(ws + U_HGG), (const bf16_t*)(ws + U_GG), P_XN);
    SEAM(PH_NGATE);
    if (IN(PH_OUTP)) {
        pg8::Gemm g{P_XN, P_WoutT, NTOK, D, D}; pg8::StaticOrder S; S.init(NTOK, D, F.G, F.bx);
        EpiResidF E{P_x, P_H};
        pg8::gemm_phase<EpiResidF, pg8::StaticOrder, true, true>(F.lds, g, S, E, F.wave);
    }
    SEAM(PH_OUTP);
#define MOE_LAYER(l, PHN, PHS, PHU, PHD, CNT, CUR)                                                                                              \
    if (IN(PHN)) { for (int i = F.bx * NTHR + F.tid; i < MOE_ROWS; i += F.G * NTHR) ((int*)(ws + WS_ROWTOK))[i] = 0; }                              \
    if (IN(PHN)) phase_norm<2, false>(F, P_H, nullptr, P_norm_ffn + (l) * D, P_XN, nullptr, nullptr, nullptr, nullptr, nullptr, nullptr,              \
                                      P_RWT + (size_t)(l) * 2048 * 48, AIN(14) + (l) * NGRP, AIN(16) + (l) * NEXP, P_EID, P_WGT, (unsigned*)(ws + WS_WGCNT) + (l) * 256 * NEXP, nullptr, nullptr, nullptr, (int*)(ws + WS_LRANK));        \
    SEAM(PHN);                                                                                                                                  \
    if (IN(PHS)) phase_scatter(F, (const int*)(ws + WS_WGCNT) + (l) * 256 * NEXP, P_EID, (const int*)(ws + WS_LRANK), P_SLOT, (int*)(ws + WS_ROWTOK));                                                \
    SEAM(PHS);                                                                                                                                  \
    if (IN(PHU)) { moe_plan(F, (const int*)(ws + WS_WGCNT) + (l) * 256 * NEXP, -1);                                                                                                    \
        moe_rows_to_lds(F, (const int*)(ws + WS_ROWTOK), *ntp * 4);                                                                            \
        pg8::Gemm g{P_XN, P_Wup + (size_t)(l) * NEXP * 1024 * D, MOE_ROWS, NEXP * 1024, D, (const LAS int*)(F.lds + LDS_MISC + MI_LOGIT)};        \
        MoeOrder S{4, 2, *ntp * 4, F.G, F.vcu, tile_e};                                                                                          \
        EpiSwigluF E{P_HMID}; pg8::gemm_phase<EpiSwigluF, MoeOrder, true, true, true>(F.lds, g, S, E, F.wave); }                                                \
    SEAM(PHU);                                                                                                                                  \
    if (IN(PHD)) { moe_plan(F, (const int*)(ws + WS_WGCNT) + (l) * 256 * NEXP, -1);                                                                                                    \
        pg8::Gemm g{P_HMID, P_Wdn + (size_t)(l) * NEXP * D * DEXP, MOE_ROWS, NEXP * D, DEXP}; MoeOrder S{8, 3, *ntp * 8, F.G, F.vcu, tile_e};        \
        EpiBf16F E{P_Y, D, 8, 0, 0}; pg8::gemm_phase<EpiBf16F, MoeOrder, true, true>(F.lds, g, S, E, F.wave); }                                           \
    SEAM(PHD);
    MOE_LAYER(0, PH_NORM_F0, PH_SCAT0, PH_UP0, PH_DN0, CW2_CNT0, CW2_CUR0)
    if (IN(PH_COMB0)) phase_norm<0, true>(F, P_H, P_H, P_norm_mix + D, P_XN, nullptr, P_Y, P_SLOT, P_WGT, nullptr, nullptr, nullptr, nullptr, nullptr, nullptr, nullptr, nullptr);
    SEAM(PH_COMB0);
    if (IN(PH_QKV)) {
        pg8::Gemm g{P_XN, P_WqkvT, NTOK, 3 * D, D}; pg8::StaticOrder S; S.init(NTOK, 3 * D, F.G, F.bx);
        EpiBf16F E{P_Qb, D, 24, 8, (size_t)NTOK * D};
        pg8::gemm_phase<EpiBf16F, pg8::StaticOrder, true, true>(F.lds, g, S, E, F.wave);
    }
    SEAM(PH_QKV);
    if (IN(PH_KMEAN)) phase_kmean(F, P_Kb, P_KMEAN);
    SEAM(PH_KMEAN);
    if (IN(PH_ATTN)) phase_attn((char*)lds_raw, F.G, F.vcu, F.wave, P_Qb, P_Kb, P_Vb, P_XN, P_KMEAN);
    F.lane = mk_lane(); F.tid = F.wave * 64 + F.lane;
    SEAM(PH_ATTN);
    if (IN(PH_OPROJ)) {
        pg8::Gemm g{P_XN, P_WoT, NTOK, D, D}; pg8::StaticOrder S; S.init(NTOK, D, F.G, F.bx);
        EpiResidF E{P_H, P_H};
        pg8::gemm_phase<EpiResidF, pg8::StaticOrder, true, true>(F.lds, g, S, E, F.wave);
    }
    SEAM(PH_OPROJ);
    MOE_LAYER(1, PH_NORM_F1, PH_SCAT1, PH_UP1, PH_DN1, CW2_CNT1, CW2_CUR1)
    if (IN(PH_FINAL)) phase_norm<3, true>(F, P_H, nullptr, P_norm_final, nullptr, a.out, P_Y, P_SLOT, P_WGT, nullptr, nullptr, nullptr, nullptr, nullptr, nullptr, nullptr, nullptr);
    if (PROBE_ID >= 0) { PRB_END(PH_FINAL);
        if (F.bx == PROBE_BLOCK && F.tid == 0) { const unsigned long long acc_ = *(volatile LAS unsigned long long*)(F.lds + LDS_MISC + MI_PROBE), t0_ = __builtin_amdgcn_s_memrealtime();
            while (__builtin_amdgcn_s_memrealtime() - t0_ < (unsigned long long)PROBE_MULT * acc_) __builtin_amdgcn_s_sleep(8); } }
#undef AIN
#undef IN
#undef SEAM
#undef MOE_LAYER
#undef P_x
#undef P_norm_mix
#undef P_norm_ffn
#undef P_norm_final
#undef P_WinT
#undef P_WoutT
#undef P_WqkvT
#undef P_WoT
#undef P_Wup
#undef P_Wdn
#undef P_XN
#undef P_H
#undef P_LB
#undef P_KMEAN
#undef P_GLOW
#undef P_EID
#undef P_WGT
#undef P_SLOT
#undef P_RWT
#undef P_Qb
#undef P_Kb
#undef P_Vb
#undef P_HMID
#undef P_Y
#undef P_XS
}


extern "C" void kernel_launch(void* const* d_in, const int* in_sizes, int n_in, void* d_out, int out_size, void* d_ws, size_t ws_size, hipStream_t stream) {
    static int grid = 0;
    if (grid == 0) {
        if (n_in != 20 || out_size != NTOK * D || ws_size < WS_TOTAL3) { fprintf(stderr, "kernel_launch: unexpected shapes / workspace (%d inputs, out %d, ws %zu need %zu)\n", n_in, out_size, ws_size, (size_t)WS_TOTAL3); grid = -1; return; }
        int dev = 0, cus = 0;
        if (hipGetDevice(&dev) != hipSuccess || hipDeviceGetAttribute(&cus, hipDeviceAttributeMultiprocessorCount, dev) != hipSuccess || cus <= 0) { grid = -1; return; }
        if (hipFuncSetAttribute((const void*)mk_fwd, hipFuncAttributeMaxDynamicSharedMemorySize, LDS_BYTES) != hipSuccess) { fprintf(stderr, "kernel_launch: hipFuncSetAttribute failed\n"); grid = -1; return; }
        int per_cu = 0; (void)hipOccupancyMaxActiveBlocksPerMultiprocessor(&per_cu, (const void*)mk_fwd, NTHR, LDS_BYTES); (void)hipGetLastError();
        if (per_cu < 1) fprintf(stderr, "kernel_launch: occupancy query reports %d\n", per_cu);
        grid = cus;
    }
    if (grid < 0) return;
    const float* x = (const float*)d_in[0];
    const float* hg_norm = (const float*)d_in[6]; const float* gk2 = (const float*)d_in[7]; const float* gkb = (const float*)d_in[8]; const float* gla_norm = (const float*)d_in[9];
    unsigned char* ws = (unsigned char*)d_ws;
    bf16_t* XN = (bf16_t*)(ws + WS_XN); float* H = (float*)(ws + WS_H);
    float* KMEAN = (float*)(ws + SM_KMEAN); float* GLOW = (float*)(ws + WS_GLOW);
    bf16_t* HQ = (bf16_t*)(ws + U_HQ); float* HLF = (float*)(ws + U_HLF); bf16_t* HI = (bf16_t*)(ws + U_HI); bf16_t* HGG = (bf16_t*)(ws + U_HGG);
    bf16_t* GQ = (bf16_t*)(ws + U_GQ); bf16_t* GK = (bf16_t*)(ws + U_GK); bf16_t* GV = (bf16_t*)(ws + U_GV); bf16_t* GG = (bf16_t*)(ws + U_GG);
    bf16_t* Qb = (bf16_t*)(ws + U_Q); bf16_t* Kb = (bf16_t*)(ws + U_K); bf16_t* Vb = (bf16_t*)(ws + U_V);
    (void)x;
    (void)hipMemsetAsync(ws + WS_CTL, 0, CTL_BYTES, stream);
    Args a{};
    for (int i = 0; i < 20; ++i) a.in[i] = (const float*)d_in[i];
    a.out = (float*)d_out; a.ws = ws;
    auto run = [&](int lo, int hi, int bi) { a.ph_lo = lo; a.ph_hi = hi; a.bar_idx = bi; a.pad = 0; hipLaunchKernelGGL(mk_fwd, dim3(grid), dim3(NTHR), LDS_BYTES, stream, a); };
    run(PH_PRO, PH_END, 0);
}
```

```cpp
#include <hip/hip_runtime.h>
#include <cstdio>
#include <cstdint>

typedef unsigned short bf16_t;
#define DI __device__ __forceinline__

constexpr int D = 2048, NB = 4, SEQ = 4096, NTOK = NB * SEQ;
constexpr int HG_H = 8, HG_DK = 128, HG_DV = 128, HG_QK = 1024, HG_V = 1024;
constexpr int GL_H = 4, GL_DK = 128, GL_DV = 256, GL_QK = 512, GL_V = 1024, GL_RANK = 16;
constexpr int EVEN_IN = 7184, EVEN_MAIN = 7168;
constexpr int MB_H = 16, MB_DH = 128, MB_BLK = 256, MB_NBLK = SEQ / MB_BLK;
constexpr int NEXP = 32, NGRP = 4, EPG = 8, DEXP = 512;
constexpr int MOE_TILE = 256, MOE_MAXT = (2 * NTOK) / MOE_TILE + NEXP, MOE_ROWS = MOE_MAXT * MOE_TILE;
constexpr float EPS = 1e-6f;

constexpr size_t MBy = 1024 * 1024;
constexpr size_t WS_CTL   = 0;
constexpr size_t CTL_BYTES = 64 * 1024;
constexpr size_t WS_SMALL = WS_CTL + CTL_BYTES;
constexpr size_t WS_WIN   = WS_SMALL + 1 * MBy;
constexpr size_t WS_WOUT  = WS_WIN + (size_t)EVEN_MAIN * D * 2;
constexpr size_t WS_WQKV  = WS_WOUT + (size_t)D * D * 2;
constexpr size_t WS_WO    = WS_WQKV + (size_t)3 * D * D * 2;
constexpr size_t WS_WUP   = WS_WO + (size_t)D * D * 2;
constexpr size_t WS_WDN   = WS_WUP + (size_t)2 * NEXP * 1024 * D * 2;
constexpr size_t WS_XN    = WS_WDN + (size_t)2 * NEXP * D * DEXP * 2;
constexpr size_t WS_H     = WS_XN + (size_t)NTOK * D * 2;
constexpr size_t WS_U     = WS_H + (size_t)NTOK * D * 4;
constexpr size_t U_HQ  = WS_U;
constexpr size_t U_HLF = U_HQ + (size_t)NTOK * 1024 * 2;
constexpr size_t U_HI  = U_HLF + (size_t)NTOK * 1024 * 4;
constexpr size_t U_HGG = U_HI + (size_t)NTOK * 1024 * 2;
constexpr size_t U_GQ  = U_HGG + (size_t)NTOK * 1024 * 2;
constexpr size_t U_GK  = U_GQ + (size_t)NTOK * 512 * 2;
constexpr size_t U_GV  = U_GK + (size_t)NTOK * 512 * 2;
constexpr size_t U_GG  = U_GV + (size_t)NTOK * 1024 * 2;
constexpr size_t U_END0 = U_GG + (size_t)NTOK * 1024 * 2;
constexpr size_t U_Q = WS_U, U_K = U_Q + (size_t)NTOK * D * 2, U_V = U_K + (size_t)NTOK * D * 2, U_END1 = U_V + (size_t)NTOK * D * 2;
constexpr size_t U_HMID = WS_U;
constexpr size_t U_Y = U_HMID + (size_t)MOE_ROWS * DEXP * 2;
constexpr size_t U_END2 = U_Y + (size_t)MOE_ROWS * D * 2;
constexpr size_t U_BYTES = U_END0 - WS_U;
static_assert(U_END1 - WS_U <= U_BYTES && U_END2 - WS_U <= U_BYTES, "union");
constexpr size_t WS_END = WS_U + U_BYTES;
constexpr size_t SM_LB    = WS_SMALL;
constexpr size_t SM_GLOW  = SM_LB + 4096;
constexpr size_t SM_KMEAN = WS_SMALL + 64 * 1024;
constexpr size_t SM_TILEE = SM_KMEAN + 512 * 1024;
constexpr size_t WS_GLOW  = WS_END;
constexpr size_t WS_EID   = WS_GLOW + (size_t)NTOK * 16 * 4;
constexpr size_t WS_WGT   = WS_EID + (size_t)NTOK * 2 * 4;
constexpr size_t WS_SLOT  = WS_WGT + (size_t)NTOK * 2 * 4;
constexpr size_t WS_ROWTOK = WS_SLOT + (size_t)NTOK * 2 * 4;
constexpr size_t WS_TOTAL = WS_ROWTOK + (size_t)MOE_ROWS * 4;
constexpr int CW_CNT = 0;
constexpr int CW_CUR = 64;
constexpr int CW_BASE = 128;
constexpr int CW_NT = 192;

DI float bf2f(bf16_t b) { return __uint_as_float(((unsigned)b) << 16); }
DI bf16_t f2bf(float f) { unsigned u = __float_as_uint(f); u += 0x7FFFu + ((u >> 16) & 1u); return (bf16_t)(u >> 16); }
DI float sigmoidf_(float x) { return 1.0f / (1.0f + __expf(-x)); }
DI float siluf_(float x) { return x / (1.0f + __expf(-x)); }
DI float wave_sum(float v) { for (int o = 32; o > 0; o >>= 1) v += __shfl_xor(v, o); return v; }

template <int MODE>
__global__ void k_transpose(const float* __restrict__ src, bf16_t* __restrict__ dst, int K, int N, int ld, int c0, int half, size_t src_bstride, size_t dst_bstride) {
    __shared__ float t[64][65];
    src += (size_t)blockIdx.z * src_bstride; dst += (size_t)blockIdx.z * dst_bstride;
    const int k0 = blockIdx.y * 64, n0 = blockIdx.x * 64, tx = threadIdx.x & 63, ty = threadIdx.x >> 6;
    for (int i = ty; i < 64; i += 4) t[i][tx] = src[(size_t)(k0 + i) * ld + c0 + n0 + tx];
    __syncthreads();
    for (int i = ty; i < 64; i += 4) { const int n = n0 + i; const int r = MODE == 0 ? n : (n / 128) * 256 + half * 128 + (n % 128);
        dst[(size_t)r * K + k0 + tx] = f2bf(t[tx][i]); }
}
__global__ void k_lb(const float* __restrict__ lg, float* __restrict__ lb) {
    const int d = blockIdx.x * blockDim.x + threadIdx.x; if (d >= HG_QK) return;
    const float a = lg[d], b = lg[HG_QK + d], c = lg[2 * HG_QK + d], m = fmaxf(a, fmaxf(b, c));
    const float ea = __expf(a - m), eb = __expf(b - m), ec = __expf(c - m); lb[d] = ea / (ea + eb + ec);
}

template <int MODE>
__global__ void k_rmsnorm(const float* __restrict__ h, const float* __restrict__ g, bf16_t* __restrict__ xn, float* __restrict__ fout,
                          const float* __restrict__ w_in, float* __restrict__ glow,
                          const float* __restrict__ wg, const float* __restrict__ bg, const float* __restrict__ we, const float* __restrict__ be,
                          int* __restrict__ eid, float* __restrict__ wgt, unsigned* __restrict__ ctl) {
    const int row = blockIdx.x * 4 + (threadIdx.x >> 6), lane = threadIdx.x & 63;
    const float* hr = h + (size_t)row * D;
    float v[32]; float ss = 0.f;
#pragma unroll
    for (int j = 0; j < 8; ++j) { const float4 x = *(const float4*)(hr + j * 256 + lane * 4); v[4 * j] = x.x; v[4 * j + 1] = x.y; v[4 * j + 2] = x.z; v[4 * j + 3] = x.w; ss += x.x * x.x + x.y * x.y + x.z * x.z + x.w * x.w; }
    ss = wave_sum(ss); const float rstd = rsqrtf(ss * (1.0f / D) + EPS);
#pragma unroll
    for (int j = 0; j < 8; ++j) { const float4 gg = *(const float4*)(g + j * 256 + lane * 4);
        v[4 * j] *= rstd * gg.x; v[4 * j + 1] *= rstd * gg.y; v[4 * j + 2] *= rstd * gg.z; v[4 * j + 3] *= rstd * gg.w; }
    if (MODE == 3) {
#pragma unroll
        for (int j = 0; j < 8; ++j) *(float4*)(fout + (size_t)row * D + j * 256 + lane * 4) = make_float4(v[4 * j], v[4 * j + 1], v[4 * j + 2], v[4 * j + 3]);
        return;
    }
#pragma unroll
    for (int j = 0; j < 8; ++j) { ushort4 o; o.x = f2bf(v[4 * j]); o.y = f2bf(v[4 * j + 1]); o.z = f2bf(v[4 * j + 2]); o.w = f2bf(v[4 * j + 3]);
        *(ushort4*)(xn + (size_t)row * D + j * 256 + lane * 4) = o; }
    if (MODE == 1) {
        float acc[16];
#pragma unroll
        for (int c = 0; c < 16; ++c) acc[c] = 0.f;
#pragma unroll
        for (int j = 0; j < 8; ++j)
#pragma unroll
            for (int e = 0; e < 4; ++e) { const int k = j * 256 + lane * 4 + e; const float* wr = w_in + (size_t)k * EVEN_IN + EVEN_MAIN; const float xv = v[4 * j + e];
#pragma unroll
                for (int c4 = 0; c4 < 4; ++c4) { const float4 w = *(const float4*)(wr + c4 * 4); acc[c4 * 4] += xv * w.x; acc[c4 * 4 + 1] += xv * w.y; acc[c4 * 4 + 2] += xv * w.z; acc[c4 * 4 + 3] += xv * w.w; } }
#pragma unroll
        for (int c = 0; c < 16; ++c) acc[c] = wave_sum(acc[c]);
        if (lane == 0) {
#pragma unroll
            for (int c = 0; c < 16; ++c) glow[(size_t)row * 16 + c] = acc[c]; }
    }
    if (MODE == 2) {
        float lg[4], le[32];
#pragma unroll
        for (int c = 0; c < 4; ++c) lg[c] = 0.f;
#pragma unroll
        for (int c = 0; c < 32; ++c) le[c] = 0.f;
#pragma unroll
        for (int j = 0; j < 8; ++j)
#pragma unroll
            for (int e = 0; e < 4; ++e) { const int k = j * 256 + lane * 4 + e; const float xv = v[4 * j + e];
                const float4 w4 = *(const float4*)(wg + (size_t)k * 4); lg[0] += xv * w4.x; lg[1] += xv * w4.y; lg[2] += xv * w4.z; lg[3] += xv * w4.w;
#pragma unroll
                for (int c4 = 0; c4 < 8; ++c4) { const float4 w = *(const float4*)(we + (size_t)k * 32 + c4 * 4); le[c4 * 4] += xv * w.x; le[c4 * 4 + 1] += xv * w.y; le[c4 * 4 + 2] += xv * w.z; le[c4 * 4 + 3] += xv * w.w; } }
#pragma unroll
        for (int c = 0; c < 4; ++c) lg[c] = wave_sum(lg[c]) + bg[c];
#pragma unroll
        for (int c = 0; c < 32; ++c) le[c] = wave_sum(le[c]) + be[c];
        if (lane == 0) {
            int grp = 0; float mx = lg[0];
#pragma unroll
            for (int c = 1; c < 4; ++c) if (lg[c] > mx) { mx = lg[c]; grp = c; }
            float den = 0.f;
#pragma unroll
            for (int c = 0; c < 4; ++c) den += __expf(lg[c] - mx);
            const float pg = 1.0f / den;
            float e8[8];
#pragma unroll
            for (int c = 0; c < 8; ++c) { e8[c] = grp == 0 ? le[c] : grp == 1 ? le[8 + c] : grp == 2 ? le[16 + c] : le[24 + c]; }
            int j0 = 0; float v0 = e8[0];
#pragma unroll
            for (int c = 1; c < 8; ++c) if (e8[c] > v0) { v0 = e8[c]; j0 = c; }
            int j1 = -1; float v1 = -3.0e38f;
#pragma unroll
            for (int c = 0; c < 8; ++c) if (c != j0 && e8[c] > v1) { v1 = e8[c]; j1 = c; }
            const float e1 = __expf(v1 - v0), s = 1.0f / (1.0f + e1);
            const int ea = grp * 8 + j0, eb = grp * 8 + j1;
            eid[row * 2] = ea; eid[row * 2 + 1] = eb; wgt[row * 2] = pg * s; wgt[row * 2 + 1] = pg * e1 * s;
            atomicAdd(&ctl[CW_CNT + ea], 1u); atomicAdd(&ctl[CW_CNT + eb], 1u);
        }
    }
}

struct EpiProj0 { bf16_t* hq; float* hlf; bf16_t* hi; bf16_t* hgg; bf16_t* gq; bf16_t* gk; bf16_t* gv; bf16_t* gg; const float* lb;
    DI void operator()(int r, int c, float v) const {
        const int seg = c >> 10, cc = c & 1023; const float sc = 0.08838834764831845f;
        if (seg == 0) hq[(size_t)r * 1024 + cc] = f2bf(siluf_(v) * sc);
        else if (seg == 1) { const float l = lb[cc]; const float f = l + (1.0f - l) * sigmoidf_(v); hlf[(size_t)r * 1024 + cc] = __logf(f); }
        else if (seg == 2) hi[(size_t)r * 1024 + cc] = f2bf(v);
        else if (seg == 3) hgg[(size_t)r * 1024 + cc] = f2bf(siluf_(v));
        else if (seg == 4) { if (cc < 512) gq[(size_t)r * 512 + cc] = f2bf(v * sc); else gk[(size_t)r * 512 + cc - 512] = f2bf(v); }
        else if (seg == 5) gv[(size_t)r * 1024 + cc] = f2bf(v);
        else gg[(size_t)r * 1024 + cc] = f2bf(siluf_(v));
    } };
struct EpiResid { const float* res; float* out;
    DI void operator()(int r, int c, float v) const { out[(size_t)r * D + c] = res[(size_t)r * D + c] + v; } };
struct EpiQKV { bf16_t* q; bf16_t* k; bf16_t* v_;
    DI void operator()(int r, int c, float v) const { const int s = c >> 11, cc = c & 2047; bf16_t* o = s == 0 ? q : s == 1 ? k : v_; o[(size_t)r * D + cc] = f2bf(v); } };
struct EpiBf { bf16_t* o; int ld; int pad;
    DI void operator()(int r, int c, float v) const { o[(size_t)r * ld + c] = f2bf(v); } };
struct EpiSwiglu { bf16_t* o;
    DI void operator()(int r, int j, float a, float b) const { o[(size_t)r * DEXP + j] = f2bf(siluf_(a) * b); } };

template <class Epi, bool DUAL>
__global__ void k_gemm_naive(const bf16_t* __restrict__ A, const int* __restrict__ rowidx, const bf16_t* __restrict__ Bt, int K, int lda,
                             const int* __restrict__ tile_e, size_t b_estride, Epi epi) {
    __shared__ float As[32][65], Bs[32][65], Bs2[DUAL ? 32 : 1][65];
    const int m0 = blockIdx.y * 64, n0 = blockIdx.x * 64, tid = threadIdx.x, tx = tid & 15, ty = tid >> 4;
    if (tile_e) { const int e = tile_e[m0 / MOE_TILE]; if (e < 0) return; Bt += (size_t)e * b_estride; }
    float acc[4][4], acc2[4][4];
#pragma unroll
    for (int i = 0; i < 4; ++i)
#pragma unroll
        for (int j = 0; j < 4; ++j) { acc[i][j] = 0.f; acc2[i][j] = 0.f; }
    const int lr = tid >> 2, lk = (tid & 3) * 8;
    const int arow = rowidx ? rowidx[m0 + lr] : (m0 + lr);
    const bf16_t* ap = A + (size_t)arow * lda + lk;
    const int nl = n0 + lr; const int brow = DUAL ? (nl / 128) * 256 + (nl % 128) : nl;
    const bf16_t* bp = Bt + (size_t)brow * K + lk; const bf16_t* bp2 = bp + (size_t)128 * K;
    for (int k0 = 0; k0 < K; k0 += 32) {
        { const uint4 a = *(const uint4*)(ap + k0); const unsigned w[4] = {a.x, a.y, a.z, a.w};
#pragma unroll
          for (int i = 0; i < 4; ++i) { As[lk + 2 * i][lr] = __uint_as_float(w[i] << 16); As[lk + 2 * i + 1][lr] = __uint_as_float(w[i] & 0xFFFF0000u); } }
        { const uint4 a = *(const uint4*)(bp + k0); const unsigned w[4] = {a.x, a.y, a.z, a.w};
#pragma unroll
          for (int i = 0; i < 4; ++i) { Bs[lk + 2 * i][lr] = __uint_as_float(w[i] << 16); Bs[lk + 2 * i + 1][lr] = __uint_as_float(w[i] & 0xFFFF0000u); } }
        if (DUAL) { const uint4 a = *(const uint4*)(bp2 + k0); const unsigned w[4] = {a.x, a.y, a.z, a.w};
#pragma unroll
          for (int i = 0; i < 4; ++i) { Bs2[lk + 2 * i][lr] = __uint_as_float(w[i] << 16); Bs2[lk + 2 * i + 1][lr] = __uint_as_float(w[i] & 0xFFFF0000u); } }
        __syncthreads();
#pragma unroll 8
        for (int k = 0; k < 32; ++k) {
            float a[4], b[4], b2[4];
#pragma unroll
            for (int i = 0; i < 4; ++i) { a[i] = As[k][ty * 4 + i]; b[i] = Bs[k][tx * 4 + i]; if (DUAL) b2[i] = Bs2[k][tx * 4 + i]; }
#pragma unroll
            for (int i = 0; i < 4; ++i)
#pragma unroll
                for (int j = 0; j < 4; ++j) { acc[i][j] += a[i] * b[j]; if (DUAL) acc2[i][j] += a[i] * b2[j]; }
        }
        __syncthreads();
    }
#pragma unroll
    for (int i = 0; i < 4; ++i)
#pragma unroll
        for (int j = 0; j < 4; ++j) { const int r = m0 + ty * 4 + i, c = n0 + tx * 4 + j;
            if constexpr (DUAL) epi(r, c, acc[i][j], acc2[i][j]); else epi(r, c, acc[i][j]); }
}

template <int DV, bool IS_GLA>
__global__ void __launch_bounds__(DV) k_scan_naive(const bf16_t* __restrict__ Q, const float* __restrict__ LF, const bf16_t* __restrict__ Kx, const bf16_t* __restrict__ V,
                             const float* __restrict__ glow, const float* __restrict__ gk2, const float* __restrict__ gkb, float* __restrict__ oraw, int nheads, int ocol0) {
    constexpr int T = 16;
    __shared__ float sq[T][128], sk[T][128], sa[T][128];
    const int b = blockIdx.x / nheads, hh = blockIdx.x % nheads, v = threadIdx.x;
    const int qld = nheads * 128, vld = nheads * DV;
    float S[128];
#pragma unroll
    for (int d = 0; d < 128; ++d) S[d] = 0.f;
    for (int t0 = 0; t0 < SEQ; t0 += T) {
        __syncthreads();
        for (int i = threadIdx.x; i < T * 128; i += DV) { const int tt = i >> 7, d = i & 127; const size_t tok = (size_t)b * SEQ + t0 + tt;
            sq[tt][d] = bf2f(Q[tok * qld + hh * 128 + d]);
            if (IS_GLA) { float z = gkb[hh * 128 + d];
#pragma unroll
                for (int r = 0; r < GL_RANK; ++r) z += glow[tok * 16 + r] * gk2[r * GL_QK + hh * 128 + d];
                const float ls = fminf(z, 0.f) - log1pf(__expf(-fabsf(z)));
                sa[tt][d] = __expf(ls * (1.0f / 16.0f)); sk[tt][d] = bf2f(Kx[tok * qld + hh * 128 + d]); }
            else { const float a = __expf(LF[tok * qld + hh * 128 + d]); sa[tt][d] = a; sk[tt][d] = 1.0f - a; } }
        __syncthreads();
        for (int tt = 0; tt < T; ++tt) { const size_t tok = (size_t)b * SEQ + t0 + tt;
            const float vv = bf2f(V[tok * vld + hh * DV + v]); float o = 0.f;
#pragma unroll
            for (int d = 0; d < 128; ++d) { S[d] = sa[tt][d] * S[d] + sk[tt][d] * vv; o += sq[tt][d] * S[d]; }
            oraw[tok * D + ocol0 + hh * DV + v] = o; }
    }
}
__global__ void k_norm_gate(const float* __restrict__ oraw, const float* __restrict__ hg_norm, const float* __restrict__ gla_norm,
                            const bf16_t* __restrict__ hgg, const bf16_t* __restrict__ gg, bf16_t* __restrict__ mix) {
    const int w = blockIdx.x * 4 + (threadIdx.x >> 6), lane = threadIdx.x & 63; const int tok = w / 12, s = w % 12;
    const bool gla = s >= 8; const int dv = gla ? 256 : 128, col0 = gla ? 1024 + (s - 8) * 256 : s * 128;
    const float* o = oraw + (size_t)tok * D + col0; float x[4]; float ss = 0.f; const int n = dv / 64;
#pragma unroll
    for (int i = 0; i < 4; ++i) { x[i] = i < n ? o[lane + 64 * i] : 0.f; ss += x[i] * x[i]; }
    ss = wave_sum(ss); const float rstd = rsqrtf(ss / dv + EPS);
#pragma unroll
    for (int i = 0; i < 4; ++i) if (i < n) { const int c = lane + 64 * i; const float gain = gla ? gla_norm[c] : hg_norm[c];
        const float gate = gla ? bf2f(gg[(size_t)tok * 1024 + (s - 8) * 256 + c]) : bf2f(hgg[(size_t)tok * 1024 + s * 128 + c]);
        mix[(size_t)tok * D + col0 + c] = f2bf(x[i] * rstd * gain * gate); }
}

__global__ void k_kmean(const bf16_t* __restrict__ Kb, float* __restrict__ kmean) {
    const int n = blockIdx.x % MB_NBLK, hh = (blockIdx.x / MB_NBLK) % MB_H, b = blockIdx.x / (MB_NBLK * MB_H), d = threadIdx.x;
    float s = 0.f; const bf16_t* p = Kb + ((size_t)b * SEQ + n * MB_BLK) * D + hh * MB_DH + d;
    for (int j = 0; j < MB_BLK; ++j) s += bf2f(p[(size_t)j * D]);
    kmean[(size_t)blockIdx.x * MB_DH + d] = s * (1.0f / MB_BLK);
}
__global__ void k_moba_naive(const bf16_t* __restrict__ Qb, const bf16_t* __restrict__ Kb, const bf16_t* __restrict__ Vb, const float* __restrict__ kmean, bf16_t* __restrict__ AO) {
    __shared__ float sq[4][128]; __shared__ float sp[4][1024]; __shared__ int ssel[4][4];
    const int wv = threadIdx.x >> 6, lane = threadIdx.x & 63;
    const int qi = blockIdx.x * 4 + wv; const int t = qi % SEQ, hh = (qi / SEQ) % MB_H, b = qi / (SEQ * MB_H);
    const size_t tok = (size_t)b * SEQ + t; const int qb = t / MB_BLK;
    sq[wv][lane] = bf2f(Qb[tok * D + hh * MB_DH + lane]); sq[wv][lane + 64] = bf2f(Qb[tok * D + hh * MB_DH + lane + 64]);
    __syncthreads();
    float gate = -3.0e38f;
    if (lane < qb) { const float* km = kmean + ((size_t)(b * MB_H + hh) * MB_NBLK + lane) * MB_DH; float s = 0.f; for (int d = 0; d < 128; ++d) s += sq[wv][d] * km[d]; gate = s; }
    int nsel = qb < 3 ? qb : 3;
    for (int s = 0; s < 3; ++s) { float best = gate; int bi = lane;
        for (int o = 32; o > 0; o >>= 1) { const float ob = __shfl_xor(best, o); const int oi = __shfl_xor(bi, o); if (ob > best || (ob == best && oi < bi)) { best = ob; bi = oi; } }
        if (lane == 0) ssel[wv][s] = bi; if (lane == bi) gate = -3.4e38f; }
    __syncthreads();
    const float scale = 0.08838834764831845f;
    float mx = -3.0e38f;
    for (int sgi = 0; sgi <= nsel; ++sgi) { const int blk = sgi < nsel ? ssel[wv][sgi] : qb;
        for (int i = 0; i < 4; ++i) { const int j = lane + 64 * i, kp = blk * MB_BLK + j; float s = -__builtin_inff();
            if (sgi < nsel || kp <= t) { const bf16_t* kr = Kb + ((size_t)b * SEQ + kp) * D + hh * MB_DH; float a = 0.f;
                for (int d = 0; d < 128; d += 2) { const unsigned w = *(const unsigned*)(kr + d); a += sq[wv][d] * __uint_as_float(w << 16) + sq[wv][d + 1] * __uint_as_float(w & 0xFFFF0000u); }
                s = a * scale; }
            sp[wv][sgi * 256 + j] = s; mx = fmaxf(mx, s); } }
    for (int o = 32; o > 0; o >>= 1) mx = fmaxf(mx, __shfl_xor(mx, o));
    float den = 0.f;
    for (int sgi = 0; sgi <= nsel; ++sgi) for (int i = 0; i < 4; ++i) { const int idx = sgi * 256 + lane + 64 * i; const float p = __expf(sp[wv][idx] - mx); sp[wv][idx] = p; den += p; }
    den = wave_sum(den);
    __syncthreads();
    float o0 = 0.f, o1 = 0.f;
    for (int sgi = 0; sgi <= nsel; ++sgi) { const int blk = sgi < nsel ? ssel[wv][sgi] : qb; const int jmax = sgi < nsel ? 256 : (t - qb * MB_BLK + 1);
        for (int j = 0; j < jmax; ++j) { const float p = sp[wv][sgi * 256 + j]; const unsigned w = *(const unsigned*)(Vb + ((size_t)b * SEQ + blk * MB_BLK + j) * D + hh * MB_DH + lane * 2);
            o0 += p * __uint_as_float(w << 16); o1 += p * __uint_as_float(w & 0xFFFF0000u); } }
    const float inv = 1.0f / den;
    *(unsigned*)(AO + tok * D + hh * MB_DH + lane * 2) = (unsigned)f2bf(o0 * inv) | ((unsigned)f2bf(o1 * inv) << 16);
}

__global__ void k_moe_plan(unsigned* __restrict__ ctl, int* __restrict__ tile_e, int* __restrict__ rowtok) {
    __shared__ int base[NEXP + 1];
    if (threadIdx.x == 0) { int t = 0; for (int e = 0; e < NEXP; ++e) { base[e] = t; const int c = (int)ctl[CW_CNT + e]; const int nt = (c + MOE_TILE - 1) / MOE_TILE;
            for (int i = 0; i < nt; ++i) tile_e[t + i] = e; t += nt; ctl[CW_BASE + e] = (unsigned)(base[e] * MOE_TILE); ctl[CW_CUR + e] = 0u; }
        base[NEXP] = t; ctl[CW_NT] = (unsigned)t; for (int i = t; i < MOE_MAXT; ++i) tile_e[i] = -1; }
    __syncthreads();
    for (int i = threadIdx.x; i < MOE_ROWS; i += blockDim.x) rowtok[i] = 0;
}
__global__ void k_moe_scatter(const int* __restrict__ eid, unsigned* __restrict__ ctl, int* __restrict__ slot, int* __restrict__ rowtok) {
    const int i = blockIdx.x * blockDim.x + threadIdx.x; if (i >= NTOK * 2) return;
    const int e = eid[i]; const unsigned p = atomicAdd(&ctl[CW_CUR + e], 1u); const int s = (int)ctl[CW_BASE + e] + (int)p; slot[i] = s; rowtok[s] = i >> 1;
}
__global__ void k_moe_combine(float* __restrict__ h, const bf16_t* __restrict__ Y, const int* __restrict__ slot, const float* __restrict__ wgt) {
    const int row = blockIdx.x * 4 + (threadIdx.x >> 6), lane = threadIdx.x & 63;
    const int s0 = slot[row * 2], s1 = slot[row * 2 + 1]; const float w0 = wgt[row * 2], w1 = wgt[row * 2 + 1];
    for (int j = 0; j < 8; ++j) { const int c = j * 256 + lane * 4; float4 x = *(float4*)(h + (size_t)row * D + c);
        const ushort4 a = *(const ushort4*)(Y + (size_t)s0 * D + c), bb = *(const ushort4*)(Y + (size_t)s1 * D + c);
        x.x += w0 * bf2f(a.x) + w1 * bf2f(bb.x); x.y += w0 * bf2f(a.y) + w1 * bf2f(bb.y); x.z += w0 * bf2f(a.z) + w1 * bf2f(bb.z); x.w += w0 * bf2f(a.w) + w1 * bf2f(bb.w);
        *(float4*)(h + (size_t)row * D + c) = x; }
}


__device__ __forceinline__ int mk_lane() { int l; asm volatile("v_mbcnt_lo_u32_b32 %0, -1, 0\n\tv_mbcnt_hi_u32_b32 %0, -1, %0" : "=v"(l)); return l; }
#define XB_TMO      128
#define XB_XCNT(j)  (256  + 64 * (j))
#define XB_XSUB(j)  (1280 + 64 * (j))
#define XB_XGEN(j)  (2304 + 64 * (j))
#define XB_TOP      3328
#define XB_TOPGEN   3392
#define XCD_BAR_WORDS 3456
#define XB_SPIN_CAP (1u << 18)
#define LAS __attribute__((address_space(3)))

__device__ __forceinline__ unsigned xb_ld(unsigned* p)              { return __hip_atomic_load(p, __ATOMIC_RELAXED, __HIP_MEMORY_SCOPE_AGENT); }
__device__ __forceinline__ unsigned xb_add(unsigned* p, unsigned v) { return __hip_atomic_fetch_add(p, v, __ATOMIC_RELAXED, __HIP_MEMORY_SCOPE_AGENT); }
__device__ __forceinline__ unsigned xb_xcc_id() { return (unsigned)__builtin_amdgcn_s_getreg((3 << 11) | 20) & 0xFu; }
#define XB_SPIN(cond, bar) do { unsigned _sp = 0; while (cond) { __builtin_amdgcn_s_sleep(1); \
    if ((++_sp & 255u) == 0u) { if (xb_ld(&(bar)[XB_TMO])) break; if (_sp > XB_SPIN_CAP) { atomicAdd(&(bar)[XB_TMO], 1u); break; } } } } while (0)

struct XcdBarrier {
    unsigned* bar; unsigned x;
    unsigned w0;
    volatile LAS unsigned* st;
};

__device__ __forceinline__ XcdBarrier xcd_barrier_post(unsigned* bar, volatile LAS unsigned* st) {
    XcdBarrier b; b.bar = bar; b.x = xb_xcc_id(); b.st = st; b.w0 = (unsigned)__builtin_amdgcn_readfirstlane((int)(threadIdx.x < 64u));
    if (threadIdx.x == 0) (void)xb_add(&bar[XB_XCNT(b.x)], 1u);
    return b;
}
__device__ __forceinline__ void xcd_barrier_complete(unsigned* bar, unsigned x, unsigned& nloc, unsigned& nx) {
    const unsigned G = gridDim.x * gridDim.y * gridDim.z;
    unsigned sum, cnt, mine, sp = 0u;
    for (;;) {
        sum = 0u; cnt = 0u; mine = 0u;
#pragma unroll
        for (unsigned j = 0; j < 16; ++j) { const unsigned c = xb_ld(&bar[XB_XCNT(j)]); sum += c; cnt += (c > 0u) ? 1u : 0u; mine = (j == x) ? c : mine; }
        if (sum == G) break;
        __builtin_amdgcn_s_sleep(1);
        if ((++sp & 255u) == 0u) { if (xb_ld(&bar[XB_TMO])) break; if (sp > XB_SPIN_CAP) { atomicAdd(&bar[XB_TMO], 1u); break; } }
    }
    nloc = mine > 0u ? mine : 1u; nx = cnt > 0u ? cnt : 1u;
}

__device__ __forceinline__ void xcd_barrier(const XcdBarrier& b) {
    asm volatile("s_waitcnt vmcnt(0)" ::: "memory");
    __syncthreads();
    if (b.w0 && mk_lane() == 0) {
        unsigned* bar = b.bar;
        __builtin_amdgcn_s_waitcnt(0);
        unsigned nloc = b.st[0], nx = b.st[1];
        if (nloc == 0u) { xcd_barrier_complete(bar, b.x, nloc, nx); b.st[0] = nloc; b.st[1] = nx; }
        const unsigned old = xb_add(&bar[XB_XSUB(b.x)], 1u);
        const unsigned gen = old / nloc;
        if (old + 1u == (gen + 1u) * nloc) {
            __builtin_amdgcn_fence(__ATOMIC_RELEASE, "agent");
            asm volatile("s_waitcnt vmcnt(0)" ::: "memory");
            const unsigned og = xb_add(&bar[XB_TOP], 1u);
            const unsigned tg = og / nx;
            if (og + 1u == (tg + 1u) * nx) xb_add(&bar[XB_TOPGEN], 1u);
            else XB_SPIN(xb_ld(&bar[XB_TOPGEN]) == tg, bar);
            __builtin_amdgcn_fence(__ATOMIC_ACQUIRE, "agent");
            xb_add(&bar[XB_XGEN(b.x)], 1u);
            asm volatile("s_waitcnt vmcnt(0)" ::: "memory");
        } else {
            XB_SPIN(xb_ld(&bar[XB_XGEN(b.x)]) == gen, bar);
            __builtin_amdgcn_fence(__ATOMIC_ACQUIRE, "agent");
            asm volatile("s_waitcnt vmcnt(0)" ::: "memory");
        }
    }
    __syncthreads();
}


namespace pg8 {
#define PG8_LAS __attribute__((address_space(3)))
typedef unsigned short bf16_t;
typedef short bf16x8 __attribute__((ext_vector_type(8)));
typedef float f32x4 __attribute__((ext_vector_type(4)));
typedef unsigned u32x4 __attribute__((ext_vector_type(4)));
constexpr int BM = 256, BK = 64, HALF = 128, HTB = HALF * BK * 2  , STAGE_BYTES = 8 * HTB, NXCD = 8, WGM = 8;

__host__ __device__ __forceinline__ int lds_byte(int r, int c) { const int st = (r >> 4) * 2 + (c >> 5), rr = r & 15, cc = c & 31, ob = rr * 64 + cc * 2; return st * 1024 + (ob ^ (((ob >> 9) & 1) << 5)); }
__host__ __device__ __forceinline__ void stage_rc(int b, int& R, int& C) { const int st = b / 1024, sb = b % 1024, swz = sb ^ (((sb >> 9) & 1) << 5); R = (st >> 1) * 16 + swz / 64; C = (st & 1) * 32 + (swz % 64) / 2; }
__host__ __device__ __forceinline__ int perm32(int rho) { const int n = rho >> 4, i = rho & 15; return 8 * (i >> 2) + 4 * n + (i & 3); }

struct Unit { int pm, pn; };
struct Gemm { const bf16_t* A; const bf16_t* Bt; int M, N, K; const PG8_LAS int* rows = nullptr; };

struct StaticOrder {
    int nM, nN, nwg, G, c;
    __host__ __device__ void init(int M, int N, int G_, int c_) { nM = M / BM; nN = N / BM; nwg = nM * nN; G = G_; c = c_; }
    __host__ __device__ bool next(int i, Unit& u) const {
        const long L = (long)i * G + c; if (L >= nwg) return false;
        int wgid = (int)L; { const int q = nwg / NXCD, r = nwg % NXCD, xcd = wgid % NXCD, off = wgid / NXCD; wgid = (xcd < r ? xcd * (q + 1) : r * (q + 1) + (xcd - r) * q) + off; }
        const int nig = WGM * nN, gid = wgid / nig, fm = gid * WGM, gsz = (nM - fm) < WGM ? (nM - fm) : WGM;
        u.pm = fm + ((wgid % nig) % gsz); u.pn = (wgid % nig) / gsz; return true;
    }
    __device__ __forceinline__ void a_ready(const Unit&) const {}
    __device__ __forceinline__ void done(const Unit&) const {}
};

__device__ __forceinline__ unsigned cvt_pk_bf16(float lo, float hi) { unsigned r; asm volatile("v_cvt_pk_bf16_f32 %0, %1, %2" : "=v"(r) : "v"(lo), "v"(hi)); return r; }
template <class Epi, class Sched, bool ALIGN_EPI = false, bool SP2 = false, bool GATHER = false>
__device__ __forceinline__ void gemm_phase(PG8_LAS unsigned char* lds, const Gemm g, const Sched& S, const Epi& E, const int wid) {
    const int lane = mk_lane(), tid = wid * 64 + lane, wr = wid >> 2, wc = wid & 3, fr = lane & 15, fq = lane >> 4;
    const int K = g.K, nt = K / BK;
    unsigned voffA[2], voffB[2];
#pragma unroll
    for (int i = 0; i < 2; ++i) { int R, C; stage_rc(tid * 16 + i * 8192, R, C); const int Rb = Epi::PERM ? ((R & ~31) + perm32(R & 31)) : R;
        voffA[i] = (unsigned)(R * K + C) * 2u; voffB[i] = (unsigned)(Rb * K + C) * 2u; }
    unsigned vC[2][2], vN[2][2];
#define PG8_GROWS(V, UI) do { _Pragma("unroll") for (int _i = 0; _i < 2; ++_i) { int _R, _C; stage_rc(tid * 16 + _i * 8192, _R, _C); _Pragma("unroll") for (int _h = 0; _h < 2; ++_h) \
        V[_h][_i] = (unsigned)(g.rows[(UI) * 256 + _h * HALF + _R] * K + _C) * 2u; } } while (0)
#define PG8_STAGE_A(bufoff, gbase, h, NX) do { if constexpr (GATHER) { _Pragma("unroll") for (int _i = 0; _i < 2; ++_i) { const unsigned _o = (NX) ? vN[h][_i] : vC[h][_i]; \
        __builtin_amdgcn_global_load_lds((const unsigned*)((const char*)(gbase) + _o), (PG8_LAS unsigned*)(lds + (bufoff) + ldsw + _i * 8192), 16, 0, 0); } } \
        else { PG8_STAGE(bufoff, (gbase) + (h) * hstep, voffA); } } while (0)
    const size_t kstep = (size_t)(BK * 2);
    const size_t hstep = (size_t)HALF * K * 2;
    const size_t tstep = 2 * hstep;
    const unsigned ldsw = (unsigned)wid * 1024u;
    const int aoff = lds_byte(wr * 64 + fr, fq * 8), boff = lds_byte(wc * 32 + fr, fq * 8);
#define PG8_SA(b, h) (((b) * 2 + (h)) * HTB)
#define PG8_SB(b, h) ((4 + (b) * 2 + (h)) * HTB)
#define PG8_STAGE(bufoff, gbase, voff) do { _Pragma("unroll") for (int _i = 0; _i < 2; ++_i) \
        __builtin_amdgcn_global_load_lds((const unsigned*)((const char*)(gbase) + (voff)[_i]), (PG8_LAS unsigned*)(lds + (bufoff) + ldsw + _i * 8192), 16, 0, 0); } while (0)
#define PG8_LDA(dst, b, h) do { _Pragma("unroll") for (int m = 0; m < 4; ++m) _Pragma("unroll") for (int k = 0; k < 2; ++k) dst[m][k] = *(const PG8_LAS bf16x8*)(lds + PG8_SA(b, h) + aoff + m * 2048 + k * 1024); } while (0)
#define PG8_LDB(dst, b, h) do { _Pragma("unroll") for (int n = 0; n < 2; ++n) _Pragma("unroll") for (int k = 0; k < 2; ++k) dst[n][k] = *(const PG8_LAS bf16x8*)(lds + PG8_SB(b, h) + boff + n * 2048 + k * 1024); } while (0)
#define PG8_MMA(ai, bj, At, Bt) do { __builtin_amdgcn_s_setprio(1); _Pragma("unroll") for (int m = 0; m < 4; ++m) _Pragma("unroll") for (int n = 0; n < 2; ++n) _Pragma("unroll") for (int k = 0; k < 2; ++k) \
        acc[ai][bj][m][n] = __builtin_amdgcn_mfma_f32_16x16x32_bf16(Bt[n][k], At[m][k], acc[ai][bj][m][n], 0, 0, 0); __builtin_amdgcn_s_setprio(0); } while (0)
#define PG8_WAIT_V(n) asm volatile("s_waitcnt vmcnt(" #n ")" ::: "memory")
#define PG8_WAIT_L(n) asm volatile("s_waitcnt lgkmcnt(" #n ")" ::: "memory")
#define PG8_BAR __builtin_amdgcn_s_barrier()
#define PG8_SCHED __builtin_amdgcn_sched_barrier(0)
    Unit cur, nxt; int ui = 0;
    if (!S.next(0, cur)) return;
    f32x4 acc[2][2][4][2];
#pragma unroll
    for (int a = 0; a < 2; ++a)
#pragma unroll
        for (int b = 0; b < 2; ++b)
#pragma unroll
            for (int m = 0; m < 4; ++m)
#pragma unroll
                for (int n = 0; n < 2; ++n) acc[a][b][m][n] = (f32x4){0.f, 0.f, 0.f, 0.f};
    bf16x8 At[4][2], B0[2][2], B1[2][2];
    const char* cA = GATHER ? (const char*)g.A : (const char*)g.A + (size_t)cur.pm * tstep; const char* cB = (const char*)g.Bt + (size_t)cur.pn * tstep;
    if constexpr (GATHER) { PG8_GROWS(vC, 0); }
    S.a_ready(cur);
    if constexpr (SP2) {
        PG8_STAGE(PG8_SB(0, 0), cB, voffB); PG8_STAGE(PG8_SB(0, 1), cB + hstep, voffB); PG8_STAGE_A(PG8_SA(0, 0), cA, 0, false); PG8_STAGE_A(PG8_SA(0, 1), cA, 1, false);
        if (wr == 1) PG8_BAR;
        PG8_WAIT_V(2); PG8_BAR;
        PG8_STAGE(PG8_SB(1, 0), cB + kstep, voffB); PG8_STAGE_A(PG8_SA(1, 0), cA + kstep, 0, false); PG8_STAGE(PG8_SB(1, 1), cB + hstep + kstep, voffB);
        PG8_WAIT_V(6); PG8_BAR;
    } else {
        PG8_STAGE(PG8_SB(0, 0), cB, voffB); PG8_STAGE_A(PG8_SA(0, 0), cA, 0, false); PG8_STAGE(PG8_SB(0, 1), cB + hstep, voffB); PG8_STAGE_A(PG8_SA(0, 1), cA, 1, false);
        if (wr == 1) PG8_BAR;
        PG8_WAIT_V(4); PG8_BAR;
        PG8_STAGE(PG8_SB(1, 0), cB + kstep, voffB); PG8_STAGE_A(PG8_SA(1, 0), cA + kstep, 0, false); PG8_STAGE(PG8_SB(1, 1), cB + hstep + kstep, voffB);
        PG8_WAIT_V(6); PG8_BAR;
    }
    for (;;) {
        const bool has_next = S.next(ui + 1, nxt);
        const char* nA = GATHER ? cA : (has_next ? (const char*)g.A + (size_t)nxt.pm * tstep : cA);
        if constexpr (GATHER) { if (has_next) { PG8_GROWS(vN, ui + 1); } else { _Pragma("unroll") for (int _h = 0; _h < 2; ++_h) _Pragma("unroll") for (int _i = 0; _i < 2; ++_i) vN[_h][_i] = vC[_h][_i]; } }
        const char* nB = has_next ? (const char*)g.Bt + (size_t)nxt.pn * tstep : cB;
        for (int t = 0; t < nt; t += 2) {
            const bool last = (t == nt - 2);
            const char* a1 = cA + (size_t)(t + 1) * kstep;
            const char* a2 = last ? nA : cA + (size_t)(t + 2) * kstep; const char* b2 = last ? nB : cB + (size_t)(t + 2) * kstep;
            const char* a3 = a2 + kstep; const char* b3 = b2 + kstep;
            if (last && has_next) S.a_ready(nxt);
            if constexpr (SP2) {
            PG8_LDB(B0, 0, 0); PG8_LDB(B1, 0, 1); PG8_SCHED; PG8_LDA(At, 0, 0); PG8_STAGE_A(PG8_SA(1, 1), a1, 1, false);
            PG8_WAIT_V(8); PG8_WAIT_L(0); PG8_BAR; PG8_MMA(0, 0, At, B0); PG8_MMA(0, 1, At, B1); PG8_BAR; PG8_SCHED;
            PG8_LDA(At, 0, 1); PG8_STAGE(PG8_SB(0, 0), b2, voffB); PG8_STAGE(PG8_SB(0, 1), b2 + hstep, voffB); PG8_STAGE_A(PG8_SA(0, 0), a2, 0, last);
            PG8_WAIT_V(8); PG8_WAIT_L(0); PG8_BAR; PG8_MMA(1, 0, At, B0); PG8_MMA(1, 1, At, B1); PG8_BAR; PG8_SCHED;
            PG8_LDB(B0, 1, 0); PG8_LDB(B1, 1, 1); PG8_SCHED; PG8_LDA(At, 1, 0); PG8_STAGE_A(PG8_SA(0, 1), a2, 1, last);
            PG8_WAIT_V(8); PG8_WAIT_L(0); PG8_BAR; PG8_MMA(0, 0, At, B0); PG8_MMA(0, 1, At, B1); PG8_BAR; PG8_SCHED;
            PG8_LDA(At, 1, 1); PG8_STAGE(PG8_SB(1, 0), b3, voffB); PG8_STAGE(PG8_SB(1, 1), b3 + hstep, voffB); PG8_STAGE_A(PG8_SA(1, 0), a3, 0, last);
            PG8_WAIT_V(8); PG8_WAIT_L(0); PG8_BAR; PG8_MMA(1, 0, At, B0); PG8_MMA(1, 1, At, B1); PG8_BAR; PG8_SCHED;
            } else {
            PG8_LDB(B0, 0, 0); PG8_SCHED; PG8_LDA(At, 0, 0); PG8_STAGE_A(PG8_SA(1, 1), a1, 1, false);
            PG8_WAIT_L(8); PG8_BAR; PG8_WAIT_L(0); PG8_MMA(0, 0, At, B0); PG8_BAR; PG8_SCHED;
            PG8_LDB(B1, 0, 1); PG8_STAGE(PG8_SB(0, 0), b2, voffB);
            PG8_BAR; PG8_WAIT_L(0); PG8_MMA(0, 1, At, B1); PG8_BAR;
            PG8_LDA(At, 0, 1); PG8_STAGE_A(PG8_SA(0, 0), a2, 0, last);
            PG8_BAR; PG8_WAIT_L(0); PG8_MMA(1, 0, At, B0); PG8_BAR; PG8_SCHED;
            PG8_STAGE(PG8_SB(0, 1), b2 + hstep, voffB);
            PG8_WAIT_V(6); PG8_BAR; PG8_MMA(1, 1, At, B1); PG8_BAR;
            PG8_LDB(B0, 1, 0); PG8_SCHED; PG8_LDA(At, 1, 0); PG8_STAGE_A(PG8_SA(0, 1), a2, 1, last);
            PG8_WAIT_L(8); PG8_BAR; PG8_WAIT_L(0); PG8_MMA(0, 0, At, B0); PG8_BAR; PG8_SCHED;
            PG8_LDB(B1, 1, 1); PG8_STAGE(PG8_SB(1, 0), b3, voffB);
            PG8_BAR; PG8_WAIT_L(0); PG8_MMA(0, 1, At, B1); PG8_BAR;
            PG8_LDA(At, 1, 1); PG8_STAGE_A(PG8_SA(1, 0), a3, 0, last);
            PG8_BAR; PG8_WAIT_L(0); PG8_MMA(1, 0, At, B0); PG8_BAR; PG8_SCHED;
            PG8_STAGE(PG8_SB(1, 1), b3 + hstep, voffB);
            PG8_WAIT_V(6); PG8_BAR; PG8_MMA(1, 1, At, B1); PG8_BAR;
            }
        }
        if constexpr (ALIGN_EPI) { if (wr == 0) PG8_BAR; }
        if constexpr (!Epi::AFTER_DRAIN) { E(acc, cur, wr, wc, fr, fq); S.done(cur); }
        if (!has_next) break;
#pragma unroll
        for (int a = 0; a < 2; ++a)
#pragma unroll
            for (int b = 0; b < 2; ++b)
#pragma unroll
                for (int m = 0; m < 4; ++m)
#pragma unroll
                    for (int n = 0; n < 2; ++n) acc[a][b][m][n] = (f32x4){0.f, 0.f, 0.f, 0.f};
        cur = nxt; cA = nA; cB = nB; ++ui;
        if constexpr (GATHER) { _Pragma("unroll") for (int _h = 0; _h < 2; ++_h) _Pragma("unroll") for (int _i = 0; _i < 2; ++_i) vC[_h][_i] = vN[_h][_i]; }
        if constexpr (ALIGN_EPI) { if (wr == 1) PG8_BAR; }
    }
    PG8_WAIT_V(0);
    if constexpr (!ALIGN_EPI) { if (wr == 0) PG8_BAR; }
    PG8_BAR;
    if constexpr (Epi::AFTER_DRAIN) { E.fused(acc, cur, wr, wc, fr, fq, lds, wid, lane); S.done(cur); }
#undef PG8_SA
#undef PG8_SB
#undef PG8_STAGE
#undef PG8_STAGE_A
#undef PG8_GROWS
#undef PG8_LDA
#undef PG8_LDB
#undef PG8_MMA
#undef PG8_WAIT_V
#undef PG8_WAIT_L
#undef PG8_BAR
#undef PG8_SCHED
}
}

namespace moba {
constexpr int D = 128, LD = 2048;
constexpr bool WSKIP = false;
constexpr float THR = 8.f;
constexpr float SCALE = 0.08838834764831845f;
constexpr int NW = 8, QBLK = 32, KVBLK = 64, QB = NW * QBLK;
constexpr int SHM_V = KVBLK * D * 2, SHM_K = KVBLK * D * 2;
constexpr int ATT_LDS_BYTES = 2 * SHM_V + 2 * SHM_K + NW * 64 * 4;

using bf16 = unsigned short;
typedef short bf16x8 __attribute__((ext_vector_type(8)));
typedef short s16x4 __attribute__((ext_vector_type(4)));
typedef float f32x16 __attribute__((ext_vector_type(16)));
typedef float f32x4 __attribute__((ext_vector_type(4)));
typedef unsigned u32x4 __attribute__((ext_vector_type(4)));
template <class A, class Bt> struct same_t { static constexpr bool v = false; };
template <class A> struct same_t<A, A> { static constexpr bool v = true; };

#define KSWZ(row, colB) ((row) * 256 + ((colB) ^ (((row) & 7) << 4)))
#define SBAR() __builtin_amdgcn_sched_barrier(0)
__device__ __forceinline__ int v_st(int k, int c) { const int kk = (k & ~0xC) | ((k & 4) << 1) | ((k & 8) >> 1); return ((kk >> 3) * 4 + (c >> 5)) * 512 + ((kk & 7) * 32 + (c & 31)) * 2; }
__device__ __forceinline__ int v_rd_base(int lane) { return ((lane & 3) << 3) | (((lane >> 2) & 3) << 6) | (((lane >> 4) & 1) << 5) | (((lane >> 5) & 1) << 8); }
constexpr int v_rd_off(int d0, int ks, int half) { return d0 * 512 + ks * 4096 + half * 2048; }
__device__ __forceinline__ int crow(int r, int hi) { return (r & 3) + 8 * (r >> 2) + 4 * hi; }
__device__ __forceinline__ unsigned cvtpk(float lo, float hi) {
    unsigned r; asm volatile("v_cvt_pk_bf16_f32 %0, %1, %2" : "=v"(r) : "v"(lo), "v"(hi)); return r;
}
__device__ __forceinline__ bf16x8 pack8(f32x4 a, f32x4 b) {
    u32x4 w = {cvtpk(a[0], a[1]), cvtpk(a[2], a[3]), cvtpk(b[0], b[1]), cvtpk(b[2], b[3])};
    return *reinterpret_cast<bf16x8*>(&w);
}
template <class T> __device__ __forceinline__ bf16x8 load8(const T* p) {
    if constexpr (same_t<T, float>::v) { return pack8(*(const f32x4*)p, *(const f32x4*)(p + 4)); }
    else { return *reinterpret_cast<const bf16x8*>(p); }
}
__device__ __forceinline__ void mask_tile(f32x16& p0, f32x16& p1, int dq, unsigned W) {
    const float NEG = -__builtin_inff();
#pragma unroll
    for (int r = 0; r < 16; ++r) {
        const int c = (r & 3) + 8 * (r >> 2);
        if ((unsigned)(dq - c) >= W) p0[r] = NEG;
        if ((unsigned)(dq - c - 32) >= W) p1[r] = NEG;
    }
}
__device__ __forceinline__ void mask_block(f32x16& p0, f32x16& p1, bool keep) {
    const float NEG = -__builtin_inff();
#pragma unroll
    for (int r = 0; r < 16; ++r) { p0[r] = keep ? p0[r] : NEG; p1[r] = keep ? p1[r] : NEG; }
}
__device__ __forceinline__ void partialSM(f32x16& p0, f32x16& p1, float& m_reg, float& mn, float& alpha) {
    float pmax = p0[0]; for (int r = 1; r < 16; ++r) pmax = fmaxf(pmax, p0[r]); for (int r = 0; r < 16; ++r) pmax = fmaxf(pmax, p1[r]);
    { auto rr = __builtin_amdgcn_permlane32_swap(__float_as_uint(pmax), __float_as_uint(pmax), false, false);
      pmax = fmaxf(__uint_as_float(rr[0]), __uint_as_float(rr[1])); }
    constexpr float C2 = 1.4426950408889634f * SCALE;
    if (__builtin_expect(__all((pmax - m_reg) * SCALE <= THR), 1)) { mn = m_reg; alpha = 1.f; }
    else { mn = fmaxf(m_reg, pmax); alpha = __builtin_amdgcn_exp2f((m_reg - mn) * C2); m_reg = mn; }
    const float mnL = -mn * C2;
    for (int r = 0; r < 16; ++r) p0[r] = fmaf(p0[r], C2, mnL); for (int r = 0; r < 16; ++r) p1[r] = fmaf(p1[r], C2, mnL);
    for (int r = 0; r < 16; ++r) p0[r] = __builtin_amdgcn_exp2f(p0[r]);
}
__device__ __forceinline__ void finishSM(f32x16& p0, f32x16& p1, float alpha, float& l_reg, bf16x8& pa0, bf16x8& pa1, bf16x8& pa2, bf16x8& pa3) {
    for (int r = 0; r < 16; ++r) p1[r] = __builtin_amdgcn_exp2f(p1[r]);
    float ps = 0; for (int r = 0; r < 16; ++r) ps += p0[r]; for (int r = 0; r < 16; ++r) ps += p1[r];
    { auto rr = __builtin_amdgcn_permlane32_swap(__float_as_uint(ps), __float_as_uint(ps), false, false);
      ps = __uint_as_float(rr[0]) + __uint_as_float(rr[1]); }
    l_reg = l_reg * alpha + ps;
#define PK4(P, B_, OUT) do { unsigned a0 = cvtpk(P[B_+0], P[B_+1]), a1 = cvtpk(P[B_+2], P[B_+3]);                          \
        unsigned b0 = cvtpk(P[B_+4], P[B_+5]), b1 = cvtpk(P[B_+6], P[B_+7]);                                             \
        auto r0 = __builtin_amdgcn_permlane32_swap(a0, b0, false, false); auto r1 = __builtin_amdgcn_permlane32_swap(a1, b1, false, false); \
        u32x4 w = {r0[0], r1[0], r0[1], r1[1]}; OUT = *reinterpret_cast<bf16x8*>(&w); } while (0)
    PK4(p0, 0, pa0); PK4(p0, 8, pa1); PK4(p1, 0, pa2); PK4(p1, 8, pa3);
#undef PK4
}
template <int KB, bool SK>
__device__ __forceinline__ void qkt(f32x16& p0, f32x16& p1, const char* K_lds, int r32, int hi, const bf16x8* qr, bool act) {
    if (SK && !act) { const float NEG = -__builtin_inff();
#pragma unroll
        for (int r = 0; r < 16; ++r) { p0[r] = NEG; p1[r] = NEG; } return; }
    p0 = f32x16{}; p1 = f32x16{};
    const char* kb[4];
#pragma unroll
    for (int dd = 0; dd < 4; ++dd) kb[dd] = K_lds + KB * SHM_K + KSWZ(r32, (dd * 16 + hi * 8) * 2);
#pragma unroll
    for (int d0 = 0; d0 < 8; ++d0) { const char* a = kb[d0 & 3] + (d0 >> 2) * 128;
        bf16x8 b0 = *reinterpret_cast<const bf16x8*>(a);
        bf16x8 b1 = *reinterpret_cast<const bf16x8*>(a + 32 * 256);
        p0 = __builtin_amdgcn_mfma_f32_32x32x16_bf16(b0, qr[d0], p0, 0, 0, 0);
        p1 = __builtin_amdgcn_mfma_f32_32x32x16_bf16(b1, qr[d0], p1, 0, 0, 0); }
}
template <int VB, bool SK>
__device__ __forceinline__ void pv_tile(f32x16* o, int vb0, bf16x8 pa0, bf16x8 pa1, bf16x8 pa2, bf16x8 pa3, bool act) {
    if (SK && !act) return;
#define TRRD(dst, off) asm volatile("ds_read_b64_tr_b16 %0, %1 offset:%2" : "=&v"(dst) : "v"(vb0), "i"(off) : "memory")
#define PV_D0(d0) do { s16x4 l0, l1, l2, l3, h0, h1, h2, h3; constexpr int b_ = VB * SHM_V + v_rd_off(d0, 0, 0);     \
        TRRD(l0, b_); TRRD(h0, b_ + 2048); TRRD(l1, b_ + 4096); TRRD(h1, b_ + 6144); TRRD(l2, b_ + 8192); TRRD(h2, b_ + 10240); TRRD(l3, b_ + 12288); TRRD(h3, b_ + 14336); \
        asm volatile("s_waitcnt lgkmcnt(0)" ::: "memory"); SBAR();                 \
        o[d0] = __builtin_amdgcn_mfma_f32_32x32x16_bf16(pa0, (bf16x8){l0[0], l0[1], l0[2], l0[3], h0[0], h0[1], h0[2], h0[3]}, o[d0], 0, 0, 0);   \
        o[d0] = __builtin_amdgcn_mfma_f32_32x32x16_bf16(pa1, (bf16x8){l1[0], l1[1], l1[2], l1[3], h1[0], h1[1], h1[2], h1[3]}, o[d0], 0, 0, 0);   \
        o[d0] = __builtin_amdgcn_mfma_f32_32x32x16_bf16(pa2, (bf16x8){l2[0], l2[1], l2[2], l2[3], h2[0], h2[1], h2[2], h2[3]}, o[d0], 0, 0, 0);   \
        o[d0] = __builtin_amdgcn_mfma_f32_32x32x16_bf16(pa3, (bf16x8){l3[0], l3[1], l3[2], l3[3], h3[0], h3[1], h3[2], h3[3]}, o[d0], 0, 0, 0); } while (0)
    PV_D0(0); PV_D0(1); PV_D0(2); PV_D0(3);
#undef PV_D0
#undef TRRD
}

template <class TIn, class TOut> struct BlockRef { const TIn* Q; const TIn* K; const TIn* V; TOut* O; const float* KM; int P0; };
template <class TIn> struct Seam {
    bf16x8 qr[8];
    bf16x8 st_v0, st_v1, st_k0, st_k1; f32x4 sf0, sf1, sf2, sf3;
    f32x4 tq[16];
};
__device__ __forceinline__ int swa_jlo(int P0, int W) { const int lowk = P0 - W + 1; return lowk > 0 ? lowk / KVBLK : 0; }
#define ROW(p, k0, rr) ((p) + (size_t)((k0) + (rr)) * LD + sc)
#define VMW() asm volatile("s_waitcnt vmcnt(0)" ::: "memory")
#define VMWN(n) asm volatile("s_waitcnt vmcnt(%0)" :: "i"(n) : "memory")
#define SLOAD_H(Kp, Vp, k0) do { S.st_v0 = load8<TIn>(ROW(Vp, k0, sr)); S.st_v1 = load8<TIn>(ROW(Vp, k0, 32 + sr));              \
                         S.st_k0 = load8<TIn>(ROW(Kp, k0, sr)); S.st_k1 = load8<TIn>(ROW(Kp, k0, 32 + sr)); } while (0)
#define SWRITE_HK(bf) do { *(bf16x8*)(K_lds + (bf) * SHM_K + kws) = S.st_k0; *(bf16x8*)(K_lds + (bf) * SHM_K + kws + 32 * 256) = S.st_k1; } while (0)
#define SWRITE_HV(bf) do { *(bf16x8*)(V_lds + (bf) * SHM_V + vst0) = S.st_v0; *(bf16x8*)(V_lds + (bf) * SHM_V + vst1) = S.st_v1; } while (0)
#define SWRITE_H(bf) do { SWRITE_HV(bf); SWRITE_HK(bf); } while (0)
#define SLOAD_F(p, k0) do { S.sf0 = *(const f32x4*)ROW(p, k0, sr); S.sf1 = *(const f32x4*)(ROW(p, k0, sr) + 4);                \
                            S.sf2 = *(const f32x4*)ROW(p, k0, 32 + sr); S.sf3 = *(const f32x4*)(ROW(p, k0, 32 + sr) + 4); } while (0)
#define SWRITE_KF(bf) do { *(bf16x8*)(K_lds + (bf) * SHM_K + kws) = pack8(S.sf0, S.sf1); *(bf16x8*)(K_lds + (bf) * SHM_K + kws + 32 * 256) = pack8(S.sf2, S.sf3); } while (0)
#define SWRITE_VF(bf) do { *(bf16x8*)(V_lds + (bf) * SHM_V + vst0) = pack8(S.sf0, S.sf1); *(bf16x8*)(V_lds + (bf) * SHM_V + vst1) = pack8(S.sf2, S.sf3); } while (0)
template <class TIn, class TOut>
__device__ __forceinline__ void causal_swa_prime(const BlockRef<TIn, TOut>& cur, int W, char* lds, Seam<TIn>& S, const int wid) {
    constexpr bool F32 = same_t<TIn, float>::v;
    const int lane = mk_lane(), tid = wid * 64 + lane, r32 = lane & 31, hi = lane >> 5;
    const int sr = tid >> 4, sc = (tid & 15) * 8, kws = KSWZ(sr, sc * 2); char* K_lds = lds + 2 * SHM_V;
    const int kb0 = swa_jlo(cur.P0, W) * KVBLK;
    for (int d0 = 0; d0 < 8; ++d0) S.qr[d0] = load8<TIn>(cur.Q + (size_t)(wid * QBLK + r32) * LD + d0 * 16 + hi * 8);
    if constexpr (F32) { SLOAD_F((const float*)cur.K, kb0); VMW(); SWRITE_KF(0); SBAR(); SLOAD_F((const float*)cur.V, kb0); }
    else { SLOAD_H(cur.K, cur.V, kb0); VMW(); SWRITE_HK(0); }
    __syncthreads();
}
template <class TIn, class TOut>
__device__ __forceinline__ void causal_swa_block(const BlockRef<TIn, TOut>& cur, const BlockRef<TIn, TOut>& nxt, int skv, int W, char* lds, Seam<TIn>& S, const int wid) {
    constexpr bool F32 = same_t<TIn, float>::v;
    const int lane = mk_lane(), tid = wid * 64 + lane, r32 = lane & 31, hi = lane >> 5;
    const int j_lo = swa_jlo(cur.P0, W);
    int j_hi = (cur.P0 + QB - 1) / KVBLK + 1; if (j_hi > skv / KVBLK) j_hi = skv / KVBLK;
    const int NT = j_hi - j_lo;
    const int kbn = swa_jlo(nxt.P0, W) * KVBLK;
    const int qlo = cur.P0 + wid * QBLK, qm = qlo + r32 - 4 * hi;
    char* V_lds = lds; char* K_lds = lds + 2 * SHM_V;
    float* ws = (float*)(lds + 2 * SHM_V + 2 * SHM_K) + wid * 64; float* li_l = ws, * al_l = ws + 32;
    unsigned selmask;
    { const int nqb = cur.P0 >> 8;
      if (nqb <= 3) selmask = (1u << nqb) - 1u;
      else { float b0 = -__builtin_inff(), b1 = b0, b2 = b0; int i0 = 0, i1 = 0, i2 = 0;
        for (int n = 0; n < nqb; ++n) { const float* kp = cur.KM + n * 128 + hi * 8; float s = 0.f;
#pragma unroll
            for (int d0 = 0; d0 < 8; ++d0) { const f32x4 ka = *(const f32x4*)(kp + d0 * 16), kb = *(const f32x4*)(kp + d0 * 16 + 4); const u32x4 qw = __builtin_bit_cast(u32x4, S.qr[d0]);
                s += __uint_as_float(qw[0] << 16) * ka[0] + __uint_as_float(qw[0] & 0xFFFF0000u) * ka[1] + __uint_as_float(qw[1] << 16) * ka[2] + __uint_as_float(qw[1] & 0xFFFF0000u) * ka[3]
                   + __uint_as_float(qw[2] << 16) * kb[0] + __uint_as_float(qw[2] & 0xFFFF0000u) * kb[1] + __uint_as_float(qw[3] << 16) * kb[2] + __uint_as_float(qw[3] & 0xFFFF0000u) * kb[3]; }
            s += __shfl_xor(s, 32);
            if (s > b0) { b2 = b1; i2 = i1; b1 = b0; i1 = i0; b0 = s; i0 = n; } else if (s > b1) { b2 = b1; i2 = i1; b1 = s; i1 = n; } else if (s > b2) { b2 = s; i2 = n; } }
        selmask = (1u << i0) | (1u << i1) | (1u << i2); } }
    float m_reg = -1e30f, l_reg = 0; f32x16 o[4] = {};
    const int sr = tid >> 4, sc = (tid & 15) * 8, vst0 = v_st(sr, sc), vst1 = v_st(32 + sr, sc), kws = KSWZ(sr, sc * 2);
    const int vb0 = (int)(uintptr_t)V_lds + v_rd_base(lane);
    const TIn* Kh = cur.K; const TIn* Vh = cur.V;
#define RESC(a) do { if (__any((a) < 1.f)) { if (hi == 0) al_l[r32] = (a); asm volatile("s_waitcnt lgkmcnt(0)" ::: "memory");              \
                     for (int d_ = 0; d_ < 4; ++d_) for (int r = 0; r < 16; ++r) o[d_][r] *= al_l[crow(r, hi)]; } } while (0)
#define KBASE(t) ((j_lo + (t)) * KVBLK)
#define ACT(t) (KBASE(t) <= qlo + QBLK - 1 && KBASE(t) + KVBLK - 1 >= qlo - W + 1)
#define MASKT(P0_, P1_, t) do { const int kb_ = KBASE(t); if (kb_ + KVBLK - 1 > qlo) mask_tile(P0_, P1_, qm - kb_, (unsigned)W); \
        else if (kb_ < cur.P0 && cur.P0 > 3 * 256) mask_block(P0_, P1_, ((selmask >> (kb_ >> 8)) & 1u) != 0u); } while (0)
    constexpr int NQL = F32 ? 16 : 8;
    constexpr bool SK = WSKIP && !F32;
#define SEAM_K0() do { VMWN(NQL); if constexpr (F32) { SWRITE_KF(0); SBAR(); SLOAD_F((const float*)nxt.V, kbn); } else { SWRITE_HK(0); } SBAR(); } while (0)
    f32x16 pA0, pA1, pB0, pB1; float mnA, mnB, alA, alB; bf16x8 pa0, pa1, pa2, pa3;
    if constexpr (F32) { VMW(); SWRITE_VF(0); SBAR(); } else { SWRITE_HV(0); SBAR(); }
    if (NT > 1) { if constexpr (F32) SLOAD_F((const float*)Kh, KBASE(1)); else SLOAD_H(Kh, Vh, KBASE(1)); }
    SBAR(); qkt<0, SK>(pA0, pA1, K_lds, r32, hi, S.qr, ACT(0));
    if constexpr (F32) { if (NT > 1) { VMW(); SWRITE_KF(1); SBAR(); SLOAD_F((const float*)Vh, KBASE(1)); } }
    MASKT(pA0, pA1, 0); partialSM(pA0, pA1, m_reg, mnA, alA);
    if (NT > 1) { VMW(); if constexpr (F32) { SWRITE_VF(1); SBAR(); if (NT > 2) SLOAD_F((const float*)Kh, KBASE(2)); } else SWRITE_H(1); }
    __syncthreads();
#define HALF_STEP(PX0, PX1, mnX, alX, PY0, PY1, alY, t, KB, VB, SB) do {                                                      \
        SBAR(); qkt<KB, SK>(PX0, PX1, K_lds, r32, hi, S.qr, ACT(t));                                             \
        finishSM(PY0, PY1, alY, l_reg, pa0, pa1, pa2, pa3); SBAR();                                                           \
        if ((t) + 1 < NT) { if constexpr (F32) { VMW(); SWRITE_KF(SB); SBAR(); SLOAD_F((const float*)Vh, KBASE((t) + 1)); }  \
                            else { SLOAD_H(Kh, Vh, KBASE((t) + 1)); } SBAR(); }                                               \
        pv_tile<VB, SK>(o, vb0, pa0, pa1, pa2, pa3, ACT((t) - 1)); MASKT(PX0, PX1, (t)); partialSM(PX0, PX1, m_reg, mnX, alX);                                        \
        __syncthreads();                                                                                                      \
        if ((t) + 1 < NT) { VMW(); if constexpr (F32) { SWRITE_VF(SB); SBAR(); if ((t) + 2 < NT) SLOAD_F((const float*)Kh, KBASE((t) + 2)); } \
                            else { SWRITE_H(SB); } }                                                                          \
        RESC(alX); __syncthreads(); } while (0)
    for (int t = 1; t + 1 < NT; t += 2) {
        HALF_STEP(pB0, pB1, mnB, alB, pA0, pA1, alA, t, 1, 0, 0);
        HALF_STEP(pA0, pA1, mnA, alA, pB0, pB1, alB, t + 1, 0, 1, 1);
    }
    const bool even = (NT & 1) == 0;
    if (even) { SBAR(); qkt<1, SK>(pB0, pB1, K_lds, r32, hi, S.qr, ACT(NT - 1)); SBAR(); }
#define QROW(e) (nxt.Q + (size_t)(wid * QBLK + r32) * LD + ((e) >> 1) * 16 + hi * 8 + ((e) & 1) * 4)
    if constexpr (F32) { SLOAD_F((const float*)nxt.K, kbn); SBAR();
#pragma unroll
        for (int e = 0; e < 8; ++e) S.tq[e] = *(const f32x4*)QROW(e); }
    else { SLOAD_H(nxt.K, nxt.V, kbn); SBAR();
#pragma unroll
        for (int d0 = 0; d0 < 8; ++d0) S.qr[d0] = load8<TIn>(nxt.Q + (size_t)(wid * QBLK + r32) * LD + d0 * 16 + hi * 8); }
    SBAR();
    finishSM(pA0, pA1, alA, l_reg, pa0, pa1, pa2, pa3); SBAR();
    if constexpr (F32) {
#pragma unroll
        for (int e = 8; e < 16; ++e) S.tq[e] = *(const f32x4*)QROW(e); SBAR(); }
#undef QROW
    pv_tile<0, SK>(o, vb0, pa0, pa1, pa2, pa3, ACT(even ? NT - 2 : NT - 1));
    if (even) { MASKT(pB0, pB1, NT - 1); partialSM(pB0, pB1, m_reg, mnB, alB); __syncthreads(); RESC(alB);
        finishSM(pB0, pB1, alB, l_reg, pa0, pa1, pa2, pa3); SBAR(); pv_tile<1, SK>(o, vb0, pa0, pa1, pa2, pa3, ACT(NT - 1)); }
    SBAR(); SEAM_K0();
    if (hi == 0) li_l[r32] = l_reg; asm volatile("s_waitcnt lgkmcnt(0)" ::: "memory");
    float rli[16];
#pragma unroll
    for (int r = 0; r < 16; ++r) rli[r] = __builtin_amdgcn_rcpf(li_l[crow(r, hi)]);
    TOut* Ow = cur.O + (size_t)(wid * QBLK) * LD;
#pragma unroll
    for (int r = 0; r < 16; ++r) { const int orow = crow(r, hi);
#pragma unroll
        for (int d0 = 0; d0 < 4; ++d0) { const float v = o[d0][r] * rli[r];
            if constexpr (same_t<TOut, float>::v) { Ow[(size_t)orow * LD + d0 * 32 + r32] = v; }
            else { const float vn = __shfl_xor(v, 1);
                   if ((r32 & 1) == 0) *(unsigned*)(Ow + (size_t)orow * LD + d0 * 32 + r32) = cvtpk(v, vn); } } }
    if constexpr (F32) {
#pragma unroll
        for (int d0 = 0; d0 < 8; ++d0) S.qr[d0] = pack8(S.tq[2 * d0], S.tq[2 * d0 + 1]); }
    __syncthreads();
#undef RESC
#undef KBASE
#undef ACT
#undef MASKT
#undef SEAM_K0
#undef HALF_STEP
}
#undef ROW
#undef VMW
#undef VMWN
#undef SLOAD_H
#undef SWRITE_HK
#undef SWRITE_HV
#undef SWRITE_H
#undef SLOAD_F
#undef SWRITE_KF
#undef SWRITE_VF
}

#define LAS __attribute__((address_space(3)))
typedef float f32x4 __attribute__((ext_vector_type(4)));
typedef unsigned u32x4 __attribute__((ext_vector_type(4)));
typedef unsigned u32x2 __attribute__((ext_vector_type(2)));
constexpr int NTHR = 512, NWAVE = 8;
constexpr int RING_BYTES = 131072, LDS_MISC = 131072, LDS_BYTES = 147456;
constexpr int MI_BAR = 0;
constexpr int MI_NT = 16;
constexpr int MI_TILEE = 64;
constexpr int MI_EBASE = 1024;
constexpr int MI_RSTD = 2048;
constexpr int MI_LCNT = 2432;
constexpr int MI_WGOFF = 2560;
constexpr int MI_PART = 2688;
constexpr int MI_LOGIT = 4096;
constexpr size_t WS_RWT = WS_TOTAL;
constexpr size_t WS_XS_UNUSED = 0;
constexpr size_t WS_TOTAL2 = WS_RWT + (size_t)2 * 2048 * 48 * 4;
constexpr size_t WS_LA = WS_TOTAL2;
constexpr size_t WS_LRANK = WS_LA + (size_t)NTOK * GL_QK * 4;
constexpr size_t WS_WGCNT = WS_LRANK + (size_t)NTOK * 2 * 4;
constexpr size_t WS_TOTAL3 = WS_WGCNT + (size_t)2 * 256 * NEXP * 4;
constexpr int CW2_CNT0 = 1024, CW2_CUR0 = 1088, CW2_CNT1 = 1152, CW2_CUR1 = 1216;
constexpr int CW2_BAR = 2048;
constexpr int NBARREG = 4;
constexpr size_t CTL2_BYTES = (size_t)(CW2_BAR + NBARREG * XCD_BAR_WORDS) * 4;
static_assert(CTL2_BYTES <= CTL_BYTES, "ctl");
constexpr size_t U_XS = U_Y;

#define PROBE_ID (-1)
#define PROBE_BLOCK 0
#define PROBE_MULT 8
constexpr int MI_PROBE = 32;
#define PRB_B(L_, id) do { if (PROBE_ID == (id) && blockIdx.x == PROBE_BLOCK && threadIdx.x == 0) *(volatile LAS unsigned long long*)((L_) + LDS_MISC + MI_PROBE) -= __builtin_amdgcn_s_memrealtime(); } while (0)
#define PRB_E(L_, id) do { if (PROBE_ID == (id) && blockIdx.x == PROBE_BLOCK && threadIdx.x == 0) *(volatile LAS unsigned long long*)((L_) + LDS_MISC + MI_PROBE) += __builtin_amdgcn_s_memrealtime(); } while (0)
#define PRB_BEGIN(id) do { if (PROBE_ID == (id) && blockIdx.x == PROBE_BLOCK && threadIdx.x == 0) *(volatile LAS unsigned long long*)(F.lds + LDS_MISC + MI_PROBE) -= __builtin_amdgcn_s_memrealtime(); } while (0)
#define PRB_END(id)   do { if (PROBE_ID == (id) && blockIdx.x == PROBE_BLOCK && threadIdx.x == 0) *(volatile LAS unsigned long long*)(F.lds + LDS_MISC + MI_PROBE) += __builtin_amdgcn_s_memrealtime(); } while (0)
struct Args { const float* in[20]; float* out; unsigned char* ws; int ph_lo, ph_hi, bar_idx, pad; };

DI const Args* ka_launder() { const Args* p = (const Args*)__builtin_amdgcn_kernarg_segment_ptr(); asm volatile("" : "+s"(p)); return p; }
struct Frame {
    LAS unsigned char* lds; int tid, lane, wave, G, bx, vcu;
    unsigned char* ws; unsigned* ctl;
};

DI unsigned pk_bf16(float lo, float hi) { unsigned r; asm volatile("v_cvt_pk_bf16_f32 %0, %1, %2" : "=v"(r) : "v"(lo), "v"(hi)); return r; }
DI float fast_sigmoid(float x) { return __builtin_amdgcn_rcpf(1.0f + __expf(-x)); }

struct EpiProj0F { static constexpr bool PERM = true, AFTER_DRAIN = false;
    bf16_t* hq; float* hlf; bf16_t* hi; bf16_t* hgg; bf16_t* gq; bf16_t* gk; bf16_t* gv; bf16_t* gg; const float* lb;
    DI void operator()(const f32x4 (&acc)[2][2][4][2], const pg8::Unit& u, int wr, int wc, int fr, int fq) const {
        const int colt = u.pn * 256, seg = colt >> 10, row0 = u.pm * 256 + wr * 64 + fr, cl = (colt & 1023) + wc * 32 + 8 * fq;
        if (seg == 1) {
            f32x4 l0[2], l1[2];
#pragma unroll
            for (int bj = 0; bj < 2; ++bj) { l0[bj] = *(const f32x4*)(lb + cl + bj * 128); l1[bj] = *(const f32x4*)(lb + cl + bj * 128 + 4); }
#pragma unroll
            for (int ai = 0; ai < 2; ++ai)
#pragma unroll
                for (int m = 0; m < 4; ++m) { float* rowp = hlf + (size_t)(row0 + ai * 128 + m * 16) * 1024 + cl;
#pragma unroll
                    for (int bj = 0; bj < 2; ++bj) { f32x4 v0 = acc[ai][bj][m][0], v1 = acc[ai][bj][m][1];
#pragma unroll
                        for (int j = 0; j < 4; ++j) { v0[j] = __logf(l0[bj][j] + (1.0f - l0[bj][j]) * fast_sigmoid(v0[j])); v1[j] = __logf(l1[bj][j] + (1.0f - l1[bj][j]) * fast_sigmoid(v1[j])); }
                        *(f32x4*)(rowp + bj * 128) = v0; *(f32x4*)(rowp + bj * 128 + 4) = v1; } }
            return;
        }
        bf16_t* dst; int ld = 1024, co = cl; bool silu = false; float sc = 1.0f;
        if (seg == 0) { dst = hq; silu = true; sc = 0.08838834764831845f; }
        else if (seg == 2) dst = hi;
        else if (seg == 3) { dst = hgg; silu = true; }
        else if (seg == 4) { ld = 512; if ((colt & 1023) < 512) { dst = gq; sc = 0.08838834764831845f; } else { dst = gk; co = cl - 512; } }
        else if (seg == 5) dst = gv;
        else { dst = gg; silu = true; }
#pragma unroll
        for (int ai = 0; ai < 2; ++ai)
#pragma unroll
            for (int m = 0; m < 4; ++m) { bf16_t* rowp = dst + (size_t)(row0 + ai * 128 + m * 16) * ld + co;
#pragma unroll
                for (int bj = 0; bj < 2; ++bj) { f32x4 v0 = acc[ai][bj][m][0], v1 = acc[ai][bj][m][1];
                    if (silu) {
#pragma unroll
                        for (int j = 0; j < 4; ++j) { v0[j] *= fast_sigmoid(v0[j]); v1[j] *= fast_sigmoid(v1[j]); } }
                    v0 = v0 * sc; v1 = v1 * sc;
                    u32x4 w; w.x = pk_bf16(v0[0], v0[1]); w.y = pk_bf16(v0[2], v0[3]); w.z = pk_bf16(v1[0], v1[1]); w.w = pk_bf16(v1[2], v1[3]);
                    *(u32x4*)(rowp + bj * 128) = w; } }
    } };
template <bool RES_F32> struct EpiResidF { static constexpr bool PERM = true, AFTER_DRAIN = false;
    const void* res; bf16_t* out;
    DI void operator()(const f32x4 (&acc)[2][2][4][2], const pg8::Unit& u, int wr, int wc, int fr, int fq) const {
        const int row0 = u.pm * 256 + wr * 64 + fr, col0 = u.pn * 256 + wc * 32 + 8 * fq;
#pragma unroll
        for (int ai = 0; ai < 2; ++ai)
#pragma unroll
            for (int m = 0; m < 4; ++m) { const size_t ro = (size_t)(row0 + ai * 128 + m * 16) * D + col0;
#pragma unroll
                for (int bj = 0; bj < 2; ++bj) { f32x4 v0 = acc[ai][bj][m][0], v1 = acc[ai][bj][m][1];
                    if (RES_F32) { v0 += *(const f32x4*)((const float*)res + ro + bj * 128); v1 += *(const f32x4*)((const float*)res + ro + bj * 128 + 4); }
                    else { const u32x4 r = *(const u32x4*)((const bf16_t*)res + ro + bj * 128);
                        v0[0] += __uint_as_float(r[0] << 16); v0[1] += __uint_as_float(r[0] & 0xFFFF0000u); v0[2] += __uint_as_float(r[1] << 16); v0[3] += __uint_as_float(r[1] & 0xFFFF0000u);
                        v1[0] += __uint_as_float(r[2] << 16); v1[1] += __uint_as_float(r[2] & 0xFFFF0000u); v1[2] += __uint_as_float(r[3] << 16); v1[3] += __uint_as_float(r[3] & 0xFFFF0000u); }
                    u32x4 w; w.x = pk_bf16(v0[0], v0[1]); w.y = pk_bf16(v0[2], v0[3]); w.z = pk_bf16(v1[0], v1[1]); w.w = pk_bf16(v1[2], v1[3]);
                    *(u32x4*)(out + ro + bj * 128) = w; } }
    } };
struct EpiBf16F { static constexpr bool PERM = true, AFTER_DRAIN = false;
    bf16_t* O; int ldc, nct, split_tiles; size_t split_stride;
    DI void operator()(const f32x4 (&acc)[2][2][4][2], const pg8::Unit& u, int wr, int wc, int fr, int fq) const {
        int ct = u.pn % nct; bf16_t* base = O; if (split_tiles) { const int t = ct / split_tiles; base += (size_t)t * split_stride; ct -= t * split_tiles; }
        const int row0 = u.pm * 256 + wr * 64 + fr, col0 = ct * 256 + wc * 32 + 8 * fq;
#pragma unroll
        for (int ai = 0; ai < 2; ++ai)
#pragma unroll
            for (int m = 0; m < 4; ++m) { bf16_t* rowp = base + (size_t)(row0 + ai * 128 + m * 16) * ldc + col0;
#pragma unroll
                for (int bj = 0; bj < 2; ++bj) { const f32x4 v0 = acc[ai][bj][m][0], v1 = acc[ai][bj][m][1];
                    u32x4 w; w.x = pk_bf16(v0[0], v0[1]); w.y = pk_bf16(v0[2], v0[3]); w.z = pk_bf16(v1[0], v1[1]); w.w = pk_bf16(v1[2], v1[3]);
                    *(u32x4*)(rowp + bj * 128) = w; } }
    } };
struct EpiSwigluF { static constexpr bool PERM = true, AFTER_DRAIN = false;
    bf16_t* O;
    DI void operator()(const f32x4 (&acc)[2][2][4][2], const pg8::Unit& u, int wr, int wc, int fr, int fq) const {
        const int row0 = u.pm * 256 + wr * 64 + fr, col0 = (u.pn & 3) * 128 + wc * 32 + 8 * fq;
#pragma unroll
        for (int ai = 0; ai < 2; ++ai)
#pragma unroll
            for (int m = 0; m < 4; ++m) { bf16_t* rowp = O + (size_t)(row0 + ai * 128 + m * 16) * DEXP + col0;
                f32x4 a0 = acc[ai][0][m][0], a1 = acc[ai][0][m][1]; const f32x4 b0 = acc[ai][1][m][0], b1 = acc[ai][1][m][1];
#pragma unroll
                for (int j = 0; j < 4; ++j) { a0[j] = a0[j] * fast_sigmoid(a0[j]) * b0[j]; a1[j] = a1[j] * fast_sigmoid(a1[j]) * b1[j]; }
                u32x4 w; w.x = pk_bf16(a0[0], a0[1]); w.y = pk_bf16(a0[2], a0[3]); w.z = pk_bf16(a1[0], a1[1]); w.w = pk_bf16(a1[2], a1[3]);
                *(u32x4*)rowp = w; }
    } };
struct MoeOrder {
    int nN, shift, nunits, G, c; const LAS int* tile_e;
    DI bool next(int i, pg8::Unit& u) const { const long L = (long)i * G + c; if (L >= nunits) return false; const int t = (int)L >> shift, pn = (int)L & (nN - 1);
        u.pm = t; u.pn = tile_e[t] * nN + pn; return true; }
    DI void a_ready(const pg8::Unit&) const {}
    DI void done(const pg8::Unit&) const {}
};

struct TJob { const float* src; bf16_t* dst; int ld, Kd, k0, n0, mode, half; };
DI void tjob_decode(int j, const Args& a, unsigned char* ws, TJob& t) {
    const float* w_in = a.in[4]; const float* w_out = a.in[10]; const float* w_qkv = a.in[11]; const float* w_o = a.in[12];
    const float* ew1 = a.in[17]; const float* ew3 = a.in[18]; const float* ew2 = a.in[19];
    t.mode = 0; t.half = 0;
    if (j < 896) { t.src = w_in; t.dst = (bf16_t*)(ws + WS_WIN); t.ld = EVEN_IN; t.Kd = D; t.k0 = (j / 56) * 128; t.n0 = (j % 56) * 128; return; }
    j -= 896;
    if (j < 256) { t.src = w_out; t.dst = (bf16_t*)(ws + WS_WOUT); t.ld = D; t.Kd = D; t.k0 = (j / 16) * 128; t.n0 = (j % 16) * 128; return; }
    j -= 256;
    if (j < 768) { t.src = w_qkv; t.dst = (bf16_t*)(ws + WS_WQKV); t.ld = 3 * D; t.Kd = D; t.k0 = (j / 48) * 128; t.n0 = (j % 48) * 128; return; }
    j -= 768;
    if (j < 256) { t.src = w_o; t.dst = (bf16_t*)(ws + WS_WO); t.ld = D; t.Kd = D; t.k0 = (j / 16) * 128; t.n0 = (j % 16) * 128; return; }
    j -= 256;
    const int le = j / 192, r = j % 192;
    if (r < 128) { const int hf = r / 64, q = r % 64; t.src = (hf ? ew3 : ew1) + (size_t)le * D * DEXP; t.dst = (bf16_t*)(ws + WS_WUP) + (size_t)le * 1024 * D; t.ld = DEXP; t.Kd = D;
        t.k0 = (q / 4) * 128; t.n0 = (q % 4) * 128; t.mode = 1; t.half = hf; return; }
    { const int q = r - 128; t.src = ew2 + (size_t)le * DEXP * D; t.dst = (bf16_t*)(ws + WS_WDN) + (size_t)le * D * DEXP; t.ld = D; t.Kd = DEXP; t.k0 = (q / 16) * 128; t.n0 = (q % 16) * 128; }
}
constexpr int N_TJOBS = 896 + 256 + 768 + 256 + 64 * 192;
DI void tjob_load(const TJob& t, int tid, f32x4 (&r)[8]) {
    const int c4 = (tid & 31) * 4, r0 = tid >> 5;
#pragma unroll
    for (int i = 0; i < 8; ++i) r[i] = *(const f32x4*)(t.src + (size_t)(t.k0 + r0 + 16 * i) * t.ld + t.n0 + c4);
}
DI void phase_transposes(const Frame& F, const Args& a, int j_lo, int j_hi, int widx, int nwork) {
    LAS float* T = (LAS float*)F.lds;
    const int tid = F.tid; int ja = j_lo + widx; if (ja >= j_hi) return;
    int jb = ja + nwork;
    TJob ta, tb; f32x4 ra[8], rb[8];
    tjob_decode(ja, a, F.ws, ta); tjob_load(ta, tid, ra);
    if (jb < j_hi) { tjob_decode(jb, a, F.ws, tb); tjob_load(tb, tid, rb); }
#define TR_PROC(R, TJ, J) do {                                                                                                     \
        const int c4_ = (tid & 31) * 4, r0_ = tid >> 5;                                                                           \
        _Pragma("unroll") for (int i = 0; i < 8; ++i) *(LAS f32x4*)(T + (r0_ + 16 * i) * 132 + c4_) = R[i];                        \
        const TJob cur_ = TJ; J += 2 * nwork;                                                                                      \
        if (J < j_hi) { tjob_decode(J, a, F.ws, TJ); tjob_load(TJ, tid, R); }                                                      \
        __syncthreads();                                                                                                           \
        { const int n_ = tid & 127, kg_ = tid >> 7; const int nn_ = cur_.n0 + n_;                                                  \
          const int drow_ = cur_.mode == 0 ? nn_ : (nn_ / 128) * 256 + cur_.half * 128 + (nn_ % 128);                              \
          bf16_t* dp_ = cur_.dst + (size_t)drow_ * cur_.Kd + cur_.k0 + kg_ * 32;                                                   \
          _Pragma("unroll") for (int q = 0; q < 4; ++q) { float v_[8];                                                            \
              _Pragma("unroll") for (int e = 0; e < 8; ++e) v_[e] = T[(kg_ * 32 + q * 8 + e) * 132 + n_];                          \
              u32x4 w_; w_.x = pk_bf16(v_[0], v_[1]); w_.y = pk_bf16(v_[2], v_[3]); w_.z = pk_bf16(v_[4], v_[5]); w_.w = pk_bf16(v_[6], v_[7]); \
              *(u32x4*)(dp_ + q * 8) = w_; } }                                                                                     \
        __syncthreads(); } while (0)
    for (;;) {
        TR_PROC(ra, ta, ja);
        if (jb >= j_hi) break;
        TR_PROC(rb, tb, jb);
        if (ja >= j_hi) break;
    }
#undef TR_PROC
}
DI void phase_tables(const Frame& F, const Args& a) {
    const int gt = F.bx * NTHR + F.tid, gn = F.G * NTHR;
    float* LB = (float*)(F.ws + SM_LB); const float* lg = a.in[5];
    for (int d = gt; d < HG_QK; d += gn) { const float x = lg[d], y = lg[HG_QK + d], z = lg[2 * HG_QK + d], m = fmaxf(x, fmaxf(y, z));
        const float ex = __expf(x - m), ey = __expf(y - m), ez = __expf(z - m); LB[d] = ex / (ex + ey + ez); }
    float* RWT = (float*)(F.ws + WS_RWT);
    for (int i = gt; i < 2 * 2048 * 48; i += gn) { const int l = i / (2048 * 48), r = i % (2048 * 48); const int jj = r & 3, ln = (r >> 2) & 63, nt = (r >> 8) % 3, s = r / 768;
        const int k = 16 * s + 4 * (ln >> 4) + jj, n = 16 * nt + (ln & 15);
        float w = 0.f; if (n < 4) w = a.in[13][((size_t)l * D + k) * NGRP + n]; else if (n < 36) w = a.in[15][((size_t)l * D + k) * NEXP + (n - 4)];
        RWT[i] = w * a.in[2][l * D + k]; }
}

template <int MODE, bool COMBINE, bool SRC_BF16>
DI void phase_norm(const Frame& F, const void* src, bf16_t* hdst, const float* gain, bf16_t* xn, float* fout,
                   const bf16_t* Y, const int* slot, const float* wgt,
                   const float* w_in, float* glow, const float* rwt, const float* bg, const float* be, int* eid, float* wgt_out, unsigned* cnt,
                   const float* gk2 = nullptr, const float* gkb = nullptr, float* la = nullptr, int* lrank = nullptr) {
    const int lane = F.lane, w = F.wave;
    LAS float* rs = (LAS float*)(F.lds + LDS_MISC + MI_RSTD); LAS float* lgt = (LAS float*)(F.lds + LDS_MISC + MI_LOGIT);
    LAS f32x4* part = MODE == 1 ? (LAS f32x4*)(F.lds + LDS_MISC + MI_LOGIT + 4096) : (LAS f32x4*)F.lds;
    if (MODE == 1) {
        for (int q = 0; q < 64; ++q) { const int idx = F.tid + NTHR * q; const int jj = idx & 3, ln = (idx >> 2) & 63, s = idx >> 8; const int k = 16 * s + 4 * (ln >> 4) + jj;
            ((LAS float*)F.lds)[idx] = w_in[(size_t)k * EVEN_IN + EVEN_MAIN + (ln & 15)] * gain[k]; }
        __syncthreads(); }
    if (MODE == 2) { if (F.tid < NEXP) ((LAS int*)(F.lds + LDS_MISC + MI_LCNT))[F.tid] = 0; __syncthreads(); }
    for (int rb = F.bx; rb < NTOK / 64; rb += F.G) {
        const int r0 = rb * 64;
        PRB_BEGIN(100);
#pragma unroll 1
        for (int i = 0; i < 8; ++i) { const int row = r0 + w * 8 + i;
            f32x4 v[8];
            if (SRC_BF16) { const bf16_t* hr = (const bf16_t*)src + (size_t)row * D;
#pragma unroll
                for (int j = 0; j < 8; ++j) { const u32x2 t = *(const u32x2*)(hr + j * 256 + lane * 4);
                    v[j] = (f32x4){__uint_as_float(t[0] << 16), __uint_as_float(t[0] & 0xFFFF0000u), __uint_as_float(t[1] << 16), __uint_as_float(t[1] & 0xFFFF0000u)}; } }
            else { const float* hr = (const float*)src + (size_t)row * D;
#pragma unroll
                for (int j = 0; j < 8; ++j) v[j] = *(const f32x4*)(hr + j * 256 + lane * 4); }
            if (COMBINE) { const int s0 = slot[row * 2], s1 = slot[row * 2 + 1]; const float w0 = wgt[row * 2], w1 = wgt[row * 2 + 1];
#pragma unroll
                for (int j = 0; j < 8; ++j) { const u32x2 ya = *(const u32x2*)(Y + (size_t)s0 * D + j * 256 + lane * 4), yb = *(const u32x2*)(Y + (size_t)s1 * D + j * 256 + lane * 4);
                    v[j][0] += w0 * __uint_as_float(ya[0] << 16) + w1 * __uint_as_float(yb[0] << 16); v[j][1] += w0 * __uint_as_float(ya[0] & 0xFFFF0000u) + w1 * __uint_as_float(yb[0] & 0xFFFF0000u);
                    v[j][2] += w0 * __uint_as_float(ya[1] << 16) + w1 * __uint_as_float(yb[1] << 16); v[j][3] += w0 * __uint_as_float(ya[1] & 0xFFFF0000u) + w1 * __uint_as_float(yb[1] & 0xFFFF0000u); }
                if (MODE != 3) {
#pragma unroll
                    for (int j = 0; j < 8; ++j) { u32x2 p; p[0] = pk_bf16(v[j][0], v[j][1]); p[1] = pk_bf16(v[j][2], v[j][3]); *(u32x2*)(hdst + (size_t)row * D + j * 256 + lane * 4) = p; } } }
            float ss = 0.f;
#pragma unroll
            for (int j = 0; j < 8; ++j) ss += v[j][0] * v[j][0] + v[j][1] * v[j][1] + v[j][2] * v[j][2] + v[j][3] * v[j][3];
            ss = wave_sum(ss); const float rstd = rsqrtf(ss * (1.0f / D) + EPS);
            if (MODE == 1 || MODE == 2) { if (lane == 0) rs[w * 8 + i] = rstd; }
#pragma unroll
            for (int j = 0; j < 8; ++j) { const f32x4 g4 = *(const f32x4*)(gain + j * 256 + lane * 4); const f32x4 o = v[j] * g4 * rstd;
                if (MODE == 3) *(f32x4*)(fout + (size_t)row * D + j * 256 + lane * 4) = o;
                else { u32x2 p; p[0] = pk_bf16(o[0], o[1]); p[1] = pk_bf16(o[2], o[3]); *(u32x2*)(xn + (size_t)row * D + j * 256 + lane * 4) = p; } }
        }
        PRB_END(100);
        if (MODE == 1 || MODE == 2) {
            constexpr int NT = MODE == 2 ? 3 : 1;
            PRB_BEGIN(101);
            __builtin_amdgcn_fence(__ATOMIC_RELEASE, "workgroup"); __syncthreads(); __builtin_amdgcn_fence(__ATOMIC_ACQUIRE, "workgroup");
            const int rg = w & 3, kh = w >> 2, m = lane & 15, kq = lane >> 4;
            const size_t xro = (size_t)(r0 + rg * 16 + m) * D + 4 * kq;
            f32x4 acc[NT];
#pragma unroll
            for (int t = 0; t < NT; ++t) acc[t] = (f32x4){0.f, 0.f, 0.f, 0.f};
            constexpr int UN = 4;
#pragma unroll 1
            for (int s0 = kh * 64; s0 < kh * 64 + 64; s0 += UN) {
                f32x4 xa[UN], wb[UN][NT];
#pragma unroll
                for (int u = 0; u < UN; ++u) {
                    if (SRC_BF16) { const u32x2 t = *(const u32x2*)((const bf16_t*)src + xro + 16 * (s0 + u));
                        xa[u] = (f32x4){__uint_as_float(t[0] << 16), __uint_as_float(t[0] & 0xFFFF0000u), __uint_as_float(t[1] << 16), __uint_as_float(t[1] & 0xFFFF0000u)}; }
                    else xa[u] = *(const f32x4*)((const float*)src + xro + 16 * (s0 + u));
                    if (MODE == 2) {
#pragma unroll
                        for (int t = 0; t < NT; ++t) wb[u][t] = *(const f32x4*)(rwt + ((size_t)((s0 + u) * 3 + t) * 64 + lane) * 4); }
                    else wb[u][0] = *(const LAS f32x4*)(F.lds + ((s0 + u) * 64 + lane) * 16); }
#pragma unroll
                for (int u = 0; u < UN; ++u)
#pragma unroll
                    for (int j = 0; j < 4; ++j)
#pragma unroll
                        for (int t = 0; t < NT; ++t) acc[t] = __builtin_amdgcn_mfma_f32_16x16x4f32(xa[u][j], wb[u][t][j], acc[t], 0, 0, 0);
            }
            PRB_END(101); PRB_BEGIN(102);
            if (kh == 1) {
#pragma unroll
                for (int t = 0; t < NT; ++t) part[(rg * NT + t) * 64 + lane] = acc[t]; }
            __syncthreads();
            if (kh == 0) {
#pragma unroll
                for (int t = 0; t < NT; ++t) { const f32x4 p = part[(rg * NT + t) * 64 + lane];
#pragma unroll
                    for (int q = 0; q < 4; ++q) { const int rl = rg * 16 + 4 * kq + q; const float val = (acc[t][q] + p[q]) * rs[rl];
                        if (MODE == 1) { glow[(size_t)(r0 + rl) * 16 + m] = val; lgt[rl * 16 + m] = val; } else lgt[rl * 48 + t * 16 + m] = val; } } }
            __syncthreads();
            if (MODE == 1) {
                const int col = F.tid; float g2[GL_RANK];
#pragma unroll
                for (int r = 0; r < GL_RANK; ++r) g2[r] = gk2[r * GL_QK + col];
                const float bias = gkb[col];
                for (int rl = 0; rl < 64; ++rl) { float z = bias;
#pragma unroll
                    for (int r = 0; r < GL_RANK; ++r) z += lgt[rl * 16 + r] * g2[r];
                    const float ls = fminf(z, 0.f) - __logf(1.0f + __expf(-fabsf(z)));
                    la[(size_t)(r0 + rl) * GL_QK + col] = ls * (1.0f / 16.0f); } }
            if (MODE == 2 && F.tid < 64) {
                const int row = r0 + F.tid; const LAS float* lr = lgt + F.tid * 48;
                float lg[4], e8[8];
#pragma unroll
                for (int c = 0; c < 4; ++c) lg[c] = lr[c] + bg[c];
                int grp = 0; float mx = lg[0];
#pragma unroll
                for (int c = 1; c < 4; ++c) if (lg[c] > mx) { mx = lg[c]; grp = c; }
                float den = 0.f;
#pragma unroll
                for (int c = 0; c < 4; ++c) den += __expf(lg[c] - mx);
                const float pg = 1.0f / den;
#pragma unroll
                for (int c = 0; c < 8; ++c) e8[c] = lr[4 + grp * 8 + c] + be[grp * 8 + c];
                int j0 = 0; float v0 = e8[0];
#pragma unroll
                for (int c = 1; c < 8; ++c) if (e8[c] > v0) { v0 = e8[c]; j0 = c; }
                int j1 = 0; float v1 = -3.0e38f;
#pragma unroll
                for (int c = 0; c < 8; ++c) if (c != j0 && e8[c] > v1) { v1 = e8[c]; j1 = c; }
                const float e1 = __expf(v1 - v0), sden = 1.0f / (1.0f + e1);
                const int ea = grp * 8 + j0, eb = grp * 8 + j1;
                eid[row * 2] = ea; eid[row * 2 + 1] = eb; wgt_out[row * 2] = pg * sden; wgt_out[row * 2 + 1] = pg * e1 * sden;
                LAS int* lcnt = (LAS int*)(F.lds + LDS_MISC + MI_LCNT);
                lrank[row * 2] = __hip_atomic_fetch_add(lcnt + ea, 1, __ATOMIC_RELAXED, __HIP_MEMORY_SCOPE_WORKGROUP);
                lrank[row * 2 + 1] = __hip_atomic_fetch_add(lcnt + eb, 1, __ATOMIC_RELAXED, __HIP_MEMORY_SCOPE_WORKGROUP);
            }
            __syncthreads();
            if (MODE == 2 && F.tid < NEXP) { LAS int* lcnt = (LAS int*)(F.lds + LDS_MISC + MI_LCNT); ((int*)cnt)[rb * NEXP + F.tid] = lcnt[F.tid]; lcnt[F.tid] = 0; }
            PRB_END(102);
        }
    }
}

DI void moe_plan(const Frame& F, const int* wgcnt, int rb) {
    LAS int* tile_e = (LAS int*)(F.lds + LDS_MISC + MI_TILEE); LAS int* ebase = (LAS int*)(F.lds + LDS_MISC + MI_EBASE); LAS int* ntp = (LAS int*)(F.lds + LDS_MISC + MI_NT);
    LAS int* part = (LAS int*)(F.lds + LDS_MISC + MI_PART); LAS int* wgoff = (LAS int*)(F.lds + LDS_MISC + MI_WGOFF); LAS int* tot = (LAS int*)(F.lds + LDS_MISC + MI_LCNT);
    { const int e = F.tid & 31, pt = F.tid >> 5; int sum = 0, pre = 0;
#pragma unroll
      for (int q = 0; q < 16; ++q) { const int r = pt * 16 + q; const int c = wgcnt[r * NEXP + e]; if (r < rb) pre += c; sum += c; }
      part[pt * 32 + e] = sum; if (rb >= 0 && pt == (rb >> 4)) wgoff[e] = pre; }
    __syncthreads();
    if (F.tid < NEXP) { int t = 0, o = 0;
#pragma unroll
        for (int pt = 0; pt < 16; ++pt) { const int c = part[pt * 32 + F.tid]; if (rb >= 0 && pt < (rb >> 4)) o += c; t += c; }
        tot[F.tid] = t; if (rb >= 0) wgoff[F.tid] += o; }
    __syncthreads();
    if (F.tid == 0) { int t = 0;
        for (int e = 0; e < NEXP; ++e) { const int c = tot[e]; const int nt = (c + MOE_TILE - 1) / MOE_TILE; ebase[e] = t * MOE_TILE;
            for (int i = 0; i < nt && t + i < MOE_MAXT; ++i) tile_e[t + i] = e; t += nt; }
        if (t > MOE_MAXT) t = MOE_MAXT; *ntp = t; }
    __syncthreads();
}
DI void phase_scatter(const Frame& F, const int* wgcnt, const int* eid, const int* lrank, int* slot, int* rowtok) {
    const LAS int* ebase = (const LAS int*)(F.lds + LDS_MISC + MI_EBASE); const LAS int* wgoff = (const LAS int*)(F.lds + LDS_MISC + MI_WGOFF);
    for (int rb = F.bx; rb < NTOK / 64; rb += F.G) {
        moe_plan(F, wgcnt, rb);
        if (F.tid < 128) { const int i = rb * 128 + F.tid; const int e = eid[i]; const int s = ebase[e] + wgoff[e] + lrank[i]; slot[i] = s; rowtok[s] = i >> 1; }
        __syncthreads();
    }
    if (F.tid < NEXP) ((LAS int*)(F.lds + LDS_MISC + MI_LCNT))[F.tid] = 0;
    __syncthreads();
}
constexpr int MOE_MAXU = 3;
DI void moe_rows_to_lds(const Frame& F, const int* rowtok, int nunits) {
    LAS int* rows = (LAS int*)(F.lds + LDS_MISC + MI_LOGIT); const LAS int* tile_e = (const LAS int*)(F.lds + LDS_MISC + MI_TILEE); (void)tile_e;
    for (int q = F.tid; q < MOE_MAXU * 256; q += NTHR) { const int i = q >> 8, r = q & 255; const long L = (long)i * F.G + F.vcu;
        rows[q] = L < nunits ? rowtok[((int)L >> 2) * 256 + r] : 0; }
    __syncthreads();
}
DI void phase_kmean(const Frame& F, const bf16_t* Kb, float* kmean) {
    LAS float* red = (LAS float*)F.lds;
    for (int it = F.bx; it < NB * MB_H * MB_NBLK; it += F.G) {
        const int n = it % MB_NBLK, hh = (it / MB_NBLK) % MB_H, b = it / (MB_NBLK * MB_H);
        const int kg = F.tid >> 4, d8 = (F.tid & 15) * 8; float s[8];
#pragma unroll
        for (int e = 0; e < 8; ++e) s[e] = 0.f;
        const bf16_t* p = Kb + ((size_t)b * SEQ + n * MB_BLK + kg * 8) * D + hh * MB_DH + d8;
#pragma unroll
        for (int j = 0; j < 8; ++j) { const u32x4 v = *(const u32x4*)(p + (size_t)j * D);
#pragma unroll
            for (int e = 0; e < 4; ++e) { s[2 * e] += __uint_as_float(v[e] << 16); s[2 * e + 1] += __uint_as_float(v[e] & 0xFFFF0000u); } }
#pragma unroll
        for (int e = 0; e < 8; ++e) red[kg * 128 + d8 + e] = s[e];
        __syncthreads();
        if (F.tid < 128) { float t = 0.f;
#pragma unroll
            for (int g = 0; g < 32; ++g) t += red[g * 128 + F.tid];
            kmean[(size_t)it * MB_DH + F.tid] = t * (1.0f / MB_BLK); }
        __syncthreads();
    }
}


template <int DV, bool IS_GLA>
DI void scan_naive_unit(LAS float* sb, int nthr_sub, int stid, int b, int hh, int nheads, const bf16_t* __restrict__ Q, const float* __restrict__ LF, const bf16_t* __restrict__ Kx, const bf16_t* __restrict__ V,
                        const float* __restrict__ glow, const float* __restrict__ gk2, const float* __restrict__ gkb, float* __restrict__ oraw, int ocol0) {
    constexpr int T = 16;
    LAS float* sq = sb; LAS float* sk = sb + T * 128; LAS float* sa = sb + 2 * T * 128;
    const int v = stid, qld = nheads * 128, vld = nheads * DV;
    float S[128];
#pragma unroll
    for (int d = 0; d < 128; ++d) S[d] = 0.f;
    for (int t0 = 0; t0 < SEQ; t0 += T) {
        __syncthreads();
        for (int i = stid; i < T * 128; i += nthr_sub) { const int tt = i >> 7, d = i & 127; const size_t tok = (size_t)b * SEQ + t0 + tt;
            sq[i] = bf2f(Q[tok * qld + hh * 128 + d]);
            if (IS_GLA) { float z = gkb[hh * 128 + d];
#pragma unroll
                for (int r = 0; r < GL_RANK; ++r) z += glow[tok * 16 + r] * gk2[r * GL_QK + hh * 128 + d];
                const float ls = fminf(z, 0.f) - log1pf(__expf(-fabsf(z)));
                sa[i] = __expf(ls * (1.0f / 16.0f)); sk[i] = bf2f(Kx[tok * qld + hh * 128 + d]); }
            else { const float al = __expf(LF[tok * qld + hh * 128 + d]); sa[i] = al; sk[i] = 1.0f - al; } }
        __syncthreads();
        for (int tt = 0; tt < T; ++tt) { const size_t tok = (size_t)b * SEQ + t0 + tt;
            const float vv = bf2f(V[tok * vld + hh * DV + v]); float o = 0.f;
#pragma unroll
            for (int d = 0; d < 128; ++d) { S[d] = sa[tt * 128 + d] * S[d] + sk[tt * 128 + d] * vv; o += sq[tt * 128 + d] * S[d]; }
            oraw[tok * D + ocol0 + hh * DV + v] = o; }
    }
}
DI void phase_scan_naive(const Frame& F, unsigned char* ws, const float* gk2, const float* gkb, float* oraw) {
    LAS float* base = (LAS float*)F.lds;
    if (F.bx < 8) { const int sub = F.tid >> 7, stid = F.tid & 127, unit = F.bx * 4 + sub;
        scan_naive_unit<128, false>(base + sub * 3 * 16 * 128, 128, stid, unit / HG_H, unit % HG_H, HG_H, (const bf16_t*)(ws + U_HQ), (const float*)(ws + U_HLF), nullptr, (const bf16_t*)(ws + U_HI), nullptr, nullptr, nullptr, oraw, 0); }
    else if (F.bx < 16) { const int sub = F.tid >> 8, stid = F.tid & 255, unit = (F.bx - 8) * 2 + sub;
        scan_naive_unit<256, true>(base + sub * 3 * 16 * 128, 256, stid, unit / GL_H, unit % GL_H, GL_H, (const bf16_t*)(ws + U_GQ), nullptr, (const bf16_t*)(ws + U_GK), (const bf16_t*)(ws + U_GV), (const float*)(ws + WS_GLOW), gk2, gkb, oraw, 1024); }
}
DI void phase_ngate(const Frame& F, const float* oraw, const float* hg_norm, const float* gla_norm, const bf16_t* hgg, const bf16_t* gg, bf16_t* mix) {
    const int lane = F.lane;
    f32x4 gn[8];
#pragma unroll
    for (int j = 0; j < 8; ++j) gn[j] = j < 4 ? *(const f32x4*)(hg_norm + ((j * 256 + lane * 4) & 127)) : *(const f32x4*)(gla_norm + lane * 4);
    for (int tok = F.bx * NWAVE + F.wave; tok < NTOK; tok += F.G * NWAVE) {
        const float* o = oraw + (size_t)tok * D; f32x4 v[8]; u32x2 gt[8];
#pragma unroll
        for (int j = 0; j < 8; ++j) { v[j] = *(const f32x4*)(o + j * 256 + lane * 4);
            gt[j] = j < 4 ? *(const u32x2*)(hgg + (size_t)tok * 1024 + j * 256 + lane * 4) : *(const u32x2*)(gg + (size_t)tok * 1024 + (j - 4) * 256 + lane * 4); }
#pragma unroll
        for (int j = 0; j < 8; ++j) { float ss = v[j][0] * v[j][0] + v[j][1] * v[j][1] + v[j][2] * v[j][2] + v[j][3] * v[j][3];
#pragma unroll
            for (int o2 = 1; o2 < 32; o2 <<= 1) ss += __shfl_xor(ss, o2);
            if (j >= 4) ss += __shfl_xor(ss, 32);
            const float rstd = rsqrtf(ss * (j < 4 ? 1.0f / 128.0f : 1.0f / 256.0f) + EPS);
            const float g0 = __uint_as_float(gt[j][0] << 16), g1 = __uint_as_float(gt[j][0] & 0xFFFF0000u), g2 = __uint_as_float(gt[j][1] << 16), g3 = __uint_as_float(gt[j][1] & 0xFFFF0000u);
            u32x2 p; p[0] = pk_bf16(v[j][0] * rstd * gn[j][0] * g0, v[j][1] * rstd * gn[j][1] * g1); p[1] = pk_bf16(v[j][2] * rstd * gn[j][2] * g2, v[j][3] * rstd * gn[j][3] * g3);
            *(u32x2*)(mix + (size_t)tok * D + j * 256 + lane * 4) = p; }
    }
}
DI void phase_moba_naive(const Frame& F, const bf16_t* __restrict__ Qb, const bf16_t* __restrict__ Kb, const bf16_t* __restrict__ Vb, const float* __restrict__ kmean, bf16_t* __restrict__ AO) {
    LAS float* sq = (LAS float*)F.lds + F.wave * 128;
    LAS float* sp = (LAS float*)F.lds + 8 * 128 + F.wave * 1024;
    LAS int* ssel = (LAS int*)((LAS float*)F.lds + 8 * 128 + 8 * 1024) + F.wave * 4;
    const int lane = F.lane;
    for (int qg = F.bx; qg < NB * MB_H * SEQ / NWAVE; qg += F.G) {
        const int qi = qg * NWAVE + F.wave; const int t = qi % SEQ, hh = (qi / SEQ) % MB_H, b = qi / (SEQ * MB_H);
        const size_t tok = (size_t)b * SEQ + t; const int qb = t / MB_BLK;
        __syncthreads();
        sq[lane] = bf2f(Qb[tok * D + hh * MB_DH + lane]); sq[lane + 64] = bf2f(Qb[tok * D + hh * MB_DH + lane + 64]);
        __syncthreads();
        float gate = -3.0e38f;
        if (lane < qb) { const float* km = kmean + ((size_t)(b * MB_H + hh) * MB_NBLK + lane) * MB_DH; float s = 0.f; for (int d = 0; d < 128; ++d) s += sq[d] * km[d]; gate = s; }
        const int nsel = qb < 3 ? qb : 3;
        for (int s = 0; s < 3; ++s) { float best = gate; int bi = lane;
            for (int o = 32; o > 0; o >>= 1) { const float ob = __shfl_xor(best, o); const int oi = __shfl_xor(bi, o); if (ob > best || (ob == best && oi < bi)) { best = ob; bi = oi; } }
            if (lane == 0) ssel[s] = bi; if (lane == bi) gate = -3.4e38f; }
        __syncthreads();
        const float scale = 0.08838834764831845f; float mx = -3.0e38f;
        for (int sgi = 0; sgi <= nsel; ++sgi) { const int blk = sgi < nsel ? ssel[sgi] : qb;
            for (int i = 0; i < 4; ++i) { const int j = lane + 64 * i, kp = blk * MB_BLK + j; float s = -__builtin_inff();
                if (sgi < nsel || kp <= t) { const bf16_t* kr = Kb + ((size_t)b * SEQ + kp) * D + hh * MB_DH; float acc = 0.f;
                    for (int d = 0; d < 128; d += 2) { const unsigned w = *(const unsigned*)(kr + d); acc += sq[d] * __uint_as_float(w << 16) + sq[d + 1] * __uint_as_float(w & 0xFFFF0000u); }
                    s = acc * scale; }
                sp[sgi * 256 + j] = s; mx = fmaxf(mx, s); } }
        for (int o = 32; o > 0; o >>= 1) mx = fmaxf(mx, __shfl_xor(mx, o));
        float den = 0.f;
        for (int sgi = 0; sgi <= nsel; ++sgi) for (int i = 0; i < 4; ++i) { const int idx = sgi * 256 + lane + 64 * i; const float p = __expf(sp[idx] - mx); sp[idx] = p; den += p; }
        den = wave_sum(den);
        __syncthreads();
        float o0 = 0.f, o1 = 0.f;
        for (int sgi = 0; sgi <= nsel; ++sgi) { const int blk = sgi < nsel ? ssel[sgi] : qb; const int jmax = sgi < nsel ? 256 : (t - qb * MB_BLK + 1);
            for (int j = 0; j < jmax; ++j) { const float p = sp[sgi * 256 + j]; const unsigned w = *(const unsigned*)(Vb + ((size_t)b * SEQ + blk * MB_BLK + j) * D + hh * MB_DH + lane * 2);
                o0 += p * __uint_as_float(w << 16); o1 += p * __uint_as_float(w & 0xFFFF0000u); } }
        const float inv = 1.0f / den;
        *(unsigned*)(AO + tok * D + hh * MB_DH + lane * 2) = (unsigned)f2bf(o0 * inv) | ((unsigned)f2bf(o1 * inv) << 16);
    }
}


DI moba::BlockRef<bf16_t, bf16_t> moba_ref(int L, int pass, const bf16_t* Q, const bf16_t* K, const bf16_t* V, bf16_t* O, const float* kmean) {
    const int bh = L >> 3, x = L & 7, qb = pass ? 15 - x : x, b = bh >> 4, h = bh & 15;
    moba::BlockRef<bf16_t, bf16_t> r; const size_t base = ((size_t)b * SEQ) * D + h * MB_DH;
    r.Q = Q + base + (size_t)qb * 256 * D; r.O = O + base + (size_t)qb * 256 * D; r.K = K + base; r.V = V + base; r.KM = kmean + (size_t)bh * MB_NBLK * MB_DH; r.P0 = qb * 256;
    return r;
}
DI void phase_attn(char* lds, int G, int c, const int wv, const bf16_t* Q, const bf16_t* K, const bf16_t* V, bf16_t* O, const float* kmean) {
    constexpr int TOTAL = 8 * NB * MB_H;
    int L = c; if (L >= TOTAL) return;
    int pass = 0;
    moba::BlockRef<bf16_t, bf16_t> cur = moba_ref(L, 0, Q, K, V, O, kmean);
    moba::Seam<bf16_t> S;
    moba::causal_swa_prime<bf16_t, bf16_t>(cur, SEQ, lds, S, wv);
    for (;;) {
        const bool more_pass = pass == 0, more_item = L + G < TOTAL, last = !more_pass && !more_item;
        int passn = pass + 1, Ln = L;
        if (!more_pass) { passn = 0; Ln = more_item ? L + G : L; }
        const moba::BlockRef<bf16_t, bf16_t> nxt = last ? cur : moba_ref(Ln, passn, Q, K, V, O, kmean);
        moba::causal_swa_block<bf16_t, bf16_t>(cur, nxt, SEQ, SEQ, lds, S, wv);
        if (last) break;
        cur = nxt; pass = passn; L = Ln;
    }
}

namespace scan {
typedef short s16x4 __attribute__((ext_vector_type(4)));
typedef short bf16x8 __attribute__((ext_vector_type(8)));
typedef float f32x16 __attribute__((ext_vector_type(16)));
typedef float f32x2 __attribute__((ext_vector_type(2)));
typedef __bf16 bf16x2_t __attribute__((ext_vector_type(2)));
constexpr int RS = 272;
constexpr int QS = 0, KD = 64 * RS, K10 = 2 * 64 * RS, QH = K10 + 32 * RS, KH = QH + 64 * RS, KH_ST = 320, VV = KH + 64 * KH_ST, PF = VV + 64 * 576, DEC = PF + 6144, LDS_END = DEC + 512;
constexpr int TOT = 131072 + 4096;
static_assert(LDS_END <= 131072 && TOT + 8192 <= 147456, "scan LDS");
DI unsigned cvt2(float lo, float hi) { const f32x2 v = {lo, hi}; return __builtin_bit_cast(unsigned, __builtin_convertvector(v, bf16x2_t)); }
DI int crow(int r, int h) { return (r & 3) + 8 * (r >> 2) + 4 * h; }
template <int S_> DI bf16x8 pack_step(const f32x16& x) {
    u32x4 p; p[0] = cvt2(x[8 * S_], x[8 * S_ + 1]); p[1] = cvt2(x[8 * S_ + 2], x[8 * S_ + 3]); p[2] = cvt2(x[8 * S_ + 4], x[8 * S_ + 5]); p[3] = cvt2(x[8 * S_ + 6], x[8 * S_ + 7]);
    return __builtin_bit_cast(bf16x8, p);
}
DI bf16x8 tr2(LAS unsigned char* p, int second_off) {
    const s16x4 lo = __builtin_amdgcn_ds_read_tr16_b64_v4i16((LAS s16x4*)p), hi = __builtin_amdgcn_ds_read_tr16_b64_v4i16((LAS s16x4*)(p + second_off));
    return __builtin_shufflevector(lo, hi, 0, 1, 2, 3, 4, 5, 6, 7);
}
DI float ex(float x) { return __builtin_amdgcn_exp2f(x * 1.4426950408889634f); }

template <int DV, bool IS_GLA>
DI void scan_unit(LAS unsigned char* L, int tid, int lane, int w, int b, int hh,
                  const bf16_t* __restrict__ Q, const float* __restrict__ G, const bf16_t* __restrict__ Kx, int qld, const bf16_t* __restrict__ V, int vcol0, float* __restrict__ oraw, int ocol0) {
    constexpr int VST = DV * 2 + 64, NVP = DV / 64, VPR = DV / 8;
    constexpr int NIH = DV == 256 ? 2 : 1;
    const int c = lane & 31, h = lane >> 5, g16 = (lane >> 4) & 1, q4 = (lane & 15) >> 2, p4 = lane & 3;
    const int vs = DV == 256 ? w : (w & 3), ih0 = DV == 256 ? 0 : (w >> 2);
    const int hq = hh * 128 + 2 * lane;
    const size_t tokb = (size_t)b * SEQ;
    f32x16 S[4];
#pragma unroll
    for (int t = 0; t < 4; ++t) S[t] = f32x16{};
    unsigned rq[8], rk[8]; f32x2 rg[8]; u32x4 rv[NVP];
#define SCAN_LOAD(ch_) do { const size_t t0_ = tokb + (size_t)(ch_) * 64;                                                                  \
        _Pragma("unroll") for (int e = 0; e < 8; ++e) { const size_t ro_ = (t0_ + 8 * w + e) * qld + hq;                                    \
            rq[e] = *(const unsigned*)(Q + ro_); rg[e] = *(const f32x2*)(G + ro_); if (IS_GLA) rk[e] = *(const unsigned*)(Kx + ro_); }      \
        _Pragma("unroll") for (int qq = 0; qq < NVP; ++qq) { const int p_ = tid + 512 * qq; const int row_ = p_ / VPR, c16_ = p_ % VPR;     \
            rv[qq] = *(const u32x4*)(V + (t0_ + row_) * 1024 + vcol0 + 8 * c16_); } } while (0)
#define SCAN_TOT(par_) do { f32x2 s_ = rg[0]; _Pragma("unroll") for (int e = 1; e < 8; ++e) s_ += rg[e];                                    \
        *(LAS f32x2*)(L + TOT + (par_) * 4096 + w * 512 + lane * 8) = s_; } while (0)
#define SCAN_PREP(par_) do {                                                                                                                \
        f32x2 Pw_ = {0.f, 0.f}, R1_ = {0.f, 0.f}, last_ = {0.f, 0.f};                                                                        \
        _Pragma("unroll") for (int w2 = 0; w2 < 8; ++w2) { const f32x2 t_ = *(const LAS f32x2*)(L + TOT + (par_) * 4096 + w2 * 512 + lane * 8); \
            if (w2 < w) Pw_ += t_; if (w2 < 4) R1_ += t_; last_ += t_; }                                                                     \
        const bool sub1_ = w >= 4; const f32x2 Rb_ = sub1_ ? R1_ : (f32x2){0.f, 0.f};                                                        \
        const f32x2 eR1_ = {ex(R1_[0]), ex(R1_[1])}; const f32x2 eLR_ = {ex(last_[0] - Rb_[0]), ex(last_[1] - Rb_[1])};                      \
        if (w == 0) *(LAS f32x2*)(L + DEC + lane * 8) = (f32x2){ex(last_[0]), ex(last_[1])};                                                 \
        f32x2 cum_ = Pw_;                                                                                                                    \
        _Pragma("unroll") for (int e = 0; e < 8; ++e) { cum_ += rg[e]; const int i_ = 8 * w + e;                                             \
            const float x0_ = fmaxf(cum_[0] - Rb_[0], -80.f), x1_ = fmaxf(cum_[1] - Rb_[1], -80.f);                                          \
            const float E0_ = ex(x0_), E1_ = ex(x1_), I0_ = ex(-x0_), I1_ = ex(-x1_);                                                        \
            const float q0_ = __uint_as_float(rq[e] << 16), q1_ = __uint_as_float(rq[e] & 0xFFFF0000u);                                      \
            float k0_, k1_; if (IS_GLA) { k0_ = __uint_as_float(rk[e] << 16); k1_ = __uint_as_float(rk[e] & 0xFFFF0000u); }                  \
            else { k0_ = 1.0f - ex(rg[e][0]); k1_ = 1.0f - ex(rg[e][1]); }                                                                   \
            const float qs0_ = q0_ * E0_, qs1_ = q1_ * E1_, kd0_ = k0_ * I0_, kd1_ = k1_ * I1_;                                              \
            const int asw_ = i_ * RS + 4 * lane;                                                                      \
            *(LAS unsigned*)(L + QS + asw_) = cvt2(qs0_, qs1_); *(LAS unsigned*)(L + KD + asw_) = cvt2(kd0_, kd1_);                          \
            if (sub1_) *(LAS unsigned*)(L + QH + asw_) = cvt2(qs0_ * eR1_[0], qs1_ * eR1_[1]);                                               \
            else { *(LAS unsigned*)(L + QH + asw_) = cvt2(qs0_, qs1_); *(LAS unsigned*)(L + K10 + asw_) = cvt2(kd0_ * eR1_[0], kd1_ * eR1_[1]); } \
            *(LAS unsigned*)(L + KH + i_ * KH_ST + 4 * lane) = cvt2(kd0_ * eLR_[0], kd1_ * eLR_[1]); }                                       \
        _Pragma("unroll") for (int qq = 0; qq < NVP; ++qq) { const int p_ = tid + 512 * qq; const int row_ = p_ / VPR, c16_ = p_ % VPR;     \
            *(LAS u32x4*)(L + VV + row_ * VST + c16_ * 16) = rv[qq]; } } while (0)

    SCAN_LOAD(0);
    __syncthreads();
    SCAN_TOT(0);
    __syncthreads();
    SCAN_PREP(0);
    SCAN_LOAD(1);
    for (int ch = 0; ch < SEQ / 64; ++ch) {
        const bool has_next = ch + 1 < SEQ / 64;
        __syncthreads();
        PRB_B(L, 120);
        if (w < 3) { const int t = w; const int rowj = (t == 2 ? 32 : 0) + c, rowi = (t == 0 ? 0 : 32) + c; const int kimg = t == 1 ? K10 : KD;
            f32x16 pt = f32x16{};
#pragma unroll
            for (int s = 0; s < 8; ++s) { const int colB = 32 * s + 16 * h;
                const bf16x8 ak = *(const LAS bf16x8*)(L + kimg + rowj * RS + colB), bq = *(const LAS bf16x8*)(L + QS + rowi * RS + colB);
                pt = __builtin_amdgcn_mfma_f32_32x32x16_bf16(ak, bq, pt, 0, 0, 0); }
            if (t != 1) {
#pragma unroll
                for (int r = 0; r < 16; ++r) pt[r] = (crow(r, h) > c) ? 0.f : pt[r]; }
            *(LAS bf16x8*)(L + PF + ((t * 2 + 0) * 64 + lane) * 16) = pack_step<0>(pt);
            *(LAS bf16x8*)(L + PF + ((t * 2 + 1) * 64 + lane) * 16) = pack_step<1>(pt); }
        f32x16 O[NIH];
#pragma unroll
        for (int x = 0; x < NIH; ++x) O[x] = f32x16{};
#pragma unroll
        for (int dt = 0; dt < 4; ++dt) {
            const bf16x8 bS0 = pack_step<0>(S[dt]), bS1 = pack_step<1>(S[dt]);
#pragma unroll
            for (int x = 0; x < NIH; ++x) { const int i = 32 * (ih0 + x) + c; LAS unsigned char* qrow = L + QH + i * RS;
                { const int cb = 64 * dt + 8 * h; const s16x4 lo = *(const LAS s16x4*)(qrow + cb), hi4 = *(const LAS s16x4*)(qrow + cb + 16);
                  O[x] = __builtin_amdgcn_mfma_f32_32x32x16_bf16(__builtin_shufflevector(lo, hi4, 0, 1, 2, 3, 4, 5, 6, 7), bS0, O[x], 0, 0, 0); }
                { const int cb = 64 * dt + 32 + 8 * h; const s16x4 lo = *(const LAS s16x4*)(qrow + cb), hi4 = *(const LAS s16x4*)(qrow + cb + 16);
                  O[x] = __builtin_amdgcn_mfma_f32_32x32x16_bf16(__builtin_shufflevector(lo, hi4, 0, 1, 2, 3, 4, 5, 6, 7), bS1, O[x], 0, 0, 0); } }
        }
#pragma unroll
        for (int dt = 0; dt < 4; ++dt)
#pragma unroll
            for (int g4 = 0; g4 < 4; ++g4) { const f32x4 dv = *(const LAS f32x4*)(L + DEC + (32 * dt + 8 * g4 + 4 * h) * 4);
#pragma unroll
                for (int jj = 0; jj < 4; ++jj) S[dt][4 * g4 + jj] *= dv[jj]; }
#pragma unroll
        for (int s = 0; s < 4; ++s) {
            const bf16x8 bV = tr2(L + VV + (16 * s + 8 * h + q4) * VST + (32 * vs + 16 * g16 + 4 * p4) * 2, 4 * VST);
#pragma unroll
            for (int dt = 0; dt < 4; ++dt) { const bf16x8 aK = tr2(L + KH + (16 * s + 8 * h + q4) * KH_ST + (32 * dt + 16 * g16 + 4 * p4) * 2, 4 * KH_ST);
                S[dt] = __builtin_amdgcn_mfma_f32_32x32x16_bf16(aK, bV, S[dt], 0, 0, 0); }
        }
        if (has_next) SCAN_TOT((ch + 1) & 1);
        PRB_E(L, 120); PRB_B(L, 123);
        __syncthreads();
        PRB_E(L, 123); PRB_B(L, 121);
#define SCAN_PV(x_, t_, jb_) do { _Pragma("unroll") for (int s2 = 0; s2 < 2; ++s2) {                                                        \
            const bf16x8 aP_ = *(const LAS bf16x8*)(L + PF + (((t_) * 2 + s2) * 64 + lane) * 16);                                            \
            const bf16x8 bV_ = tr2(L + VV + (32 * (jb_) + 16 * s2 + 4 * h + q4) * VST + (32 * vs + 16 * g16 + 4 * p4) * 2, 8 * VST);         \
            O[x_] = __builtin_amdgcn_mfma_f32_32x32x16_bf16(aP_, bV_, O[x_], 0, 0, 0); } } while (0)
        if (NIH == 2) { SCAN_PV(0, 0, 0); SCAN_PV(NIH - 1, 1, 0); SCAN_PV(NIH - 1, 2, 1); }
        else { if (ih0 == 0) { SCAN_PV(0, 0, 0); } else { SCAN_PV(0, 1, 0); SCAN_PV(0, 2, 1); } }
#undef SCAN_PV
        { float* op = oraw + (tokb + (size_t)ch * 64) * D + ocol0 + 32 * vs + c;
#pragma unroll
          for (int x = 0; x < NIH; ++x)
#pragma unroll
              for (int r = 0; r < 16; ++r) op[(size_t)(32 * (ih0 + x) + crow(r, h)) * D] = O[x][r]; }
        PRB_E(L, 121); PRB_B(L, 124);
        __syncthreads();
        PRB_E(L, 124); PRB_B(L, 122);
        if (has_next) { SCAN_PREP((ch + 1) & 1); if (ch + 2 < SEQ / 64) SCAN_LOAD(ch + 2); }
        PRB_E(L, 122);
    }
#undef SCAN_LOAD
#undef SCAN_TOT
#undef SCAN_PREP
}
}

constexpr int SCAN_UNITS = NB * HG_H + NB * GL_H * 2;
DI void phase_scan_fast(LAS unsigned char* L, int tid, int lane, int w, int G, int bx, unsigned char* ws, float* oraw) {
    for (int u = bx; u < SCAN_UNITS; u += G) {
        if (u < NB * HG_H) { const int hh = u % HG_H;
            scan::scan_unit<128, false>(L, tid, lane, w, u / HG_H, hh, (const bf16_t*)(ws + U_HQ), (const float*)(ws + U_HLF), nullptr, 1024, (const bf16_t*)(ws + U_HI), hh * 128, oraw, hh * 128); }
        else { const int v = u - NB * HG_H; const int b = v / (GL_H * 2), hh = (v % (GL_H * 2)) >> 1, half = v & 1;
            scan::scan_unit<128, true>(L, tid, lane, w, b, hh, (const bf16_t*)(ws + U_GQ), (const float*)(ws + WS_LA), (const bf16_t*)(ws + U_GK), 512, (const bf16_t*)(ws + U_GV), hh * 256 + half * 128, oraw, 1024 + hh * 256 + half * 128); }
        __syncthreads();
    }
}

enum { PH_PRO = 0, PH_GEMM1 = 1, PH_SCAN = 2, PH_NGATE = 3, PH_OUTP = 4, PH_NORM_F0 = 5, PH_SCAT0 = 6, PH_UP0 = 7, PH_DN0 = 8, PH_COMB0 = 9, PH_QKV = 10, PH_KMEAN = 11, PH_ATTN = 12,
       PH_OPROJ = 13, PH_NORM_F1 = 14, PH_SCAT1 = 15, PH_UP1 = 16, PH_DN1 = 17, PH_FINAL = 18, PH_END = 19 };

__global__ void __launch_bounds__(NTHR, 2) mk_fwd(Args a) {
#define AIN(k) (ka_launder()->in[k])
    extern __shared__ __attribute__((aligned(16))) unsigned char lds_raw[];
    Frame F; F.lds = (LAS unsigned char*)lds_raw; F.tid = threadIdx.x; F.lane = F.tid & 63; F.wave = __builtin_amdgcn_readfirstlane(F.tid >> 6);
    F.G = gridDim.x; F.bx = blockIdx.x; F.vcu = (F.G % 8 == 0) ? (F.bx % 8) * (F.G / 8) + F.bx / 8 : F.bx;
    F.ws = a.ws; F.ctl = (unsigned*)(a.ws + WS_CTL);
    unsigned char* ws = a.ws;
    if (F.tid < 4) ((LAS unsigned*)(F.lds + LDS_MISC + MI_BAR))[F.tid] = 0u;
    if (F.tid == 0) *(volatile LAS unsigned long long*)(F.lds + LDS_MISC + MI_PROBE) = 0ull;
    __syncthreads();
    const int lo = a.ph_lo, hi = a.ph_hi;
    XcdBarrier bar; bar.bar = F.ctl + CW2_BAR + a.bar_idx * XCD_BAR_WORDS; bar.x = 0; bar.w0 = 0; bar.st = (volatile LAS unsigned*)(F.lds + LDS_MISC + MI_BAR);
    if (hi - lo > 1) bar = xcd_barrier_post(F.ctl + CW2_BAR + a.bar_idx * XCD_BAR_WORDS, (volatile LAS unsigned*)(F.lds + LDS_MISC + MI_BAR));
#define IN(k) (lo <= (k) && (k) < hi)
    if (PROBE_ID >= 0) PRB_BEGIN(0);
#define SEAM(k) do { if (IN(k) && IN((k) + 1)) xcd_barrier(bar); if (PROBE_ID >= 0) { PRB_END(k); PRB_BEGIN((k) + 1); } } while (0)
#define P_x (AIN(0))
#define P_norm_mix (AIN(1))
#define P_norm_ffn (AIN(2))
#define P_norm_final (AIN(3))
#define P_WinT ((bf16_t*)(ws + WS_WIN))
#define P_WoutT ((bf16_t*)(ws + WS_WOUT))
#define P_WqkvT ((bf16_t*)(ws + WS_WQKV))
#define P_WoT ((bf16_t*)(ws + WS_WO))
#define P_Wup ((bf16_t*)(ws + WS_WUP))
#define P_Wdn ((bf16_t*)(ws + WS_WDN))
#define P_XN ((bf16_t*)(ws + WS_XN))
#define P_H ((bf16_t*)(ws + WS_H))
#define P_LB ((float*)(ws + SM_LB))
#define P_KMEAN ((float*)(ws + SM_KMEAN))
#define P_GLOW ((float*)(ws + WS_GLOW))
#define P_EID ((int*)(ws + WS_EID))
#define P_WGT ((float*)(ws + WS_WGT))
#define P_SLOT ((int*)(ws + WS_SLOT))
#define P_RWT ((float*)(ws + WS_RWT))
#define P_Qb ((bf16_t*)(ws + U_Q))
#define P_Kb ((bf16_t*)(ws + U_K))
#define P_Vb ((bf16_t*)(ws + U_V))
#define P_HMID ((bf16_t*)(ws + U_HMID))
#define P_Y ((bf16_t*)(ws + U_Y))
#define P_XS ((bf16_t*)(ws + U_XS))
    const LAS int* tile_e = (const LAS int*)(F.lds + LDS_MISC + MI_TILEE); const LAS int* ntp = (const LAS int*)(F.lds + LDS_MISC + MI_NT);

    if (IN(PH_PRO)) {
        phase_tables(F, *ka_launder());
        phase_norm<1, false, false>(F, P_x, nullptr, P_norm_mix, P_XN, nullptr, nullptr, nullptr, nullptr, AIN(4), P_GLOW, nullptr, nullptr, nullptr, nullptr, nullptr, nullptr, AIN(7), AIN(8), (float*)(ws + WS_LA));
        __syncthreads();
        phase_transposes(F, *ka_launder(), 0, 896, F.bx, F.G);
    }
    SEAM(PH_PRO);
    if (IN(PH_GEMM1)) {
        pg8::Gemm g{P_XN, P_WinT, NTOK, EVEN_MAIN, D}; pg8::StaticOrder S; S.init(NTOK, EVEN_MAIN, F.G, F.bx);
        EpiProj0F E{(bf16_t*)(ws + U_HQ), (float*)(ws + U_HLF), (bf16_t*)(ws + U_HI), (bf16_t*)(ws + U_HGG), (bf16_t*)(ws + U_GQ), (bf16_t*)(ws + U_GK), (bf16_t*)(ws + U_GV), (bf16_t*)(ws + U_GG), P_LB};
        pg8::gemm_phase<EpiProj0F, pg8::StaticOrder, true, true>(F.lds, g, S, E, F.wave);
    }
    SEAM(PH_GEMM1);
    if (IN(PH_SCAN)) { constexpr int NSU = SCAN_UNITS;
        if (F.G > 2 * NSU) { if (F.bx < NSU) { PRB_BEGIN(110); phase_scan_fast(F.lds, F.tid, F.lane, F.wave, NSU, F.bx, ws, (float*)(ws + WS_H)); PRB_END(110); } else { PRB_BEGIN(111); phase_transposes(F, *ka_launder(), 896, N_TJOBS, F.bx - NSU, F.G - NSU); PRB_END(111); } }
        else { phase_scan_fast(F.lds, F.tid, F.lane, F.wave, F.G, F.bx, ws, (float*)(ws + WS_H)); __syncthreads(); phase_transposes(F, *ka_launder(), 896, N_TJOBS, F.bx, F.G); } }
    SEAM(PH_SCAN);
    if (IN(PH_NGATE)) phase_ngate(F, (const float*)(ws + WS_H), AIN(6), AIN(9), (const bf16_t*)(ws + U_HGG), (const bf16_t*)(ws + U_GG), P_XN);
    SEAM(PH_NGATE);
    if (IN(PH_OUTP)) {
        pg8::Gemm g{P_XN, P_WoutT, NTOK, D, D}; pg8::StaticOrder S; S.init(NTOK, D, F.G, F.bx);
        EpiResidF<true> E{P_x, P_H};
        pg8::gemm_phase<EpiResidF<true>, pg8::StaticOrder, true, true>(F.lds, g, S, E, F.wave);
    }
    SEAM(PH_OUTP);
#define MOE_LAYER(l, PHN, PHS, PHU, PHD, CNT, CUR)                                                                                              \
    if (IN(PHN)) { for (int i = F.bx * NTHR + F.tid; i < MOE_ROWS; i += F.G * NTHR) ((int*)(ws + WS_ROWTOK))[i] = 0; }                              \
    if (IN(PHN)) phase_norm<2, false, true>(F, P_H, nullptr, P_norm_ffn + (l) * D, P_XN, nullptr, nullptr, nullptr, nullptr, nullptr, nullptr,              \
                                      P_RWT + (size_t)(l) * 2048 * 48, AIN(14) + (l) * NGRP, AIN(16) + (l) * NEXP, P_EID, P_WGT, (unsigned*)(ws + WS_WGCNT) + (l) * 256 * NEXP, nullptr, nullptr, nullptr, (int*)(ws + WS_LRANK));        \
    SEAM(PHN);                                                                                                                                  \
    if (IN(PHS)) phase_scatter(F, (const int*)(ws + WS_WGCNT) + (l) * 256 * NEXP, P_EID, (const int*)(ws + WS_LRANK), P_SLOT, (int*)(ws + WS_ROWTOK));                                                \
    SEAM(PHS);                                                                                                                                  \
    if (IN(PHU)) { moe_plan(F, (const int*)(ws + WS_WGCNT) + (l) * 256 * NEXP, -1);                                                                                                    \
        moe_rows_to_lds(F, (const int*)(ws + WS_ROWTOK), *ntp * 4);                                                                            \
        pg8::Gemm g{P_XN, P_Wup + (size_t)(l) * NEXP * 1024 * D, MOE_ROWS, NEXP * 1024, D, (const LAS int*)(F.lds + LDS_MISC + MI_LOGIT)};        \
        MoeOrder S{4, 2, *ntp * 4, F.G, F.vcu, tile_e};                                                                                          \
        EpiSwigluF E{P_HMID}; pg8::gemm_phase<EpiSwigluF, MoeOrder, true, true, true>(F.lds, g, S, E, F.wave); }                                                \
    SEAM(PHU);                                                                                                                                  \
    if (IN(PHD)) { moe_plan(F, (const int*)(ws + WS_WGCNT) + (l) * 256 * NEXP, -1);                                                                                                    \
        pg8::Gemm g{P_HMID, P_Wdn + (size_t)(l) * NEXP * D * DEXP, MOE_ROWS, NEXP * D, DEXP}; MoeOrder S{8, 3, *ntp * 8, F.G, F.vcu, tile_e};        \
        EpiBf16F E{P_Y, D, 8, 0, 0}; pg8::gemm_phase<EpiBf16F, MoeOrder, true, true>(F.lds, g, S, E, F.wave); }                                           \
    SEAM(PHD);
    MOE_LAYER(0, PH_NORM_F0, PH_SCAT0, PH_UP0, PH_DN0, CW2_CNT0, CW2_CUR0)
    if (IN(PH_COMB0)) phase_norm<0, true, true>(F, P_H, P_H, P_norm_mix + D, P_XN, nullptr, P_Y, P_SLOT, P_WGT, nullptr, nullptr, nullptr, nullptr, nullptr, nullptr, nullptr, nullptr);
    SEAM(PH_COMB0);
    if (IN(PH_QKV)) {
        pg8::Gemm g{P_XN, P_WqkvT, NTOK, 3 * D, D}; pg8::StaticOrder S; S.init(NTOK, 3 * D, F.G, F.bx);
        EpiBf16F E{P_Qb, D, 24, 8, (size_t)NTOK * D};
        pg8::gemm_phase<EpiBf16F, pg8::StaticOrder, true, true>(F.lds, g, S, E, F.wave);
    }
    SEAM(PH_QKV);
    if (IN(PH_KMEAN)) phase_kmean(F, P_Kb, P_KMEAN);
    SEAM(PH_KMEAN);
    if (IN(PH_ATTN)) phase_attn((char*)lds_raw, F.G, F.vcu, F.wave, P_Qb, P_Kb, P_Vb, P_XN, P_KMEAN);
    F.lane = mk_lane(); F.tid = F.wave * 64 + F.lane;
    SEAM(PH_ATTN);
    if (IN(PH_OPROJ)) {
        pg8::Gemm g{P_XN, P_WoT, NTOK, D, D}; pg8::StaticOrder S; S.init(NTOK, D, F.G, F.bx);
        EpiResidF<false> E{P_H, P_H};
        pg8::gemm_phase<EpiResidF<false>, pg8::StaticOrder, true, true>(F.lds, g, S, E, F.wave);
    }
    SEAM(PH_OPROJ);
    MOE_LAYER(1, PH_NORM_F1, PH_SCAT1, PH_UP1, PH_DN1, CW2_CNT1, CW2_CUR1)
    if (IN(PH_FINAL)) phase_norm<3, true, true>(F, P_H, nullptr, P_norm_final, nullptr, a.out, P_Y, P_SLOT, P_WGT, nullptr, nullptr, nullptr, nullptr, nullptr, nullptr, nullptr, nullptr);
    if (PROBE_ID >= 0) { PRB_END(PH_FINAL);
        if (F.bx == PROBE_BLOCK && F.tid == 0) { const unsigned long long acc_ = *(volatile LAS unsigned long long*)(F.lds + LDS_MISC + MI_PROBE), t0_ = __builtin_amdgcn_s_memrealtime();
            while (__builtin_amdgcn_s_memrealtime() - t0_ < (unsigned long long)PROBE_MULT * acc_) __builtin_amdgcn_s_sleep(8); } }
#undef AIN
#undef IN
#undef SEAM
#undef MOE_LAYER
#undef P_x
#undef P_norm_mix
#undef P_norm_ffn
#undef P_norm_final
#undef P_WinT
#undef P_WoutT
#undef P_WqkvT
#undef P_WoT
#undef P_Wup
#undef P_Wdn
#undef P_XN
#undef P_H
#undef P_LB
#undef P_KMEAN
#undef P_GLOW
#undef P_EID
#undef P_WGT
#undef P_SLOT
#undef P_RWT
#undef P_Qb
#undef P_Kb
#undef P_Vb
#undef P_HMID
#undef P_Y
#undef P_XS
}


extern "C" void kernel_launch(void* const* d_in, const int* in_sizes, int n_in, void* d_out, int out_size, void* d_ws, size_t ws_size, hipStream_t stream) {
    static int grid = 0;
    if (grid == 0) {
        if (n_in != 20 || out_size != NTOK * D || ws_size < WS_TOTAL3) { fprintf(stderr, "kernel_launch: unexpected shapes / workspace (%d inputs, out %d, ws %zu need %zu)\n", n_in, out_size, ws_size, (size_t)WS_TOTAL3); grid = -1; return; }
        int dev = 0, cus = 0;
        if (hipGetDevice(&dev) != hipSuccess || hipDeviceGetAttribute(&cus, hipDeviceAttributeMultiprocessorCount, dev) != hipSuccess || cus <= 0) { grid = -1; return; }
        if (hipFuncSetAttribute((const void*)mk_fwd, hipFuncAttributeMaxDynamicSharedMemorySize, LDS_BYTES) != hipSuccess) { fprintf(stderr, "kernel_launch: hipFuncSetAttribute failed\n"); grid = -1; return; }
        int per_cu = 0; (void)hipOccupancyMaxActiveBlocksPerMultiprocessor(&per_cu, (const void*)mk_fwd, NTHR, LDS_BYTES); (void)hipGetLastError();
        if (per_cu < 1) fprintf(stderr, "kernel_launch: occupancy query reports %d\n", per_cu);
        grid = cus;
    }
    if (grid < 0) return;
    const float* x = (const float*)d_in[0];
    const float* hg_norm = (const float*)d_in[6]; const float* gk2 = (const float*)d_in[7]; const float* gkb = (const float*)d_in[8]; const float* gla_norm = (const float*)d_in[9];
    unsigned char* ws = (unsigned char*)d_ws;
    bf16_t* XN = (bf16_t*)(ws + WS_XN); float* H = (float*)(ws + WS_H);
    float* KMEAN = (float*)(ws + SM_KMEAN); float* GLOW = (float*)(ws + WS_GLOW);
    bf16_t* HQ = (bf16_t*)(ws + U_HQ); float* HLF = (float*)(ws + U_HLF); bf16_t* HI = (bf16_t*)(ws + U_HI); bf16_t* HGG = (bf16_t*)(ws + U_HGG);
    bf16_t* GQ = (bf16_t*)(ws + U_GQ); bf16_t* GK = (bf16_t*)(ws + U_GK); bf16_t* GV = (bf16_t*)(ws + U_GV); bf16_t* GG = (bf16_t*)(ws + U_GG);
    bf16_t* Qb = (bf16_t*)(ws + U_Q); bf16_t* Kb = (bf16_t*)(ws + U_K); bf16_t* Vb = (bf16_t*)(ws + U_V);
    (void)x;
    (void)hipMemsetAsync(ws + WS_CTL, 0, CTL_BYTES, stream);
    Args a{};
    for (int i = 0; i < 20; ++i) a.in[i] = (const float*)d_in[i];
    a.out = (float*)d_out; a.ws = ws;
    auto run = [&](int lo, int hi, int bi) { a.ph_lo = lo; a.ph_hi = hi; a.bar_idx = bi; a.pad = 0; hipLaunchKernelGGL(mk_fwd, dim3(grid), dim3(NTHR), LDS_BYTES, stream, a); };
    run(PH_PRO, PH_END, 0);
}
```
